# Optimizing an MI355X kernel written in HIP

```python
import math
import jax, jax.numpy as jnp
from jax import lax
import numpy as np

D_MODEL = 1024
BATCH = 2
SEQ = 8192
DEPTH = 1

D_MIX = D_MODEL
D_POOL = D_MIX // 4
POOL_WINDOWS = (2, 4, 8, 16)
N_POOL_GROUPS = len(POOL_WINDOWS)
POOL_GROUP = D_POOL // N_POOL_GROUPS
D_RWKV = D_MIX - D_POOL
HEAD_SIZE = 64
N_RWKV_HEADS = D_RWKV // HEAD_SIZE
D_DECAY_LORA = 64
D_AAA_LORA = 64
D_GATE_LORA = 128
D_RWKV_IN = 3 * D_RWKV + D_DECAY_LORA + D_AAA_LORA + D_GATE_LORA
D_IN = D_POOL + D_RWKV_IN

N_GROUPS = 4
EXPERTS_PER_GROUP = 8
N_EXPERTS = N_GROUPS * EXPERTS_PER_GROUP
TOP_K = 2
D_EXPERT = D_MODEL // 4
ROW_BLOCK = 128

LN_EPS = 1e-5
LNX_EPS = 64e-5
DEEPNORM_ALPHA = (2.0 * DEPTH) ** 0.25
DEEPNORM_BETA = (8.0 * DEPTH) ** -0.25

kernel_name = "hybrid_pool_rwkv7_hiermoe_deepnorm"


def layer_norm(x, g, b):
    xf = x.astype(jnp.float32)
    mu = jnp.mean(xf, axis=-1, keepdims=True)
    var = jnp.mean(jnp.square(xf - mu), axis=-1, keepdims=True)
    return ((xf - mu) * lax.rsqrt(var + LN_EPS) * g.astype(jnp.float32) + b.astype(jnp.float32)).astype(x.dtype)


def multiscale_pool(p, pool_w, pool_scale):
    b, s, _ = p.shape
    pf = p.astype(jnp.float32)
    csum = jnp.cumsum(pf, axis=1)
    count = jnp.arange(1, s + 1, dtype=jnp.float32)[None, :, None]
    outs = []
    for gi, win in enumerate(POOL_WINDOWS):
        c = csum[..., gi * POOL_GROUP:(gi + 1) * POOL_GROUP]
        c_lag = jnp.pad(c, ((0, 0), (win, 0), (0, 0)))[:, :s]
        mean = (c - c_lag) / jnp.minimum(count, float(win))
        outs.append(mean - pf[..., gi * POOL_GROUP:(gi + 1) * POOL_GROUP])
    diff = jnp.stack(outs, axis=2)
    mixed = jnp.einsum('bsgc,gcd->bsgd', diff, pool_w.astype(jnp.float32)).reshape(b, s, D_POOL)
    return (mixed * pool_scale.astype(jnp.float32)).astype(p.dtype)


def rwkv7_step(state, inp):
    r, decay, k, v, kk, a = inp
    sa = jnp.einsum('bhij,bhj->bhi', state, -kk)
    state = (state * decay[:, :, None, :]
             + sa[..., None] * (kk * a)[:, :, None, :]
             + v[..., None] * k[:, :, None, :])
    out = jnp.einsum('bhij,bhj->bhi', state, r)
    return state, out


def rwkv7_mix(z, mu_shift, w0, w_up, a0, a_up, g_up, k_k, k_a, r_k, lnx_g, lnx_b):
    b, s, _ = z.shape
    f32 = jnp.float32
    zf = z.astype(f32)
    prev = jnp.pad(zf, ((0, 0), (1, 0), (0, 0)))[:, :s]
    zm = zf + (prev - zf) * mu_shift.astype(f32)
    o = 0
    r = zm[..., o:o + D_RWKV]; o += D_RWKV
    k = zm[..., o:o + D_RWKV]; o += D_RWKV
    v = zm[..., o:o + D_RWKV]; o += D_RWKV
    wd = zm[..., o:o + D_DECAY_LORA]; o += D_DECAY_LORA
    ad = zm[..., o:o + D_AAA_LORA]; o += D_AAA_LORA
    gd = zm[..., o:o + D_GATE_LORA]
    w_log = -jax.nn.softplus(-(w0.astype(f32) + jnp.tanh(wd) @ w_up.astype(f32))) - 0.5
    decay = jnp.exp(-jnp.exp(w_log))
    a = jax.nn.sigmoid(a0.astype(f32) + ad @ a_up.astype(f32))
    g = jax.nn.sigmoid(gd) @ g_up.astype(f32)
    kk = k * k_k.astype(f32)
    k = k * (1.0 + (a - 1.0) * k_a.astype(f32))
    hs = lambda t: t.reshape(b, s, N_RWKV_HEADS, HEAD_SIZE)
    r, k, v, kk, a, decay = hs(r), hs(k), hs(v), hs(kk), hs(a), hs(decay)
    kk = kk / jnp.maximum(jnp.sqrt(jnp.sum(kk * kk, axis=-1, keepdims=True)), 1e-12)
    tmaj = lambda t: jnp.moveaxis(t, 1, 0)
    state0 = jnp.zeros((b, N_RWKV_HEADS, HEAD_SIZE, HEAD_SIZE), f32)
    _, y = lax.scan(rwkv7_step, state0, (tmaj(r), tmaj(decay), tmaj(k), tmaj(v), tmaj(kk), tmaj(a)))
    y = jnp.moveaxis(y, 0, 1)
    mu = jnp.mean(y, axis=-1, keepdims=True)
    var = jnp.mean(jnp.square(y - mu), axis=-1, keepdims=True)
    y = ((y - mu) * lax.rsqrt(var + LNX_EPS)).reshape(b, s, D_RWKV) * lnx_g.astype(f32) + lnx_b.astype(f32)
    bonus = jnp.sum(r * k * r_k.astype(f32), axis=-1, keepdims=True) * v
    y = (y + bonus.reshape(b, s, D_RWKV)) * g
    return y.astype(z.dtype)


def hierarchical_moe(h, router_group, router_group_b, router_expert, router_expert_b,
                     exp_gate, exp_up, exp_down):
    n, d = h.shape
    hf = h.astype(jnp.float32)
    g_prob = jax.nn.softmax(hf @ router_group.astype(jnp.float32) + router_group_b.astype(jnp.float32), axis=-1)
    g_top_p, g_idx = lax.top_k(g_prob, 1)
    e_logits = (hf @ router_expert.astype(jnp.float32) + router_expert_b.astype(jnp.float32)
                ).reshape(n, N_GROUPS, EXPERTS_PER_GROUP)
    e_sel = jnp.take_along_axis(e_logits, g_idx[:, :, None], axis=1)[:, 0]
    e_top_logit, e_idx = lax.top_k(e_sel, TOP_K)
    weights = g_top_p * jax.nn.softmax(e_top_logit, axis=-1)
    expert_id = g_idx * EXPERTS_PER_GROUP + e_idx

    m = n * TOP_K
    flat_e = expert_id.reshape(m).astype(jnp.int32)
    flat_tok = jnp.repeat(jnp.arange(n, dtype=jnp.int32), TOP_K)
    flat_w = weights.reshape(m)
    order = jnp.argsort(flat_e)
    e_sorted, tok_sorted, w_sorted = flat_e[order], flat_tok[order], flat_w[order]
    counts = jnp.bincount(flat_e, length=N_EXPERTS)
    padded = (counts + ROW_BLOCK - 1) // ROW_BLOCK * ROW_BLOCK
    start = jnp.cumsum(counts) - counts
    pend = jnp.cumsum(padded)
    pstart = pend - padded
    dest = pstart[e_sorted] + (jnp.arange(m, dtype=jnp.int32) - start[e_sorted])
    m_pad = (m + ROW_BLOCK - 1) // ROW_BLOCK * ROW_BLOCK + N_EXPERTS * ROW_BLOCK
    n_blocks = m_pad // ROW_BLOCK
    row_tok = jnp.zeros((m_pad,), jnp.int32).at[dest].set(tok_sorted)
    row_w = jnp.zeros((m_pad,), h.dtype).at[dest].set(w_sorted.astype(h.dtype))
    block_start = jnp.arange(n_blocks, dtype=jnp.int32) * ROW_BLOCK
    block_expert = jnp.minimum(jnp.searchsorted(pend, block_start, side='right'), N_EXPERTS - 1)

    def expert_block(args):
        tok, wgt, e = args
        xb = h[tok]
        hid = jax.nn.silu(xb @ exp_gate[e]) * (xb @ exp_up[e])
        return (hid @ exp_down[e]) * wgt[:, None]

    ys = lax.map(expert_block, (row_tok.reshape(n_blocks, ROW_BLOCK),
                                row_w.reshape(n_blocks, ROW_BLOCK), block_expert))
    return jnp.zeros((n, d), h.dtype).at[row_tok].add(ys.reshape(m_pad, d))


def hybrid_layer(x, w_in, pool_w, pool_scale, mu_shift, w0, w_up, a0, a_up, g_up, k_k, k_a, r_k,
                 lnx_g, lnx_b, w_out, ln1_g, ln1_b, router_group, router_group_b, router_expert,
                 router_expert_b, exp_gate, exp_up, exp_down, ln2_g, ln2_b):
    b, s, d = x.shape
    proj = x @ w_in
    pool_out = multiscale_pool(proj[..., :D_POOL], pool_w, pool_scale)
    rwkv_out = rwkv7_mix(proj[..., D_POOL:], mu_shift, w0, w_up, a0, a_up, g_up,
                         k_k, k_a, r_k, lnx_g, lnx_b)
    mixed = jnp.concatenate([pool_out, rwkv_out], axis=-1) @ w_out
    h = layer_norm(DEEPNORM_ALPHA * x + mixed, ln1_g, ln1_b)
    ffn = hierarchical_moe(h.reshape(b * s, d), router_group, router_group_b, router_expert,
                           router_expert_b, exp_gate, exp_up, exp_down).reshape(b, s, d)
    return layer_norm(DEEPNORM_ALPHA * h + ffn, ln2_g, ln2_b)


def setup_inputs(seed: int = 0) -> dict:
    key = jax.random.key(seed)
    ks = jax.random.split(key, 28)
    nrm = lambda k, shape, scale: jax.random.normal(k, shape, jnp.float32) * scale
    L = DEPTH
    return {
        "x": nrm(ks[0], (BATCH, SEQ, D_MODEL), 1.0),
        "w_in": nrm(ks[1], (L, D_MODEL, D_IN), D_MODEL ** -0.5),
        "pool_w": nrm(ks[2], (L, N_POOL_GROUPS, POOL_GROUP, POOL_GROUP), POOL_GROUP ** -0.5),
        "pool_scale": 1.0 + nrm(ks[3], (L, D_POOL), 0.1),
        "mu_shift": jax.random.uniform(ks[4], (L, D_RWKV_IN), jnp.float32),
        "w0": jnp.linspace(-6.0, -1.0, D_RWKV, dtype=jnp.float32)[None, :] + nrm(ks[5], (L, D_RWKV), 0.1),
        "w_up": nrm(ks[6], (L, D_DECAY_LORA, D_RWKV), 0.1),
        "a0": nrm(ks[7], (L, D_RWKV), 0.1),
        "a_up": nrm(ks[8], (L, D_AAA_LORA, D_RWKV), 0.1),
        "g_up": nrm(ks[9], (L, D_GATE_LORA, D_RWKV), D_GATE_LORA ** -0.5),
        "k_k": 0.85 + nrm(ks[10], (L, D_RWKV), 0.05),
        "k_a": 1.0 + nrm(ks[11], (L, D_RWKV), 0.05),
        "r_k": nrm(ks[12], (L, N_RWKV_HEADS, HEAD_SIZE), 0.1),
        "lnx_g": 1.0 + nrm(ks[13], (L, D_RWKV), 0.1),
        "lnx_b": nrm(ks[14], (L, D_RWKV), 0.01),
        "w_out": nrm(ks[15], (L, D_MIX, D_MODEL), D_MIX ** -0.5 * DEEPNORM_BETA),
        "ln1_g": 1.0 + nrm(ks[16], (L, D_MODEL), 0.05),
        "ln1_b": nrm(ks[17], (L, D_MODEL), 0.01),
        "router_group": nrm(ks[18], (L, D_MODEL, N_GROUPS), D_MODEL ** -0.5),
        "router_group_b": nrm(ks[19], (L, N_GROUPS), 0.01),
        "router_expert": nrm(ks[20], (L, D_MODEL, N_EXPERTS), D_MODEL ** -0.5),
        "router_expert_b": nrm(ks[21], (L, N_EXPERTS), 0.01),
        "exp_gate": nrm(ks[22], (L, N_EXPERTS, D_MODEL, D_EXPERT), D_MODEL ** -0.5),
        "exp_up": nrm(ks[23], (L, N_EXPERTS, D_MODEL, D_EXPERT), D_MODEL ** -0.5),
        "exp_down": nrm(ks[24], (L, N_EXPERTS, D_EXPERT, D_MODEL), D_EXPERT ** -0.5 * DEEPNORM_BETA),
        "ln2_g": 1.0 + nrm(ks[25], (L, D_MODEL), 0.05),
        "ln2_b": nrm(ks[26], (L, D_MODEL), 0.01),
    }


def reference(x, w_in, pool_w, pool_scale, mu_shift, w0, w_up, a0, a_up, g_up, k_k, k_a, r_k,
              lnx_g, lnx_b, w_out, ln1_g, ln1_b, router_group, router_group_b, router_expert,
              router_expert_b, exp_gate, exp_up, exp_down, ln2_g, ln2_b):
    for l in range(DEPTH):
        x = hybrid_layer(x, w_in[l], pool_w[l], pool_scale[l], mu_shift[l], w0[l], w_up[l], a0[l],
                         a_up[l], g_up[l], k_k[l], k_a[l], r_k[l], lnx_g[l], lnx_b[l], w_out[l],
                         ln1_g[l], ln1_b[l], router_group[l], router_group_b[l], router_expert[l],
                         router_expert_b[l], exp_gate[l], exp_up[l], exp_down[l], ln2_g[l], ln2_b[l])
    return x
```

```cpp
#include <hip/hip_runtime.h>
#include <hip/hip_cooperative_groups.h>
#include <cstdio>
#include <cstdint>
namespace cg = cooperative_groups;

typedef unsigned short bf16;
typedef short bf16x8 __attribute__((ext_vector_type(8)));
typedef float f32x4 __attribute__((ext_vector_type(4)));
typedef unsigned u32x4 __attribute__((ext_vector_type(4)));
typedef unsigned u32x2 __attribute__((ext_vector_type(2)));

constexpr int DM = 1024, BATCH = 2, SEQ = 8192, NTOK = BATCH * SEQ;
constexpr int D_POOL = 256, D_RWKV = 768, NH = 12, HS = 64;
constexpr int D_IN = 2816;
constexpr int C_R = 256, C_K = 1024, C_V = 1792, C_WD = 2560, C_AD = 2624, C_GD = 2688;
constexpr int NEXP = 32, DE = 256;
constexpr float LN_EPS = 1e-5f, LNX_EPS = 64e-5f;
constexpr float ALPHA = 1.189207115002721f;
constexpr int NT = 512;
constexpr int LDS_BYTES = 147456;

constexpr size_t MiB = 1u << 20;
constexpr size_t WS_CTL = 0;
constexpr size_t WS_WIN_T = 1 * MiB;
constexpr size_t WS_WOUT_T = 7 * MiB;
constexpr size_t WS_XB = 10 * MiB;
constexpr size_t WS_MIXIN = 42 * MiB;
constexpr size_t WS_PROJ = 74 * MiB;
constexpr size_t WS_HID = 74 * MiB;
constexpr size_t WS_YS = 94 * MiB;
constexpr size_t WS_EGU = 162 * MiB;
constexpr size_t WS_EDN = 194 * MiB;
constexpr size_t WS_HB = 210 * MiB;
constexpr size_t WS_LIST = 242 * MiB;
constexpr size_t WS_LWT = 244 * MiB;

struct Params {
    const float* in[27];
    float* out;
    unsigned char* ws;
    int phase;
    int pad;
};

__device__ __forceinline__ unsigned f2bf(float f) { unsigned u = __builtin_bit_cast(unsigned, f); return (u + 0x7fffu + ((u >> 16) & 1u)) >> 16; }
__device__ __forceinline__ unsigned pk2(float lo, float hi) { return f2bf(lo) | (f2bf(hi) << 16); }
__device__ __forceinline__ float bf2f(unsigned short b) { return __builtin_bit_cast(float, (unsigned)b << 16); }
__device__ __forceinline__ float bflo(unsigned u) { return __builtin_bit_cast(float, u << 16); }
__device__ __forceinline__ float bfhi(unsigned u) { return __builtin_bit_cast(float, u & 0xffff0000u); }
__device__ __forceinline__ float wave_sum(float v) {
#pragma unroll
    for (int o = 1; o < 64; o <<= 1) v += __shfl_xor(v, o);
    return v;
}
__device__ __forceinline__ float sigmoidf_(float x) { return 1.f / (1.f + __expf(-x)); }

template <class Epi>
__device__ __forceinline__ void gemm_unit(unsigned char* lds, const bf16* const (&arow)[4], const bf16* const (&brow)[4], int K, Epi& epi) {
    const int tid = threadIdx.x, lane = tid & 63, w = tid >> 6, wr = w >> 2, wc = w & 3;
    const int srow = tid >> 3, sslot = tid & 7;
    const int st_off = srow * 128 + ((sslot ^ ((srow >> 1) & 7)) << 4);
    const int fr = lane & 15, fq = lane >> 4, x = fr >> 1;
    int offA[2], offB[2];
#pragma unroll
    for (int s = 0; s < 2; ++s) {
        const int slot = (s * 4 + fq) ^ x;
        offA[s] = (wr * 128 + fr) * 128 + (slot << 4);
        offB[s] = 32768 + (wc * 64 + fr) * 128 + (slot << 4);
    }
    f32x4 acc[8][4];
#pragma unroll
    for (int m = 0; m < 8; ++m)
#pragma unroll
        for (int n = 0; n < 4; ++n) acc[m][n] = (f32x4){0.f, 0.f, 0.f, 0.f};
    u32x4 ra[4], rb[4];
#pragma unroll
    for (int i = 0; i < 4; ++i) { ra[i] = *(const u32x4*)(arow[i]); rb[i] = *(const u32x4*)(brow[i]); }
    __syncthreads();
#pragma unroll
    for (int i = 0; i < 4; ++i) { *(u32x4*)(lds + st_off + i * 8192) = ra[i]; *(u32x4*)(lds + 32768 + st_off + i * 8192) = rb[i]; }
    __syncthreads();
    const int KT = K >> 6;
    for (int kt = 0; kt < KT; ++kt) {
        unsigned char* cur = lds + (kt & 1) * 65536;
        unsigned char* nxt = lds + ((kt + 1) & 1) * 65536;
        if (kt + 1 < KT) {
#pragma unroll
            for (int i = 0; i < 4; ++i) { ra[i] = *(const u32x4*)(arow[i] + (kt + 1) * 64); rb[i] = *(const u32x4*)(brow[i] + (kt + 1) * 64); }
        }
#pragma unroll
        for (int s = 0; s < 2; ++s) {
            bf16x8 bfr[4];
#pragma unroll
            for (int n = 0; n < 4; ++n) bfr[n] = *(const bf16x8*)(cur + offB[s] + n * 2048);
#pragma unroll
            for (int m = 0; m < 8; ++m) {
                const bf16x8 afr = *(const bf16x8*)(cur + offA[s] + m * 2048);
#pragma unroll
                for (int n = 0; n < 4; ++n) acc[m][n] = __builtin_amdgcn_mfma_f32_16x16x32_bf16(bfr[n], afr, acc[m][n], 0, 0, 0);
            }
        }
        if (kt + 1 < KT) {
#pragma unroll
            for (int i = 0; i < 4; ++i) { *(u32x4*)(nxt + st_off + i * 8192) = ra[i]; *(u32x4*)(nxt + 32768 + st_off + i * 8192) = rb[i]; }
        }
        __syncthreads();
    }
    epi(acc, wr, wc, fr, fq);
}

__device__ __forceinline__ int gu_row(int c, int half) { return ((c >> 7) << 8) + (((c >> 5) & 3) << 6) + (half << 5) + (c & 31); }
__device__ __forceinline__ void tr_tile(unsigned char* lds, const float* __restrict__ src, int ldsrc, int k0, int n0, bf16* __restrict__ dst, int ldd, int mode) {
    float* t = (float*)lds;
    const int tid = threadIdx.x;
    __syncthreads();
#pragma unroll
    for (int i = 0; i < 8; ++i) { const int e = tid + i * NT, k = e >> 6, n = e & 63; t[k * 65 + n] = src[(size_t)(k0 + k) * ldsrc + n0 + n]; }
    __syncthreads();
    const int n = tid >> 3, kc = tid & 7;
    const float* s = t + (kc * 8) * 65 + n;
    u32x4 o; o.x = pk2(s[0], s[65]); o.y = pk2(s[2 * 65], s[3 * 65]); o.z = pk2(s[4 * 65], s[5 * 65]); o.w = pk2(s[6 * 65], s[7 * 65]);
    const int nn = n0 + n;
    const int drow = mode == 0 ? nn : gu_row(nn, mode - 1);
    *(u32x4*)(dst + (size_t)drow * ldd + k0 + kc * 8) = o;
}

__device__ __forceinline__ void phase_convert(const Params& p, unsigned char* lds, int bid, int nb) {
    const int tid = threadIdx.x;
    {
        const float* x = p.in[0]; bf16* xb = (bf16*)(p.ws + WS_XB);
        const size_t n8 = (size_t)NTOK * DM / 8;
        for (size_t i = (size_t)bid * NT + tid; i < n8; i += (size_t)nb * NT) {
            const f32x4 a = *(const f32x4*)(x + i * 8), b = *(const f32x4*)(x + i * 8 + 4);
            u32x4 o; o.x = pk2(a.x, a.y); o.y = pk2(a.z, a.w); o.z = pk2(b.x, b.y); o.w = pk2(b.z, b.w);
            *(u32x4*)(xb + i * 8) = o;
        }
    }
    constexpr int T_WIN = (DM / 64) * (D_IN / 64);
    constexpr int T_WOUT = (DM / 64) * (DM / 64);
    constexpr int T_EG = NEXP * (DM / 64) * (DE / 64);
    constexpr int T_ED = NEXP * (DE / 64) * (DM / 64);
    constexpr int T_ALL = T_WIN + T_WOUT + 2 * T_EG + T_ED;
    for (int it = bid; it < T_ALL; it += nb) {
        int r = it;
        if (r < T_WIN) { const int kb = r / (D_IN / 64), nbk = r % (D_IN / 64); tr_tile(lds, p.in[1], D_IN, kb * 64, nbk * 64, (bf16*)(p.ws + WS_WIN_T), DM, 0); continue; }
        r -= T_WIN;
        if (r < T_WOUT) { const int kb = r / (DM / 64), nbk = r % (DM / 64); tr_tile(lds, p.in[15], DM, kb * 64, nbk * 64, (bf16*)(p.ws + WS_WOUT_T), DM, 0); continue; }
        r -= T_WOUT;
        if (r < 2 * T_EG) {
            const int half = r / T_EG; r -= half * T_EG;
            const int e = r / 64, q = r % 64, kb = q / 4, nbk = q % 4;
            tr_tile(lds, p.in[22 + half] + (size_t)e * DM * DE, DE, kb * 64, nbk * 64, (bf16*)(p.ws + WS_EGU) + (size_t)e * 512 * DM, DM, 1 + half); continue;
        }
        r -= 2 * T_EG;
        { const int e = r / 64, q = r % 64, kb = q / 16, nbk = q % 16;
          tr_tile(lds, p.in[24] + (size_t)e * DE * DM, DM, kb * 64, nbk * 64, (bf16*)(p.ws + WS_EDN) + (size_t)e * DM * DE, DE, 0); }
    }
}

struct EpiProj {
    bf16* O; int row0, col0;
    __device__ __forceinline__ void operator()(const f32x4 (&acc)[8][4], int wr, int wc, int fr, int fq) const {
#pragma unroll
        for (int m = 0; m < 8; ++m) {
            bf16* rp = O + (size_t)(row0 + wr * 128 + m * 16 + fr) * D_IN + col0 + wc * 64 + fq * 4;
#pragma unroll
            for (int n = 0; n < 4; ++n) { u32x2 v; v.x = pk2(acc[m][n][0], acc[m][n][1]); v.y = pk2(acc[m][n][2], acc[m][n][3]); *(u32x2*)(rp + n * 16) = v; }
        }
    }
};
__device__ __forceinline__ void phase_proj(const Params& p, unsigned char* lds, int bid, int nb) {
    const int tid = threadIdx.x;
    const bf16* xb = (const bf16*)(p.ws + WS_XB); const bf16* wt = (const bf16*)(p.ws + WS_WIN_T);
    constexpr int NU = 64 * 11;
    for (int u = bid; u < NU; u += nb) {
        const int pm = u & 63, pn = u >> 6;
        const bf16* arow[4]; const bf16* brow[4];
#pragma unroll
        for (int i = 0; i < 4; ++i) { const int pp = tid + NT * i, r = pp >> 3, s = pp & 7;
            arow[i] = xb + (size_t)(pm * 256 + r) * DM + s * 8; brow[i] = wt + (size_t)(pn * 256 + r) * DM + s * 8; }
        EpiProj e{(bf16*)(p.ws + WS_PROJ), pm * 256, pn * 256};
        gemm_unit(lds, arow, brow, DM, e);
    }
}

__device__ __forceinline__ void phase_pool(const Params& p, unsigned char* lds, int bid, int nb) {
    const int tid = threadIdx.x;
    const bf16* proj = (const bf16*)(p.ws + WS_PROJ);
    bf16* mix = (bf16*)(p.ws + WS_MIXIN);
    const float* pw = p.in[2]; const float* ps = p.in[3];
    float* pbuf = (float*)lds;
    float* diff = (float*)(lds + 81920);
    for (int it = bid; it < NTOK / 64; it += nb) {
        const int tok0 = it * 64, t0 = tok0 % SEQ;
        __syncthreads();
        for (int e = tid; e < 79 * 64; e += NT) {
            const int r = e >> 6, c4 = e & 63; const int tt = t0 - 15 + r;
            float4 v = {0.f, 0.f, 0.f, 0.f};
            if (tt >= 0) { const u32x2 q = *(const u32x2*)(proj + (size_t)(tok0 - 15 + r) * D_IN + c4 * 4); v.x = bflo(q.x); v.y = bfhi(q.x); v.z = bflo(q.y); v.w = bfhi(q.y); }
            *(float4*)(pbuf + r * 256 + c4 * 4) = v;
        }
        __syncthreads();
        for (int e = tid; e < 64 * 256; e += NT) {
            const int t = e >> 8, c = e & 255, g = c >> 6, win = 2 << g;
            const int cnt = min(t0 + t + 1, win);
            float s = 0.f;
            for (int j = 0; j < cnt; ++j) s += pbuf[(t + 15 - j) * 256 + c];
            diff[t * 256 + c] = s / (float)cnt - pbuf[(t + 15) * 256 + c];
        }
        __syncthreads();
        {
            const int t = tid >> 3, dq = tid & 7;
#pragma unroll 1
            for (int g = 0; g < 4; ++g) {
                float o[8];
#pragma unroll
                for (int j = 0; j < 8; ++j) o[j] = 0.f;
                const float* wg = pw + (size_t)g * 4096 + dq * 8;
                for (int c = 0; c < 64; ++c) {
                    const float dv = diff[t * 256 + g * 64 + c];
                    const f32x4 w0 = *(const f32x4*)(wg + c * 64), w1 = *(const f32x4*)(wg + c * 64 + 4);
                    o[0] += dv * w0.x; o[1] += dv * w0.y; o[2] += dv * w0.z; o[3] += dv * w0.w;
                    o[4] += dv * w1.x; o[5] += dv * w1.y; o[6] += dv * w1.z; o[7] += dv * w1.w;
                }
                const float* sc = ps + g * 64 + dq * 8;
                u32x4 v; v.x = pk2(o[0] * sc[0], o[1] * sc[1]); v.y = pk2(o[2] * sc[2], o[3] * sc[3]); v.z = pk2(o[4] * sc[4], o[5] * sc[5]); v.w = pk2(o[6] * sc[6], o[7] * sc[7]);
                *(u32x4*)(mix + (size_t)(tok0 + t) * DM + g * 64 + dq * 8) = v;
            }
        }
    }
}

__device__ __forceinline__ void phase_rwkv_seq(const Params& p, unsigned char* lds, int bid, int nb) {
    const int tid = threadIdx.x;
    const bf16* proj = (const bf16*)(p.ws + WS_PROJ);
    bf16* mix = (bf16*)(p.ws + WS_MIXIN);
    const float* mu = p.in[4]; const float* w0 = p.in[5]; const float* w_up = p.in[6]; const float* a0 = p.in[7]; const float* a_up = p.in[8];
    const float* g_up = p.in[9]; const float* k_k = p.in[10]; const float* k_a = p.in[11]; const float* r_k = p.in[12];
    const float* lnx_g = p.in[13]; const float* lnx_b = p.in[14];
    float* R = (float*)lds;
    float* Kp = R + 4096;
    float* V = Kp + 4096;
    float* G = V + 4096;
    float* LIN = G + 4096;
    float* W = LIN;
    float* KK = W + 4096;
    float* Bb = KK + 4096;
    float* OUT = Bb + 4096;
    float* BON = LIN + 16384;
    for (int it = bid; it < BATCH * NH; it += nb) {
        const int b = it / NH, h = it % NH;
        float S[8];
#pragma unroll
        for (int j = 0; j < 8; ++j) S[j] = 0.f;
        const int si = tid >> 3, sj = (tid & 7) * 8;
        for (int c = 0; c < SEQ / 64; ++c) {
            const int tok0 = b * SEQ + c * 64;
            __syncthreads();
            for (int e = tid; e < 64 * 64; e += NT) {
                const int t = e >> 6, ch = e & 63;
                const bf16* cur = proj + (size_t)(tok0 + t) * D_IN; const bf16* prv = cur - D_IN;
                const bool hp = (c * 64 + t) > 0;
#pragma unroll
                for (int q = 0; q < 3; ++q) {
                    const int col = C_R + q * D_RWKV + h * 64 + ch;
                    const float zc = bf2f(cur[col]), zp = hp ? bf2f(prv[col]) : 0.f;
                    const float zm = zc + (zp - zc) * mu[col - D_POOL];
                    (q == 0 ? R : (q == 1 ? Kp : V))[t * 64 + ch] = zm;
                }
            }
            for (int e = tid; e < 64 * 256; e += NT) {
                const int t = e >> 8, k = e & 255;
                const bf16* cur = proj + (size_t)(tok0 + t) * D_IN; const bf16* prv = cur - D_IN;
                const bool hp = (c * 64 + t) > 0;
                const int col = C_WD + k;
                const float zc = bf2f(cur[col]), zp = hp ? bf2f(prv[col]) : 0.f;
                const float zm = zc + (zp - zc) * mu[col - D_POOL];
                LIN[t * 256 + k] = k < 64 ? tanhf(zm) : (k < 128 ? zm : sigmoidf_(zm));
            }
            __syncthreads();
            {
                const int t = tid >> 3, c8 = (tid & 7) * 8, hc = h * 64 + c8;
                float wl[8], al[8], gl[8];
#pragma unroll
                for (int j = 0; j < 8; ++j) { wl[j] = 0.f; al[j] = 0.f; gl[j] = 0.f; }
                for (int k = 0; k < 64; ++k) {
                    const float xw = LIN[t * 256 + k], xa = LIN[t * 256 + 64 + k];
                    const f32x4 u0 = *(const f32x4*)(w_up + k * D_RWKV + hc), u1 = *(const f32x4*)(w_up + k * D_RWKV + hc + 4);
                    const f32x4 v0 = *(const f32x4*)(a_up + k * D_RWKV + hc), v1 = *(const f32x4*)(a_up + k * D_RWKV + hc + 4);
                    wl[0] += xw * u0.x; wl[1] += xw * u0.y; wl[2] += xw * u0.z; wl[3] += xw * u0.w; wl[4] += xw * u1.x; wl[5] += xw * u1.y; wl[6] += xw * u1.z; wl[7] += xw * u1.w;
                    al[0] += xa * v0.x; al[1] += xa * v0.y; al[2] += xa * v0.z; al[3] += xa * v0.w; al[4] += xa * v1.x; al[5] += xa * v1.y; al[6] += xa * v1.z; al[7] += xa * v1.w;
                }
                for (int k = 0; k < 128; ++k) {
                    const float xg = LIN[t * 256 + 128 + k];
                    const f32x4 u0 = *(const f32x4*)(g_up + k * D_RWKV + hc), u1 = *(const f32x4*)(g_up + k * D_RWKV + hc + 4);
                    gl[0] += xg * u0.x; gl[1] += xg * u0.y; gl[2] += xg * u0.z; gl[3] += xg * u0.w; gl[4] += xg * u1.x; gl[5] += xg * u1.y; gl[6] += xg * u1.z; gl[7] += xg * u1.w;
                }
                float kkr[8], av[8], wv[8], nsq = 0.f, bon = 0.f;
#pragma unroll
                for (int j = 0; j < 8; ++j) {
                    const int ch = hc + j;
                    const float xx = w0[ch] + wl[j];
                    const float sp = (-xx > 20.f) ? -xx : log1pf(__expf(-xx));
                    const float wlog = -sp - 0.5f;
                    wv[j] = __expf(-__expf(wlog));
                    av[j] = sigmoidf_(a0[ch] + al[j]);
                    const float km = Kp[t * 64 + c8 + j];
                    kkr[j] = km * k_k[ch]; nsq += kkr[j] * kkr[j];
                    const float kn = km * (1.f + (av[j] - 1.f) * k_a[ch]);
                    Kp[t * 64 + c8 + j] = kn;
                    bon += R[t * 64 + c8 + j] * kn * r_k[ch];
                    G[t * 64 + c8 + j] = gl[j];
                }
                nsq += __shfl_xor(nsq, 1); nsq += __shfl_xor(nsq, 2); nsq += __shfl_xor(nsq, 4);
                bon += __shfl_xor(bon, 1); bon += __shfl_xor(bon, 2); bon += __shfl_xor(bon, 4);
                const float inv = 1.f / fmaxf(sqrtf(nsq), 1e-12f);
                __syncthreads();
#pragma unroll
                for (int j = 0; j < 8; ++j) { const float kn = kkr[j] * inv; KK[t * 64 + c8 + j] = kn; Bb[t * 64 + c8 + j] = kn * av[j]; W[t * 64 + c8 + j] = wv[j]; }
                if ((tid & 7) == 0) BON[t] = bon;
            }
            __syncthreads();
            for (int t = 0; t < 64; ++t) {
                const f32x4 k0 = *(const f32x4*)(KK + t * 64 + sj), k1 = *(const f32x4*)(KK + t * 64 + sj + 4);
                float sa = S[0] * k0.x + S[1] * k0.y + S[2] * k0.z + S[3] * k0.w + S[4] * k1.x + S[5] * k1.y + S[6] * k1.z + S[7] * k1.w;
                sa += __shfl_xor(sa, 1); sa += __shfl_xor(sa, 2); sa += __shfl_xor(sa, 4);
                sa = -sa;
                const f32x4 w0v = *(const f32x4*)(W + t * 64 + sj), w1v = *(const f32x4*)(W + t * 64 + sj + 4);
                const f32x4 b0 = *(const f32x4*)(Bb + t * 64 + sj), b1 = *(const f32x4*)(Bb + t * 64 + sj + 4);
                const f32x4 q0 = *(const f32x4*)(Kp + t * 64 + sj), q1 = *(const f32x4*)(Kp + t * 64 + sj + 4);
                const f32x4 r0 = *(const f32x4*)(R + t * 64 + sj), r1 = *(const f32x4*)(R + t * 64 + sj + 4);
                const float vi = V[t * 64 + si];
                S[0] = S[0] * w0v.x + sa * b0.x + vi * q0.x; S[1] = S[1] * w0v.y + sa * b0.y + vi * q0.y; S[2] = S[2] * w0v.z + sa * b0.z + vi * q0.z; S[3] = S[3] * w0v.w + sa * b0.w + vi * q0.w;
                S[4] = S[4] * w1v.x + sa * b1.x + vi * q1.x; S[5] = S[5] * w1v.y + sa * b1.y + vi * q1.y; S[6] = S[6] * w1v.z + sa * b1.z + vi * q1.z; S[7] = S[7] * w1v.w + sa * b1.w + vi * q1.w;
                float o = S[0] * r0.x + S[1] * r0.y + S[2] * r0.z + S[3] * r0.w + S[4] * r1.x + S[5] * r1.y + S[6] * r1.z + S[7] * r1.w;
                o += __shfl_xor(o, 1); o += __shfl_xor(o, 2); o += __shfl_xor(o, 4);
                if ((tid & 7) == 0) OUT[t * 64 + si] = o;
            }
            __syncthreads();
            {
                const int t = tid >> 3, c8 = (tid & 7) * 8, hc = h * 64 + c8;
                float y[8], s = 0.f;
#pragma unroll
                for (int j = 0; j < 8; ++j) { y[j] = OUT[t * 64 + c8 + j]; s += y[j]; }
                s += __shfl_xor(s, 1); s += __shfl_xor(s, 2); s += __shfl_xor(s, 4);
                const float mean = s * (1.f / 64.f);
                float s2 = 0.f;
#pragma unroll
                for (int j = 0; j < 8; ++j) { y[j] -= mean; s2 += y[j] * y[j]; }
                s2 += __shfl_xor(s2, 1); s2 += __shfl_xor(s2, 2); s2 += __shfl_xor(s2, 4);
                const float rstd = rsqrtf(s2 * (1.f / 64.f) + LNX_EPS);
                const float bon = BON[t];
                float o[8];
#pragma unroll
                for (int j = 0; j < 8; ++j) o[j] = (y[j] * rstd * lnx_g[hc + j] + lnx_b[hc + j] + bon * V[t * 64 + c8 + j]) * G[t * 64 + c8 + j];
                u32x4 v; v.x = pk2(o[0], o[1]); v.y = pk2(o[2], o[3]); v.z = pk2(o[4], o[5]); v.w = pk2(o[6], o[7]);
                *(u32x4*)(mix + (size_t)(tok0 + t) * DM + D_POOL + hc) = v;
            }
        }
    }
}

struct EpiOut {
    const float* X; float* O; int row0, col0;
    __device__ __forceinline__ void operator()(const f32x4 (&acc)[8][4], int wr, int wc, int fr, int fq) const {
#pragma unroll
        for (int m = 0; m < 8; ++m) {
            const size_t off = (size_t)(row0 + wr * 128 + m * 16 + fr) * DM + col0 + wc * 64 + fq * 4;
#pragma unroll
            for (int n = 0; n < 4; ++n) { const f32x4 xv = *(const f32x4*)(X + off + n * 16); *(f32x4*)(O + off + n * 16) = xv * ALPHA + acc[m][n]; }
        }
    }
};
__device__ __forceinline__ void phase_outproj(const Params& p, unsigned char* lds, int bid, int nb) {
    const int tid = threadIdx.x;
    const bf16* a = (const bf16*)(p.ws + WS_MIXIN); const bf16* wt = (const bf16*)(p.ws + WS_WOUT_T);
    for (int u = bid; u < 256; u += nb) {
        const int pm = u & 63, pn = u >> 6;
        const bf16* arow[4]; const bf16* brow[4];
#pragma unroll
        for (int i = 0; i < 4; ++i) { const int pp = tid + NT * i, r = pp >> 3, s = pp & 7;
            arow[i] = a + (size_t)(pm * 256 + r) * DM + s * 8; brow[i] = wt + (size_t)(pn * 256 + r) * DM + s * 8; }
        EpiOut e{p.in[0], p.out, pm * 256, pn * 256};
        gemm_unit(lds, arow, brow, DM, e);
    }
}

__device__ __forceinline__ void phase_ln_router(const Params& p, unsigned char* lds, int bid, int nb) {
    const int tid = threadIdx.x, lane = tid & 63, w = tid >> 6;
    float* RT = (float*)lds;
    const float* rg = p.in[18]; const float* re = p.in[20];
    __syncthreads();
    for (int e = tid; e < 36 * 1024; e += NT) { const int j = e >> 10, k = e & 1023; RT[e] = j < 4 ? rg[k * 4 + j] : re[k * 32 + (j - 4)]; }
    __syncthreads();
    const float* g1 = p.in[16]; const float* b1 = p.in[17]; const float* rgb = p.in[19]; const float* reb = p.in[21];
    float* H = p.out; bf16* hb = (bf16*)(p.ws + WS_HB);
    unsigned* cnt = (unsigned*)(p.ws + WS_CTL);
    int* list = (int*)(p.ws + WS_LIST); float* lwt = (float*)(p.ws + WS_LWT);
    for (int row = bid * 8 + w; row < NTOK; row += nb * 8) {
        float* hr = H + (size_t)row * DM;
        f32x4 v[4]; float s = 0.f;
#pragma unroll
        for (int j = 0; j < 4; ++j) { v[j] = *(const f32x4*)(hr + j * 256 + lane * 4); s += (v[j].x + v[j].y) + (v[j].z + v[j].w); }
        const float mean = wave_sum(s) * (1.f / DM);
        float s2 = 0.f;
#pragma unroll
        for (int j = 0; j < 4; ++j) { v[j] = v[j] - mean; s2 += (v[j].x * v[j].x + v[j].y * v[j].y) + (v[j].z * v[j].z + v[j].w * v[j].w); }
        const float rstd = rsqrtf(wave_sum(s2) * (1.f / DM) + LN_EPS);
#pragma unroll
        for (int j = 0; j < 4; ++j) {
            const f32x4 g = *(const f32x4*)(g1 + j * 256 + lane * 4), bb = *(const f32x4*)(b1 + j * 256 + lane * 4);
            v[j] = v[j] * rstd * g + bb;
            *(f32x4*)(hr + j * 256 + lane * 4) = v[j];
            u32x2 o; o.x = pk2(v[j].x, v[j].y); o.y = pk2(v[j].z, v[j].w);
            *(u32x2*)(hb + (size_t)row * DM + j * 256 + lane * 4) = o;
        }
        float gl[4];
#pragma unroll
        for (int q = 0; q < 4; ++q) {
            float a = 0.f;
#pragma unroll
            for (int j = 0; j < 4; ++j) { const f32x4 r = *(const f32x4*)(RT + q * 1024 + j * 256 + lane * 4); a += v[j].x * r.x + v[j].y * r.y + v[j].z * r.z + v[j].w * r.w; }
            gl[q] = wave_sum(a) + rgb[q];
        }
        int gi = 0; float gm = gl[0];
#pragma unroll
        for (int q = 1; q < 4; ++q) if (gl[q] > gm) { gm = gl[q]; gi = q; }
        float den = 0.f;
#pragma unroll
        for (int q = 0; q < 4; ++q) den += __expf(gl[q] - gm);
        const float gp = 1.f / den;
        gi = __builtin_amdgcn_readfirstlane(gi);
        float el[8];
#pragma unroll
        for (int q = 0; q < 8; ++q) el[q] = 0.f;
#pragma unroll 1
        for (int q = 0; q < 8; ++q) {
            const float* rt = RT + (4 + gi * 8 + q) * 1024 + lane * 4;
            float a = 0.f;
#pragma unroll
            for (int j = 0; j < 4; ++j) { const f32x4 r = *(const f32x4*)(rt + j * 256); a += v[j].x * r.x + v[j].y * r.y + v[j].z * r.z + v[j].w * r.w; }
            a = wave_sum(a) + reb[gi * 8 + q];
#pragma unroll
            for (int qq = 0; qq < 8; ++qq) el[qq] = (qq == q) ? a : el[qq];
        }
        int i0 = 0; float m0 = el[0];
#pragma unroll
        for (int q = 1; q < 8; ++q) if (el[q] > m0) { m0 = el[q]; i0 = q; }
        int i1 = -1; float m1 = -3.0e38f;
#pragma unroll
        for (int q = 0; q < 8; ++q) if (q != i0 && el[q] > m1) { m1 = el[q]; i1 = q; }
        const float e1 = __expf(m1 - m0);
        const float w0 = gp / (1.f + e1), w1 = gp * e1 / (1.f + e1);
        if (lane == 0) {
            const int ex0 = gi * 8 + i0, ex1 = gi * 8 + i1;
            const unsigned p0 = atomicAdd(&cnt[ex0], 1u), p1 = atomicAdd(&cnt[ex1], 1u);
            list[ex0 * NTOK + p0] = row * 2; lwt[ex0 * NTOK + p0] = w0;
            list[ex1 * NTOK + p1] = row * 2 + 1; lwt[ex1 * NTOK + p1] = w1;
        }
    }
}

__device__ __forceinline__ float siluf_(float x) { return x / (1.f + __expf(-x)); }
struct EpiGU {
    bf16* O; int row0, ct;
    __device__ __forceinline__ void operator()(const f32x4 (&acc)[8][4], int wr, int wc, int fr, int fq) const {
#pragma unroll
        for (int m = 0; m < 8; ++m) {
            bf16* rp = O + (size_t)(row0 + wr * 128 + m * 16 + fr) * DE + ct * 128 + wc * 32 + fq * 4;
#pragma unroll
            for (int n = 0; n < 2; ++n) {
                const f32x4 g = acc[m][n], u = acc[m][n + 2];
                u32x2 v; v.x = pk2(siluf_(g[0]) * u[0], siluf_(g[1]) * u[1]); v.y = pk2(siluf_(g[2]) * u[2], siluf_(g[3]) * u[3]);
                *(u32x2*)(rp + n * 16) = v;
            }
        }
    }
};
struct EpiDown {
    bf16* YS; const int* list; const float* lwt; int pos0, nvalid, col0;
    __device__ __forceinline__ void operator()(const f32x4 (&acc)[8][4], int wr, int wc, int fr, int fq) const {
#pragma unroll
        for (int m = 0; m < 8; ++m) {
            const int r = wr * 128 + m * 16 + fr;
            if (r < nvalid) {
                const int ts = list[pos0 + r]; const float wt = lwt[pos0 + r];
                bf16* rp = YS + (size_t)ts * DM + col0 + wc * 64 + fq * 4;
#pragma unroll
                for (int n = 0; n < 4; ++n) { u32x2 v; v.x = pk2(acc[m][n][0] * wt, acc[m][n][1] * wt); v.y = pk2(acc[m][n][2] * wt, acc[m][n][3] * wt); *(u32x2*)(rp + n * 16) = v; }
            }
        }
    }
};
__device__ __forceinline__ bool find_tile(const unsigned* cnt, int tile, int& e, int& rt, int& hoff) {
    int acc = 0;
    for (int i = 0; i < NEXP; ++i) { const int nt = ((int)cnt[i] + 255) >> 8; if (tile < acc + nt) { e = i; rt = tile - acc; hoff = (acc + rt) * 256; return true; } acc += nt; }
    return false;
}
__device__ __forceinline__ void phase_gateup(const Params& p, unsigned char* lds, int bid, int nb) {
    const int tid = threadIdx.x;
    const unsigned* cnt = (const unsigned*)(p.ws + WS_CTL);
    const int* list = (const int*)(p.ws + WS_LIST);
    const bf16* hb = (const bf16*)(p.ws + WS_HB);
    for (int u = bid;; u += nb) {
        const int tile = u >> 1, ct = u & 1; int e, rt, hoff;
        if (!find_tile(cnt, tile, e, rt, hoff)) break;
        const int nv = min(256, (int)cnt[e] - rt * 256);
        const bf16* arow[4]; const bf16* brow[4];
        const bf16* wt = (const bf16*)(p.ws + WS_EGU) + (size_t)e * 512 * DM + (size_t)ct * 256 * DM;
#pragma unroll
        for (int i = 0; i < 4; ++i) { const int pp = tid + NT * i, r = pp >> 3, s = pp & 7;
            const int tok = r < nv ? (list[e * NTOK + rt * 256 + r] >> 1) : 0;
            arow[i] = hb + (size_t)tok * DM + s * 8; brow[i] = wt + (size_t)r * DM + s * 8; }
        EpiGU ep{(bf16*)(p.ws + WS_HID), hoff, ct};
        gemm_unit(lds, arow, brow, DM, ep);
    }
}
__device__ __forceinline__ void phase_down(const Params& p, unsigned char* lds, int bid, int nb) {
    const int tid = threadIdx.x;
    const unsigned* cnt = (const unsigned*)(p.ws + WS_CTL);
    const bf16* hid = (const bf16*)(p.ws + WS_HID);
    for (int u = bid;; u += nb) {
        const int tile = u >> 2, ct = u & 3; int e, rt, hoff;
        if (!find_tile(cnt, tile, e, rt, hoff)) break;
        const int nv = min(256, (int)cnt[e] - rt * 256);
        const bf16* arow[4]; const bf16* brow[4];
        const bf16* wt = (const bf16*)(p.ws + WS_EDN) + (size_t)e * DM * DE + (size_t)ct * 256 * DE;
#pragma unroll
        for (int i = 0; i < 4; ++i) { const int pp = tid + NT * i, r = pp >> 3, s = pp & 7;
            arow[i] = hid + (size_t)(hoff + r) * DE + s * 8; brow[i] = wt + (size_t)r * DE + s * 8; }
        EpiDown ep{(bf16*)(p.ws + WS_YS), (const int*)(p.ws + WS_LIST) + e * NTOK, (const float*)(p.ws + WS_LWT) + e * NTOK, rt * 256, nv, ct * 256};
        gemm_unit(lds, arow, brow, DE, ep);
    }
}

__device__ __forceinline__ void phase_final(const Params& p, int bid, int nb) {
    const int tid = threadIdx.x, lane = tid & 63, w = tid >> 6;
    const float* g2 = p.in[25]; const float* b2 = p.in[26];
    const bf16* ys = (const bf16*)(p.ws + WS_YS);
    for (int row = bid * 8 + w; row < NTOK; row += nb * 8) {
        float* hr = p.out + (size_t)row * DM;
        f32x4 v[4]; float s = 0.f;
#pragma unroll
        for (int j = 0; j < 4; ++j) {
            const f32x4 hv = *(const f32x4*)(hr + j * 256 + lane * 4);
            const u32x2 y0 = *(const u32x2*)(ys + (size_t)row * 2 * DM + j * 256 + lane * 4), y1 = *(const u32x2*)(ys + (size_t)row * 2 * DM + DM + j * 256 + lane * 4);
            v[j].x = hv.x * ALPHA + (bflo(y0.x) + bflo(y1.x)); v[j].y = hv.y * ALPHA + (bfhi(y0.x) + bfhi(y1.x));
            v[j].z = hv.z * ALPHA + (bflo(y0.y) + bflo(y1.y)); v[j].w = hv.w * ALPHA + (bfhi(y0.y) + bfhi(y1.y));
            s += (v[j].x + v[j].y) + (v[j].z + v[j].w);
        }
        const float mean = wave_sum(s) * (1.f / DM);
        float s2 = 0.f;
#pragma unroll
        for (int j = 0; j < 4; ++j) { v[j] = v[j] - mean; s2 += (v[j].x * v[j].x + v[j].y * v[j].y) + (v[j].z * v[j].z + v[j].w * v[j].w); }
        const float rstd = rsqrtf(wave_sum(s2) * (1.f / DM) + LN_EPS);
#pragma unroll
        for (int j = 0; j < 4; ++j) {
            const f32x4 g = *(const f32x4*)(g2 + j * 256 + lane * 4), bb = *(const f32x4*)(b2 + j * 256 + lane * 4);
            *(f32x4*)(hr + j * 256 + lane * 4) = v[j] * rstd * g + bb;
        }
    }
}

__global__ void __launch_bounds__(NT) fwd_kernel(Params p) {
    extern __shared__ __attribute__((aligned(16))) unsigned char lds[];
    const int bid = blockIdx.x, nb = gridDim.x;
    switch (p.phase) {
        case 0: phase_convert(p, lds, bid, nb); break;
        case 1: phase_proj(p, lds, bid, nb); break;
        case 2: phase_pool(p, lds, bid, nb); break;
        case 3: phase_rwkv_seq(p, lds, bid, nb); break;
        case 4: phase_outproj(p, lds, bid, nb); break;
        case 5: phase_ln_router(p, lds, bid, nb); break;
        case 6: phase_gateup(p, lds, bid, nb); break;
        case 7: phase_down(p, lds, bid, nb); break;
        case 8: phase_final(p, bid, nb); break;
        default: break;
    }
}

extern "C" void kernel_launch(void* const* d_in, const int* in_sizes, int n_in, void* d_out, int out_size, void* d_ws, size_t ws_size, hipStream_t stream) {
    static int inited = 0;
    if (!inited) {
        hipFuncSetAttribute((const void*)fwd_kernel, hipFuncAttributeMaxDynamicSharedMemorySize, LDS_BYTES);
        inited = 1;
    }
    Params p{};
    for (int i = 0; i < 27; ++i) p.in[i] = (const float*)d_in[i];
    p.out = (float*)d_out; p.ws = (unsigned char*)d_ws;
    hipMemsetAsync((char*)d_ws + WS_CTL, 0, 4096, stream);
    for (int ph = 0; ph <= 8; ++ph) {
        p.phase = ph;
        hipLaunchKernelGGL(fwd_kernel, dim3(256), dim3(NT), LDS_BYTES, stream, p);
    }
}
```

```cpp
#include <hip/hip_runtime.h>
#include <hip/hip_cooperative_groups.h>
#include <cstdio>
#include <cstdint>
namespace cg = cooperative_groups;

typedef unsigned short bf16;
typedef short bf16x8 __attribute__((ext_vector_type(8)));
typedef float f32x4 __attribute__((ext_vector_type(4)));
typedef unsigned u32x4 __attribute__((ext_vector_type(4)));
typedef unsigned u32x2 __attribute__((ext_vector_type(2)));

constexpr int DM = 1024, BATCH = 2, SEQ = 8192, NTOK = BATCH * SEQ;
constexpr int D_POOL = 256, D_RWKV = 768, NH = 12, HS = 64;
constexpr int D_IN = 2816;
constexpr int C_R = 256, C_K = 1024, C_V = 1792, C_WD = 2560, C_AD = 2624, C_GD = 2688;
constexpr int NEXP = 32, DE = 256;
constexpr float LN_EPS = 1e-5f, LNX_EPS = 64e-5f;
constexpr float ALPHA = 1.189207115002721f;
constexpr int NT = 512;
constexpr int LDS_BYTES = 147456;

constexpr size_t MiB = 1u << 20;
constexpr size_t WS_CTL = 0;
constexpr size_t WS_WIN_T = 1 * MiB;
constexpr size_t WS_WOUT_T = 7 * MiB;
constexpr size_t WS_XB = 10 * MiB;
constexpr size_t WS_MIXIN = 42 * MiB;
constexpr size_t WS_PROJ = 74 * MiB;
constexpr size_t WS_HID = 74 * MiB;
constexpr size_t WS_YS = 94 * MiB;
constexpr size_t WS_EGU = 162 * MiB;
constexpr size_t WS_EDN = 194 * MiB;
constexpr size_t WS_HB = 210 * MiB;
constexpr size_t WS_LIST = 242 * MiB;
constexpr size_t WS_LWT = 244 * MiB;

struct Params {
    const float* in[27];
    float* out;
    unsigned char* ws;
    int phase;
    int pad;
};

__device__ __forceinline__ unsigned f2bf(float f) { unsigned u = __builtin_bit_cast(unsigned, f); return (u + 0x7fffu + ((u >> 16) & 1u)) >> 16; }
__device__ __forceinline__ unsigned pk2(float lo, float hi) { return f2bf(lo) | (f2bf(hi) << 16); }
__device__ __forceinline__ float bf2f(unsigned short b) { return __builtin_bit_cast(float, (unsigned)b << 16); }
__device__ __forceinline__ float bflo(unsigned u) { return __builtin_bit_cast(float, u << 16); }
__device__ __forceinline__ float bfhi(unsigned u) { return __builtin_bit_cast(float, u & 0xffff0000u); }
__device__ __forceinline__ float wave_sum(float v) {
#pragma unroll
    for (int o = 1; o < 64; o <<= 1) v += __shfl_xor(v, o);
    return v;
}
__device__ __forceinline__ float sigmoidf_(float x) { return 1.f / (1.f + __expf(-x)); }

template <class Epi>
__device__ __forceinline__ void gemm_unit(unsigned char* lds, const bf16* const (&arow)[4], const bf16* const (&brow)[4], int K, Epi& epi) {
    const int tid = threadIdx.x, lane = tid & 63, w = tid >> 6, wr = w >> 2, wc = w & 3;
    const int srow = tid >> 3, sslot = tid & 7;
    const int st_off = srow * 128 + ((sslot ^ ((srow >> 1) & 7)) << 4);
    const int fr = lane & 15, fq = lane >> 4, x = fr >> 1;
    int offA[2], offB[2];
#pragma unroll
    for (int s = 0; s < 2; ++s) {
        const int slot = (s * 4 + fq) ^ x;
        offA[s] = (wr * 128 + fr) * 128 + (slot << 4);
        offB[s] = 32768 + (wc * 64 + fr) * 128 + (slot << 4);
    }
    f32x4 acc[8][4];
#pragma unroll
    for (int m = 0; m < 8; ++m)
#pragma unroll
        for (int n = 0; n < 4; ++n) acc[m][n] = (f32x4){0.f, 0.f, 0.f, 0.f};
    u32x4 ra[4], rb[4];
#pragma unroll
    for (int i = 0; i < 4; ++i) { ra[i] = *(const u32x4*)(arow[i]); rb[i] = *(const u32x4*)(brow[i]); }
    __syncthreads();
#pragma unroll
    for (int i = 0; i < 4; ++i) { *(u32x4*)(lds + st_off + i * 8192) = ra[i]; *(u32x4*)(lds + 32768 + st_off + i * 8192) = rb[i]; }
    __syncthreads();
    const int KT = K >> 6;
    for (int kt = 0; kt < KT; ++kt) {
        unsigned char* cur = lds + (kt & 1) * 65536;
        unsigned char* nxt = lds + ((kt + 1) & 1) * 65536;
        if (kt + 1 < KT) {
#pragma unroll
            for (int i = 0; i < 4; ++i) { ra[i] = *(const u32x4*)(arow[i] + (kt + 1) * 64); rb[i] = *(const u32x4*)(brow[i] + (kt + 1) * 64); }
        }
#pragma unroll
        for (int s = 0; s < 2; ++s) {
            bf16x8 bfr[4];
#pragma unroll
            for (int n = 0; n < 4; ++n) bfr[n] = *(const bf16x8*)(cur + offB[s] + n * 2048);
#pragma unroll
            for (int m = 0; m < 8; ++m) {
                const bf16x8 afr = *(const bf16x8*)(cur + offA[s] + m * 2048);
#pragma unroll
                for (int n = 0; n < 4; ++n) acc[m][n] = __builtin_amdgcn_mfma_f32_16x16x32_bf16(bfr[n], afr, acc[m][n], 0, 0, 0);
            }
        }
        if (kt + 1 < KT) {
#pragma unroll
            for (int i = 0; i < 4; ++i) { *(u32x4*)(nxt + st_off + i * 8192) = ra[i]; *(u32x4*)(nxt + 32768 + st_off + i * 8192) = rb[i]; }
        }
        __syncthreads();
    }
    epi(acc, wr, wc, fr, fq);
}

__device__ __forceinline__ int gu_row(int c, int half) { return ((c >> 7) << 8) + (((c >> 5) & 3) << 6) + (half << 5) + (c & 31); }
__device__ __forceinline__ void tr_tile(unsigned char* lds, const float* __restrict__ src, int ldsrc, int k0, int n0, bf16* __restrict__ dst, int ldd, int mode) {
    float* t = (float*)lds;
    const int tid = threadIdx.x;
    __syncthreads();
#pragma unroll
    for (int i = 0; i < 8; ++i) { const int e = tid + i * NT, k = e >> 6, n = e & 63; t[k * 65 + n] = src[(size_t)(k0 + k) * ldsrc + n0 + n]; }
    __syncthreads();
    const int n = tid >> 3, kc = tid & 7;
    const float* s = t + (kc * 8) * 65 + n;
    u32x4 o; o.x = pk2(s[0], s[65]); o.y = pk2(s[2 * 65], s[3 * 65]); o.z = pk2(s[4 * 65], s[5 * 65]); o.w = pk2(s[6 * 65], s[7 * 65]);
    const int nn = n0 + n;
    const int drow = mode == 0 ? nn : gu_row(nn, mode - 1);
    *(u32x4*)(dst + (size_t)drow * ldd + k0 + kc * 8) = o;
}

__device__ __forceinline__ void phase_convert(const Params& p, unsigned char* lds, int bid, int nb) {
    const int tid = threadIdx.x;
    {
        const float* x = p.in[0]; bf16* xb = (bf16*)(p.ws + WS_XB);
        const size_t n8 = (size_t)NTOK * DM / 8;
        for (size_t i = (size_t)bid * NT + tid; i < n8; i += (size_t)nb * NT) {
            const f32x4 a = *(const f32x4*)(x + i * 8), b = *(const f32x4*)(x + i * 8 + 4);
            u32x4 o; o.x = pk2(a.x, a.y); o.y = pk2(a.z, a.w); o.z = pk2(b.x, b.y); o.w = pk2(b.z, b.w);
            *(u32x4*)(xb + i * 8) = o;
        }
    }
    constexpr int T_WIN = (DM / 64) * (D_IN / 64);
    constexpr int T_WOUT = (DM / 64) * (DM / 64);
    constexpr int T_EG = NEXP * (DM / 64) * (DE / 64);
    constexpr int T_ED = NEXP * (DE / 64) * (DM / 64);
    constexpr int T_ALL = T_WIN + T_WOUT + 2 * T_EG + T_ED;
    for (int it = bid; it < T_ALL; it += nb) {
        int r = it;
        if (r < T_WIN) { const int kb = r / (D_IN / 64), nbk = r % (D_IN / 64); tr_tile(lds, p.in[1], D_IN, kb * 64, nbk * 64, (bf16*)(p.ws + WS_WIN_T), DM, 0); continue; }
        r -= T_WIN;
        if (r < T_WOUT) { const int kb = r / (DM / 64), nbk = r % (DM / 64); tr_tile(lds, p.in[15], DM, kb * 64, nbk * 64, (bf16*)(p.ws + WS_WOUT_T), DM, 0); continue; }
        r -= T_WOUT;
        if (r < 2 * T_EG) {
            const int half = r / T_EG; r -= half * T_EG;
            const int e = r / 64, q = r % 64, kb = q / 4, nbk = q % 4;
            tr_tile(lds, p.in[22 + half] + (size_t)e * DM * DE, DE, kb * 64, nbk * 64, (bf16*)(p.ws + WS_EGU) + (size_t)e * 512 * DM, DM, 1 + half); continue;
        }
        r -= 2 * T_EG;
        { const int e = r / 64, q = r % 64, kb = q / 16, nbk = q % 16;
          tr_tile(lds, p.in[24] + (size_t)e * DE * DM, DM, kb * 64, nbk * 64, (bf16*)(p.ws + WS_EDN) + (size_t)e * DM * DE, DE, 0); }
    }
}

struct EpiProj {
    bf16* O; int row0, col0;
    __device__ __forceinline__ void operator()(const f32x4 (&acc)[8][4], int wr, int wc, int fr, int fq) const {
#pragma unroll
        for (int m = 0; m < 8; ++m) {
            bf16* rp = O + (size_t)(row0 + wr * 128 + m * 16 + fr) * D_IN + col0 + wc * 64 + fq * 4;
#pragma unroll
            for (int n = 0; n < 4; ++n) { u32x2 v; v.x = pk2(acc[m][n][0], acc[m][n][1]); v.y = pk2(acc[m][n][2], acc[m][n][3]); *(u32x2*)(rp + n * 16) = v; }
        }
    }
};
__device__ __forceinline__ void phase_proj(const Params& p, unsigned char* lds, int bid, int nb) {
    const int tid = threadIdx.x;
    const bf16* xb = (const bf16*)(p.ws + WS_XB); const bf16* wt = (const bf16*)(p.ws + WS_WIN_T);
    constexpr int NU = 64 * 11;
    for (int u = bid; u < NU; u += nb) {
        const int pm = u & 63, pn = u >> 6;
        const bf16* arow[4]; const bf16* brow[4];
#pragma unroll
        for (int i = 0; i < 4; ++i) { const int pp = tid + NT * i, r = pp >> 3, s = pp & 7;
            arow[i] = xb + (size_t)(pm * 256 + r) * DM + s * 8; brow[i] = wt + (size_t)(pn * 256 + r) * DM + s * 8; }
        EpiProj e{(bf16*)(p.ws + WS_PROJ), pm * 256, pn * 256};
        gemm_unit(lds, arow, brow, DM, e);
    }
}

__device__ __forceinline__ void phase_pool(const Params& p, unsigned char* lds, int bid, int nb) {
    const int tid = threadIdx.x;
    const bf16* proj = (const bf16*)(p.ws + WS_PROJ);
    bf16* mix = (bf16*)(p.ws + WS_MIXIN);
    const float* pw = p.in[2]; const float* ps = p.in[3];
    float* pbuf = (float*)lds;
    float* diff = (float*)(lds + 81920);
    for (int it = bid; it < NTOK / 64; it += nb) {
        const int tok0 = it * 64, t0 = tok0 % SEQ;
        __syncthreads();
        for (int e = tid; e < 79 * 64; e += NT) {
            const int r = e >> 6, c4 = e & 63; const int tt = t0 - 15 + r;
            float4 v = {0.f, 0.f, 0.f, 0.f};
            if (tt >= 0) { const u32x2 q = *(const u32x2*)(proj + (size_t)(tok0 - 15 + r) * D_IN + c4 * 4); v.x = bflo(q.x); v.y = bfhi(q.x); v.z = bflo(q.y); v.w = bfhi(q.y); }
            *(float4*)(pbuf + r * 256 + c4 * 4) = v;
        }
        __syncthreads();
        for (int e = tid; e < 64 * 256; e += NT) {
            const int t = e >> 8, c = e & 255, g = c >> 6, win = 2 << g;
            const int cnt = min(t0 + t + 1, win);
            float s = 0.f;
            for (int j = 0; j < cnt; ++j) s += pbuf[(t + 15 - j) * 256 + c];
            diff[t * 256 + c] = s / (float)cnt - pbuf[(t + 15) * 256 + c];
        }
        __syncthreads();
        {
            const int t = tid >> 3, dq = tid & 7;
#pragma unroll 1
            for (int g = 0; g < 4; ++g) {
                float o[8];
#pragma unroll
                for (int j = 0; j < 8; ++j) o[j] = 0.f;
                const float* wg = pw + (size_t)g * 4096 + dq * 8;
                for (int c = 0; c < 64; ++c) {
                    const float dv = diff[t * 256 + g * 64 + c];
                    const f32x4 w0 = *(const f32x4*)(wg + c * 64), w1 = *(const f32x4*)(wg + c * 64 + 4);
                    o[0] += dv * w0.x; o[1] += dv * w0.y; o[2] += dv * w0.z; o[3] += dv * w0.w;
                    o[4] += dv * w1.x; o[5] += dv * w1.y; o[6] += dv * w1.z; o[7] += dv * w1.w;
                }
                const float* sc = ps + g * 64 + dq * 8;
                u32x4 v; v.x = pk2(o[0] * sc[0], o[1] * sc[1]); v.y = pk2(o[2] * sc[2], o[3] * sc[3]); v.z = pk2(o[4] * sc[4], o[5] * sc[5]); v.w = pk2(o[6] * sc[6], o[7] * sc[7]);
                *(u32x4*)(mix + (size_t)(tok0 + t) * DM + g * 64 + dq * 8) = v;
            }
        }
    }
}

__device__ __forceinline__ void phase_rwkv_seq(const Params& p, unsigned char* lds, int bid, int nb) {
    const int tid = threadIdx.x;
    const bf16* proj = (const bf16*)(p.ws + WS_PROJ);
    bf16* mix = (bf16*)(p.ws + WS_MIXIN);
    const float* mu = p.in[4]; const float* w0 = p.in[5]; const float* w_up = p.in[6]; const float* a0 = p.in[7]; const float* a_up = p.in[8];
    const float* g_up = p.in[9]; const float* k_k = p.in[10]; const float* k_a = p.in[11]; const float* r_k = p.in[12];
    const float* lnx_g = p.in[13]; const float* lnx_b = p.in[14];
    float* R = (float*)lds;
    float* Kp = R + 4096;
    float* V = Kp + 4096;
    float* G = V + 4096;
    float* LIN = G + 4096;
    float* W = LIN;
    float* KK = W + 4096;
    float* Bb = KK + 4096;
    float* OUT = Bb + 4096;
    float* BON = LIN + 16384;
    for (int it = bid; it < BATCH * NH; it += nb) {
        const int b = it / NH, h = it % NH;
        float S[8];
#pragma unroll
        for (int j = 0; j < 8; ++j) S[j] = 0.f;
        const int si = tid >> 3, sj = (tid & 7) * 8;
        for (int c = 0; c < SEQ / 64; ++c) {
            const int tok0 = b * SEQ + c * 64;
            __syncthreads();
            for (int e = tid; e < 64 * 64; e += NT) {
                const int t = e >> 6, ch = e & 63;
                const bf16* cur = proj + (size_t)(tok0 + t) * D_IN; const bf16* prv = cur - D_IN;
                const bool hp = (c * 64 + t) > 0;
#pragma unroll
                for (int q = 0; q < 3; ++q) {
                    const int col = C_R + q * D_RWKV + h * 64 + ch;
                    const float zc = bf2f(cur[col]), zp = hp ? bf2f(prv[col]) : 0.f;
                    const float zm = zc + (zp - zc) * mu[col - D_POOL];
                    (q == 0 ? R : (q == 1 ? Kp : V))[t * 64 + ch] = zm;
                }
            }
            for (int e = tid; e < 64 * 256; e += NT) {
                const int t = e >> 8, k = e & 255;
                const bf16* cur = proj + (size_t)(tok0 + t) * D_IN; const bf16* prv = cur - D_IN;
                const bool hp = (c * 64 + t) > 0;
                const int col = C_WD + k;
                const float zc = bf2f(cur[col]), zp = hp ? bf2f(prv[col]) : 0.f;
                const float zm = zc + (zp - zc) * mu[col - D_POOL];
                LIN[t * 256 + k] = k < 64 ? tanhf(zm) : (k < 128 ? zm : sigmoidf_(zm));
            }
            __syncthreads();
            {
                const int t = tid >> 3, c8 = (tid & 7) * 8, hc = h * 64 + c8;
                float wl[8], al[8], gl[8];
#pragma unroll
                for (int j = 0; j < 8; ++j) { wl[j] = 0.f; al[j] = 0.f; gl[j] = 0.f; }
                for (int k = 0; k < 64; ++k) {
                    const float xw = LIN[t * 256 + k], xa = LIN[t * 256 + 64 + k];
                    const f32x4 u0 = *(const f32x4*)(w_up + k * D_RWKV + hc), u1 = *(const f32x4*)(w_up + k * D_RWKV + hc + 4);
                    const f32x4 v0 = *(const f32x4*)(a_up + k * D_RWKV + hc), v1 = *(const f32x4*)(a_up + k * D_RWKV + hc + 4);
                    wl[0] += xw * u0.x; wl[1] += xw * u0.y; wl[2] += xw * u0.z; wl[3] += xw * u0.w; wl[4] += xw * u1.x; wl[5] += xw * u1.y; wl[6] += xw * u1.z; wl[7] += xw * u1.w;
                    al[0] += xa * v0.x; al[1] += xa * v0.y; al[2] += xa * v0.z; al[3] += xa * v0.w; al[4] += xa * v1.x; al[5] += xa * v1.y; al[6] += xa * v1.z; al[7] += xa * v1.w;
                }
                for (int k = 0; k < 128; ++k) {
                    const float xg = LIN[t * 256 + 128 + k];
                    const f32x4 u0 = *(const f32x4*)(g_up + k * D_RWKV + hc), u1 = *(const f32x4*)(g_up + k * D_RWKV + hc + 4);
                    gl[0] += xg * u0.x; gl[1] += xg * u0.y; gl[2] += xg * u0.z; gl[3] += xg * u0.w; gl[4] += xg * u1.x; gl[5] += xg * u1.y; gl[6] += xg * u1.z; gl[7] += xg * u1.w;
                }
                float kkr[8], av[8], wv[8], nsq = 0.f, bon = 0.f;
#pragma unroll
                for (int j = 0; j < 8; ++j) {
                    const int ch = hc + j;
                    const float xx = w0[ch] + wl[j];
                    const float sp = (-xx > 20.f) ? -xx : log1pf(__expf(-xx));
                    const float wlog = -sp - 0.5f;
                    wv[j] = __expf(-__expf(wlog));
                    av[j] = sigmoidf_(a0[ch] + al[j]);
                    const float km = Kp[t * 64 + c8 + j];
                    kkr[j] = km * k_k[ch]; nsq += kkr[j] * kkr[j];
                    const float kn = km * (1.f + (av[j] - 1.f) * k_a[ch]);
                    Kp[t * 64 + c8 + j] = kn;
                    bon += R[t * 64 + c8 + j] * kn * r_k[ch];
                    G[t * 64 + c8 + j] = gl[j];
                }
                nsq += __shfl_xor(nsq, 1); nsq += __shfl_xor(nsq, 2); nsq += __shfl_xor(nsq, 4);
                bon += __shfl_xor(bon, 1); bon += __shfl_xor(bon, 2); bon += __shfl_xor(bon, 4);
                const float inv = 1.f / fmaxf(sqrtf(nsq), 1e-12f);
                __syncthreads();
#pragma unroll
                for (int j = 0; j < 8; ++j) { const float kn = kkr[j] * inv; KK[t * 64 + c8 + j] = kn; Bb[t * 64 + c8 + j] = kn * av[j]; W[t * 64 + c8 + j] = wv[j]; }
                if ((tid & 7) == 0) BON[t] = bon;
            }
            __syncthreads();
            for (int t = 0; t < 64; ++t) {
                const f32x4 k0 = *(const f32x4*)(KK + t * 64 + sj), k1 = *(const f32x4*)(KK + t * 64 + sj + 4);
                float sa = S[0] * k0.x + S[1] * k0.y + S[2] * k0.z + S[3] * k0.w + S[4] * k1.x + S[5] * k1.y + S[6] * k1.z + S[7] * k1.w;
                sa += __shfl_xor(sa, 1); sa += __shfl_xor(sa, 2); sa += __shfl_xor(sa, 4);
                sa = -sa;
                const f32x4 w0v = *(const f32x4*)(W + t * 64 + sj), w1v = *(const f32x4*)(W + t * 64 + sj + 4);
                const f32x4 b0 = *(const f32x4*)(Bb + t * 64 + sj), b1 = *(const f32x4*)(Bb + t * 64 + sj + 4);
                const f32x4 q0 = *(const f32x4*)(Kp + t * 64 + sj), q1 = *(const f32x4*)(Kp + t * 64 + sj + 4);
                const f32x4 r0 = *(const f32x4*)(R + t * 64 + sj), r1 = *(const f32x4*)(R + t * 64 + sj + 4);
                const float vi = V[t * 64 + si];
                S[0] = S[0] * w0v.x + sa * b0.x + vi * q0.x; S[1] = S[1] * w0v.y + sa * b0.y + vi * q0.y; S[2] = S[2] * w0v.z + sa * b0.z + vi * q0.z; S[3] = S[3] * w0v.w + sa * b0.w + vi * q0.w;
                S[4] = S[4] * w1v.x + sa * b1.x + vi * q1.x; S[5] = S[5] * w1v.y + sa * b1.y + vi * q1.y; S[6] = S[6] * w1v.z + sa * b1.z + vi * q1.z; S[7] = S[7] * w1v.w + sa * b1.w + vi * q1.w;
                float o = S[0] * r0.x + S[1] * r0.y + S[2] * r0.z + S[3] * r0.w + S[4] * r1.x + S[5] * r1.y + S[6] * r1.z + S[7] * r1.w;
                o += __shfl_xor(o, 1); o += __shfl_xor(o, 2); o += __shfl_xor(o, 4);
                if ((tid & 7) == 0) OUT[t * 64 + si] = o;
            }
            __syncthreads();
            {
                const int t = tid >> 3, c8 = (tid & 7) * 8, hc = h * 64 + c8;
                float y[8], s = 0.f;
#pragma unroll
                for (int j = 0; j < 8; ++j) { y[j] = OUT[t * 64 + c8 + j]; s += y[j]; }
                s += __shfl_xor(s, 1); s += __shfl_xor(s, 2); s += __shfl_xor(s, 4);
                const float mean = s * (1.f / 64.f);
                float s2 = 0.f;
#pragma unroll
                for (int j = 0; j < 8; ++j) { y[j] -= mean; s2 += y[j] * y[j]; }
                s2 += __shfl_xor(s2, 1); s2 += __shfl_xor(s2, 2); s2 += __shfl_xor(s2, 4);
                const float rstd = rsqrtf(s2 * (1.f / 64.f) + LNX_EPS);
                const float bon = BON[t];
                float o[8];
#pragma unroll
                for (int j = 0; j < 8; ++j) o[j] = (y[j] * rstd * lnx_g[hc + j] + lnx_b[hc + j] + bon * V[t * 64 + c8 + j]) * G[t * 64 + c8 + j];
                u32x4 v; v.x = pk2(o[0], o[1]); v.y = pk2(o[2], o[3]); v.z = pk2(o[4], o[5]); v.w = pk2(o[6], o[7]);
                *(u32x4*)(mix + (size_t)(tok0 + t) * DM + D_POOL + hc) = v;
            }
        }
    }
}

struct EpiOut {
    const float* X; float* O; int row0, col0;
    __device__ __forceinline__ void operator()(const f32x4 (&acc)[8][4], int wr, int wc, int fr, int fq) const {
#pragma unroll
        for (int m = 0; m < 8; ++m) {
            const size_t off = (size_t)(row0 + wr * 128 + m * 16 + fr) * DM + col0 + wc * 64 + fq * 4;
#pragma unroll
            for (int n = 0; n < 4; ++n) { const f32x4 xv = *(const f32x4*)(X + off + n * 16); *(f32x4*)(O + off + n * 16) = xv * ALPHA + acc[m][n]; }
        }
    }
};
__device__ __forceinline__ void phase_outproj(const Params& p, unsigned char* lds, int bid, int nb) {
    const int tid = threadIdx.x;
    const bf16* a = (const bf16*)(p.ws + WS_MIXIN); const bf16* wt = (const bf16*)(p.ws + WS_WOUT_T);
    for (int u = bid; u < 256; u += nb) {
        const int pm = u & 63, pn = u >> 6;
        const bf16* arow[4]; const bf16* brow[4];
#pragma unroll
        for (int i = 0; i < 4; ++i) { const int pp = tid + NT * i, r = pp >> 3, s = pp & 7;
            arow[i] = a + (size_t)(pm * 256 + r) * DM + s * 8; brow[i] = wt + (size_t)(pn * 256 + r) * DM + s * 8; }
        EpiOut e{p.in[0], p.out, pm * 256, pn * 256};
        gemm_unit(lds, arow, brow, DM, e);
    }
}

__device__ __forceinline__ void phase_ln_router(const Params& p, unsigned char* lds, int bid, int nb) {
    const int tid = threadIdx.x, lane = tid & 63, w = tid >> 6;
    float* RT = (float*)lds;
    const float* rg = p.in[18]; const float* re = p.in[20];
    __syncthreads();
    for (int e = tid; e < 36 * 1024; e += NT) { const int j = e >> 10, k = e & 1023; RT[e] = j < 4 ? rg[k * 4 + j] : re[k * 32 + (j - 4)]; }
    __syncthreads();
    const float* g1 = p.in[16]; const float* b1 = p.in[17]; const float* rgb = p.in[19]; const float* reb = p.in[21];
    float* H = p.out; bf16* hb = (bf16*)(p.ws + WS_HB);
    unsigned* cnt = (unsigned*)(p.ws + WS_CTL);
    int* list = (int*)(p.ws + WS_LIST); float* lwt = (float*)(p.ws + WS_LWT);
    for (int row = bid * 8 + w; row < NTOK; row += nb * 8) {
        float* hr = H + (size_t)row * DM;
        f32x4 v[4]; float s = 0.f;
#pragma unroll
        for (int j = 0; j < 4; ++j) { v[j] = *(const f32x4*)(hr + j * 256 + lane * 4); s += (v[j].x + v[j].y) + (v[j].z + v[j].w); }
        const float mean = wave_sum(s) * (1.f / DM);
        float s2 = 0.f;
#pragma unroll
        for (int j = 0; j < 4; ++j) { v[j] = v[j] - mean; s2 += (v[j].x * v[j].x + v[j].y * v[j].y) + (v[j].z * v[j].z + v[j].w * v[j].w); }
        const float rstd = rsqrtf(wave_sum(s2) * (1.f / DM) + LN_EPS);
#pragma unroll
        for (int j = 0; j < 4; ++j) {
            const f32x4 g = *(const f32x4*)(g1 + j * 256 + lane * 4), bb = *(const f32x4*)(b1 + j * 256 + lane * 4);
            v[j] = v[j] * rstd * g + bb;
            *(f32x4*)(hr + j * 256 + lane * 4) = v[j];
            u32x2 o; o.x = pk2(v[j].x, v[j].y); o.y = pk2(v[j].z, v[j].w);
            *(u32x2*)(hb + (size_t)row * DM + j * 256 + lane * 4) = o;
        }
        float gl[4];
#pragma unroll
        for (int q = 0; q < 4; ++q) {
            float a = 0.f;
#pragma unroll
            for (int j = 0; j < 4; ++j) { const f32x4 r = *(const f32x4*)(RT + q * 1024 + j * 256 + lane * 4); a += v[j].x * r.x + v[j].y * r.y + v[j].z * r.z + v[j].w * r.w; }
            gl[q] = wave_sum(a) + rgb[q];
        }
        int gi = 0; float gm = gl[0];
#pragma unroll
        for (int q = 1; q < 4; ++q) if (gl[q] > gm) { gm = gl[q]; gi = q; }
        float den = 0.f;
#pragma unroll
        for (int q = 0; q < 4; ++q) den += __expf(gl[q] - gm);
        const float gp = 1.f / den;
        gi = __builtin_amdgcn_readfirstlane(gi);
        float el[8];
#pragma unroll
        for (int q = 0; q < 8; ++q) el[q] = 0.f;
#pragma unroll 1
        for (int q = 0; q < 8; ++q) {
            const float* rt = RT + (4 + gi * 8 + q) * 1024 + lane * 4;
            float a = 0.f;
#pragma unroll
            for (int j = 0; j < 4; ++j) { const f32x4 r = *(const f32x4*)(rt + j * 256); a += v[j].x * r.x + v[j].y * r.y + v[j].z * r.z + v[j].w * r.w; }
            a = wave_sum(a) + reb[gi * 8 + q];
#pragma unroll
            for (int qq = 0; qq < 8; ++qq) el[qq] = (qq == q) ? a : el[qq];
        }
        int i0 = 0; float m0 = el[0];
#pragma unroll
        for (int q = 1; q < 8; ++q) if (el[q] > m0) { m0 = el[q]; i0 = q; }
        int i1 = -1; float m1 = -3.0e38f;
#pragma unroll
        for (int q = 0; q < 8; ++q) if (q != i0 && el[q] > m1) { m1 = el[q]; i1 = q; }
        const float e1 = __expf(m1 - m0);
        const float w0 = gp / (1.f + e1), w1 = gp * e1 / (1.f + e1);
        if (lane == 0) {
            const int ex0 = gi * 8 + i0, ex1 = gi * 8 + i1;
            const unsigned p0 = atomicAdd(&cnt[ex0], 1u), p1 = atomicAdd(&cnt[ex1], 1u);
            list[ex0 * NTOK + p0] = row * 2; lwt[ex0 * NTOK + p0] = w0;
            list[ex1 * NTOK + p1] = row * 2 + 1; lwt[ex1 * NTOK + p1] = w1;
        }
    }
}

__device__ __forceinline__ float siluf_(float x) { return x / (1.f + __expf(-x)); }
struct EpiGU {
    bf16* O; int row0, ct;
    __device__ __forceinline__ void operator()(const f32x4 (&acc)[8][4], int wr, int wc, int fr, int fq) const {
#pragma unroll
        for (int m = 0; m < 8; ++m) {
            bf16* rp = O + (size_t)(row0 + wr * 128 + m * 16 + fr) * DE + ct * 128 + wc * 32 + fq * 4;
#pragma unroll
            for (int n = 0; n < 2; ++n) {
                const f32x4 g = acc[m][n], u = acc[m][n + 2];
                u32x2 v; v.x = pk2(siluf_(g[0]) * u[0], siluf_(g[1]) * u[1]); v.y = pk2(siluf_(g[2]) * u[2], siluf_(g[3]) * u[3]);
                *(u32x2*)(rp + n * 16) = v;
            }
        }
    }
};
struct EpiDown {
    bf16* YS; const int* list; const float* lwt; int pos0, nvalid, col0;
    __device__ __forceinline__ void operator()(const f32x4 (&acc)[8][4], int wr, int wc, int fr, int fq) const {
#pragma unroll
        for (int m = 0; m < 8; ++m) {
            const int r = wr * 128 + m * 16 + fr;
            if (r < nvalid) {
                const int ts = list[pos0 + r]; const float wt = lwt[pos0 + r];
                bf16* rp = YS + (size_t)ts * DM + col0 + wc * 64 + fq * 4;
#pragma unroll
                for (int n = 0; n < 4; ++n) { u32x2 v; v.x = pk2(acc[m][n][0] * wt, acc[m][n][1] * wt); v.y = pk2(acc[m][n][2] * wt, acc[m][n][3] * wt); *(u32x2*)(rp + n * 16) = v; }
            }
        }
    }
};
__device__ __forceinline__ bool find_tile(const unsigned* cnt, int tile, int& e, int& rt, int& hoff) {
    int acc = 0;
    for (int i = 0; i < NEXP; ++i) { const int nt = ((int)cnt[i] + 255) >> 8; if (tile < acc + nt) { e = i; rt = tile - acc; hoff = (acc + rt) * 256; return true; } acc += nt; }
    return false;
}
__device__ __forceinline__ void phase_gateup(const Params& p, unsigned char* lds, int bid, int nb) {
    const int tid = threadIdx.x;
    const unsigned* cnt = (const unsigned*)(p.ws + WS_CTL);
    const int* list = (const int*)(p.ws + WS_LIST);
    const bf16* hb = (const bf16*)(p.ws + WS_HB);
    for (int u = bid;; u += nb) {
        const int tile = u >> 1, ct = u & 1; int e, rt, hoff;
        if (!find_tile(cnt, tile, e, rt, hoff)) break;
        const int nv = min(256, (int)cnt[e] - rt * 256);
        const bf16* arow[4]; const bf16* brow[4];
        const bf16* wt = (const bf16*)(p.ws + WS_EGU) + (size_t)e * 512 * DM + (size_t)ct * 256 * DM;
#pragma unroll
        for (int i = 0; i < 4; ++i) { const int pp = tid + NT * i, r = pp >> 3, s = pp & 7;
            const int tok = r < nv ? (list[e * NTOK + rt * 256 + r] >> 1) : 0;
            arow[i] = hb + (size_t)tok * DM + s * 8; brow[i] = wt + (size_t)r * DM + s * 8; }
        EpiGU ep{(bf16*)(p.ws + WS_HID), hoff, ct};
        gemm_unit(lds, arow, brow, DM, ep);
    }
}
__device__ __forceinline__ void phase_down(const Params& p, unsigned char* lds, int bid, int nb) {
    const int tid = threadIdx.x;
    const unsigned* cnt = (const unsigned*)(p.ws + WS_CTL);
    const bf16* hid = (const bf16*)(p.ws + WS_HID);
    for (int u = bid;; u += nb) {
        const int tile = u >> 2, ct = u & 3; int e, rt, hoff;
        if (!find_tile(cnt, tile, e, rt, hoff)) break;
        const int nv = min(256, (int)cnt[e] - rt * 256);
        const bf16* arow[4]; const bf16* brow[4];
        const bf16* wt = (const bf16*)(p.ws + WS_EDN) + (size_t)e * DM * DE + (size_t)ct * 256 * DE;
#pragma unroll
        for (int i = 0; i < 4; ++i) { const int pp = tid + NT * i, r = pp >> 3, s = pp & 7;
            arow[i] = hid + (size_t)(hoff + r) * DE + s * 8; brow[i] = wt + (size_t)r * DE + s * 8; }
        EpiDown ep{(bf16*)(p.ws + WS_YS), (const int*)(p.ws + WS_LIST) + e * NTOK, (const float*)(p.ws + WS_LWT) + e * NTOK, rt * 256, nv, ct * 256};
        gemm_unit(lds, arow, brow, DE, ep);
    }
}

__device__ __forceinline__ void phase_final(const Params& p, int bid, int nb) {
    const int tid = threadIdx.x, lane = tid & 63, w = tid >> 6;
    const float* g2 = p.in[25]; const float* b2 = p.in[26];
    const bf16* ys = (const bf16*)(p.ws + WS_YS);
    for (int row = bid * 8 + w; row < NTOK; row += nb * 8) {
        float* hr = p.out + (size_t)row * DM;
        f32x4 v[4]; float s = 0.f;
#pragma unroll
        for (int j = 0; j < 4; ++j) {
            const f32x4 hv = *(const f32x4*)(hr + j * 256 + lane * 4);
            const u32x2 y0 = *(const u32x2*)(ys + (size_t)row * 2 * DM + j * 256 + lane * 4), y1 = *(const u32x2*)(ys + (size_t)row * 2 * DM + DM + j * 256 + lane * 4);
            v[j].x = hv.x * ALPHA + (bflo(y0.x) + bflo(y1.x)); v[j].y = hv.y * ALPHA + (bfhi(y0.x) + bfhi(y1.x));
            v[j].z = hv.z * ALPHA + (bflo(y0.y) + bflo(y1.y)); v[j].w = hv.w * ALPHA + (bfhi(y0.y) + bfhi(y1.y));
            s += (v[j].x + v[j].y) + (v[j].z + v[j].w);
        }
        const float mean = wave_sum(s) * (1.f / DM);
        float s2 = 0.f;
#pragma unroll
        for (int j = 0; j < 4; ++j) { v[j] = v[j] - mean; s2 += (v[j].x * v[j].x + v[j].y * v[j].y) + (v[j].z * v[j].z + v[j].w * v[j].w); }
        const float rstd = rsqrtf(wave_sum(s2) * (1.f / DM) + LN_EPS);
#pragma unroll
        for (int j = 0; j < 4; ++j) {
            const f32x4 g = *(const f32x4*)(g2 + j * 256 + lane * 4), bb = *(const f32x4*)(b2 + j * 256 + lane * 4);
            *(f32x4*)(hr + j * 256 + lane * 4) = v[j] * rstd * g + bb;
        }
    }
}

__global__ void __launch_bounds__(NT) fwd_kernel(Params p) {
    extern __shared__ __attribute__((aligned(16))) unsigned char lds[];
    cg::grid_group grid = cg::this_grid();
    const int bid = blockIdx.x, nb = gridDim.x;
    phase_convert(p, lds, bid, nb);
    grid.sync();
    phase_proj(p, lds, bid, nb);
    grid.sync();
    if (bid < BATCH * NH) phase_rwkv_seq(p, lds, bid, BATCH * NH);
    else phase_pool(p, lds, bid - BATCH * NH, nb - BATCH * NH);
    grid.sync();
    phase_outproj(p, lds, bid, nb);
    grid.sync();
    phase_ln_router(p, lds, bid, nb);
    grid.sync();
    phase_gateup(p, lds, bid, nb);
    grid.sync();
    phase_down(p, lds, bid, nb);
    grid.sync();
    phase_final(p, bid, nb);
}

extern "C" void kernel_launch(void* const* d_in, const int* in_sizes, int n_in, void* d_out, int out_size, void* d_ws, size_t ws_size, hipStream_t stream) {
    static int grid_blocks = 0;
    if (!grid_blocks) {
        if (hipFuncSetAttribute((const void*)fwd_kernel, hipFuncAttributeMaxDynamicSharedMemorySize, LDS_BYTES) != hipSuccess) fprintf(stderr, "hipFuncSetAttribute failed\n");
        int dev = 0, cus = 0, per_cu = 0;
        (void)hipGetDevice(&dev);
        (void)hipDeviceGetAttribute(&cus, hipDeviceAttributeMultiprocessorCount, dev);
        (void)hipOccupancyMaxActiveBlocksPerMultiprocessor(&per_cu, (const void*)fwd_kernel, NT, LDS_BYTES);
        if (per_cu < 1) { fprintf(stderr, "occupancy query says %d blocks/CU\n", per_cu); per_cu = 1; }
        grid_blocks = cus;
        fprintf(stderr, "grid %d (cus %d, per_cu %d)\n", grid_blocks, cus, per_cu);
    }
    Params p{};
    for (int i = 0; i < 27; ++i) p.in[i] = (const float*)d_in[i];
    p.out = (float*)d_out; p.ws = (unsigned char*)d_ws;
    (void)hipMemsetAsync((char*)d_ws + WS_CTL, 0, 4096, stream);
    void* args[] = {&p};
    hipError_t e = hipLaunchCooperativeKernel((const void*)fwd_kernel, dim3(grid_blocks), dim3(NT), args, LDS_BYTES, stream);
    if (e != hipSuccess) fprintf(stderr, "cooperative launch failed: %s (grid %d)\n", hipGetErrorString(e), grid_blocks);
}
```

```cpp
#include <hip/hip_runtime.h>
#include <hip/hip_cooperative_groups.h>
#include <cstdio>
#include <cstdint>
namespace cg = cooperative_groups;

typedef unsigned short bf16;
typedef short bf16x8 __attribute__((ext_vector_type(8)));
typedef float f32x4 __attribute__((ext_vector_type(4)));
typedef unsigned u32x4 __attribute__((ext_vector_type(4)));
typedef unsigned u32x2 __attribute__((ext_vector_type(2)));
typedef float f32x16 __attribute__((ext_vector_type(16)));
typedef float f32x2 __attribute__((ext_vector_type(2)));
typedef __bf16 bf16x2_t __attribute__((ext_vector_type(2)));

constexpr int DM = 1024, BATCH = 2, SEQ = 8192, NTOK = BATCH * SEQ;
constexpr int D_POOL = 256, D_RWKV = 768, NH = 12, HS = 64;
constexpr int D_IN = 2816;
constexpr int C_R = 256, C_K = 1024, C_V = 1792, C_WD = 2560, C_AD = 2624, C_GD = 2688;
constexpr int NEXP = 32, DE = 256;
constexpr float LN_EPS = 1e-5f, LNX_EPS = 64e-5f;
constexpr float ALPHA = 1.189207115002721f;
constexpr int NT = 512;
constexpr int LDS_BYTES = 150528;

constexpr size_t MiB = 1u << 20;
constexpr size_t WS_CTL = 0;
constexpr size_t WS_WIN_T = 1 * MiB;
constexpr size_t WS_WOUT_T = 7 * MiB;
constexpr size_t WS_WUPT = 9 * MiB;
constexpr size_t WS_AUPT = 9 * MiB + 128 * 1024;
constexpr size_t WS_GUPT = 9 * MiB + 256 * 1024;
constexpr size_t WS_XB = 10 * MiB;
constexpr size_t WS_TC = 10 * MiB;
constexpr size_t WS_MIXIN = 42 * MiB;
constexpr size_t WS_PROJ = 74 * MiB;
constexpr size_t WS_EGU = 74 * MiB;
constexpr size_t WS_EDN = 106 * MiB;
constexpr size_t WS_S0 = 122 * MiB;
constexpr size_t WS_GC = 162 * MiB;
constexpr size_t WS_QC = 186 * MiB;
constexpr size_t WS_OL = 210 * MiB;
constexpr size_t OUT_G1 = 0;
constexpr size_t OUT_G2 = 24 * MiB;
constexpr size_t WS_YS = 122 * MiB;
constexpr size_t WS_HB = 186 * MiB;
constexpr size_t WS_LIST = 218 * MiB;
constexpr size_t WS_LWT = 220 * MiB;
constexpr size_t WS_HID = 222 * MiB;

struct Params {
    const float* in[27];
    float* out;
    unsigned char* ws;
    int phase;
    int pad;
};

__device__ __forceinline__ unsigned f2bf(float f) { unsigned u = __builtin_bit_cast(unsigned, f); return (u + 0x7fffu + ((u >> 16) & 1u)) >> 16; }
__device__ __forceinline__ unsigned pk2(float lo, float hi) { f32x2 v = {lo, hi}; bf16x2_t b = __builtin_convertvector(v, bf16x2_t); return __builtin_bit_cast(unsigned, b); }
__device__ __forceinline__ float bf2f(unsigned short b) { return __builtin_bit_cast(float, (unsigned)b << 16); }
__device__ __forceinline__ float bflo(unsigned u) { return __builtin_bit_cast(float, u << 16); }
__device__ __forceinline__ float bfhi(unsigned u) { return __builtin_bit_cast(float, u & 0xffff0000u); }
__device__ __forceinline__ float wave_sum(float v) {
#pragma unroll
    for (int o = 1; o < 64; o <<= 1) v += __shfl_xor(v, o);
    return v;
}
__device__ __forceinline__ int opaque_tid() { int t = threadIdx.x; asm volatile("" : "+v"(t)); return t; }
__device__ __forceinline__ float sigmoidf_(float x) { return 1.f / (1.f + __expf(-x)); }

template <class Epi>
__device__ __forceinline__ void gemm_unit(unsigned char* lds, const bf16* __restrict__ abase, const unsigned (&arow)[4], const bf16* __restrict__ bbase, const unsigned (&brow)[4], int K, Epi& epi) {
    const int tid = opaque_tid(), lane = tid & 63, w = tid >> 6, wr = w >> 2, wc = w & 3;
    const int srow = tid >> 3, sslot = tid & 7;
    const int st_off = srow * 128 + ((sslot ^ ((srow >> 1) & 7)) << 4);
    const int fr = lane & 15, fq = lane >> 4, x = fr >> 1;
    int offA[2], offB[2];
#pragma unroll
    for (int s = 0; s < 2; ++s) {
        const int slot = (s * 4 + fq) ^ x;
        offA[s] = (wr * 128 + fr) * 128 + (slot << 4);
        offB[s] = 32768 + (wc * 64 + fr) * 128 + (slot << 4);
    }
    f32x4 acc[8][4];
#pragma unroll
    for (int m = 0; m < 8; ++m)
#pragma unroll
        for (int n = 0; n < 4; ++n) acc[m][n] = (f32x4){0.f, 0.f, 0.f, 0.f};
    u32x4 ra[4], rb[4];
#pragma unroll
    for (int i = 0; i < 4; ++i) { ra[i] = *(const u32x4*)(abase + arow[i]); rb[i] = *(const u32x4*)(bbase + brow[i]); }
    __syncthreads();
#pragma unroll
    for (int i = 0; i < 4; ++i) { *(u32x4*)(lds + st_off + i * 8192) = ra[i]; *(u32x4*)(lds + 32768 + st_off + i * 8192) = rb[i]; }
    __syncthreads();
    const int KT = K >> 6;
    for (int kt = 0; kt < KT; ++kt) {
        unsigned char* cur = lds + (kt & 1) * 65536;
        unsigned char* nxt = lds + ((kt + 1) & 1) * 65536;
        if (kt + 1 < KT) {
#pragma unroll
            for (int i = 0; i < 4; ++i) { ra[i] = *(const u32x4*)(abase + arow[i] + (kt + 1) * 64); rb[i] = *(const u32x4*)(bbase + brow[i] + (kt + 1) * 64); }
        }
#pragma unroll
        for (int s = 0; s < 2; ++s) {
            bf16x8 bfr[4];
#pragma unroll
            for (int n = 0; n < 4; ++n) bfr[n] = *(const bf16x8*)(cur + offB[s] + n * 2048);
#pragma unroll
            for (int m = 0; m < 8; ++m) {
                const bf16x8 afr = *(const bf16x8*)(cur + offA[s] + m * 2048);
#pragma unroll
                for (int n = 0; n < 4; ++n) acc[m][n] = __builtin_amdgcn_mfma_f32_16x16x32_bf16(bfr[n], afr, acc[m][n], 0, 0, 0);
            }
        }
        if (kt + 1 < KT) {
#pragma unroll
            for (int i = 0; i < 4; ++i) { *(u32x4*)(nxt + st_off + i * 8192) = ra[i]; *(u32x4*)(nxt + 32768 + st_off + i * 8192) = rb[i]; }
        }
        __syncthreads();
    }
    epi(acc, wr, wc, fr, fq);
}

__device__ __forceinline__ int gu_row(int c, int half) { return ((c >> 7) << 8) + (((c >> 5) & 3) << 6) + (half << 5) + (c & 31); }
__device__ __forceinline__ void tr_tile(unsigned char* lds, const float* __restrict__ src, int ldsrc, int k0, int n0, bf16* __restrict__ dst, int ldd, int mode) {
    float* t = (float*)lds;
    const int tid = opaque_tid();
    __syncthreads();
#pragma unroll
    for (int i = 0; i < 8; ++i) { const int e = tid + i * NT, k = e >> 6, n = e & 63; t[k * 65 + n] = src[(size_t)(k0 + k) * ldsrc + n0 + n]; }
    __syncthreads();
    const int n = tid >> 3, kc = tid & 7;
    const float* s = t + (kc * 8) * 65 + n;
    u32x4 o; o.x = pk2(s[0], s[65]); o.y = pk2(s[2 * 65], s[3 * 65]); o.z = pk2(s[4 * 65], s[5 * 65]); o.w = pk2(s[6 * 65], s[7 * 65]);
    const int nn = n0 + n;
    const int drow = mode == 0 ? nn : gu_row(nn, mode - 1);
    *(u32x4*)(dst + (size_t)drow * ldd + k0 + kc * 8) = o;
}

__device__ __forceinline__ void phase_convert(const Params& p, unsigned char* lds, int bid, int nb) {
    const int tid = opaque_tid();
    {
        const float* x = p.in[0]; bf16* xb = (bf16*)(p.ws + WS_XB);
        const size_t n8 = (size_t)NTOK * DM / 8;
        for (size_t i = (size_t)bid * NT + tid; i < n8; i += (size_t)nb * NT) {
            const f32x4 a = *(const f32x4*)(x + i * 8), b = *(const f32x4*)(x + i * 8 + 4);
            u32x4 o; o.x = pk2(a.x, a.y); o.y = pk2(a.z, a.w); o.z = pk2(b.x, b.y); o.w = pk2(b.z, b.w);
            *(u32x4*)(xb + i * 8) = o;
        }
    }
    constexpr int T_WIN = (DM / 64) * (D_IN / 64);
    constexpr int T_WOUT = (DM / 64) * (DM / 64);
    constexpr int T_ALL = T_WIN + T_WOUT + 12 + 12 + 24;
    for (int it = bid; it < T_ALL; it += nb) {
        int r = it;
        if (r < T_WIN) { const int kb = r / (D_IN / 64), nbk = r % (D_IN / 64); tr_tile(lds, p.in[1], D_IN, kb * 64, nbk * 64, (bf16*)(p.ws + WS_WIN_T), DM, 0); continue; }
        r -= T_WIN;
        if (r < T_WOUT) { const int kb = r / (DM / 64), nbk = r % (DM / 64); tr_tile(lds, p.in[15], DM, kb * 64, nbk * 64, (bf16*)(p.ws + WS_WOUT_T), DM, 0); continue; }
        r -= T_WOUT;
        if (r < 12) { tr_tile(lds, p.in[6], D_RWKV, 0, r * 64, (bf16*)(p.ws + WS_WUPT), 64, 0); continue; }
        r -= 12;
        if (r < 12) { tr_tile(lds, p.in[8], D_RWKV, 0, r * 64, (bf16*)(p.ws + WS_AUPT), 64, 0); continue; }
        r -= 12;
        { tr_tile(lds, p.in[9], D_RWKV, (r / 12) * 64, (r % 12) * 64, (bf16*)(p.ws + WS_GUPT), 128, 0); }
    }
}
__device__ __forceinline__ void phase_convert_experts(const Params& p, unsigned char* lds, int bid, int nb) {
    constexpr int T_EG = NEXP * (DM / 64) * (DE / 64);
    constexpr int T_ED = NEXP * (DE / 64) * (DM / 64);
    constexpr int T_ALL = 2 * T_EG + T_ED;
    for (int it = bid; it < T_ALL; it += nb) {
        int r = it;
        if (r < 2 * T_EG) {
            const int half = r / T_EG; r -= half * T_EG;
            const int e = r / 64, q = r % 64, kb = q / 4, nbk = q % 4;
            tr_tile(lds, p.in[22 + half] + (size_t)e * DM * DE, DE, kb * 64, nbk * 64, (bf16*)(p.ws + WS_EGU) + (size_t)e * 512 * DM, DM, 1 + half); continue;
        }
        r -= 2 * T_EG;
        { const int e = r / 64, q = r % 64, kb = q / 16, nbk = q % 16;
          tr_tile(lds, p.in[24] + (size_t)e * DE * DM, DM, kb * 64, nbk * 64, (bf16*)(p.ws + WS_EDN) + (size_t)e * DM * DE, DE, 0); }
    }
}

struct EpiProj {
    bf16* O; int row0, col0;
    __device__ __forceinline__ void operator()(const f32x4 (&acc)[8][4], int wr, int wc, int fr, int fq) const {
#pragma unroll
        for (int m = 0; m < 8; ++m) {
            bf16* rp = O + (size_t)(row0 + wr * 128 + m * 16 + fr) * D_IN + col0 + wc * 64 + fq * 4;
#pragma unroll
            for (int n = 0; n < 4; ++n) { u32x2 v; v.x = pk2(acc[m][n][0], acc[m][n][1]); v.y = pk2(acc[m][n][2], acc[m][n][3]); *(u32x2*)(rp + n * 16) = v; }
        }
    }
};
__device__ __forceinline__ void phase_proj(const Params& p, unsigned char* lds, int bid, int nb) {
    const int tid = opaque_tid();
    const bf16* xb = (const bf16*)(p.ws + WS_XB); const bf16* wt = (const bf16*)(p.ws + WS_WIN_T);
    constexpr int NU = 64 * 11;
    for (int u = bid; u < NU; u += nb) {
        const int pm = u & 63, pn = u >> 6;
        unsigned arow[4], brow[4];
#pragma unroll
        for (int i = 0; i < 4; ++i) { const int pp = tid + NT * i, r = pp >> 3, s = pp & 7;
            arow[i] = (unsigned)((pm * 256 + r) * DM + s * 8); brow[i] = (unsigned)((pn * 256 + r) * DM + s * 8); }
        EpiProj e{(bf16*)(p.ws + WS_PROJ), pm * 256, pn * 256};
        gemm_unit(lds, xb, arow, wt, brow, DM, e);
    }
}

__device__ __forceinline__ void phase_pool(const Params& p, unsigned char* lds, int bid, int nb) {
    const int tid = opaque_tid();
    const bf16* proj = (const bf16*)(p.ws + WS_PROJ);
    bf16* mix = (bf16*)(p.ws + WS_MIXIN);
    const float* pw = p.in[2]; const float* ps = p.in[3];
    float* pbuf = (float*)lds;
    float* diff = (float*)(lds + 81920);
    for (int it = bid; it < NTOK / 64; it += nb) {
        const int tok0 = it * 64, t0 = tok0 % SEQ;
        __syncthreads();
        for (int e = tid; e < 79 * 64; e += NT) {
            const int r = e >> 6, c4 = e & 63; const int tt = t0 - 15 + r;
            float4 v = {0.f, 0.f, 0.f, 0.f};
            if (tt >= 0) { const u32x2 q = *(const u32x2*)(proj + (size_t)(tok0 - 15 + r) * D_IN + c4 * 4); v.x = bflo(q.x); v.y = bfhi(q.x); v.z = bflo(q.y); v.w = bfhi(q.y); }
            *(float4*)(pbuf + r * 256 + c4 * 4) = v;
        }
        __syncthreads();
        for (int e = tid; e < 64 * 256; e += NT) {
            const int t = e >> 8, c = e & 255, g = c >> 6, win = 2 << g;
            const int cnt = min(t0 + t + 1, win);
            float s = 0.f;
            for (int j = 0; j < cnt; ++j) s += pbuf[(t + 15 - j) * 256 + c];
            diff[t * 256 + c] = s / (float)cnt - pbuf[(t + 15) * 256 + c];
        }
        __syncthreads();
        {
            const int t = tid >> 3, dq = tid & 7;
#pragma unroll 1
            for (int g = 0; g < 4; ++g) {
                float o[8];
#pragma unroll
                for (int j = 0; j < 8; ++j) o[j] = 0.f;
                const float* wg = pw + (size_t)g * 4096 + dq * 8;
                for (int c = 0; c < 64; ++c) {
                    const float dv = diff[t * 256 + g * 64 + c];
                    const f32x4 w0 = *(const f32x4*)(wg + c * 64), w1 = *(const f32x4*)(wg + c * 64 + 4);
                    o[0] += dv * w0.x; o[1] += dv * w0.y; o[2] += dv * w0.z; o[3] += dv * w0.w;
                    o[4] += dv * w1.x; o[5] += dv * w1.y; o[6] += dv * w1.z; o[7] += dv * w1.w;
                }
                const float* sc = ps + g * 64 + dq * 8;
                u32x4 v; v.x = pk2(o[0] * sc[0], o[1] * sc[1]); v.y = pk2(o[2] * sc[2], o[3] * sc[3]); v.z = pk2(o[4] * sc[4], o[5] * sc[5]); v.w = pk2(o[6] * sc[6], o[7] * sc[7]);
                *(u32x4*)(mix + (size_t)(tok0 + t) * DM + g * 64 + dq * 8) = v;
            }
        }
    }
}

constexpr int SLOTB = 8192;
__device__ __forceinline__ int sw_off(int row, int col) { return row * 128 + ((((col >> 3) ^ ((row >> 1) & 7)) << 4) | ((col & 7) << 1)); }
#define MFMA32(a, b, c) __builtin_amdgcn_mfma_f32_32x32x16_bf16((a), (b), (c), 0, 0, 0)
#define MFMA16(a, b, c) __builtin_amdgcn_mfma_f32_16x16x32_bf16((a), (b), (c), 0, 0, 0)
__device__ __forceinline__ f32x16 mm32(const unsigned char* X, const int (&ox)[4], const unsigned char* Y, const int (&oy)[4], f32x16 acc) {
#pragma unroll
    for (int s = 0; s < 4; ++s) {
        const bf16x8 a = *(const bf16x8*)(X + ox[s]);
        const bf16x8 b = *(const bf16x8*)(Y + oy[s]);
        acc = MFMA32(a, b, acc);
    }
    return acc;
}
template <class F>
__device__ __forceinline__ void store_T(unsigned char* Z, const f32x16& d, int mt, int nt, int lane, const int (&ost)[4], F f) {
    const int n = nt * 32 + (lane & 31), h = lane >> 5;
#pragma unroll
    for (int g = 0; g < 4; ++g) {
        const int m0 = mt * 32 + 8 * g + 4 * h;
        u32x2 v; v.x = pk2(f(d[4 * g], m0, n), f(d[4 * g + 1], m0 + 1, n)); v.y = pk2(f(d[4 * g + 2], m0 + 2, n), f(d[4 * g + 3], m0 + 3, n));
        *(u32x2*)(Z + ost[g]) = v;
    }
}
__device__ __forceinline__ f32x16 zero16() { f32x16 z; for (int i = 0; i < 16; ++i) z[i] = 0.f; return z; }
__device__ __forceinline__ void st_b16(unsigned char* Z, int row, int col, float v) { *(unsigned short*)(Z + sw_off(row, col)) = (unsigned short)pk2(v, 0.f); }

__device__ __forceinline__ void phase_prep(const Params& p, unsigned char* lds, int bid, int nb) {
    const int tid = opaque_tid();
    const bf16* proj = (const bf16*)(p.ws + WS_PROJ);
    const float* mu = p.in[4]; const float* w0 = p.in[5]; const float* a0 = p.in[7];
    const float* k_k = p.in[10]; const float* k_a = p.in[11]; const float* r_k = p.in[12];
    const float* lnx_g = p.in[13]; const float* lnx_b = p.in[14];
    const bf16* wupT = (const bf16*)(p.ws + WS_WUPT); const bf16* aupT = (const bf16*)(p.ws + WS_AUPT); const bf16* gupT = (const bf16*)(p.ws + WS_GUPT);
    bf16* TC = (bf16*)(p.ws + WS_TC); bf16* GC = (bf16*)(p.ws + WS_GC); bf16* QC = (bf16*)(p.ws + WS_QC); bf16* OL = (bf16*)(p.ws + WS_OL);
    bf16* G1 = (bf16*)((unsigned char*)p.out + OUT_G1); bf16* G2 = (bf16*)((unsigned char*)p.out + OUT_G2);
#define SL(i) (lds + (i) * SLOTB)
    float* PC = (float*)(lds + 18 * SLOTB);
    for (int it = bid; it < BATCH * (SEQ / 64); it += nb) {
        const int b = it / (SEQ / 64), c = it % (SEQ / 64), tok0 = b * SEQ + c * 64;
        __syncthreads();
#pragma unroll 1
        for (int e = tid; e < 64 * 32; e += NT) {
            const int tt = e >> 5, k8 = (e & 31) * 8;
            const bf16* cur = proj + (size_t)(tok0 + tt) * D_IN + C_WD + k8;
            const u32x4 cv = *(const u32x4*)cur;
            u32x4 pv = {0u, 0u, 0u, 0u};
            if (c * 64 + tt > 0) pv = *(const u32x4*)(cur - D_IN);
            const f32x4 m0 = *(const f32x4*)(mu + C_WD - D_POOL + k8), m1 = *(const f32x4*)(mu + C_WD - D_POOL + k8 + 4);
            float z[8];
            z[0] = bflo(cv.x) + (bflo(pv.x) - bflo(cv.x)) * m0.x; z[1] = bfhi(cv.x) + (bfhi(pv.x) - bfhi(cv.x)) * m0.y;
            z[2] = bflo(cv.y) + (bflo(pv.y) - bflo(cv.y)) * m0.z; z[3] = bfhi(cv.y) + (bfhi(pv.y) - bfhi(cv.y)) * m0.w;
            z[4] = bflo(cv.z) + (bflo(pv.z) - bflo(cv.z)) * m1.x; z[5] = bfhi(cv.z) + (bfhi(pv.z) - bfhi(cv.z)) * m1.y;
            z[6] = bflo(cv.w) + (bflo(pv.w) - bflo(cv.w)) * m1.z; z[7] = bfhi(cv.w) + (bfhi(pv.w) - bfhi(cv.w)) * m1.w;
            if (k8 < 64) { for (int j = 0; j < 8; ++j) z[j] = 1.f - 2.f / (1.f + __expf(2.f * z[j])); }
            else if (k8 >= 128) { for (int j = 0; j < 8; ++j) z[j] = sigmoidf_(z[j]); }
            u32x4 o; o.x = pk2(z[0], z[1]); o.y = pk2(z[2], z[3]); o.z = pk2(z[4], z[5]); o.w = pk2(z[6], z[7]);
            *(u32x4*)(SL(k8 >> 6) + sw_off(tt, k8 & 63)) = o;
        }
#pragma unroll 1
        for (int h = 0; h < NH; ++h) {
            const size_t item = ((size_t)(b * (SEQ / 64) + c)) * NH + h;
            int tid_ = tid; asm volatile("" : "+v"(tid_));
            const int lane = tid_ & 63, w = __builtin_amdgcn_readfirstlane(tid_ >> 6);
            const int ts = w & 3, tl = lane & 15, q = lane >> 4, t = ts * 16 + tl;
            const int tmt = (w >> 1) & 1, tnt = w & 1, hh = lane >> 5;
            int offT[4], offR[4], offL[2], offM[2];
        #pragma unroll
            for (int r = 0; r < 4; ++r) { offT[r] = sw_off(4 * q + r, t); offR[r] = sw_off(t, r * 16 + 4 * q); }
        #pragma unroll
            for (int ks = 0; ks < 2; ++ks) { offL[ks] = sw_off(t, 32 * ks + 8 * q); offM[ks] = sw_off(tl, 32 * ks + 8 * q); }
            int oxm[4], oyn[4], ost[4];
        #pragma unroll
            for (int s_ = 0; s_ < 4; ++s_) { oxm[s_] = sw_off(tmt * 32 + (lane & 31), 16 * s_ + 8 * hh); oyn[s_] = sw_off(tnt * 32 + (lane & 31), 16 * s_ + 8 * hh); ost[s_] = sw_off(tnt * 32 + (lane & 31), tmt * 32 + 8 * s_ + 4 * hh); }
            __syncthreads();
            if (w < 4) {
                float lw[16], kap[16], bv[16], kn[16], rm[16];
                float vm[16];
                float nsq = 0.f, bon = 0.f;
                {
                    f32x4 accw[4], acca[4];
#pragma unroll
                    for (int m = 0; m < 4; ++m) { accw[m] = (f32x4){0.f, 0.f, 0.f, 0.f}; acca[m] = accw[m]; }
#pragma unroll
                    for (int ks = 0; ks < 2; ++ks) {
                        const bf16x8 bw = *(const bf16x8*)(SL(0) + offL[ks]);
                        const bf16x8 ba = *(const bf16x8*)(SL(1) + offL[ks]);
#pragma unroll
                        for (int m = 0; m < 4; ++m) {
                            const bf16x8 aw = *(const bf16x8*)(wupT + (size_t)(h * 64 + m * 16 + tl) * 64 + 32 * ks + 8 * q);
                            const bf16x8 aa = *(const bf16x8*)(aupT + (size_t)(h * 64 + m * 16 + tl) * 64 + 32 * ks + 8 * q);
                            accw[m] = MFMA16(aw, bw, accw[m]); acca[m] = MFMA16(aa, ba, acca[m]);
                        }
                    }
                    const bool hp = (c * 64 + t) > 0;
#pragma unroll
                    for (int m = 0; m < 4; ++m) {
                        const int ch0 = m * 16 + 4 * q, gch = h * 64 + ch0;
                        const bf16* cur = proj + (size_t)(tok0 + t) * D_IN + C_R + gch;
                        float zz[3][4];
#pragma unroll
                        for (int x = 0; x < 3; ++x) {
                            const u32x2 cv = *(const u32x2*)(cur + x * D_RWKV);
                            u32x2 pv = {0u, 0u};
                            if (hp) pv = *(const u32x2*)(cur + x * D_RWKV - D_IN);
                            const f32x4 mm = *(const f32x4*)(mu + (C_R - D_POOL) + x * D_RWKV + gch);
                            zz[x][0] = bflo(cv.x) + (bflo(pv.x) - bflo(cv.x)) * mm.x; zz[x][1] = bfhi(cv.x) + (bfhi(pv.x) - bfhi(cv.x)) * mm.y;
                            zz[x][2] = bflo(cv.y) + (bflo(pv.y) - bflo(cv.y)) * mm.z; zz[x][3] = bfhi(cv.y) + (bfhi(pv.y) - bfhi(cv.y)) * mm.w;
                        }
                        const f32x4 w0v = *(const f32x4*)(w0 + gch), a0v = *(const f32x4*)(a0 + gch), kkv = *(const f32x4*)(k_k + gch), kav = *(const f32x4*)(k_a + gch), rkv = *(const f32x4*)(r_k + gch);
#pragma unroll
                        for (int r = 0; r < 4; ++r) {
                            const int e = m * 4 + r;
                            const float xx = w0v[r] + accw[m][r];
                            const float sp = (-xx > 20.f) ? -xx : __logf(1.f + __expf(-xx));
                            lw[e] = -__expf(-sp - 0.5f);
                            const float av = sigmoidf_(a0v[r] + acca[m][r]);
                            rm[e] = zz[0][r]; vm[e] = zz[2][r];
                            kap[e] = zz[1][r] * kkv[r]; nsq += kap[e] * kap[e];
                            kn[e] = zz[1][r] * (1.f + (av - 1.f) * kav[r]);
                            bon += rm[e] * kn[e] * rkv[r];
                            bv[e] = av;
                        }
                        __builtin_amdgcn_sched_barrier(0);
                    }
                }
                nsq += __shfl_xor(nsq, 16); nsq += __shfl_xor(nsq, 32);
                bon += __shfl_xor(bon, 16); bon += __shfl_xor(bon, 32);
                const float inv = 1.f / fmaxf(sqrtf(nsq), 1e-12f);
#pragma unroll
                for (int m = 0; m < 4; ++m) {
#pragma unroll
                    for (int r = 0; r < 4; ++r) {
                        const int e = m * 4 + r;
                        kap[e] *= inv; bv[e] *= kap[e];
                        const unsigned hi = pk2(lw[e], 0.f) & 0xffffu; const float hif = __builtin_bit_cast(float, hi << 16);
                        *(unsigned short*)(SL(4) + offT[r] + m * 2048) = (unsigned short)hi;
                        *(unsigned short*)(SL(5) + offT[r] + m * 2048) = (unsigned short)pk2(lw[e] - hif, 0.f);
                        *(unsigned short*)(SL(13) + offT[r] + m * 2048) = (unsigned short)pk2(vm[e], 0.f);
                    }
                }
                {
                    f32x4 accg[4];
#pragma unroll
                    for (int m = 0; m < 4; ++m) accg[m] = (f32x4){0.f, 0.f, 0.f, 0.f};
#pragma unroll
                    for (int ks = 0; ks < 4; ++ks) {
                        const bf16x8 bg = *(const bf16x8*)(SL(2 + (ks >> 1)) + offL[ks & 1]);
#pragma unroll
                        for (int m = 0; m < 4; ++m) {
                            const bf16x8 ag = *(const bf16x8*)(gupT + (size_t)(h * 64 + m * 16 + tl) * 128 + 32 * ks + 8 * q);
                            accg[m] = MFMA16(ag, bg, accg[m]);
                        }
                    }
#pragma unroll
                    for (int m = 0; m < 4; ++m) {
                        const int ch0 = m * 16 + 4 * q, gch = h * 64 + ch0;
                        const f32x4 lg = *(const f32x4*)(lnx_g + gch), lb = *(const f32x4*)(lnx_b + gch);
                        u32x2 v1, v2;
                        v1.x = pk2(lg[0] * accg[m][0], lg[1] * accg[m][1]); v1.y = pk2(lg[2] * accg[m][2], lg[3] * accg[m][3]);
                        v2.x = pk2((lb[0] + bon * vm[m * 4]) * accg[m][0], (lb[1] + bon * vm[m * 4 + 1]) * accg[m][1]);
                        v2.y = pk2((lb[2] + bon * vm[m * 4 + 2]) * accg[m][2], (lb[3] + bon * vm[m * 4 + 3]) * accg[m][3]);
                        *(u32x2*)(G1 + item * 4096 + t * 64 + ch0) = v1;
                        *(u32x2*)(G2 + item * 4096 + t * 64 + ch0) = v2;
                    }
                }
                __syncthreads();
                f32x4 La[4], Ta[4];
#pragma unroll
                for (int m = 0; m < 4; ++m) { La[m] = (f32x4){0.f, 0.f, 0.f, 0.f}; Ta[m] = La[m]; }
#pragma unroll
                for (int ks = 0; ks < 2; ++ks) {
                    bf16x8 btri, bone;
#pragma unroll
                    for (int e = 0; e < 8; ++e) { const int s_ = 32 * ks + 8 * q + e; btri[e] = (short)((s_ <= t) ? 0x3F80 : 0); bone[e] = (short)0x3F80; }
#pragma unroll
                    for (int m = 0; m < 4; ++m) {
                        const bf16x8 ah = *(const bf16x8*)(SL(4) + offM[ks] + m * 2048);
                        const bf16x8 al = *(const bf16x8*)(SL(5) + offM[ks] + m * 2048);
                        La[m] = MFMA16(ah, btri, La[m]); La[m] = MFMA16(al, btri, La[m]);
                        Ta[m] = MFMA16(ah, bone, Ta[m]); Ta[m] = MFMA16(al, bone, Ta[m]);
                    }
                }
                __syncthreads();
#pragma unroll
                for (int m = 0; m < 4; ++m) {
                    const int ch0 = m * 16 + 4 * q;
                    float kt[4], rt[4], bt[4], kkt[4];
#pragma unroll
                    for (int r = 0; r < 4; ++r) {
                        const int e = m * 4 + r;
                        const float L = La[m][r], Lt = Ta[m][r];
                        const float eL = __expf(L), em = __expf(-L), eh = __expf(Lt - L), ex = __expf(L - lw[e]);
                        kt[r] = kap[e] * ex; rt[r] = rm[e] * eL; bt[r] = bv[e] * em; kkt[r] = kn[e] * em;
                        *(unsigned short*)(SL(9) + offT[r] + m * 2048) = (unsigned short)pk2(kt[r], 0.f);
                        *(unsigned short*)(SL(11) + offT[r] + m * 2048) = (unsigned short)pk2(bv[e] * eh, 0.f);
                        *(unsigned short*)(SL(12) + offT[r] + m * 2048) = (unsigned short)pk2(kn[e] * eh, 0.f);
                        if (t == 0) PC[ch0 + r] = __expf(Lt);
                    }
                    u32x2 v;
                    v.x = pk2(kt[0], kt[1]); v.y = pk2(kt[2], kt[3]); *(u32x2*)(SL(6) + offR[m]) = v;
                    v.x = pk2(bt[0], bt[1]); v.y = pk2(bt[2], bt[3]); *(u32x2*)(SL(7) + offR[m]) = v;
                    v.x = pk2(kkt[0], kkt[1]); v.y = pk2(kkt[2], kkt[3]); *(u32x2*)(SL(8) + offR[m]) = v;
                    v.x = pk2(rt[0], rt[1]); v.y = pk2(rt[2], rt[3]); *(u32x2*)(SL(10) + offR[m]) = v;
                }
            } else {
                __syncthreads();
                __syncthreads();
            }
            __syncthreads();
            f32x16 racc = zero16();
            {
                if (w < 4) {
                    f32x16 d = mm32(SL(7), oxm, SL(6), oyn, zero16());
                    const int tq_ = tnt * 32 + (lane & 31);
#pragma unroll
                    for (int r = 0; r < 16; ++r) { const int s_ = tmt * 32 + (r & 3) + 8 * (r >> 2) + 4 * hh; const float v = (s_ < tq_) ? d[r] : 0.f; d[r] = v; racc[r] = ((s_ == tq_) ? 1.f : 0.f) - v; }
                    store_T(SL(4), d, tmt, tnt, lane, ost, [](float v, int, int) { return v; });
                    store_T(SL(17), racc, tmt, tnt, lane, ost, [](float v, int, int) { return v; });
                } else {
                    f32x16 d = mm32(SL(6), oxm, SL(7), oyn, zero16());
                    store_T(SL(5), d, tmt, tnt, lane, ost, [](float v, int m, int n) { return (n < m) ? v : 0.f; });
                }
                if (w < 4) {
                    f32x16 d = mm32(SL(8), oxm, SL(6), oyn, zero16());
                    store_T(SL(14), d, tmt, tnt, lane, ost, [](float v, int m, int n) { return (m < n) ? v : 0.f; });
                } else {
                    f32x16 d = mm32(SL(7), oxm, SL(10), oyn, zero16());
                    store_T(SL(15), d, tmt, tnt, lane, ost, [](float v, int m, int n) { return (m <= n) ? v : 0.f; });
                }
                if (w < 4) {
                    f32x16 d = mm32(SL(8), oxm, SL(10), oyn, zero16());
                    store_T(SL(16), d, tmt, tnt, lane, ost, [](float v, int m, int n) { return (m <= n) ? v : 0.f; });
                }
            }
            __syncthreads();
            auto ident = [](float v, int, int) { return v; };
            if (w < 4) { f32x16 d = mm32(SL(5), oxm, SL(4), oyn, zero16()); store_T(SL(6), d, tmt, tnt, lane, ost, ident); }
            else       { f32x16 d = mm32(SL(4), oxm, SL(5), oyn, zero16()); store_T(SL(7), d, tmt, tnt, lane, ost, ident); }
            __syncthreads();
            if (w < 4) { f32x16 d = mm32(SL(7), oxm, SL(6), oyn, zero16()); store_T(SL(4), d, tmt, tnt, lane, ost, ident);
                         racc = mm32(SL(7), oxm, SL(17), oyn, racc); store_T(SL(8), racc, tmt, tnt, lane, ost, ident); }
            else       { f32x16 d = mm32(SL(6), oxm, SL(7), oyn, zero16()); store_T(SL(5), d, tmt, tnt, lane, ost, ident); }
            __syncthreads();
            if (w < 4) { f32x16 d = mm32(SL(5), oxm, SL(4), oyn, zero16()); store_T(SL(6), d, tmt, tnt, lane, ost, ident);
                         racc = mm32(SL(5), oxm, SL(8), oyn, racc); store_T(SL(17), racc, tmt, tnt, lane, ost, ident); }
            else       { f32x16 d = mm32(SL(4), oxm, SL(5), oyn, zero16()); store_T(SL(7), d, tmt, tnt, lane, ost, ident); }
            __syncthreads();
            if (w < 4) { f32x16 d = mm32(SL(7), oxm, SL(6), oyn, zero16()); store_T(SL(4), d, tmt, tnt, lane, ost, ident);
                         racc = mm32(SL(7), oxm, SL(17), oyn, racc); store_T(SL(8), racc, tmt, tnt, lane, ost, ident); }
            else       { f32x16 d = mm32(SL(6), oxm, SL(7), oyn, zero16()); store_T(SL(5), d, tmt, tnt, lane, ost, ident); }
            __syncthreads();
            if (w < 4) { racc = mm32(SL(5), oxm, SL(8), oyn, racc); store_T(SL(17), racc, tmt, tnt, lane, ost, ident); }
            else       { f32x16 d = mm32(SL(4), oxm, SL(5), oyn, zero16()); store_T(SL(7), d, tmt, tnt, lane, ost, ident); }
            __syncthreads();
            if (w < 4) { racc = mm32(SL(7), oxm, SL(17), oyn, racc); store_T(SL(8), racc, tmt, tnt, lane, ost, ident); }
            else       { f32x16 d = mm32(SL(14), oxm, SL(13), oyn, zero16()); store_T(SL(6), d, tmt, tnt, lane, ost, ident); }
            __syncthreads();
            if (w < 4) { f32x16 d = mm32(SL(8), oxm, SL(9), oyn, zero16()); store_T(SL(4), d, tmt, tnt, lane, ost, ident); }
            else       { f32x16 d = mm32(SL(8), oxm, SL(6), oyn, zero16()); store_T(SL(5), d, tmt, tnt, lane, ost, [](float v, int, int) { return -v; }); }
            __syncthreads();
            {
                const int ln = lane & 31;
                if (w < 4) {
                    const f32x16 d = mm32(SL(4), oxm, SL(11), oyn, zero16());
                    const int j = tnt * 32 + ln; const float pc = PC[j];
                    bf16* dst = TC + item * 4096;
#pragma unroll
                    for (int g = 0; g < 4; ++g) {
                        const int jp0 = tmt * 32 + 8 * g + 4 * hh;
                        float v[4];
#pragma unroll
                        for (int r = 0; r < 4; ++r) v[r] = ((jp0 + r == j) ? pc : 0.f) - d[4 * g + r];
                        const int a = jp0 >> 4, qp = (jp0 & 15) >> 2, s_ = a >> 1, m16 = j >> 4, L = (qp << 4) | (j & 15);
                        u32x2 o; o.x = pk2(v[0], v[1]); o.y = pk2(v[2], v[3]);
                        *(u32x2*)(dst + ((m16 * 2 + s_) * 64 + L) * 8 + (a & 1) * 4) = o;
                    }
                    const f32x16 d2 = mm32(SL(4), oxm, SL(15), oyn, zero16());
                    const int tq_ = tnt * 32 + ln;
                    bf16* dq = QC + item * 4096;
#pragma unroll
                    for (int g = 0; g < 4; ++g) {
                        const int j0 = tmt * 32 + 8 * g + 4 * hh;
                        const u32x2 rv = *(const u32x2*)(SL(10) + ost[g]);
                        u32x2 o; o.x = pk2(bflo(rv.x) - d2[4 * g], bfhi(rv.x) - d2[4 * g + 1]); o.y = pk2(bflo(rv.y) - d2[4 * g + 2], bfhi(rv.y) - d2[4 * g + 3]);
                        *(u32x2*)(dq + tq_ * 64 + j0) = o;
                    }
                } else {
                    f32x16 d = mm32(SL(11), oxm, SL(5), oyn, zero16());
                    d = mm32(SL(12), oxm, SL(13), oyn, d);
                    const int i = tnt * 32 + ln;
                    bf16* dg = GC + item * 4096;
#pragma unroll
                    for (int g = 0; g < 4; ++g) {
                        const int j0 = tmt * 32 + 8 * g + 4 * hh;
                        const int m16 = j0 >> 4, qq = (j0 & 15) >> 2, L = (qq << 4) | (i & 15), iq = i >> 4;
                        u32x2 o; o.x = pk2(d[4 * g], d[4 * g + 1]); o.y = pk2(d[4 * g + 2], d[4 * g + 3]);
                        *(u32x2*)(dg + (iq * 64 + L) * 16 + m16 * 4) = o;
                    }
                    f32x16 d2 = mm32(SL(5), oxm, SL(15), oyn, zero16());
                    d2 = mm32(SL(13), oxm, SL(16), oyn, d2);
                    bf16* dol = OL + item * 4096;
#pragma unroll
                    for (int g = 0; g < 4; ++g) {
                        u32x2 o; o.x = pk2(d2[4 * g], d2[4 * g + 1]); o.y = pk2(d2[4 * g + 2], d2[4 * g + 3]);
                        *(u32x2*)(dol + (((tnt * 2 + tmt) * 4 + g) * 64 + lane) * 4) = o;
                    }
                }
            }
        }
    }
#undef SL
}

__device__ __forceinline__ void phase_scan(const Params& p, int chain) {
    const int lane = opaque_tid() & 63;
    const int b = chain / 48, h = (chain >> 2) % NH, iq = chain & 3;
    const int q = lane >> 4, il = lane & 15;
    const bf16* TC = (const bf16*)(p.ws + WS_TC); const bf16* GC = (const bf16*)(p.ws + WS_GC); bf16* S0 = (bf16*)(p.ws + WS_S0);
    const size_t item0 = (size_t)(b * (SEQ / 64)) * NH + h;
    constexpr int PD = 4;
    u32x4 tq[PD][8]; u32x4 gq[PD][2];
    f32x4 S[4];
#pragma unroll
    for (int m = 0; m < 4; ++m) S[m] = (f32x4){0.f, 0.f, 0.f, 0.f};
#define P2_LOAD(d, cc) do { const bf16* tb = TC + (item0 + (size_t)(cc) * NH) * 4096; const bf16* gb = GC + (item0 + (size_t)(cc) * NH) * 4096 + (iq * 64 + lane) * 16; \
        _Pragma("unroll") for (int x = 0; x < 8; ++x) tq[d][x] = *(const u32x4*)(tb + (x * 64 + lane) * 8); \
        gq[d][0] = *(const u32x4*)(gb); gq[d][1] = *(const u32x4*)(gb + 8); } while (0)
#pragma unroll
    for (int d = 0; d < PD; ++d) P2_LOAD(d, d);
    for (int c = 0; c < SEQ / 64; c += PD) {
#pragma unroll
        for (int d = 0; d < PD; ++d) {
            const int cc = c + d;
            u32x4 sb0, sb1;
            sb0.x = pk2(S[0][0], S[0][1]); sb0.y = pk2(S[0][2], S[0][3]); sb0.z = pk2(S[1][0], S[1][1]); sb0.w = pk2(S[1][2], S[1][3]);
            sb1.x = pk2(S[2][0], S[2][1]); sb1.y = pk2(S[2][2], S[2][3]); sb1.z = pk2(S[3][0], S[3][1]); sb1.w = pk2(S[3][2], S[3][3]);
            bf16* so = S0 + (item0 + (size_t)cc * NH) * 4096 + (iq * 16 + il) * 64 + 4 * q;
            *(u32x2*)(so) = (u32x2){sb0.x, sb0.y}; *(u32x2*)(so + 16) = (u32x2){sb0.z, sb0.w};
            *(u32x2*)(so + 32) = (u32x2){sb1.x, sb1.y}; *(u32x2*)(so + 48) = (u32x2){sb1.z, sb1.w};
            f32x4 gi[4];
            gi[0] = (f32x4){bflo(gq[d][0].x), bfhi(gq[d][0].x), bflo(gq[d][0].y), bfhi(gq[d][0].y)};
            gi[1] = (f32x4){bflo(gq[d][0].z), bfhi(gq[d][0].z), bflo(gq[d][0].w), bfhi(gq[d][0].w)};
            gi[2] = (f32x4){bflo(gq[d][1].x), bfhi(gq[d][1].x), bflo(gq[d][1].y), bfhi(gq[d][1].y)};
            gi[3] = (f32x4){bflo(gq[d][1].z), bfhi(gq[d][1].z), bflo(gq[d][1].w), bfhi(gq[d][1].w)};
            const bf16x8 b0 = __builtin_bit_cast(bf16x8, sb0), b1 = __builtin_bit_cast(bf16x8, sb1);
#pragma unroll
            for (int m = 0; m < 4; ++m) {
                S[m] = MFMA16(__builtin_bit_cast(bf16x8, tq[d][2 * m]), b0, gi[m]);
                S[m] = MFMA16(__builtin_bit_cast(bf16x8, tq[d][2 * m + 1]), b1, S[m]);
            }
            if (cc + PD < SEQ / 64) P2_LOAD(d, cc + PD);
        }
    }
#undef P2_LOAD
}

__device__ __forceinline__ void phase_rwkv_out(const Params& p, int bid, int nb) {
    const int tid = opaque_tid(), lane = tid & 63, w = tid >> 6, ln = lane & 31, hh = lane >> 5;
    const bf16* S0 = (const bf16*)(p.ws + WS_S0); const bf16* QC = (const bf16*)(p.ws + WS_QC); const bf16* OL = (const bf16*)(p.ws + WS_OL);
    const bf16* G1 = (const bf16*)((const unsigned char*)p.out + OUT_G1); const bf16* G2 = (const bf16*)((const unsigned char*)p.out + OUT_G2);
    bf16* mix = (bf16*)(p.ws + WS_MIXIN);
    const int ntask = BATCH * (SEQ / 64) * NH * 2;
    for (int task = bid * 8 + w; task < ntask; task += nb * 8) {
        const int item = task >> 1, nt = task & 1;
        const int h = item % NH, bc = item / NH;
        const int tok0 = bc * 64;
        f32x16 acc[2];
#pragma unroll
        for (int mt = 0; mt < 2; ++mt)
#pragma unroll
            for (int g = 0; g < 4; ++g) {
                const u32x2 v = *(const u32x2*)(OL + (size_t)item * 4096 + (((nt * 2 + mt) * 4 + g) * 64 + lane) * 4);
                acc[mt][4 * g] = bflo(v.x); acc[mt][4 * g + 1] = bfhi(v.x); acc[mt][4 * g + 2] = bflo(v.y); acc[mt][4 * g + 3] = bfhi(v.y);
            }
        const int t = nt * 32 + ln;
#pragma unroll
        for (int s = 0; s < 4; ++s) {
            const bf16x8 bq = *(const bf16x8*)(QC + (size_t)item * 4096 + t * 64 + 16 * s + 8 * hh);
#pragma unroll
            for (int mt = 0; mt < 2; ++mt) {
                const bf16x8 a = *(const bf16x8*)(S0 + (size_t)item * 4096 + (mt * 32 + ln) * 64 + 16 * s + 8 * hh);
                acc[mt] = MFMA32(a, bq, acc[mt]);
            }
        }
        float s1 = 0.f;
#pragma unroll
        for (int mt = 0; mt < 2; ++mt)
#pragma unroll
            for (int r = 0; r < 16; ++r) s1 += acc[mt][r];
        s1 += __shfl_xor(s1, 32);
        const float mean = s1 * (1.f / 64.f);
        float s2 = 0.f;
#pragma unroll
        for (int mt = 0; mt < 2; ++mt)
#pragma unroll
            for (int r = 0; r < 16; ++r) { acc[mt][r] -= mean; s2 += acc[mt][r] * acc[mt][r]; }
        s2 += __shfl_xor(s2, 32);
        const float rstd = rsqrtf(s2 * (1.f / 64.f) + LNX_EPS);
#pragma unroll
        for (int mt = 0; mt < 2; ++mt)
#pragma unroll
            for (int g = 0; g < 4; ++g) {
                const int i0 = mt * 32 + 8 * g + 4 * hh;
                const u32x2 a1 = *(const u32x2*)(G1 + (size_t)item * 4096 + t * 64 + i0), a2 = *(const u32x2*)(G2 + (size_t)item * 4096 + t * 64 + i0);
                u32x2 o;
                o.x = pk2(acc[mt][4 * g] * rstd * bflo(a1.x) + bflo(a2.x), acc[mt][4 * g + 1] * rstd * bfhi(a1.x) + bfhi(a2.x));
                o.y = pk2(acc[mt][4 * g + 2] * rstd * bflo(a1.y) + bflo(a2.y), acc[mt][4 * g + 3] * rstd * bfhi(a1.y) + bfhi(a2.y));
                *(u32x2*)(mix + (size_t)(tok0 + t) * DM + D_POOL + h * 64 + i0) = o;
            }
    }
}

struct EpiOut {
    const float* X; float* O; int row0, col0;
    __device__ __forceinline__ void operator()(const f32x4 (&acc)[8][4], int wr, int wc, int fr, int fq) const {
#pragma unroll
        for (int m = 0; m < 8; ++m) {
            const size_t off = (size_t)(row0 + wr * 128 + m * 16 + fr) * DM + col0 + wc * 64 + fq * 4;
#pragma unroll
            for (int n = 0; n < 4; ++n) { const f32x4 xv = *(const f32x4*)(X + off + n * 16); *(f32x4*)(O + off + n * 16) = xv * ALPHA + acc[m][n]; }
        }
    }
};
__device__ __forceinline__ void phase_outproj(const Params& p, unsigned char* lds, int bid, int nb) {
    const int tid = opaque_tid();
    const bf16* a = (const bf16*)(p.ws + WS_MIXIN); const bf16* wt = (const bf16*)(p.ws + WS_WOUT_T);
    for (int u = bid; u < 256; u += nb) {
        const int pm = u & 63, pn = u >> 6;
        unsigned arow[4], brow[4];
#pragma unroll
        for (int i = 0; i < 4; ++i) { const int pp = tid + NT * i, r = pp >> 3, s = pp & 7;
            arow[i] = (unsigned)((pm * 256 + r) * DM + s * 8); brow[i] = (unsigned)((pn * 256 + r) * DM + s * 8); }
        EpiOut e{p.in[0], p.out, pm * 256, pn * 256};
        gemm_unit(lds, a, arow, wt, brow, DM, e);
    }
}

__device__ __forceinline__ void phase_ln_router(const Params& p, unsigned char* lds, int bid, int nb) {
    const int tid = opaque_tid(), lane = tid & 63, w = tid >> 6;
    float* RT = (float*)lds;
    const float* rg = p.in[18]; const float* re = p.in[20];
    __syncthreads();
    for (int e = tid; e < 36 * 1024; e += NT) { const int j = e >> 10, k = e & 1023; RT[e] = j < 4 ? rg[k * 4 + j] : re[k * 32 + (j - 4)]; }
    __syncthreads();
    const float* g1 = p.in[16]; const float* b1 = p.in[17]; const float* rgb = p.in[19]; const float* reb = p.in[21];
    float* H = p.out; bf16* hb = (bf16*)(p.ws + WS_HB);
    unsigned* cnt = (unsigned*)(p.ws + WS_CTL);
    int* list = (int*)(p.ws + WS_LIST); float* lwt = (float*)(p.ws + WS_LWT);
    for (int row = bid * 8 + w; row < NTOK; row += nb * 8) {
        float* hr = H + (size_t)row * DM;
        f32x4 v[4]; float s = 0.f;
#pragma unroll
        for (int j = 0; j < 4; ++j) { v[j] = *(const f32x4*)(hr + j * 256 + lane * 4); s += (v[j].x + v[j].y) + (v[j].z + v[j].w); }
        const float mean = wave_sum(s) * (1.f / DM);
        float s2 = 0.f;
#pragma unroll
        for (int j = 0; j < 4; ++j) { v[j] = v[j] - mean; s2 += (v[j].x * v[j].x + v[j].y * v[j].y) + (v[j].z * v[j].z + v[j].w * v[j].w); }
        const float rstd = rsqrtf(wave_sum(s2) * (1.f / DM) + LN_EPS);
#pragma unroll
        for (int j = 0; j < 4; ++j) {
            const f32x4 g = *(const f32x4*)(g1 + j * 256 + lane * 4), bb = *(const f32x4*)(b1 + j * 256 + lane * 4);
            v[j] = v[j] * rstd * g + bb;
            *(f32x4*)(hr + j * 256 + lane * 4) = v[j];
            u32x2 o; o.x = pk2(v[j].x, v[j].y); o.y = pk2(v[j].z, v[j].w);
            *(u32x2*)(hb + (size_t)row * DM + j * 256 + lane * 4) = o;
        }
        float gl[4];
#pragma unroll
        for (int q = 0; q < 4; ++q) {
            float a = 0.f;
#pragma unroll
            for (int j = 0; j < 4; ++j) { const f32x4 r = *(const f32x4*)(RT + q * 1024 + j * 256 + lane * 4); a += v[j].x * r.x + v[j].y * r.y + v[j].z * r.z + v[j].w * r.w; }
            gl[q] = wave_sum(a) + rgb[q];
        }
        int gi = 0; float gm = gl[0];
#pragma unroll
        for (int q = 1; q < 4; ++q) if (gl[q] > gm) { gm = gl[q]; gi = q; }
        float den = 0.f;
#pragma unroll
        for (int q = 0; q < 4; ++q) den += __expf(gl[q] - gm);
        const float gp = 1.f / den;
        gi = __builtin_amdgcn_readfirstlane(gi);
        float el[8];
#pragma unroll
        for (int q = 0; q < 8; ++q) el[q] = 0.f;
#pragma unroll 1
        for (int q = 0; q < 8; ++q) {
            const float* rt = RT + (4 + gi * 8 + q) * 1024 + lane * 4;
            float a = 0.f;
#pragma unroll
            for (int j = 0; j < 4; ++j) { const f32x4 r = *(const f32x4*)(rt + j * 256); a += v[j].x * r.x + v[j].y * r.y + v[j].z * r.z + v[j].w * r.w; }
            a = wave_sum(a) + reb[gi * 8 + q];
#pragma unroll
            for (int qq = 0; qq < 8; ++qq) el[qq] = (qq == q) ? a : el[qq];
        }
        int i0 = 0; float m0 = el[0];
#pragma unroll
        for (int q = 1; q < 8; ++q) if (el[q] > m0) { m0 = el[q]; i0 = q; }
        int i1 = -1; float m1 = -3.0e38f;
#pragma unroll
        for (int q = 0; q < 8; ++q) if (q != i0 && el[q] > m1) { m1 = el[q]; i1 = q; }
        const float e1 = __expf(m1 - m0);
        const float w0 = gp / (1.f + e1), w1 = gp * e1 / (1.f + e1);
        if (lane == 0) {
            const int ex0 = gi * 8 + i0, ex1 = gi * 8 + i1;
            const unsigned p0 = atomicAdd(&cnt[ex0], 1u), p1 = atomicAdd(&cnt[ex1], 1u);
            list[ex0 * NTOK + p0] = row * 2; lwt[ex0 * NTOK + p0] = w0;
            list[ex1 * NTOK + p1] = row * 2 + 1; lwt[ex1 * NTOK + p1] = w1;
        }
    }
}

__device__ __forceinline__ float siluf_(float x) { return x / (1.f + __expf(-x)); }
struct EpiGU {
    bf16* O; int row0, ct;
    __device__ __forceinline__ void operator()(const f32x4 (&acc)[8][4], int wr, int wc, int fr, int fq) const {
#pragma unroll
        for (int m = 0; m < 8; ++m) {
            bf16* rp = O + (size_t)(row0 + wr * 128 + m * 16 + fr) * DE + ct * 128 + wc * 32 + fq * 4;
#pragma unroll
            for (int n = 0; n < 2; ++n) {
                const f32x4 g = acc[m][n], u = acc[m][n + 2];
                u32x2 v; v.x = pk2(siluf_(g[0]) * u[0], siluf_(g[1]) * u[1]); v.y = pk2(siluf_(g[2]) * u[2], siluf_(g[3]) * u[3]);
                *(u32x2*)(rp + n * 16) = v;
            }
        }
    }
};
struct EpiDown {
    bf16* YS; const int* list; const float* lwt; int pos0, nvalid, col0;
    __device__ __forceinline__ void operator()(const f32x4 (&acc)[8][4], int wr, int wc, int fr, int fq) const {
#pragma unroll
        for (int m = 0; m < 8; ++m) {
            const int r = wr * 128 + m * 16 + fr;
            if (r < nvalid) {
                const int ts = list[pos0 + r]; const float wt = lwt[pos0 + r];
                bf16* rp = YS + (size_t)ts * DM + col0 + wc * 64 + fq * 4;
#pragma unroll
                for (int n = 0; n < 4; ++n) { u32x2 v; v.x = pk2(acc[m][n][0] * wt, acc[m][n][1] * wt); v.y = pk2(acc[m][n][2] * wt, acc[m][n][3] * wt); *(u32x2*)(rp + n * 16) = v; }
            }
        }
    }
};
__device__ __forceinline__ bool find_tile(const unsigned* cnt, int tile, int& e, int& rt, int& hoff) {
    int acc = 0;
    for (int i = 0; i < NEXP; ++i) { const int nt = ((int)cnt[i] + 255) >> 8; if (tile < acc + nt) { e = i; rt = tile - acc; hoff = (acc + rt) * 256; return true; } acc += nt; }
    return false;
}
__device__ __forceinline__ void phase_gateup(const Params& p, unsigned char* lds, int bid, int nb) {
    const int tid = opaque_tid();
    const unsigned* cnt = (const unsigned*)(p.ws + WS_CTL);
    const int* list = (const int*)(p.ws + WS_LIST);
    const bf16* hb = (const bf16*)(p.ws + WS_HB);
    for (int u = bid;; u += nb) {
        const int tile = u >> 1, ct = u & 1; int e, rt, hoff;
        if (!find_tile(cnt, tile, e, rt, hoff)) break;
        const int nv = min(256, (int)cnt[e] - rt * 256);
        unsigned arow[4], brow[4];
        const bf16* wt = (const bf16*)(p.ws + WS_EGU) + (size_t)e * 512 * DM + (size_t)ct * 256 * DM;
#pragma unroll
        for (int i = 0; i < 4; ++i) { const int pp = tid + NT * i, r = pp >> 3, s = pp & 7;
            const int tok = r < nv ? (list[e * NTOK + rt * 256 + r] >> 1) : 0;
            arow[i] = (unsigned)(tok * DM + s * 8); brow[i] = (unsigned)(r * DM + s * 8); }
        EpiGU ep{(bf16*)(p.ws + WS_HID), hoff, ct};
        gemm_unit(lds, hb, arow, wt, brow, DM, ep);
    }
}
__device__ __forceinline__ void phase_down(const Params& p, unsigned char* lds, int bid, int nb) {
    const int tid = opaque_tid();
    const unsigned* cnt = (const unsigned*)(p.ws + WS_CTL);
    const bf16* hid = (const bf16*)(p.ws + WS_HID);
    for (int u = bid;; u += nb) {
        const int tile = u >> 2, ct = u & 3; int e, rt, hoff;
        if (!find_tile(cnt, tile, e, rt, hoff)) break;
        const int nv = min(256, (int)cnt[e] - rt * 256);
        unsigned arow[4], brow[4];
        const bf16* wt = (const bf16*)(p.ws + WS_EDN) + (size_t)e * DM * DE + (size_t)ct * 256 * DE;
#pragma unroll
        for (int i = 0; i < 4; ++i) { const int pp = tid + NT * i, r = pp >> 3, s = pp & 7;
            arow[i] = (unsigned)((hoff + r) * DE + s * 8); brow[i] = (unsigned)(r * DE + s * 8); }
        EpiDown ep{(bf16*)(p.ws + WS_YS), (const int*)(p.ws + WS_LIST) + e * NTOK, (const float*)(p.ws + WS_LWT) + e * NTOK, rt * 256, nv, ct * 256};
        gemm_unit(lds, hid, arow, wt, brow, DE, ep);
    }
}

__device__ __forceinline__ void phase_final(const Params& p, int bid, int nb) {
    const int tid = opaque_tid(), lane = tid & 63, w = tid >> 6;
    const float* g2 = p.in[25]; const float* b2 = p.in[26];
    const bf16* ys = (const bf16*)(p.ws + WS_YS);
    for (int row = bid * 8 + w; row < NTOK; row += nb * 8) {
        float* hr = p.out + (size_t)row * DM;
        f32x4 v[4]; float s = 0.f;
#pragma unroll
        for (int j = 0; j < 4; ++j) {
            const f32x4 hv = *(const f32x4*)(hr + j * 256 + lane * 4);
            const u32x2 y0 = *(const u32x2*)(ys + (size_t)row * 2 * DM + j * 256 + lane * 4), y1 = *(const u32x2*)(ys + (size_t)row * 2 * DM + DM + j * 256 + lane * 4);
            v[j].x = hv.x * ALPHA + (bflo(y0.x) + bflo(y1.x)); v[j].y = hv.y * ALPHA + (bfhi(y0.x) + bfhi(y1.x));
            v[j].z = hv.z * ALPHA + (bflo(y0.y) + bflo(y1.y)); v[j].w = hv.w * ALPHA + (bfhi(y0.y) + bfhi(y1.y));
            s += (v[j].x + v[j].y) + (v[j].z + v[j].w);
        }
        const float mean = wave_sum(s) * (1.f / DM);
        float s2 = 0.f;
#pragma unroll
        for (int j = 0; j < 4; ++j) { v[j] = v[j] - mean; s2 += (v[j].x * v[j].x + v[j].y * v[j].y) + (v[j].z * v[j].z + v[j].w * v[j].w); }
        const float rstd = rsqrtf(wave_sum(s2) * (1.f / DM) + LN_EPS);
#pragma unroll
        for (int j = 0; j < 4; ++j) {
            const f32x4 g = *(const f32x4*)(g2 + j * 256 + lane * 4), bb = *(const f32x4*)(b2 + j * 256 + lane * 4);
            *(f32x4*)(hr + j * 256 + lane * 4) = v[j] * rstd * g + bb;
        }
    }
}

__global__ void __launch_bounds__(NT) fwd_kernel(Params p) {
    extern __shared__ __attribute__((aligned(16))) unsigned char lds[];
    cg::grid_group grid = cg::this_grid();
    const int bid = blockIdx.x, nb = gridDim.x;
    phase_convert(p, lds, bid, nb);
    grid.sync();
    phase_proj(p, lds, bid, nb);
    grid.sync();
    phase_prep(p, lds, bid, nb);
    phase_pool(p, lds, bid, nb);
    grid.sync();
    if (bid < 96) { if (threadIdx.x < 64) phase_scan(p, bid); }
    else phase_convert_experts(p, lds, bid - 96, nb - 96);
    grid.sync();
    phase_rwkv_out(p, bid, nb);
    grid.sync();
    phase_outproj(p, lds, bid, nb);
    grid.sync();
    phase_ln_router(p, lds, bid, nb);
    grid.sync();
    phase_gateup(p, lds, bid, nb);
    grid.sync();
    phase_down(p, lds, bid, nb);
    grid.sync();
    phase_final(p, bid, nb);
}

extern "C" void kernel_launch(void* const* d_in, const int* in_sizes, int n_in, void* d_out, int out_size, void* d_ws, size_t ws_size, hipStream_t stream) {
    static int grid_blocks = 0;
    if (!grid_blocks) {
        if (hipFuncSetAttribute((const void*)fwd_kernel, hipFuncAttributeMaxDynamicSharedMemorySize, LDS_BYTES) != hipSuccess) fprintf(stderr, "hipFuncSetAttribute failed\n");
        int dev = 0, cus = 0, per_cu = 0;
        (void)hipGetDevice(&dev);
        (void)hipDeviceGetAttribute(&cus, hipDeviceAttributeMultiprocessorCount, dev);
        (void)hipOccupancyMaxActiveBlocksPerMultiprocessor(&per_cu, (const void*)fwd_kernel, NT, LDS_BYTES);
        if (per_cu < 1) { fprintf(stderr, "occupancy query says %d blocks/CU\n", per_cu); per_cu = 1; }
        grid_blocks = cus;
        fprintf(stderr, "grid %d (cus %d, per_cu %d)\n", grid_blocks, cus, per_cu);
    }
    Params p{};
    for (int i = 0; i < 27; ++i) p.in[i] = (const float*)d_in[i];
    p.out = (float*)d_out; p.ws = (unsigned char*)d_ws;
    (void)hipMemsetAsync((char*)d_ws + WS_CTL, 0, 4096, stream);
    void* args[] = {&p};
    hipError_t e = hipLaunchCooperativeKernel((const void*)fwd_kernel, dim3(grid_blocks), dim3(NT), args, LDS_BYTES, stream);
    if (e != hipSuccess) fprintf(stderr, "cooperative launch failed: %s (grid %d)\n", hipGetErrorString(e), grid_blocks);
}
```

```cpp
#include <hip/hip_runtime.h>
#include <hip/hip_cooperative_groups.h>
#include <cstdio>
#include <cstdint>
namespace cg = cooperative_groups;

typedef unsigned short bf16;
typedef short bf16x8 __attribute__((ext_vector_type(8)));
typedef float f32x4 __attribute__((ext_vector_type(4)));
typedef unsigned u32x4 __attribute__((ext_vector_type(4)));
typedef unsigned u32x2 __attribute__((ext_vector_type(2)));
typedef float f32x16 __attribute__((ext_vector_type(16)));
typedef float f32x2 __attribute__((ext_vector_type(2)));
typedef __bf16 bf16x2_t __attribute__((ext_vector_type(2)));

constexpr int DM = 1024, BATCH = 2, SEQ = 8192, NTOK = BATCH * SEQ;
constexpr int D_POOL = 256, D_RWKV = 768, NH = 12, HS = 64;
constexpr int D_IN = 2816;
constexpr int C_R = 256, C_K = 1024, C_V = 1792, C_WD = 2560, C_AD = 2624, C_GD = 2688;
constexpr int NEXP = 32, DE = 256;
constexpr float LN_EPS = 1e-5f, LNX_EPS = 64e-5f;
constexpr float ALPHA = 1.189207115002721f;
constexpr int NT = 512;
constexpr int BAR_LDS_OFF = 147968;
constexpr int CW_BAR = 4096;
constexpr int LDS_BYTES = 150528;

constexpr size_t MiB = 1u << 20;
constexpr size_t WS_CTL = 0;
constexpr size_t WS_WIN_T = 1 * MiB;
constexpr size_t WS_WOUT_T = 7 * MiB;
constexpr size_t WS_WUPT = 9 * MiB;
constexpr size_t WS_AUPT = 9 * MiB + 128 * 1024;
constexpr size_t WS_GUPT = 9 * MiB + 256 * 1024;
constexpr size_t WS_XB = 10 * MiB;
constexpr size_t WS_TC = 10 * MiB;
constexpr size_t WS_MIXIN = 42 * MiB;
constexpr size_t WS_PROJ = 74 * MiB;
constexpr size_t WS_EGU = 74 * MiB;
constexpr size_t WS_EDN = 106 * MiB;
constexpr size_t WS_S0 = 122 * MiB;
constexpr size_t WS_GC = 162 * MiB;
constexpr size_t WS_QC = 186 * MiB;
constexpr size_t WS_OL = 210 * MiB;
constexpr size_t OUT_G1 = 0;
constexpr size_t OUT_G2 = 24 * MiB;
constexpr size_t WS_YS = 122 * MiB;
constexpr size_t WS_HB = 186 * MiB;
constexpr size_t WS_LIST = 218 * MiB;
constexpr size_t WS_LWT = 220 * MiB;
constexpr size_t WS_HID = 222 * MiB;

struct Params {
    const float* in[27];
    float* out;
    unsigned char* ws;
    int phase;
    int pad;
};

__device__ __forceinline__ unsigned f2bf(float f) { unsigned u = __builtin_bit_cast(unsigned, f); return (u + 0x7fffu + ((u >> 16) & 1u)) >> 16; }
__device__ __forceinline__ unsigned pk2(float lo, float hi) { f32x2 v = {lo, hi}; bf16x2_t b = __builtin_convertvector(v, bf16x2_t); return __builtin_bit_cast(unsigned, b); }
__device__ __forceinline__ float bf2f(unsigned short b) { return __builtin_bit_cast(float, (unsigned)b << 16); }
__device__ __forceinline__ float bflo(unsigned u) { return __builtin_bit_cast(float, u << 16); }
__device__ __forceinline__ float bfhi(unsigned u) { return __builtin_bit_cast(float, u & 0xffff0000u); }
__device__ __forceinline__ float wave_sum(float v) {
#pragma unroll
    for (int o = 1; o < 64; o <<= 1) v += __shfl_xor(v, o);
    return v;
}
__device__ __forceinline__ int opaque_tid() { int t = threadIdx.x; asm volatile("" : "+v"(t)); return t; }
__device__ __forceinline__ float sigmoidf_(float x) { return 1.f / (1.f + __expf(-x)); }

template <class Epi>
__device__ __forceinline__ void gemm_unit(unsigned char* lds, const bf16* __restrict__ abase, const unsigned (&arow)[4], const bf16* __restrict__ bbase, const unsigned (&brow)[4], int K, Epi& epi) {
    const int tid = opaque_tid(), lane = tid & 63, w = tid >> 6, wr = w >> 2, wc = w & 3;
    const int srow = tid >> 3, sslot = tid & 7;
    const int st_off = srow * 128 + ((sslot ^ ((srow >> 1) & 7)) << 4);
    const int fr = lane & 15, fq = lane >> 4, x = fr >> 1;
    int offA[2], offB[2];
#pragma unroll
    for (int s = 0; s < 2; ++s) {
        const int slot = (s * 4 + fq) ^ x;
        offA[s] = (wr * 128 + fr) * 128 + (slot << 4);
        offB[s] = 32768 + (wc * 64 + fr) * 128 + (slot << 4);
    }
    f32x4 acc[8][4];
#pragma unroll
    for (int m = 0; m < 8; ++m)
#pragma unroll
        for (int n = 0; n < 4; ++n) acc[m][n] = (f32x4){0.f, 0.f, 0.f, 0.f};
    u32x4 ra[4], rb[4];
#pragma unroll
    for (int i = 0; i < 4; ++i) { ra[i] = *(const u32x4*)(abase + arow[i]); rb[i] = *(const u32x4*)(bbase + brow[i]); }
    __syncthreads();
#pragma unroll
    for (int i = 0; i < 4; ++i) { *(u32x4*)(lds + st_off + i * 8192) = ra[i]; *(u32x4*)(lds + 32768 + st_off + i * 8192) = rb[i]; }
    __syncthreads();
    const int KT = K >> 6;
    for (int kt = 0; kt < KT; ++kt) {
        unsigned char* cur = lds + (kt & 1) * 65536;
        unsigned char* nxt = lds + ((kt + 1) & 1) * 65536;
        if (kt + 1 < KT) {
#pragma unroll
            for (int i = 0; i < 4; ++i) { ra[i] = *(const u32x4*)(abase + arow[i] + (kt + 1) * 64); rb[i] = *(const u32x4*)(bbase + brow[i] + (kt + 1) * 64); }
        }
#pragma unroll
        for (int s = 0; s < 2; ++s) {
            bf16x8 bfr[4];
#pragma unroll
            for (int n = 0; n < 4; ++n) bfr[n] = *(const bf16x8*)(cur + offB[s] + n * 2048);
#pragma unroll
            for (int m = 0; m < 8; ++m) {
                const bf16x8 afr = *(const bf16x8*)(cur + offA[s] + m * 2048);
#pragma unroll
                for (int n = 0; n < 4; ++n) acc[m][n] = __builtin_amdgcn_mfma_f32_16x16x32_bf16(bfr[n], afr, acc[m][n], 0, 0, 0);
            }
        }
        if (kt + 1 < KT) {
#pragma unroll
            for (int i = 0; i < 4; ++i) { *(u32x4*)(nxt + st_off + i * 8192) = ra[i]; *(u32x4*)(nxt + 32768 + st_off + i * 8192) = rb[i]; }
        }
        __syncthreads();
    }
    epi(acc, wr, wc, fr, fq);
}

__device__ __forceinline__ int gu_row(int c, int half) { return ((c >> 7) << 8) + (((c >> 5) & 3) << 6) + (half << 5) + (c & 31); }
__device__ __forceinline__ void tr_tile(unsigned char* lds, const float* __restrict__ src, int ldsrc, int k0, int n0, bf16* __restrict__ dst, int ldd, int mode) {
    float* t = (float*)lds;
    const int tid = opaque_tid();
    __syncthreads();
#pragma unroll
    for (int i = 0; i < 8; ++i) { const int e = tid + i * NT, k = e >> 6, n = e & 63; t[k * 65 + n] = src[(size_t)(k0 + k) * ldsrc + n0 + n]; }
    __syncthreads();
    const int n = tid >> 3, kc = tid & 7;
    const float* s = t + (kc * 8) * 65 + n;
    u32x4 o; o.x = pk2(s[0], s[65]); o.y = pk2(s[2 * 65], s[3 * 65]); o.z = pk2(s[4 * 65], s[5 * 65]); o.w = pk2(s[6 * 65], s[7 * 65]);
    const int nn = n0 + n;
    const int drow = mode == 0 ? nn : gu_row(nn, mode - 1);
    *(u32x4*)(dst + (size_t)drow * ldd + k0 + kc * 8) = o;
}

__device__ __forceinline__ void phase_convert(const Params& p, unsigned char* lds, int bid, int nb) {
    const int tid = opaque_tid();
    {
        const float* x = p.in[0]; bf16* xb = (bf16*)(p.ws + WS_XB);
        const size_t n8 = (size_t)NTOK * DM / 8;
        for (size_t i = (size_t)bid * NT + tid; i < n8; i += (size_t)nb * NT) {
            const f32x4 a = *(const f32x4*)(x + i * 8), b = *(const f32x4*)(x + i * 8 + 4);
            u32x4 o; o.x = pk2(a.x, a.y); o.y = pk2(a.z, a.w); o.z = pk2(b.x, b.y); o.w = pk2(b.z, b.w);
            *(u32x4*)(xb + i * 8) = o;
        }
    }
    constexpr int T_WIN = (DM / 64) * (D_IN / 64);
    constexpr int T_WOUT = (DM / 64) * (DM / 64);
    constexpr int T_ALL = T_WIN + T_WOUT + 12 + 12 + 24;
    for (int it = bid; it < T_ALL; it += nb) {
        int r = it;
        if (r < T_WIN) { const int kb = r / (D_IN / 64), nbk = r % (D_IN / 64); tr_tile(lds, p.in[1], D_IN, kb * 64, nbk * 64, (bf16*)(p.ws + WS_WIN_T), DM, 0); continue; }
        r -= T_WIN;
        if (r < T_WOUT) { const int kb = r / (DM / 64), nbk = r % (DM / 64); tr_tile(lds, p.in[15], DM, kb * 64, nbk * 64, (bf16*)(p.ws + WS_WOUT_T), DM, 0); continue; }
        r -= T_WOUT;
        if (r < 12) { tr_tile(lds, p.in[6], D_RWKV, 0, r * 64, (bf16*)(p.ws + WS_WUPT), 64, 0); continue; }
        r -= 12;
        if (r < 12) { tr_tile(lds, p.in[8], D_RWKV, 0, r * 64, (bf16*)(p.ws + WS_AUPT), 64, 0); continue; }
        r -= 12;
        { tr_tile(lds, p.in[9], D_RWKV, (r / 12) * 64, (r % 12) * 64, (bf16*)(p.ws + WS_GUPT), 128, 0); }
    }
}
__device__ __forceinline__ void phase_convert_experts(const Params& p, unsigned char* lds, int bid, int nb) {
    constexpr int T_EG = NEXP * (DM / 64) * (DE / 64);
    constexpr int T_ED = NEXP * (DE / 64) * (DM / 64);
    constexpr int T_ALL = 2 * T_EG + T_ED;
    for (int it = bid; it < T_ALL; it += nb) {
        int r = it;
        if (r < 2 * T_EG) {
            const int half = r / T_EG; r -= half * T_EG;
            const int e = r / 64, q = r % 64, kb = q / 4, nbk = q % 4;
            tr_tile(lds, p.in[22 + half] + (size_t)e * DM * DE, DE, kb * 64, nbk * 64, (bf16*)(p.ws + WS_EGU) + (size_t)e * 512 * DM, DM, 1 + half); continue;
        }
        r -= 2 * T_EG;
        { const int e = r / 64, q = r % 64, kb = q / 16, nbk = q % 16;
          tr_tile(lds, p.in[24] + (size_t)e * DE * DM, DM, kb * 64, nbk * 64, (bf16*)(p.ws + WS_EDN) + (size_t)e * DM * DE, DE, 0); }
    }
}

struct EpiProj {
    bf16* O; int row0, col0;
    __device__ __forceinline__ void operator()(const f32x4 (&acc)[8][4], int wr, int wc, int fr, int fq) const {
#pragma unroll
        for (int m = 0; m < 8; ++m) {
            bf16* rp = O + (size_t)(row0 + wr * 128 + m * 16 + fr) * D_IN + col0 + wc * 64 + fq * 4;
#pragma unroll
            for (int n = 0; n < 4; ++n) { u32x2 v; v.x = pk2(acc[m][n][0], acc[m][n][1]); v.y = pk2(acc[m][n][2], acc[m][n][3]); *(u32x2*)(rp + n * 16) = v; }
        }
    }
};
__device__ __forceinline__ void phase_proj(const Params& p, unsigned char* lds, int bid, int nb) {
    const int tid = opaque_tid();
    const bf16* xb = (const bf16*)(p.ws + WS_XB); const bf16* wt = (const bf16*)(p.ws + WS_WIN_T);
    constexpr int NU = 64 * 11;
    for (int u = bid; u < NU; u += nb) {
        const int pm = u & 63, pn = u >> 6;
        unsigned arow[4], brow[4];
#pragma unroll
        for (int i = 0; i < 4; ++i) { const int pp = tid + NT * i, r = pp >> 3, s = pp & 7;
            arow[i] = (unsigned)((pm * 256 + r) * DM + s * 8); brow[i] = (unsigned)((pn * 256 + r) * DM + s * 8); }
        EpiProj e{(bf16*)(p.ws + WS_PROJ), pm * 256, pn * 256};
        gemm_unit(lds, xb, arow, wt, brow, DM, e);
    }
}

__device__ __forceinline__ void phase_pool(const Params& p, unsigned char* lds, int bid, int nb) {
    const int tid = opaque_tid();
    const bf16* proj = (const bf16*)(p.ws + WS_PROJ);
    bf16* mix = (bf16*)(p.ws + WS_MIXIN);
    const float* pw = p.in[2]; const float* ps = p.in[3];
    float* pbuf = (float*)lds;
    float* diff = (float*)(lds + 81920);
    for (int it = bid; it < NTOK / 64; it += nb) {
        const int tok0 = it * 64, t0 = tok0 % SEQ;
        __syncthreads();
        for (int e = tid; e < 79 * 64; e += NT) {
            const int r = e >> 6, c4 = e & 63; const int tt = t0 - 15 + r;
            float4 v = {0.f, 0.f, 0.f, 0.f};
            if (tt >= 0) { const u32x2 q = *(const u32x2*)(proj + (size_t)(tok0 - 15 + r) * D_IN + c4 * 4); v.x = bflo(q.x); v.y = bfhi(q.x); v.z = bflo(q.y); v.w = bfhi(q.y); }
            *(float4*)(pbuf + r * 256 + c4 * 4) = v;
        }
        __syncthreads();
        for (int e = tid; e < 64 * 256; e += NT) {
            const int t = e >> 8, c = e & 255, g = c >> 6, win = 2 << g;
            const int cnt = min(t0 + t + 1, win);
            float s = 0.f;
            for (int j = 0; j < cnt; ++j) s += pbuf[(t + 15 - j) * 256 + c];
            diff[t * 256 + c] = s / (float)cnt - pbuf[(t + 15) * 256 + c];
        }
        __syncthreads();
        {
            const int t = tid >> 3, dq = tid & 7;
#pragma unroll 1
            for (int g = 0; g < 4; ++g) {
                float o[8];
#pragma unroll
                for (int j = 0; j < 8; ++j) o[j] = 0.f;
                const float* wg = pw + (size_t)g * 4096 + dq * 8;
                for (int c = 0; c < 64; ++c) {
                    const float dv = diff[t * 256 + g * 64 + c];
                    const f32x4 w0 = *(const f32x4*)(wg + c * 64), w1 = *(const f32x4*)(wg + c * 64 + 4);
                    o[0] += dv * w0.x; o[1] += dv * w0.y; o[2] += dv * w0.z; o[3] += dv * w0.w;
                    o[4] += dv * w1.x; o[5] += dv * w1.y; o[6] += dv * w1.z; o[7] += dv * w1.w;
                }
                const float* sc = ps + g * 64 + dq * 8;
                u32x4 v; v.x = pk2(o[0] * sc[0], o[1] * sc[1]); v.y = pk2(o[2] * sc[2], o[3] * sc[3]); v.z = pk2(o[4] * sc[4], o[5] * sc[5]); v.w = pk2(o[6] * sc[6], o[7] * sc[7]);
                *(u32x4*)(mix + (size_t)(tok0 + t) * DM + g * 64 + dq * 8) = v;
            }
        }
    }
}

constexpr int SLOTB = 8192;
__device__ __forceinline__ int sw_off(int row, int col) { return row * 128 + ((((col >> 3) ^ ((row >> 1) & 7)) << 4) | ((col & 7) << 1)); }
#define MFMA32(a, b, c) __builtin_amdgcn_mfma_f32_32x32x16_bf16((a), (b), (c), 0, 0, 0)
#define MFMA16(a, b, c) __builtin_amdgcn_mfma_f32_16x16x32_bf16((a), (b), (c), 0, 0, 0)
__device__ __forceinline__ f32x16 mm32(const unsigned char* X, const int (&ox)[4], const unsigned char* Y, const int (&oy)[4], f32x16 acc) {
#pragma unroll
    for (int s = 0; s < 4; ++s) {
        const bf16x8 a = *(const bf16x8*)(X + ox[s]);
        const bf16x8 b = *(const bf16x8*)(Y + oy[s]);
        acc = MFMA32(a, b, acc);
    }
    return acc;
}
template <class F>
__device__ __forceinline__ void store_T(unsigned char* Z, const f32x16& d, int mt, int nt, int lane, const int (&ost)[4], F f) {
    const int n = nt * 32 + (lane & 31), h = lane >> 5;
#pragma unroll
    for (int g = 0; g < 4; ++g) {
        const int m0 = mt * 32 + 8 * g + 4 * h;
        u32x2 v; v.x = pk2(f(d[4 * g], m0, n), f(d[4 * g + 1], m0 + 1, n)); v.y = pk2(f(d[4 * g + 2], m0 + 2, n), f(d[4 * g + 3], m0 + 3, n));
        *(u32x2*)(Z + ost[g]) = v;
    }
}
__device__ __forceinline__ f32x16 zero16() { f32x16 z; for (int i = 0; i < 16; ++i) z[i] = 0.f; return z; }
__device__ __forceinline__ void st_b16(unsigned char* Z, int row, int col, float v) { *(unsigned short*)(Z + sw_off(row, col)) = (unsigned short)pk2(v, 0.f); }

__device__ __forceinline__ void phase_prep(const Params& p, unsigned char* lds, int bid, int nb) {
    const int tid = opaque_tid();
    const bf16* proj = (const bf16*)(p.ws + WS_PROJ);
    const float* mu = p.in[4]; const float* w0 = p.in[5]; const float* a0 = p.in[7];
    const float* k_k = p.in[10]; const float* k_a = p.in[11]; const float* r_k = p.in[12];
    const float* lnx_g = p.in[13]; const float* lnx_b = p.in[14];
    const bf16* wupT = (const bf16*)(p.ws + WS_WUPT); const bf16* aupT = (const bf16*)(p.ws + WS_AUPT); const bf16* gupT = (const bf16*)(p.ws + WS_GUPT);
    bf16* TC = (bf16*)(p.ws + WS_TC); bf16* GC = (bf16*)(p.ws + WS_GC); bf16* QC = (bf16*)(p.ws + WS_QC); bf16* OL = (bf16*)(p.ws + WS_OL);
    bf16* G1 = (bf16*)((unsigned char*)p.out + OUT_G1); bf16* G2 = (bf16*)((unsigned char*)p.out + OUT_G2);
#define SL(i) (lds + (i) * SLOTB)
    float* PC = (float*)(lds + 18 * SLOTB);
    for (int it = bid; it < BATCH * (SEQ / 64); it += nb) {
        const int b = it / (SEQ / 64), c = it % (SEQ / 64), tok0 = b * SEQ + c * 64;
        __syncthreads();
#pragma unroll 1
        for (int e = tid; e < 64 * 32; e += NT) {
            const int tt = e >> 5, k8 = (e & 31) * 8;
            const bf16* cur = proj + (size_t)(tok0 + tt) * D_IN + C_WD + k8;
            const u32x4 cv = *(const u32x4*)cur;
            u32x4 pv = {0u, 0u, 0u, 0u};
            if (c * 64 + tt > 0) pv = *(const u32x4*)(cur - D_IN);
            const f32x4 m0 = *(const f32x4*)(mu + C_WD - D_POOL + k8), m1 = *(const f32x4*)(mu + C_WD - D_POOL + k8 + 4);
            float z[8];
            z[0] = bflo(cv.x) + (bflo(pv.x) - bflo(cv.x)) * m0.x; z[1] = bfhi(cv.x) + (bfhi(pv.x) - bfhi(cv.x)) * m0.y;
            z[2] = bflo(cv.y) + (bflo(pv.y) - bflo(cv.y)) * m0.z; z[3] = bfhi(cv.y) + (bfhi(pv.y) - bfhi(cv.y)) * m0.w;
            z[4] = bflo(cv.z) + (bflo(pv.z) - bflo(cv.z)) * m1.x; z[5] = bfhi(cv.z) + (bfhi(pv.z) - bfhi(cv.z)) * m1.y;
            z[6] = bflo(cv.w) + (bflo(pv.w) - bflo(cv.w)) * m1.z; z[7] = bfhi(cv.w) + (bfhi(pv.w) - bfhi(cv.w)) * m1.w;
            if (k8 < 64) { for (int j = 0; j < 8; ++j) z[j] = 1.f - 2.f / (1.f + __expf(2.f * z[j])); }
            else if (k8 >= 128) { for (int j = 0; j < 8; ++j) z[j] = sigmoidf_(z[j]); }
            u32x4 o; o.x = pk2(z[0], z[1]); o.y = pk2(z[2], z[3]); o.z = pk2(z[4], z[5]); o.w = pk2(z[6], z[7]);
            *(u32x4*)(SL(k8 >> 6) + sw_off(tt, k8 & 63)) = o;
        }
#pragma unroll 1
        for (int h = 0; h < NH; ++h) {
            const size_t item = ((size_t)(b * (SEQ / 64) + c)) * NH + h;
            int tid_ = tid; asm volatile("" : "+v"(tid_));
            const int lane = tid_ & 63, w = __builtin_amdgcn_readfirstlane(tid_ >> 6);
            const int ts = w & 3, tl = lane & 15, q = lane >> 4, t = ts * 16 + tl;
            const int tmt = (w >> 1) & 1, tnt = w & 1, hh = lane >> 5;
            int offT[4], offR[4], offL[2], offM[2];
        #pragma unroll
            for (int r = 0; r < 4; ++r) { offT[r] = sw_off(4 * q + r, t); offR[r] = sw_off(t, r * 16 + 4 * q); }
        #pragma unroll
            for (int ks = 0; ks < 2; ++ks) { offL[ks] = sw_off(t, 32 * ks + 8 * q); offM[ks] = sw_off(tl, 32 * ks + 8 * q); }
            int oxm[4], oyn[4], ost[4];
        #pragma unroll
            for (int s_ = 0; s_ < 4; ++s_) { oxm[s_] = sw_off(tmt * 32 + (lane & 31), 16 * s_ + 8 * hh); oyn[s_] = sw_off(tnt * 32 + (lane & 31), 16 * s_ + 8 * hh); ost[s_] = sw_off(tnt * 32 + (lane & 31), tmt * 32 + 8 * s_ + 4 * hh); }
            __syncthreads();
            if (w < 4) {
                float lw[16], kap[16], bv[16], kn[16], rm[16];
                float vm[16];
                float nsq = 0.f, bon = 0.f;
                {
                    f32x4 accw[4], acca[4];
#pragma unroll
                    for (int m = 0; m < 4; ++m) { accw[m] = (f32x4){0.f, 0.f, 0.f, 0.f}; acca[m] = accw[m]; }
#pragma unroll
                    for (int ks = 0; ks < 2; ++ks) {
                        const bf16x8 bw = *(const bf16x8*)(SL(0) + offL[ks]);
                        const bf16x8 ba = *(const bf16x8*)(SL(1) + offL[ks]);
#pragma unroll
                        for (int m = 0; m < 4; ++m) {
                            const bf16x8 aw = *(const bf16x8*)(wupT + (size_t)(h * 64 + m * 16 + tl) * 64 + 32 * ks + 8 * q);
                            const bf16x8 aa = *(const bf16x8*)(aupT + (size_t)(h * 64 + m * 16 + tl) * 64 + 32 * ks + 8 * q);
                            accw[m] = MFMA16(aw, bw, accw[m]); acca[m] = MFMA16(aa, ba, acca[m]);
                        }
                    }
                    const bool hp = (c * 64 + t) > 0;
#pragma unroll
                    for (int m = 0; m < 4; ++m) {
                        const int ch0 = m * 16 + 4 * q, gch = h * 64 + ch0;
                        const bf16* cur = proj + (size_t)(tok0 + t) * D_IN + C_R + gch;
                        float zz[3][4];
#pragma unroll
                        for (int x = 0; x < 3; ++x) {
                            const u32x2 cv = *(const u32x2*)(cur + x * D_RWKV);
                            u32x2 pv = {0u, 0u};
                            if (hp) pv = *(const u32x2*)(cur + x * D_RWKV - D_IN);
                            const f32x4 mm = *(const f32x4*)(mu + (C_R - D_POOL) + x * D_RWKV + gch);
                            zz[x][0] = bflo(cv.x) + (bflo(pv.x) - bflo(cv.x)) * mm.x; zz[x][1] = bfhi(cv.x) + (bfhi(pv.x) - bfhi(cv.x)) * mm.y;
                            zz[x][2] = bflo(cv.y) + (bflo(pv.y) - bflo(cv.y)) * mm.z; zz[x][3] = bfhi(cv.y) + (bfhi(pv.y) - bfhi(cv.y)) * mm.w;
                        }
                        const f32x4 w0v = *(const f32x4*)(w0 + gch), a0v = *(const f32x4*)(a0 + gch), kkv = *(const f32x4*)(k_k + gch), kav = *(const f32x4*)(k_a + gch), rkv = *(const f32x4*)(r_k + gch);
#pragma unroll
                        for (int r = 0; r < 4; ++r) {
                            const int e = m * 4 + r;
                            const float xx = w0v[r] + accw[m][r];
                            const float sp = (-xx > 20.f) ? -xx : __logf(1.f + __expf(-xx));
                            lw[e] = -__expf(-sp - 0.5f);
                            const float av = sigmoidf_(a0v[r] + acca[m][r]);
                            rm[e] = zz[0][r]; vm[e] = zz[2][r];
                            kap[e] = zz[1][r] * kkv[r]; nsq += kap[e] * kap[e];
                            kn[e] = zz[1][r] * (1.f + (av - 1.f) * kav[r]);
                            bon += rm[e] * kn[e] * rkv[r];
                            bv[e] = av;
                        }
                        __builtin_amdgcn_sched_barrier(0);
                    }
                }
                nsq += __shfl_xor(nsq, 16); nsq += __shfl_xor(nsq, 32);
                bon += __shfl_xor(bon, 16); bon += __shfl_xor(bon, 32);
                const float inv = 1.f / fmaxf(sqrtf(nsq), 1e-12f);
#pragma unroll
                for (int m = 0; m < 4; ++m) {
#pragma unroll
                    for (int r = 0; r < 4; ++r) {
                        const int e = m * 4 + r;
                        kap[e] *= inv; bv[e] *= kap[e];
                        const unsigned hi = pk2(lw[e], 0.f) & 0xffffu; const float hif = __builtin_bit_cast(float, hi << 16);
                        *(unsigned short*)(SL(4) + offT[r] + m * 2048) = (unsigned short)hi;
                        *(unsigned short*)(SL(5) + offT[r] + m * 2048) = (unsigned short)pk2(lw[e] - hif, 0.f);
                        *(unsigned short*)(SL(13) + offT[r] + m * 2048) = (unsigned short)pk2(vm[e], 0.f);
                    }
                }
                {
                    f32x4 accg[4];
#pragma unroll
                    for (int m = 0; m < 4; ++m) accg[m] = (f32x4){0.f, 0.f, 0.f, 0.f};
#pragma unroll
                    for (int ks = 0; ks < 4; ++ks) {
                        const bf16x8 bg = *(const bf16x8*)(SL(2 + (ks >> 1)) + offL[ks & 1]);
#pragma unroll
                        for (int m = 0; m < 4; ++m) {
                            const bf16x8 ag = *(const bf16x8*)(gupT + (size_t)(h * 64 + m * 16 + tl) * 128 + 32 * ks + 8 * q);
                            accg[m] = MFMA16(ag, bg, accg[m]);
                        }
                    }
#pragma unroll
                    for (int m = 0; m < 4; ++m) {
                        const int ch0 = m * 16 + 4 * q, gch = h * 64 + ch0;
                        const f32x4 lg = *(const f32x4*)(lnx_g + gch), lb = *(const f32x4*)(lnx_b + gch);
                        u32x2 v1, v2;
                        v1.x = pk2(lg[0] * accg[m][0], lg[1] * accg[m][1]); v1.y = pk2(lg[2] * accg[m][2], lg[3] * accg[m][3]);
                        v2.x = pk2((lb[0] + bon * vm[m * 4]) * accg[m][0], (lb[1] + bon * vm[m * 4 + 1]) * accg[m][1]);
                        v2.y = pk2((lb[2] + bon * vm[m * 4 + 2]) * accg[m][2], (lb[3] + bon * vm[m * 4 + 3]) * accg[m][3]);
                        *(u32x2*)(G1 + item * 4096 + t * 64 + ch0) = v1;
                        *(u32x2*)(G2 + item * 4096 + t * 64 + ch0) = v2;
                    }
                }
                __syncthreads();
                f32x4 La[4], Ta[4];
#pragma unroll
                for (int m = 0; m < 4; ++m) { La[m] = (f32x4){0.f, 0.f, 0.f, 0.f}; Ta[m] = La[m]; }
#pragma unroll
                for (int ks = 0; ks < 2; ++ks) {
                    bf16x8 btri, bone;
#pragma unroll
                    for (int e = 0; e < 8; ++e) { const int s_ = 32 * ks + 8 * q + e; btri[e] = (short)((s_ <= t) ? 0x3F80 : 0); bone[e] = (short)0x3F80; }
#pragma unroll
                    for (int m = 0; m < 4; ++m) {
                        const bf16x8 ah = *(const bf16x8*)(SL(4) + offM[ks] + m * 2048);
                        const bf16x8 al = *(const bf16x8*)(SL(5) + offM[ks] + m * 2048);
                        La[m] = MFMA16(ah, btri, La[m]); La[m] = MFMA16(al, btri, La[m]);
                        Ta[m] = MFMA16(ah, bone, Ta[m]); Ta[m] = MFMA16(al, bone, Ta[m]);
                    }
                }
                __syncthreads();
#pragma unroll
                for (int m = 0; m < 4; ++m) {
                    const int ch0 = m * 16 + 4 * q;
                    float kt[4], rt[4], bt[4], kkt[4];
#pragma unroll
                    for (int r = 0; r < 4; ++r) {
                        const int e = m * 4 + r;
                        const float L = La[m][r], Lt = Ta[m][r];
                        const float eL = __expf(L), em = __expf(-L), eh = __expf(Lt - L), ex = __expf(L - lw[e]);
                        kt[r] = kap[e] * ex; rt[r] = rm[e] * eL; bt[r] = bv[e] * em; kkt[r] = kn[e] * em;
                        *(unsigned short*)(SL(9) + offT[r] + m * 2048) = (unsigned short)pk2(kt[r], 0.f);
                        *(unsigned short*)(SL(11) + offT[r] + m * 2048) = (unsigned short)pk2(bv[e] * eh, 0.f);
                        *(unsigned short*)(SL(12) + offT[r] + m * 2048) = (unsigned short)pk2(kn[e] * eh, 0.f);
                        if (t == 0) PC[ch0 + r] = __expf(Lt);
                    }
                    u32x2 v;
                    v.x = pk2(kt[0], kt[1]); v.y = pk2(kt[2], kt[3]); *(u32x2*)(SL(6) + offR[m]) = v;
                    v.x = pk2(bt[0], bt[1]); v.y = pk2(bt[2], bt[3]); *(u32x2*)(SL(7) + offR[m]) = v;
                    v.x = pk2(kkt[0], kkt[1]); v.y = pk2(kkt[2], kkt[3]); *(u32x2*)(SL(8) + offR[m]) = v;
                    v.x = pk2(rt[0], rt[1]); v.y = pk2(rt[2], rt[3]); *(u32x2*)(SL(10) + offR[m]) = v;
                }
            } else {
                __syncthreads();
                __syncthreads();
            }
            __syncthreads();
            f32x16 racc = zero16();
            {
                if (w < 4) {
                    f32x16 d = mm32(SL(7), oxm, SL(6), oyn, zero16());
                    const int tq_ = tnt * 32 + (lane & 31);
#pragma unroll
                    for (int r = 0; r < 16; ++r) { const int s_ = tmt * 32 + (r & 3) + 8 * (r >> 2) + 4 * hh; const float v = (s_ < tq_) ? d[r] : 0.f; d[r] = v; racc[r] = ((s_ == tq_) ? 1.f : 0.f) - v; }
                    store_T(SL(4), d, tmt, tnt, lane, ost, [](float v, int, int) { return v; });
                    store_T(SL(17), racc, tmt, tnt, lane, ost, [](float v, int, int) { return v; });
                } else {
                    f32x16 d = mm32(SL(6), oxm, SL(7), oyn, zero16());
                    store_T(SL(5), d, tmt, tnt, lane, ost, [](float v, int m, int n) { return (n < m) ? v : 0.f; });
                }
                if (w < 4) {
                    f32x16 d = mm32(SL(8), oxm, SL(6), oyn, zero16());
                    store_T(SL(14), d, tmt, tnt, lane, ost, [](float v, int m, int n) { return (m < n) ? v : 0.f; });
                } else {
                    f32x16 d = mm32(SL(7), oxm, SL(10), oyn, zero16());
                    store_T(SL(15), d, tmt, tnt, lane, ost, [](float v, int m, int n) { return (m <= n) ? v : 0.f; });
                }
                if (w < 4) {
                    f32x16 d = mm32(SL(8), oxm, SL(10), oyn, zero16());
                    store_T(SL(16), d, tmt, tnt, lane, ost, [](float v, int m, int n) { return (m <= n) ? v : 0.f; });
                }
            }
            __syncthreads();
            auto ident = [](float v, int, int) { return v; };
            if (w < 4) { f32x16 d = mm32(SL(5), oxm, SL(4), oyn, zero16()); store_T(SL(6), d, tmt, tnt, lane, ost, ident); }
            else       { f32x16 d = mm32(SL(4), oxm, SL(5), oyn, zero16()); store_T(SL(7), d, tmt, tnt, lane, ost, ident); }
            __syncthreads();
            if (w < 4) { f32x16 d = mm32(SL(7), oxm, SL(6), oyn, zero16()); store_T(SL(4), d, tmt, tnt, lane, ost, ident);
                         racc = mm32(SL(7), oxm, SL(17), oyn, racc); store_T(SL(8), racc, tmt, tnt, lane, ost, ident); }
            else       { f32x16 d = mm32(SL(6), oxm, SL(7), oyn, zero16()); store_T(SL(5), d, tmt, tnt, lane, ost, ident); }
            __syncthreads();
            if (w < 4) { f32x16 d = mm32(SL(5), oxm, SL(4), oyn, zero16()); store_T(SL(6), d, tmt, tnt, lane, ost, ident);
                         racc = mm32(SL(5), oxm, SL(8), oyn, racc); store_T(SL(17), racc, tmt, tnt, lane, ost, ident); }
            else       { f32x16 d = mm32(SL(4), oxm, SL(5), oyn, zero16()); store_T(SL(7), d, tmt, tnt, lane, ost, ident); }
            __syncthreads();
            if (w < 4) { f32x16 d = mm32(SL(7), oxm, SL(6), oyn, zero16()); store_T(SL(4), d, tmt, tnt, lane, ost, ident);
                         racc = mm32(SL(7), oxm, SL(17), oyn, racc); store_T(SL(8), racc, tmt, tnt, lane, ost, ident); }
            else       { f32x16 d = mm32(SL(6), oxm, SL(7), oyn, zero16()); store_T(SL(5), d, tmt, tnt, lane, ost, ident); }
            __syncthreads();
            if (w < 4) { racc = mm32(SL(5), oxm, SL(8), oyn, racc); store_T(SL(17), racc, tmt, tnt, lane, ost, ident); }
            else       { f32x16 d = mm32(SL(4), oxm, SL(5), oyn, zero16()); store_T(SL(7), d, tmt, tnt, lane, ost, ident); }
            __syncthreads();
            if (w < 4) { racc = mm32(SL(7), oxm, SL(17), oyn, racc); store_T(SL(8), racc, tmt, tnt, lane, ost, ident); }
            else       { f32x16 d = mm32(SL(14), oxm, SL(13), oyn, zero16()); store_T(SL(6), d, tmt, tnt, lane, ost, ident); }
            __syncthreads();
            if (w < 4) { f32x16 d = mm32(SL(8), oxm, SL(9), oyn, zero16()); store_T(SL(4), d, tmt, tnt, lane, ost, ident); }
            else       { f32x16 d = mm32(SL(8), oxm, SL(6), oyn, zero16()); store_T(SL(5), d, tmt, tnt, lane, ost, [](float v, int, int) { return -v; }); }
            __syncthreads();
            {
                const int ln = lane & 31;
                if (w < 4) {
                    const f32x16 d = mm32(SL(4), oxm, SL(11), oyn, zero16());
                    const int j = tnt * 32 + ln; const float pc = PC[j];
                    bf16* dst = TC + item * 4096;
#pragma unroll
                    for (int g = 0; g < 4; ++g) {
                        const int jp0 = tmt * 32 + 8 * g + 4 * hh;
                        float v[4];
#pragma unroll
                        for (int r = 0; r < 4; ++r) v[r] = ((jp0 + r == j) ? pc : 0.f) - d[4 * g + r];
                        const int a = jp0 >> 4, qp = (jp0 & 15) >> 2, s_ = a >> 1, m16 = j >> 4, L = (qp << 4) | (j & 15);
                        u32x2 o; o.x = pk2(v[0], v[1]); o.y = pk2(v[2], v[3]);
                        *(u32x2*)(dst + ((m16 * 2 + s_) * 64 + L) * 8 + (a & 1) * 4) = o;
                    }
                    const f32x16 d2 = mm32(SL(4), oxm, SL(15), oyn, zero16());
                    const int tq_ = tnt * 32 + ln;
                    bf16* dq = QC + item * 4096;
#pragma unroll
                    for (int g = 0; g < 4; ++g) {
                        const int j0 = tmt * 32 + 8 * g + 4 * hh;
                        const u32x2 rv = *(const u32x2*)(SL(10) + ost[g]);
                        u32x2 o; o.x = pk2(bflo(rv.x) - d2[4 * g], bfhi(rv.x) - d2[4 * g + 1]); o.y = pk2(bflo(rv.y) - d2[4 * g + 2], bfhi(rv.y) - d2[4 * g + 3]);
                        *(u32x2*)(dq + tq_ * 64 + j0) = o;
                    }
                } else {
                    f32x16 d = mm32(SL(11), oxm, SL(5), oyn, zero16());
                    d = mm32(SL(12), oxm, SL(13), oyn, d);
                    const int i = tnt * 32 + ln;
                    bf16* dg = GC + item * 4096;
#pragma unroll
                    for (int g = 0; g < 4; ++g) {
                        const int j0 = tmt * 32 + 8 * g + 4 * hh;
                        const int m16 = j0 >> 4, qq = (j0 & 15) >> 2, L = (qq << 4) | (i & 15), iq = i >> 4;
                        u32x2 o; o.x = pk2(d[4 * g], d[4 * g + 1]); o.y = pk2(d[4 * g + 2], d[4 * g + 3]);
                        *(u32x2*)(dg + (iq * 64 + L) * 16 + m16 * 4) = o;
                    }
                    f32x16 d2 = mm32(SL(5), oxm, SL(15), oyn, zero16());
                    d2 = mm32(SL(13), oxm, SL(16), oyn, d2);
                    bf16* dol = OL + item * 4096;
#pragma unroll
                    for (int g = 0; g < 4; ++g) {
                        u32x2 o; o.x = pk2(d2[4 * g], d2[4 * g + 1]); o.y = pk2(d2[4 * g + 2], d2[4 * g + 3]);
                        *(u32x2*)(dol + (((tnt * 2 + tmt) * 4 + g) * 64 + lane) * 4) = o;
                    }
                }
            }
        }
    }
#undef SL
}

__device__ __forceinline__ void phase_scan(const Params& p, int chain) {
    const int lane = opaque_tid() & 63;
    const int b = chain / 48, h = (chain >> 2) % NH, iq = chain & 3;
    const int q = lane >> 4, il = lane & 15;
    const bf16* TC = (const bf16*)(p.ws + WS_TC); const bf16* GC = (const bf16*)(p.ws + WS_GC); bf16* S0 = (bf16*)(p.ws + WS_S0);
    const size_t item0 = (size_t)(b * (SEQ / 64)) * NH + h;
    constexpr int PD = 4;
    u32x4 tq[PD][8]; u32x4 gq[PD][2];
    f32x4 S[4];
#pragma unroll
    for (int m = 0; m < 4; ++m) S[m] = (f32x4){0.f, 0.f, 0.f, 0.f};
#define P2_LOAD(d, cc) do { const bf16* tb = TC + (item0 + (size_t)(cc) * NH) * 4096; const bf16* gb = GC + (item0 + (size_t)(cc) * NH) * 4096 + (iq * 64 + lane) * 16; \
        _Pragma("unroll") for (int x = 0; x < 8; ++x) tq[d][x] = *(const u32x4*)(tb + (x * 64 + lane) * 8); \
        gq[d][0] = *(const u32x4*)(gb); gq[d][1] = *(const u32x4*)(gb + 8); } while (0)
#pragma unroll
    for (int d = 0; d < PD; ++d) P2_LOAD(d, d);
    for (int c = 0; c < SEQ / 64; c += PD) {
#pragma unroll
        for (int d = 0; d < PD; ++d) {
            const int cc = c + d;
            u32x4 sb0, sb1;
            sb0.x = pk2(S[0][0], S[0][1]); sb0.y = pk2(S[0][2], S[0][3]); sb0.z = pk2(S[1][0], S[1][1]); sb0.w = pk2(S[1][2], S[1][3]);
            sb1.x = pk2(S[2][0], S[2][1]); sb1.y = pk2(S[2][2], S[2][3]); sb1.z = pk2(S[3][0], S[3][1]); sb1.w = pk2(S[3][2], S[3][3]);
            bf16* so = S0 + (item0 + (size_t)cc * NH) * 4096 + (iq * 16 + il) * 64 + 4 * q;
            *(u32x2*)(so) = (u32x2){sb0.x, sb0.y}; *(u32x2*)(so + 16) = (u32x2){sb0.z, sb0.w};
            *(u32x2*)(so + 32) = (u32x2){sb1.x, sb1.y}; *(u32x2*)(so + 48) = (u32x2){sb1.z, sb1.w};
            f32x4 gi[4];
            gi[0] = (f32x4){bflo(gq[d][0].x), bfhi(gq[d][0].x), bflo(gq[d][0].y), bfhi(gq[d][0].y)};
            gi[1] = (f32x4){bflo(gq[d][0].z), bfhi(gq[d][0].z), bflo(gq[d][0].w), bfhi(gq[d][0].w)};
            gi[2] = (f32x4){bflo(gq[d][1].x), bfhi(gq[d][1].x), bflo(gq[d][1].y), bfhi(gq[d][1].y)};
            gi[3] = (f32x4){bflo(gq[d][1].z), bfhi(gq[d][1].z), bflo(gq[d][1].w), bfhi(gq[d][1].w)};
            const bf16x8 b0 = __builtin_bit_cast(bf16x8, sb0), b1 = __builtin_bit_cast(bf16x8, sb1);
#pragma unroll
            for (int m = 0; m < 4; ++m) {
                S[m] = MFMA16(__builtin_bit_cast(bf16x8, tq[d][2 * m]), b0, gi[m]);
                S[m] = MFMA16(__builtin_bit_cast(bf16x8, tq[d][2 * m + 1]), b1, S[m]);
            }
            if (cc + PD < SEQ / 64) P2_LOAD(d, cc + PD);
        }
    }
#undef P2_LOAD
}

__device__ __forceinline__ void phase_rwkv_out(const Params& p, int bid, int nb) {
    const int tid = opaque_tid(), lane = tid & 63, w = tid >> 6, ln = lane & 31, hh = lane >> 5;
    const bf16* S0 = (const bf16*)(p.ws + WS_S0); const bf16* QC = (const bf16*)(p.ws + WS_QC); const bf16* OL = (const bf16*)(p.ws + WS_OL);
    const bf16* G1 = (const bf16*)((const unsigned char*)p.out + OUT_G1); const bf16* G2 = (const bf16*)((const unsigned char*)p.out + OUT_G2);
    bf16* mix = (bf16*)(p.ws + WS_MIXIN);
    const int ntask = BATCH * (SEQ / 64) * NH * 2;
    for (int task = bid * 8 + w; task < ntask; task += nb * 8) {
        const int item = task >> 1, nt = task & 1;
        const int h = item % NH, bc = item / NH;
        const int tok0 = bc * 64;
        f32x16 acc[2];
#pragma unroll
        for (int mt = 0; mt < 2; ++mt)
#pragma unroll
            for (int g = 0; g < 4; ++g) {
                const u32x2 v = *(const u32x2*)(OL + (size_t)item * 4096 + (((nt * 2 + mt) * 4 + g) * 64 + lane) * 4);
                acc[mt][4 * g] = bflo(v.x); acc[mt][4 * g + 1] = bfhi(v.x); acc[mt][4 * g + 2] = bflo(v.y); acc[mt][4 * g + 3] = bfhi(v.y);
            }
        const int t = nt * 32 + ln;
#pragma unroll
        for (int s = 0; s < 4; ++s) {
            const bf16x8 bq = *(const bf16x8*)(QC + (size_t)item * 4096 + t * 64 + 16 * s + 8 * hh);
#pragma unroll
            for (int mt = 0; mt < 2; ++mt) {
                const bf16x8 a = *(const bf16x8*)(S0 + (size_t)item * 4096 + (mt * 32 + ln) * 64 + 16 * s + 8 * hh);
                acc[mt] = MFMA32(a, bq, acc[mt]);
            }
        }
        float s1 = 0.f;
#pragma unroll
        for (int mt = 0; mt < 2; ++mt)
#pragma unroll
            for (int r = 0; r < 16; ++r) s1 += acc[mt][r];
        s1 += __shfl_xor(s1, 32);
        const float mean = s1 * (1.f / 64.f);
        float s2 = 0.f;
#pragma unroll
        for (int mt = 0; mt < 2; ++mt)
#pragma unroll
            for (int r = 0; r < 16; ++r) { acc[mt][r] -= mean; s2 += acc[mt][r] * acc[mt][r]; }
        s2 += __shfl_xor(s2, 32);
        const float rstd = rsqrtf(s2 * (1.f / 64.f) + LNX_EPS);
#pragma unroll
        for (int mt = 0; mt < 2; ++mt)
#pragma unroll
            for (int g = 0; g < 4; ++g) {
                const int i0 = mt * 32 + 8 * g + 4 * hh;
                const u32x2 a1 = *(const u32x2*)(G1 + (size_t)item * 4096 + t * 64 + i0), a2 = *(const u32x2*)(G2 + (size_t)item * 4096 + t * 64 + i0);
                u32x2 o;
                o.x = pk2(acc[mt][4 * g] * rstd * bflo(a1.x) + bflo(a2.x), acc[mt][4 * g + 1] * rstd * bfhi(a1.x) + bfhi(a2.x));
                o.y = pk2(acc[mt][4 * g + 2] * rstd * bflo(a1.y) + bflo(a2.y), acc[mt][4 * g + 3] * rstd * bfhi(a1.y) + bfhi(a2.y));
                *(u32x2*)(mix + (size_t)(tok0 + t) * DM + D_POOL + h * 64 + i0) = o;
            }
    }
}

struct EpiOut {
    const float* X; float* O; int row0, col0;
    __device__ __forceinline__ void operator()(const f32x4 (&acc)[8][4], int wr, int wc, int fr, int fq) const {
#pragma unroll
        for (int m = 0; m < 8; ++m) {
            const size_t off = (size_t)(row0 + wr * 128 + m * 16 + fr) * DM + col0 + wc * 64 + fq * 4;
#pragma unroll
            for (int n = 0; n < 4; ++n) { const f32x4 xv = *(const f32x4*)(X + off + n * 16); *(f32x4*)(O + off + n * 16) = xv * ALPHA + acc[m][n]; }
        }
    }
};
__device__ __forceinline__ void phase_outproj(const Params& p, unsigned char* lds, int bid, int nb) {
    const int tid = opaque_tid();
    const bf16* a = (const bf16*)(p.ws + WS_MIXIN); const bf16* wt = (const bf16*)(p.ws + WS_WOUT_T);
    for (int u = bid; u < 256; u += nb) {
        const int pm = u & 63, pn = u >> 6;
        unsigned arow[4], brow[4];
#pragma unroll
        for (int i = 0; i < 4; ++i) { const int pp = tid + NT * i, r = pp >> 3, s = pp & 7;
            arow[i] = (unsigned)((pm * 256 + r) * DM + s * 8); brow[i] = (unsigned)((pn * 256 + r) * DM + s * 8); }
        EpiOut e{p.in[0], p.out, pm * 256, pn * 256};
        gemm_unit(lds, a, arow, wt, brow, DM, e);
    }
}

__device__ __forceinline__ void phase_ln_router(const Params& p, unsigned char* lds, int bid, int nb) {
    const int tid = opaque_tid(), lane = tid & 63, w = tid >> 6;
    float* RT = (float*)lds;
    const float* rg = p.in[18]; const float* re = p.in[20];
    __syncthreads();
    for (int e = tid; e < 36 * 1024; e += NT) { const int j = e >> 10, k = e & 1023; RT[e] = j < 4 ? rg[k * 4 + j] : re[k * 32 + (j - 4)]; }
    __syncthreads();
    const float* g1 = p.in[16]; const float* b1 = p.in[17]; const float* rgb = p.in[19]; const float* reb = p.in[21];
    float* H = p.out; bf16* hb = (bf16*)(p.ws + WS_HB);
    unsigned* cnt = (unsigned*)(p.ws + WS_CTL);
    int* list = (int*)(p.ws + WS_LIST); float* lwt = (float*)(p.ws + WS_LWT);
    for (int row = bid * 8 + w; row < NTOK; row += nb * 8) {
        float* hr = H + (size_t)row * DM;
        f32x4 v[4]; float s = 0.f;
#pragma unroll
        for (int j = 0; j < 4; ++j) { v[j] = *(const f32x4*)(hr + j * 256 + lane * 4); s += (v[j].x + v[j].y) + (v[j].z + v[j].w); }
        const float mean = wave_sum(s) * (1.f / DM);
        float s2 = 0.f;
#pragma unroll
        for (int j = 0; j < 4; ++j) { v[j] = v[j] - mean; s2 += (v[j].x * v[j].x + v[j].y * v[j].y) + (v[j].z * v[j].z + v[j].w * v[j].w); }
        const float rstd = rsqrtf(wave_sum(s2) * (1.f / DM) + LN_EPS);
#pragma unroll
        for (int j = 0; j < 4; ++j) {
            const f32x4 g = *(const f32x4*)(g1 + j * 256 + lane * 4), bb = *(const f32x4*)(b1 + j * 256 + lane * 4);
            v[j] = v[j] * rstd * g + bb;
            *(f32x4*)(hr + j * 256 + lane * 4) = v[j];
            u32x2 o; o.x = pk2(v[j].x, v[j].y); o.y = pk2(v[j].z, v[j].w);
            *(u32x2*)(hb + (size_t)row * DM + j * 256 + lane * 4) = o;
        }
        float gl[4];
#pragma unroll
        for (int q = 0; q < 4; ++q) {
            float a = 0.f;
#pragma unroll
            for (int j = 0; j < 4; ++j) { const f32x4 r = *(const f32x4*)(RT + q * 1024 + j * 256 + lane * 4); a += v[j].x * r.x + v[j].y * r.y + v[j].z * r.z + v[j].w * r.w; }
            gl[q] = wave_sum(a) + rgb[q];
        }
        int gi = 0; float gm = gl[0];
#pragma unroll
        for (int q = 1; q < 4; ++q) if (gl[q] > gm) { gm = gl[q]; gi = q; }
        float den = 0.f;
#pragma unroll
        for (int q = 0; q < 4; ++q) den += __expf(gl[q] - gm);
        const float gp = 1.f / den;
        gi = __builtin_amdgcn_readfirstlane(gi);
        float el[8];
#pragma unroll
        for (int q = 0; q < 8; ++q) el[q] = 0.f;
#pragma unroll 1
        for (int q = 0; q < 8; ++q) {
            const float* rt = RT + (4 + gi * 8 + q) * 1024 + lane * 4;
            float a = 0.f;
#pragma unroll
            for (int j = 0; j < 4; ++j) { const f32x4 r = *(const f32x4*)(rt + j * 256); a += v[j].x * r.x + v[j].y * r.y + v[j].z * r.z + v[j].w * r.w; }
            a = wave_sum(a) + reb[gi * 8 + q];
#pragma unroll
            for (int qq = 0; qq < 8; ++qq) el[qq] = (qq == q) ? a : el[qq];
        }
        int i0 = 0; float m0 = el[0];
#pragma unroll
        for (int q = 1; q < 8; ++q) if (el[q] > m0) { m0 = el[q]; i0 = q; }
        int i1 = -1; float m1 = -3.0e38f;
#pragma unroll
        for (int q = 0; q < 8; ++q) if (q != i0 && el[q] > m1) { m1 = el[q]; i1 = q; }
        const float e1 = __expf(m1 - m0);
        const float w0 = gp / (1.f + e1), w1 = gp * e1 / (1.f + e1);
        if (lane == 0) {
            const int ex0 = gi * 8 + i0, ex1 = gi * 8 + i1;
            const unsigned p0 = atomicAdd(&cnt[ex0], 1u), p1 = atomicAdd(&cnt[ex1], 1u);
            list[ex0 * NTOK + p0] = row * 2; lwt[ex0 * NTOK + p0] = w0;
            list[ex1 * NTOK + p1] = row * 2 + 1; lwt[ex1 * NTOK + p1] = w1;
        }
    }
}

__device__ __forceinline__ float siluf_(float x) { return x / (1.f + __expf(-x)); }
struct EpiGU {
    bf16* O; int row0, ct;
    __device__ __forceinline__ void operator()(const f32x4 (&acc)[8][4], int wr, int wc, int fr, int fq) const {
#pragma unroll
        for (int m = 0; m < 8; ++m) {
            bf16* rp = O + (size_t)(row0 + wr * 128 + m * 16 + fr) * DE + ct * 128 + wc * 32 + fq * 4;
#pragma unroll
            for (int n = 0; n < 2; ++n) {
                const f32x4 g = acc[m][n], u = acc[m][n + 2];
                u32x2 v; v.x = pk2(siluf_(g[0]) * u[0], siluf_(g[1]) * u[1]); v.y = pk2(siluf_(g[2]) * u[2], siluf_(g[3]) * u[3]);
                *(u32x2*)(rp + n * 16) = v;
            }
        }
    }
};
struct EpiDown {
    bf16* YS; const int* list; const float* lwt; int pos0, nvalid, col0;
    __device__ __forceinline__ void operator()(const f32x4 (&acc)[8][4], int wr, int wc, int fr, int fq) const {
#pragma unroll
        for (int m = 0; m < 8; ++m) {
            const int r = wr * 128 + m * 16 + fr;
            if (r < nvalid) {
                const int ts = list[pos0 + r]; const float wt = lwt[pos0 + r];
                bf16* rp = YS + (size_t)ts * DM + col0 + wc * 64 + fq * 4;
#pragma unroll
                for (int n = 0; n < 4; ++n) { u32x2 v; v.x = pk2(acc[m][n][0] * wt, acc[m][n][1] * wt); v.y = pk2(acc[m][n][2] * wt, acc[m][n][3] * wt); *(u32x2*)(rp + n * 16) = v; }
            }
        }
    }
};
__device__ __forceinline__ bool find_tile(const unsigned* cnt, int tile, int& e, int& rt, int& hoff) {
    int acc = 0;
    for (int i = 0; i < NEXP; ++i) { const int nt = ((int)cnt[i] + 255) >> 8; if (tile < acc + nt) { e = i; rt = tile - acc; hoff = (acc + rt) * 256; return true; } acc += nt; }
    return false;
}
__device__ __forceinline__ void phase_gateup(const Params& p, unsigned char* lds, int bid, int nb) {
    const int tid = opaque_tid();
    const unsigned* cnt = (const unsigned*)(p.ws + WS_CTL);
    const int* list = (const int*)(p.ws + WS_LIST);
    const bf16* hb = (const bf16*)(p.ws + WS_HB);
    for (int u = bid;; u += nb) {
        const int tile = u >> 1, ct = u & 1; int e, rt, hoff;
        if (!find_tile(cnt, tile, e, rt, hoff)) break;
        const int nv = min(256, (int)cnt[e] - rt * 256);
        unsigned arow[4], brow[4];
        const bf16* wt = (const bf16*)(p.ws + WS_EGU) + (size_t)e * 512 * DM + (size_t)ct * 256 * DM;
#pragma unroll
        for (int i = 0; i < 4; ++i) { const int pp = tid + NT * i, r = pp >> 3, s = pp & 7;
            const int tok = r < nv ? (list[e * NTOK + rt * 256 + r] >> 1) : 0;
            arow[i] = (unsigned)(tok * DM + s * 8); brow[i] = (unsigned)(r * DM + s * 8); }
        EpiGU ep{(bf16*)(p.ws + WS_HID), hoff, ct};
        gemm_unit(lds, hb, arow, wt, brow, DM, ep);
    }
}
__device__ __forceinline__ void phase_down(const Params& p, unsigned char* lds, int bid, int nb) {
    const int tid = opaque_tid();
    const unsigned* cnt = (const unsigned*)(p.ws + WS_CTL);
    const bf16* hid = (const bf16*)(p.ws + WS_HID);
    for (int u = bid;; u += nb) {
        const int tile = u >> 2, ct = u & 3; int e, rt, hoff;
        if (!find_tile(cnt, tile, e, rt, hoff)) break;
        const int nv = min(256, (int)cnt[e] - rt * 256);
        unsigned arow[4], brow[4];
        const bf16* wt = (const bf16*)(p.ws + WS_EDN) + (size_t)e * DM * DE + (size_t)ct * 256 * DE;
#pragma unroll
        for (int i = 0; i < 4; ++i) { const int pp = tid + NT * i, r = pp >> 3, s = pp & 7;
            arow[i] = (unsigned)((hoff + r) * DE + s * 8); brow[i] = (unsigned)(r * DE + s * 8); }
        EpiDown ep{(bf16*)(p.ws + WS_YS), (const int*)(p.ws + WS_LIST) + e * NTOK, (const float*)(p.ws + WS_LWT) + e * NTOK, rt * 256, nv, ct * 256};
        gemm_unit(lds, hid, arow, wt, brow, DE, ep);
    }
}

__device__ __forceinline__ void phase_final(const Params& p, int bid, int nb) {
    const int tid = opaque_tid(), lane = tid & 63, w = tid >> 6;
    const float* g2 = p.in[25]; const float* b2 = p.in[26];
    const bf16* ys = (const bf16*)(p.ws + WS_YS);
    for (int row = bid * 8 + w; row < NTOK; row += nb * 8) {
        float* hr = p.out + (size_t)row * DM;
        f32x4 v[4]; float s = 0.f;
#pragma unroll
        for (int j = 0; j < 4; ++j) {
            const f32x4 hv = *(const f32x4*)(hr + j * 256 + lane * 4);
            const u32x2 y0 = *(const u32x2*)(ys + (size_t)row * 2 * DM + j * 256 + lane * 4), y1 = *(const u32x2*)(ys + (size_t)row * 2 * DM + DM + j * 256 + lane * 4);
            v[j].x = hv.x * ALPHA + (bflo(y0.x) + bflo(y1.x)); v[j].y = hv.y * ALPHA + (bfhi(y0.x) + bfhi(y1.x));
            v[j].z = hv.z * ALPHA + (bflo(y0.y) + bflo(y1.y)); v[j].w = hv.w * ALPHA + (bfhi(y0.y) + bfhi(y1.y));
            s += (v[j].x + v[j].y) + (v[j].z + v[j].w);
        }
        const float mean = wave_sum(s) * (1.f / DM);
        float s2 = 0.f;
#pragma unroll
        for (int j = 0; j < 4; ++j) { v[j] = v[j] - mean; s2 += (v[j].x * v[j].x + v[j].y * v[j].y) + (v[j].z * v[j].z + v[j].w * v[j].w); }
        const float rstd = rsqrtf(wave_sum(s2) * (1.f / DM) + LN_EPS);
#pragma unroll
        for (int j = 0; j < 4; ++j) {
            const f32x4 g = *(const f32x4*)(g2 + j * 256 + lane * 4), bb = *(const f32x4*)(b2 + j * 256 + lane * 4);
            *(f32x4*)(hr + j * 256 + lane * 4) = v[j] * rstd * g + bb;
        }
    }
}

#define LAS __attribute__((address_space(3)))
#define XB_TMO      128
#define XB_XCNT(j)  (256  + 64 * (j))
#define XB_XSUB(j)  (1280 + 64 * (j))
#define XB_XGEN(j)  (2304 + 64 * (j))
#define XB_TOP      3328
#define XB_TOPGEN   3392
#define XCD_BAR_WORDS 3456
#define XB_SPIN_CAP (1u << 18)
__device__ __forceinline__ unsigned xb_ld(unsigned* p)              { return __hip_atomic_load(p, __ATOMIC_RELAXED, __HIP_MEMORY_SCOPE_AGENT); }
__device__ __forceinline__ unsigned xb_add(unsigned* p, unsigned v) { return __hip_atomic_fetch_add(p, v, __ATOMIC_RELAXED, __HIP_MEMORY_SCOPE_AGENT); }
__device__ __forceinline__ unsigned xb_xcc_id() { return (unsigned)__builtin_amdgcn_s_getreg((3 << 11) | 20) & 0xFu; }
#define XB_SPIN(cond, bar) do { unsigned _sp = 0; while (cond) { __builtin_amdgcn_s_sleep(1); \
    if ((++_sp & 255u) == 0u) { if (xb_ld(&(bar)[XB_TMO])) break; if (_sp > XB_SPIN_CAP) { atomicAdd(&(bar)[XB_TMO], 1u); break; } } } } while (0)
struct XcdBarrier { unsigned* bar; unsigned x; volatile LAS unsigned* st; };
__device__ __forceinline__ XcdBarrier xcd_barrier_post(unsigned* bar, volatile LAS unsigned* st) {
    XcdBarrier b; b.bar = bar; b.x = xb_xcc_id(); b.st = st;
    if (threadIdx.x == 0) (void)xb_add(&bar[XB_XCNT(b.x)], 1u);
    return b;
}
__device__ __forceinline__ void xcd_barrier_complete(unsigned* bar, unsigned x, unsigned& nloc, unsigned& nx) {
    const unsigned G = gridDim.x * gridDim.y * gridDim.z;
    unsigned sum, cnt, mine, sp = 0u;
    for (;;) {
        sum = 0u; cnt = 0u; mine = 0u;
#pragma unroll
        for (unsigned j = 0; j < 16; ++j) { const unsigned c = xb_ld(&bar[XB_XCNT(j)]); sum += c; cnt += (c > 0u) ? 1u : 0u; mine = (j == x) ? c : mine; }
        if (sum == G) break;
        __builtin_amdgcn_s_sleep(1);
        if ((++sp & 255u) == 0u) { if (xb_ld(&bar[XB_TMO])) break; if (sp > XB_SPIN_CAP) { atomicAdd(&bar[XB_TMO], 1u); break; } }
    }
    nloc = mine > 0u ? mine : 1u; nx = cnt > 0u ? cnt : 1u;
}
__device__ __forceinline__ void xcd_barrier(const XcdBarrier& b) {
    asm volatile("s_waitcnt vmcnt(0)" ::: "memory");
    __syncthreads();
    if (threadIdx.x == 0) {
        unsigned* bar = b.bar;
        __builtin_amdgcn_s_waitcnt(0);
        unsigned nloc = b.st[0], nx = b.st[1];
        if (nloc == 0u) { xcd_barrier_complete(bar, b.x, nloc, nx); b.st[0] = nloc; b.st[1] = nx; }
        const unsigned old = xb_add(&bar[XB_XSUB(b.x)], 1u);
        const unsigned gen = old / nloc;
        if (old + 1u == (gen + 1u) * nloc) {
            __builtin_amdgcn_fence(__ATOMIC_RELEASE, "agent");
            asm volatile("s_waitcnt vmcnt(0)" ::: "memory");
            const unsigned og = xb_add(&bar[XB_TOP], 1u);
            const unsigned tg = og / nx;
            if (og + 1u == (tg + 1u) * nx) xb_add(&bar[XB_TOPGEN], 1u);
            else XB_SPIN(xb_ld(&bar[XB_TOPGEN]) == tg, bar);
            __builtin_amdgcn_fence(__ATOMIC_ACQUIRE, "agent");
            xb_add(&bar[XB_XGEN(b.x)], 1u);
            asm volatile("s_waitcnt vmcnt(0)" ::: "memory");
        } else {
            XB_SPIN(xb_ld(&bar[XB_XGEN(b.x)]) == gen, bar);
            __builtin_amdgcn_fence(__ATOMIC_ACQUIRE, "agent");
            asm volatile("s_waitcnt vmcnt(0)" ::: "memory");
        }
    }
    __syncthreads();
}

__global__ void __launch_bounds__(NT) fwd_kernel(Params p) {
    extern __shared__ __attribute__((aligned(16))) unsigned char lds[];
    cg::grid_group grid = cg::this_grid();
    const int bid = blockIdx.x, nb = gridDim.x;
    volatile LAS unsigned* bst = (volatile LAS unsigned*)(LAS unsigned char*)(lds + BAR_LDS_OFF);
    if (threadIdx.x < 2) bst[threadIdx.x] = 0u;
    __syncthreads();
    XcdBarrier xb = xcd_barrier_post((unsigned*)(p.ws + WS_CTL) + CW_BAR, bst);
#define GRID_BAR() xcd_barrier(xb)
    phase_convert(p, lds, bid, nb);
    grid.sync();
    phase_proj(p, lds, bid, nb);
    GRID_BAR();
    phase_prep(p, lds, bid, nb);
    phase_pool(p, lds, bid, nb);
    GRID_BAR();
    if (bid < 96) { if (threadIdx.x < 64) phase_scan(p, bid); }
    else phase_convert_experts(p, lds, bid - 96, nb - 96);
    GRID_BAR();
    phase_rwkv_out(p, bid, nb);
    GRID_BAR();
    phase_outproj(p, lds, bid, nb);
    GRID_BAR();
    phase_ln_router(p, lds, bid, nb);
    GRID_BAR();
    phase_gateup(p, lds, bid, nb);
    GRID_BAR();
    phase_down(p, lds, bid, nb);
    GRID_BAR();
    phase_final(p, bid, nb);
}

extern "C" void kernel_launch(void* const* d_in, const int* in_sizes, int n_in, void* d_out, int out_size, void* d_ws, size_t ws_size, hipStream_t stream) {
    static int grid_blocks = 0;
    if (!grid_blocks) {
        if (hipFuncSetAttribute((const void*)fwd_kernel, hipFuncAttributeMaxDynamicSharedMemorySize, LDS_BYTES) != hipSuccess) fprintf(stderr, "hipFuncSetAttribute failed\n");
        int dev = 0, cus = 0, per_cu = 0;
        (void)hipGetDevice(&dev);
        (void)hipDeviceGetAttribute(&cus, hipDeviceAttributeMultiprocessorCount, dev);
        (void)hipOccupancyMaxActiveBlocksPerMultiprocessor(&per_cu, (const void*)fwd_kernel, NT, LDS_BYTES);
        if (per_cu < 1) { fprintf(stderr, "occupancy query says %d blocks/CU\n", per_cu); per_cu = 1; }
        grid_blocks = cus;
        fprintf(stderr, "grid %d (cus %d, per_cu %d)\n", grid_blocks, cus, per_cu);
    }
    Params p{};
    for (int i = 0; i < 27; ++i) p.in[i] = (const float*)d_in[i];
    p.out = (float*)d_out; p.ws = (unsigned char*)d_ws;
    (void)hipMemsetAsync((char*)d_ws + WS_CTL, 0, 65536, stream);
    void* args[] = {&p};
    hipError_t e = hipLaunchCooperativeKernel((const void*)fwd_kernel, dim3(grid_blocks), dim3(NT), args, LDS_BYTES, stream);
    if (e != hipSuccess) fprintf(stderr, "cooperative launch failed: %s (grid %d)\n", hipGetErrorString(e), grid_blocks);
}
```

```cpp
#include <hip/hip_runtime.h>
#include <hip/hip_cooperative_groups.h>
#include <cstdio>
#include <cstdint>
namespace cg = cooperative_groups;

typedef unsigned short bf16;
typedef short bf16x8 __attribute__((ext_vector_type(8)));
typedef float f32x4 __attribute__((ext_vector_type(4)));
typedef unsigned u32x4 __attribute__((ext_vector_type(4)));
typedef unsigned u32x2 __attribute__((ext_vector_type(2)));
typedef float f32x16 __attribute__((ext_vector_type(16)));
typedef float f32x2 __attribute__((ext_vector_type(2)));
typedef __bf16 bf16x2_t __attribute__((ext_vector_type(2)));

constexpr int DM = 1024, BATCH = 2, SEQ = 8192, NTOK = BATCH * SEQ;
constexpr int D_POOL = 256, D_RWKV = 768, NH = 12, HS = 64;
constexpr int D_IN = 2816;
constexpr int C_R = 256, C_K = 1024, C_V = 1792, C_WD = 2560, C_AD = 2624, C_GD = 2688;
constexpr int NEXP = 32, DE = 256;
constexpr float LN_EPS = 1e-5f, LNX_EPS = 64e-5f;
constexpr float ALPHA = 1.189207115002721f;
constexpr int NT = 512;
constexpr int BAR_LDS_OFF = 147968;
constexpr int CW_BAR = 4096;
constexpr int LDS_BYTES = 150528;

constexpr size_t MiB = 1u << 20;
constexpr size_t WS_CTL = 0;
constexpr size_t WS_WIN_T = 1 * MiB;
constexpr size_t WS_WOUT_T = 7 * MiB;
constexpr size_t WS_WUPT = 9 * MiB;
constexpr size_t WS_AUPT = 9 * MiB + 128 * 1024;
constexpr size_t WS_GUPT = 9 * MiB + 256 * 1024;
constexpr size_t WS_RTT = 9 * MiB + 512 * 1024;
constexpr size_t WS_PWT = 9 * MiB + 768 * 1024;
constexpr size_t WS_XB = 10 * MiB;
constexpr size_t WS_TC = 10 * MiB;
constexpr size_t WS_MIXIN = 42 * MiB;
constexpr size_t WS_PROJ = 74 * MiB;
constexpr size_t WS_EGU = 74 * MiB;
constexpr size_t WS_EDN = 106 * MiB;
constexpr size_t WS_S0 = 122 * MiB;
constexpr size_t WS_GC = 162 * MiB;
constexpr size_t WS_QC = 186 * MiB;
constexpr size_t WS_OL = 210 * MiB;
constexpr size_t OUT_G1 = 0;
constexpr size_t OUT_G2 = 24 * MiB;
constexpr size_t WS_YS = 122 * MiB;
constexpr size_t WS_HB = 186 * MiB;
constexpr size_t WS_LIST = 218 * MiB;
constexpr size_t WS_LWT = 220 * MiB;
constexpr size_t WS_HID = 222 * MiB;

struct Params {
    const float* in[27];
    float* out;
    unsigned char* ws;
    int phase;
    int pad;
};

__device__ __forceinline__ unsigned f2bf(float f) { unsigned u = __builtin_bit_cast(unsigned, f); return (u + 0x7fffu + ((u >> 16) & 1u)) >> 16; }
__device__ __forceinline__ unsigned pk2(float lo, float hi) { f32x2 v = {lo, hi}; bf16x2_t b = __builtin_convertvector(v, bf16x2_t); return __builtin_bit_cast(unsigned, b); }
__device__ __forceinline__ float bf2f(unsigned short b) { return __builtin_bit_cast(float, (unsigned)b << 16); }
__device__ __forceinline__ float bflo(unsigned u) { return __builtin_bit_cast(float, u << 16); }
__device__ __forceinline__ float bfhi(unsigned u) { return __builtin_bit_cast(float, u & 0xffff0000u); }
__device__ __forceinline__ float wave_sum(float v) {
#pragma unroll
    for (int o = 1; o < 64; o <<= 1) v += __shfl_xor(v, o);
    return v;
}
__device__ __forceinline__ int opaque_tid() { int t = threadIdx.x; asm volatile("" : "+v"(t)); return t; }
__device__ __forceinline__ float sigmoidf_(float x) { return 1.f / (1.f + __expf(-x)); }

template <class Epi>
__device__ __forceinline__ void gemm_unit(unsigned char* lds, const bf16* __restrict__ abase, const unsigned (&arow)[4], const bf16* __restrict__ bbase, const unsigned (&brow)[4], int K, Epi& epi) {
    const int tid = opaque_tid(), lane = tid & 63, w = tid >> 6, wr = w >> 2, wc = w & 3;
    const int srow = tid >> 3, sslot = tid & 7;
    const int st_off = srow * 128 + ((sslot ^ ((srow >> 1) & 7)) << 4);
    const int fr = lane & 15, fq = lane >> 4, x = fr >> 1;
    int offA[2], offB[2];
#pragma unroll
    for (int s = 0; s < 2; ++s) {
        const int slot = (s * 4 + fq) ^ x;
        offA[s] = (wr * 128 + fr) * 128 + (slot << 4);
        offB[s] = 32768 + (wc * 64 + fr) * 128 + (slot << 4);
    }
    f32x4 acc[8][4];
#pragma unroll
    for (int m = 0; m < 8; ++m)
#pragma unroll
        for (int n = 0; n < 4; ++n) acc[m][n] = (f32x4){0.f, 0.f, 0.f, 0.f};
    u32x4 ra[4], rb[4];
#pragma unroll
    for (int i = 0; i < 4; ++i) { ra[i] = *(const u32x4*)(abase + arow[i]); rb[i] = *(const u32x4*)(bbase + brow[i]); }
    __syncthreads();
#pragma unroll
    for (int i = 0; i < 4; ++i) { *(u32x4*)(lds + st_off + i * 8192) = ra[i]; *(u32x4*)(lds + 32768 + st_off + i * 8192) = rb[i]; }
    __syncthreads();
    const int KT = K >> 6;
    for (int kt = 0; kt < KT; ++kt) {
        unsigned char* cur = lds + (kt & 1) * 65536;
        unsigned char* nxt = lds + ((kt + 1) & 1) * 65536;
        if (kt + 1 < KT) {
#pragma unroll
            for (int i = 0; i < 4; ++i) { ra[i] = *(const u32x4*)(abase + arow[i] + (kt + 1) * 64); rb[i] = *(const u32x4*)(bbase + brow[i] + (kt + 1) * 64); }
        }
#pragma unroll
        for (int s = 0; s < 2; ++s) {
            bf16x8 bfr[4];
#pragma unroll
            for (int n = 0; n < 4; ++n) bfr[n] = *(const bf16x8*)(cur + offB[s] + n * 2048);
#pragma unroll
            for (int m = 0; m < 8; ++m) {
                const bf16x8 afr = *(const bf16x8*)(cur + offA[s] + m * 2048);
#pragma unroll
                for (int n = 0; n < 4; ++n) acc[m][n] = __builtin_amdgcn_mfma_f32_16x16x32_bf16(bfr[n], afr, acc[m][n], 0, 0, 0);
            }
        }
        if (kt + 1 < KT) {
#pragma unroll
            for (int i = 0; i < 4; ++i) { *(u32x4*)(nxt + st_off + i * 8192) = ra[i]; *(u32x4*)(nxt + 32768 + st_off + i * 8192) = rb[i]; }
        }
        __syncthreads();
    }
    epi(acc, wr, wc, fr, fq);
}

__device__ __forceinline__ int gu_row(int c, int half) { return ((c >> 7) << 8) + (((c >> 5) & 3) << 6) + (half << 5) + (c & 31); }
__device__ __forceinline__ void tr_tile(unsigned char* lds, const float* __restrict__ src, int ldsrc, int k0, int n0, bf16* __restrict__ dst, int ldd, int mode) {
    float* t = (float*)lds;
    const int tid = opaque_tid();
    __syncthreads();
#pragma unroll
    for (int i = 0; i < 8; ++i) { const int e = tid + i * NT, k = e >> 6, n = e & 63; t[k * 65 + n] = src[(size_t)(k0 + k) * ldsrc + n0 + n]; }
    __syncthreads();
    const int n = tid >> 3, kc = tid & 7;
    const float* s = t + (kc * 8) * 65 + n;
    u32x4 o; o.x = pk2(s[0], s[65]); o.y = pk2(s[2 * 65], s[3 * 65]); o.z = pk2(s[4 * 65], s[5 * 65]); o.w = pk2(s[6 * 65], s[7 * 65]);
    const int nn = n0 + n;
    const int drow = mode == 0 ? nn : gu_row(nn, mode - 1);
    *(u32x4*)(dst + (size_t)drow * ldd + k0 + kc * 8) = o;
}

__device__ __forceinline__ void phase_convert(const Params& p, unsigned char* lds, int bid, int nb) {
    const int tid = opaque_tid();
    {
        const float* x = p.in[0]; bf16* xb = (bf16*)(p.ws + WS_XB);
        const size_t n8 = (size_t)NTOK * DM / 8;
        for (size_t i = (size_t)bid * NT + tid; i < n8; i += (size_t)nb * NT) {
            const f32x4 a = *(const f32x4*)(x + i * 8), b = *(const f32x4*)(x + i * 8 + 4);
            u32x4 o; o.x = pk2(a.x, a.y); o.y = pk2(a.z, a.w); o.z = pk2(b.x, b.y); o.w = pk2(b.z, b.w);
            *(u32x4*)(xb + i * 8) = o;
        }
    }
    constexpr int T_WIN = (DM / 64) * (D_IN / 64);
    constexpr int T_WOUT = (DM / 64) * (DM / 64);
    constexpr int T_ALL = T_WIN + T_WOUT + 12 + 12 + 24 + 4;
    for (int it = bid; it < T_ALL; it += nb) {
        int r = it;
        if (r < T_WIN) { const int kb = r / (D_IN / 64), nbk = r % (D_IN / 64); tr_tile(lds, p.in[1], D_IN, kb * 64, nbk * 64, (bf16*)(p.ws + WS_WIN_T), DM, 0); continue; }
        r -= T_WIN;
        if (r < T_WOUT) { const int kb = r / (DM / 64), nbk = r % (DM / 64); tr_tile(lds, p.in[15], DM, kb * 64, nbk * 64, (bf16*)(p.ws + WS_WOUT_T), DM, 0); continue; }
        r -= T_WOUT;
        if (r < 12) { tr_tile(lds, p.in[6], D_RWKV, 0, r * 64, (bf16*)(p.ws + WS_WUPT), 64, 0); continue; }
        r -= 12;
        if (r < 12) { tr_tile(lds, p.in[8], D_RWKV, 0, r * 64, (bf16*)(p.ws + WS_AUPT), 64, 0); continue; }
        r -= 12;
        if (r < 24) { tr_tile(lds, p.in[9], D_RWKV, (r / 12) * 64, (r % 12) * 64, (bf16*)(p.ws + WS_GUPT), 128, 0); continue; }
        r -= 24;
        { tr_tile(lds, p.in[2] + r * 4096, 64, 0, 0, (bf16*)(p.ws + WS_PWT) + r * 4096, 64, 0); }
    }
    {
        float* rtt = (float*)(p.ws + WS_RTT); const float* rg = p.in[18]; const float* re = p.in[20];
        for (int e = bid * NT + tid; e < 36 * 1024; e += nb * NT) { const int j = e >> 10, k = e & 1023; rtt[e] = j < 4 ? rg[k * 4 + j] : re[k * 32 + (j - 4)]; }
    }
}
__device__ __forceinline__ void phase_convert_experts(const Params& p, unsigned char* lds, int bid, int nb) {
    constexpr int T_EG = NEXP * (DM / 64) * (DE / 64);
    constexpr int T_ED = NEXP * (DE / 64) * (DM / 64);
    constexpr int T_ALL = 2 * T_EG + T_ED;
    for (int it = bid; it < T_ALL; it += nb) {
        int r = it;
        if (r < 2 * T_EG) {
            const int half = r / T_EG; r -= half * T_EG;
            const int e = r / 64, q = r % 64, kb = q / 4, nbk = q % 4;
            tr_tile(lds, p.in[22 + half] + (size_t)e * DM * DE, DE, kb * 64, nbk * 64, (bf16*)(p.ws + WS_EGU) + (size_t)e * 512 * DM, DM, 1 + half); continue;
        }
        r -= 2 * T_EG;
        { const int e = r / 64, q = r % 64, kb = q / 16, nbk = q % 16;
          tr_tile(lds, p.in[24] + (size_t)e * DE * DM, DM, kb * 64, nbk * 64, (bf16*)(p.ws + WS_EDN) + (size_t)e * DM * DE, DE, 0); }
    }
}

struct EpiProj {
    bf16* O; int row0, col0;
    __device__ __forceinline__ void operator()(const f32x4 (&acc)[8][4], int wr, int wc, int fr, int fq) const {
#pragma unroll
        for (int m = 0; m < 8; ++m) {
            bf16* rp = O + (size_t)(row0 + wr * 128 + m * 16 + fr) * D_IN + col0 + wc * 64 + fq * 4;
#pragma unroll
            for (int n = 0; n < 4; ++n) { u32x2 v; v.x = pk2(acc[m][n][0], acc[m][n][1]); v.y = pk2(acc[m][n][2], acc[m][n][3]); *(u32x2*)(rp + n * 16) = v; }
        }
    }
};
__device__ __forceinline__ void phase_proj(const Params& p, unsigned char* lds, int bid, int nb) {
    const int tid = opaque_tid();
    const bf16* xb = (const bf16*)(p.ws + WS_XB); const bf16* wt = (const bf16*)(p.ws + WS_WIN_T);
    constexpr int NU = 64 * 11;
    for (int u = bid; u < NU; u += nb) {
        const int pm = u & 63, pn = u >> 6;
        unsigned arow[4], brow[4];
#pragma unroll
        for (int i = 0; i < 4; ++i) { const int pp = tid + NT * i, r = pp >> 3, s = pp & 7;
            arow[i] = (unsigned)((pm * 256 + r) * DM + s * 8); brow[i] = (unsigned)((pn * 256 + r) * DM + s * 8); }
        EpiProj e{(bf16*)(p.ws + WS_PROJ), pm * 256, pn * 256};
        gemm_unit(lds, xb, arow, wt, brow, DM, e);
    }
}

__device__ __forceinline__ int sw_off(int row, int col) { return row * 128 + ((((col >> 3) ^ ((row >> 1) & 7)) << 4) | ((col & 7) << 1)); }
__device__ __forceinline__ void phase_pool(const Params& p, unsigned char* lds, int bid, int nb) {
    const int tid = opaque_tid(), lane = tid & 63, w = __builtin_amdgcn_readfirstlane(tid >> 6);
    const bf16* proj = (const bf16*)(p.ws + WS_PROJ);
    bf16* mix = (bf16*)(p.ws + WS_MIXIN);
    const bf16* pwT = (const bf16*)(p.ws + WS_PWT); const float* ps = p.in[3];
    float* pbuf = (float*)lds;
    unsigned char* dslot = lds + 81920;
    for (int it = bid; it < NTOK / 64; it += nb) {
        const int tok0 = it * 64, t0 = tok0 % SEQ;
        __syncthreads();
#pragma unroll 2
        for (int e = tid; e < 79 * 64; e += NT) {
            const int r = e >> 6, c4 = e & 63; const int tt = t0 - 15 + r;
            float4 v = {0.f, 0.f, 0.f, 0.f};
            if (tt >= 0) { const u32x2 q = *(const u32x2*)(proj + (size_t)(tok0 - 15 + r) * D_IN + c4 * 4); v.x = bflo(q.x); v.y = bfhi(q.x); v.z = bflo(q.y); v.w = bfhi(q.y); }
            *(float4*)(pbuf + r * 256 + c4 * 4) = v;
        }
        __syncthreads();
#pragma unroll 2
        for (int e = tid; e < 64 * 64; e += NT) {
            const int t = e >> 6, c = (e & 63) * 4, g = c >> 6, win = 2 << g;
            const int cnt = min(t0 + t + 1, win);
            f32x4 sm = {0.f, 0.f, 0.f, 0.f};
            for (int j = 0; j < cnt; ++j) sm += *(const f32x4*)(pbuf + (t + 15 - j) * 256 + c);
            const f32x4 d = sm * (1.f / (float)cnt) - *(const f32x4*)(pbuf + (t + 15) * 256 + c);
            u32x2 o; o.x = pk2(d.x, d.y); o.y = pk2(d.z, d.w);
            *(u32x2*)(dslot + g * 8192 + sw_off(t, c & 63)) = o;
        }
        __syncthreads();
        {
            const int g = w >> 1, nt = w & 1, ln = lane & 31, hh = lane >> 5, t = nt * 32 + ln;
            f32x16 acc[2];
#pragma unroll
            for (int mt = 0; mt < 2; ++mt) for (int r = 0; r < 16; ++r) acc[mt][r] = 0.f;
#pragma unroll
            for (int s_ = 0; s_ < 4; ++s_) {
                const bf16x8 bd = *(const bf16x8*)(dslot + g * 8192 + sw_off(t, 16 * s_ + 8 * hh));
#pragma unroll
                for (int mt = 0; mt < 2; ++mt) {
                    const bf16x8 aw = *(const bf16x8*)(pwT + g * 4096 + (mt * 32 + ln) * 64 + 16 * s_ + 8 * hh);
                    acc[mt] = __builtin_amdgcn_mfma_f32_32x32x16_bf16(aw, bd, acc[mt], 0, 0, 0);
                }
            }
#pragma unroll
            for (int mt = 0; mt < 2; ++mt)
#pragma unroll
                for (int gg = 0; gg < 4; ++gg) {
                    const int d0 = mt * 32 + 8 * gg + 4 * hh;
                    const f32x4 sc = *(const f32x4*)(ps + g * 64 + d0);
                    u32x2 o; o.x = pk2(acc[mt][4 * gg] * sc.x, acc[mt][4 * gg + 1] * sc.y); o.y = pk2(acc[mt][4 * gg + 2] * sc.z, acc[mt][4 * gg + 3] * sc.w);
                    *(u32x2*)(mix + (size_t)(tok0 + t) * DM + g * 64 + d0) = o;
                }
        }
    }
}

constexpr int SLOTB = 8192;
#define MFMA32(a, b, c) __builtin_amdgcn_mfma_f32_32x32x16_bf16((a), (b), (c), 0, 0, 0)
#define MFMA16(a, b, c) __builtin_amdgcn_mfma_f32_16x16x32_bf16((a), (b), (c), 0, 0, 0)
__device__ __forceinline__ f32x16 mm32(const unsigned char* X, const int (&ox)[4], const unsigned char* Y, const int (&oy)[4], f32x16 acc) {
#pragma unroll
    for (int s = 0; s < 4; ++s) {
        const bf16x8 a = *(const bf16x8*)(X + ox[s]);
        const bf16x8 b = *(const bf16x8*)(Y + oy[s]);
        acc = MFMA32(a, b, acc);
    }
    return acc;
}
template <class F>
__device__ __forceinline__ void store_T(unsigned char* Z, const f32x16& d, int mt, int nt, int lane, const int (&ost)[4], F f) {
    const int n = nt * 32 + (lane & 31), h = lane >> 5;
#pragma unroll
    for (int g = 0; g < 4; ++g) {
        const int m0 = mt * 32 + 8 * g + 4 * h;
        u32x2 v; v.x = pk2(f(d[4 * g], m0, n), f(d[4 * g + 1], m0 + 1, n)); v.y = pk2(f(d[4 * g + 2], m0 + 2, n), f(d[4 * g + 3], m0 + 3, n));
        *(u32x2*)(Z + ost[g]) = v;
    }
}
__device__ __forceinline__ f32x16 zero16() { f32x16 z; for (int i = 0; i < 16; ++i) z[i] = 0.f; return z; }
__device__ __forceinline__ void st_b16(unsigned char* Z, int row, int col, float v) { *(unsigned short*)(Z + sw_off(row, col)) = (unsigned short)pk2(v, 0.f); }

__device__ __forceinline__ void phase_prep(const Params& p, unsigned char* lds, int bid, int nb) {
    const int tid = opaque_tid();
    const bf16* proj = (const bf16*)(p.ws + WS_PROJ);
    const float* mu = p.in[4]; const float* w0 = p.in[5]; const float* a0 = p.in[7];
    const float* k_k = p.in[10]; const float* k_a = p.in[11]; const float* r_k = p.in[12];
    const float* lnx_g = p.in[13]; const float* lnx_b = p.in[14];
    const bf16* wupT = (const bf16*)(p.ws + WS_WUPT); const bf16* aupT = (const bf16*)(p.ws + WS_AUPT); const bf16* gupT = (const bf16*)(p.ws + WS_GUPT);
    bf16* TC = (bf16*)(p.ws + WS_TC); bf16* GC = (bf16*)(p.ws + WS_GC); bf16* QC = (bf16*)(p.ws + WS_QC); bf16* OL = (bf16*)(p.ws + WS_OL);
    bf16* G1 = (bf16*)((unsigned char*)p.out + OUT_G1); bf16* G2 = (bf16*)((unsigned char*)p.out + OUT_G2);
#define SL(i) (lds + (i) * SLOTB)
    float* PC = (float*)(lds + 18 * SLOTB);
    for (int it = bid; it < BATCH * (SEQ / 64); it += nb) {
        const int b = it / (SEQ / 64), c = it % (SEQ / 64), tok0 = b * SEQ + c * 64;
        __syncthreads();
#pragma unroll 1
        for (int e = tid; e < 64 * 32; e += NT) {
            const int tt = e >> 5, k8 = (e & 31) * 8;
            const bf16* cur = proj + (size_t)(tok0 + tt) * D_IN + C_WD + k8;
            const u32x4 cv = *(const u32x4*)cur;
            u32x4 pv = {0u, 0u, 0u, 0u};
            if (c * 64 + tt > 0) pv = *(const u32x4*)(cur - D_IN);
            const f32x4 m0 = *(const f32x4*)(mu + C_WD - D_POOL + k8), m1 = *(const f32x4*)(mu + C_WD - D_POOL + k8 + 4);
            float z[8];
            z[0] = bflo(cv.x) + (bflo(pv.x) - bflo(cv.x)) * m0.x; z[1] = bfhi(cv.x) + (bfhi(pv.x) - bfhi(cv.x)) * m0.y;
            z[2] = bflo(cv.y) + (bflo(pv.y) - bflo(cv.y)) * m0.z; z[3] = bfhi(cv.y) + (bfhi(pv.y) - bfhi(cv.y)) * m0.w;
            z[4] = bflo(cv.z) + (bflo(pv.z) - bflo(cv.z)) * m1.x; z[5] = bfhi(cv.z) + (bfhi(pv.z) - bfhi(cv.z)) * m1.y;
            z[6] = bflo(cv.w) + (bflo(pv.w) - bflo(cv.w)) * m1.z; z[7] = bfhi(cv.w) + (bfhi(pv.w) - bfhi(cv.w)) * m1.w;
            if (k8 < 64) { for (int j = 0; j < 8; ++j) z[j] = 1.f - 2.f / (1.f + __expf(2.f * z[j])); }
            else if (k8 >= 128) { for (int j = 0; j < 8; ++j) z[j] = sigmoidf_(z[j]); }
            u32x4 o; o.x = pk2(z[0], z[1]); o.y = pk2(z[2], z[3]); o.z = pk2(z[4], z[5]); o.w = pk2(z[6], z[7]);
            *(u32x4*)(SL(k8 >> 6) + sw_off(tt, k8 & 63)) = o;
        }
#pragma unroll 1
        for (int h = 0; h < NH; ++h) {
            const size_t item = ((size_t)(b * (SEQ / 64) + c)) * NH + h;
            int tid_ = tid; asm volatile("" : "+v"(tid_));
            const int lane = tid_ & 63, w = __builtin_amdgcn_readfirstlane(tid_ >> 6);
            const int ts = w & 3, tl = lane & 15, q = lane >> 4, t = ts * 16 + tl;
            const int tmt = (w >> 1) & 1, tnt = w & 1, hh = lane >> 5;
            int offT[4], offR[4], offL[2], offM[2];
        #pragma unroll
            for (int r = 0; r < 4; ++r) { offT[r] = sw_off(4 * q + r, t); offR[r] = sw_off(t, r * 16 + 4 * q); }
        #pragma unroll
            for (int ks = 0; ks < 2; ++ks) { offL[ks] = sw_off(t, 32 * ks + 8 * q); offM[ks] = sw_off(tl, 32 * ks + 8 * q); }
            int oxm[4], oyn[4], ost[4];
        #pragma unroll
            for (int s_ = 0; s_ < 4; ++s_) { oxm[s_] = sw_off(tmt * 32 + (lane & 31), 16 * s_ + 8 * hh); oyn[s_] = sw_off(tnt * 32 + (lane & 31), 16 * s_ + 8 * hh); ost[s_] = sw_off(tnt * 32 + (lane & 31), tmt * 32 + 8 * s_ + 4 * hh); }
            __syncthreads();
            if (w < 4) {
                float lw[16], kap[16], bv[16], kn[16], rm[16];
                float vm[16];
                float nsq = 0.f, bon = 0.f;
                {
                    f32x4 accw[4], acca[4];
#pragma unroll
                    for (int m = 0; m < 4; ++m) { accw[m] = (f32x4){0.f, 0.f, 0.f, 0.f}; acca[m] = accw[m]; }
#pragma unroll
                    for (int ks = 0; ks < 2; ++ks) {
                        const bf16x8 bw = *(const bf16x8*)(SL(0) + offL[ks]);
                        const bf16x8 ba = *(const bf16x8*)(SL(1) + offL[ks]);
#pragma unroll
                        for (int m = 0; m < 4; ++m) {
                            const bf16x8 aw = *(const bf16x8*)(wupT + (size_t)(h * 64 + m * 16 + tl) * 64 + 32 * ks + 8 * q);
                            const bf16x8 aa = *(const bf16x8*)(aupT + (size_t)(h * 64 + m * 16 + tl) * 64 + 32 * ks + 8 * q);
                            accw[m] = MFMA16(aw, bw, accw[m]); acca[m] = MFMA16(aa, ba, acca[m]);
                        }
                    }
                    const bool hp = (c * 64 + t) > 0;
#pragma unroll
                    for (int m = 0; m < 4; ++m) {
                        const int ch0 = m * 16 + 4 * q, gch = h * 64 + ch0;
                        const bf16* cur = proj + (size_t)(tok0 + t) * D_IN + C_R + gch;
                        float zz[3][4];
#pragma unroll
                        for (int x = 0; x < 3; ++x) {
                            const u32x2 cv = *(const u32x2*)(cur + x * D_RWKV);
                            u32x2 pv = {0u, 0u};
                            if (hp) pv = *(const u32x2*)(cur + x * D_RWKV - D_IN);
                            const f32x4 mm = *(const f32x4*)(mu + (C_R - D_POOL) + x * D_RWKV + gch);
                            zz[x][0] = bflo(cv.x) + (bflo(pv.x) - bflo(cv.x)) * mm.x; zz[x][1] = bfhi(cv.x) + (bfhi(pv.x) - bfhi(cv.x)) * mm.y;
                            zz[x][2] = bflo(cv.y) + (bflo(pv.y) - bflo(cv.y)) * mm.z; zz[x][3] = bfhi(cv.y) + (bfhi(pv.y) - bfhi(cv.y)) * mm.w;
                        }
                        const f32x4 w0v = *(const f32x4*)(w0 + gch), a0v = *(const f32x4*)(a0 + gch), kkv = *(const f32x4*)(k_k + gch), kav = *(const f32x4*)(k_a + gch), rkv = *(const f32x4*)(r_k + gch);
#pragma unroll
                        for (int r = 0; r < 4; ++r) {
                            const int e = m * 4 + r;
                            const float xx = w0v[r] + accw[m][r];
                            const float sp = (-xx > 20.f) ? -xx : __logf(1.f + __expf(-xx));
                            lw[e] = -__expf(-sp - 0.5f);
                            const float av = sigmoidf_(a0v[r] + acca[m][r]);
                            rm[e] = zz[0][r]; vm[e] = zz[2][r];
                            kap[e] = zz[1][r] * kkv[r]; nsq += kap[e] * kap[e];
                            kn[e] = zz[1][r] * (1.f + (av - 1.f) * kav[r]);
                            bon += rm[e] * kn[e] * rkv[r];
                            bv[e] = av;
                        }
                        __builtin_amdgcn_sched_barrier(0);
                    }
                }
                nsq += __shfl_xor(nsq, 16); nsq += __shfl_xor(nsq, 32);
                bon += __shfl_xor(bon, 16); bon += __shfl_xor(bon, 32);
                const float inv = 1.f / fmaxf(sqrtf(nsq), 1e-12f);
#pragma unroll
                for (int m = 0; m < 4; ++m) {
#pragma unroll
                    for (int r = 0; r < 4; ++r) {
                        const int e = m * 4 + r;
                        kap[e] *= inv; bv[e] *= kap[e];
                        const unsigned hi = pk2(lw[e], 0.f) & 0xffffu; const float hif = __builtin_bit_cast(float, hi << 16);
                        *(unsigned short*)(SL(4) + offT[r] + m * 2048) = (unsigned short)hi;
                        *(unsigned short*)(SL(5) + offT[r] + m * 2048) = (unsigned short)pk2(lw[e] - hif, 0.f);
                        *(unsigned short*)(SL(13) + offT[r] + m * 2048) = (unsigned short)pk2(vm[e], 0.f);
                    }
                }
                {
                    f32x4 accg[4];
#pragma unroll
                    for (int m = 0; m < 4; ++m) accg[m] = (f32x4){0.f, 0.f, 0.f, 0.f};
#pragma unroll
                    for (int ks = 0; ks < 4; ++ks) {
                        const bf16x8 bg = *(const bf16x8*)(SL(2 + (ks >> 1)) + offL[ks & 1]);
#pragma unroll
                        for (int m = 0; m < 4; ++m) {
                            const bf16x8 ag = *(const bf16x8*)(gupT + (size_t)(h * 64 + m * 16 + tl) * 128 + 32 * ks + 8 * q);
                            accg[m] = MFMA16(ag, bg, accg[m]);
                        }
                    }
#pragma unroll
                    for (int m = 0; m < 4; ++m) {
                        const int ch0 = m * 16 + 4 * q, gch = h * 64 + ch0;
                        const f32x4 lg = *(const f32x4*)(lnx_g + gch), lb = *(const f32x4*)(lnx_b + gch);
                        u32x2 v1, v2;
                        v1.x = pk2(lg[0] * accg[m][0], lg[1] * accg[m][1]); v1.y = pk2(lg[2] * accg[m][2], lg[3] * accg[m][3]);
                        v2.x = pk2((lb[0] + bon * vm[m * 4]) * accg[m][0], (lb[1] + bon * vm[m * 4 + 1]) * accg[m][1]);
                        v2.y = pk2((lb[2] + bon * vm[m * 4 + 2]) * accg[m][2], (lb[3] + bon * vm[m * 4 + 3]) * accg[m][3]);
                        *(u32x2*)(G1 + item * 4096 + t * 64 + ch0) = v1;
                        *(u32x2*)(G2 + item * 4096 + t * 64 + ch0) = v2;
                    }
                }
                __syncthreads();
                f32x4 La[4], Ta[4];
#pragma unroll
                for (int m = 0; m < 4; ++m) { La[m] = (f32x4){0.f, 0.f, 0.f, 0.f}; Ta[m] = La[m]; }
#pragma unroll
                for (int ks = 0; ks < 2; ++ks) {
                    bf16x8 btri, bone;
#pragma unroll
                    for (int e = 0; e < 8; ++e) { const int s_ = 32 * ks + 8 * q + e; btri[e] = (short)((s_ <= t) ? 0x3F80 : 0); bone[e] = (short)0x3F80; }
#pragma unroll
                    for (int m = 0; m < 4; ++m) {
                        const bf16x8 ah = *(const bf16x8*)(SL(4) + offM[ks] + m * 2048);
                        const bf16x8 al = *(const bf16x8*)(SL(5) + offM[ks] + m * 2048);
                        La[m] = MFMA16(ah, btri, La[m]); La[m] = MFMA16(al, btri, La[m]);
                        Ta[m] = MFMA16(ah, bone, Ta[m]); Ta[m] = MFMA16(al, bone, Ta[m]);
                    }
                }
                __syncthreads();
#pragma unroll
                for (int m = 0; m < 4; ++m) {
                    const int ch0 = m * 16 + 4 * q;
                    float kt[4], rt[4], bt[4], kkt[4];
#pragma unroll
                    for (int r = 0; r < 4; ++r) {
                        const int e = m * 4 + r;
                        const float L = La[m][r], Lt = Ta[m][r];
                        const float eL = __expf(L), em = __expf(-L), eh = __expf(Lt - L), ex = __expf(L - lw[e]);
                        kt[r] = kap[e] * ex; rt[r] = rm[e] * eL; bt[r] = bv[e] * em; kkt[r] = kn[e] * em;
                        *(unsigned short*)(SL(9) + offT[r] + m * 2048) = (unsigned short)pk2(kt[r], 0.f);
                        *(unsigned short*)(SL(11) + offT[r] + m * 2048) = (unsigned short)pk2(bv[e] * eh, 0.f);
                        *(unsigned short*)(SL(12) + offT[r] + m * 2048) = (unsigned short)pk2(kn[e] * eh, 0.f);
                        if (t == 0) PC[ch0 + r] = __expf(Lt);
                    }
                    u32x2 v;
                    v.x = pk2(kt[0], kt[1]); v.y = pk2(kt[2], kt[3]); *(u32x2*)(SL(6) + offR[m]) = v;
                    v.x = pk2(bt[0], bt[1]); v.y = pk2(bt[2], bt[3]); *(u32x2*)(SL(7) + offR[m]) = v;
                    v.x = pk2(kkt[0], kkt[1]); v.y = pk2(kkt[2], kkt[3]); *(u32x2*)(SL(8) + offR[m]) = v;
                    v.x = pk2(rt[0], rt[1]); v.y = pk2(rt[2], rt[3]); *(u32x2*)(SL(10) + offR[m]) = v;
                }
            } else {
                __syncthreads();
                __syncthreads();
            }
            __syncthreads();
            f32x16 racc = zero16();
            {
                if (w < 4) {
                    f32x16 d = mm32(SL(7), oxm, SL(6), oyn, zero16());
                    const int tq_ = tnt * 32 + (lane & 31);
#pragma unroll
                    for (int r = 0; r < 16; ++r) { const int s_ = tmt * 32 + (r & 3) + 8 * (r >> 2) + 4 * hh; const float v = (s_ < tq_) ? d[r] : 0.f; d[r] = v; racc[r] = ((s_ == tq_) ? 1.f : 0.f) - v; }
                    store_T(SL(4), d, tmt, tnt, lane, ost, [](float v, int, int) { return v; });
                    store_T(SL(17), racc, tmt, tnt, lane, ost, [](float v, int, int) { return v; });
                } else {
                    f32x16 d = mm32(SL(6), oxm, SL(7), oyn, zero16());
                    store_T(SL(5), d, tmt, tnt, lane, ost, [](float v, int m, int n) { return (n < m) ? v : 0.f; });
                }
                if (w < 4) {
                    f32x16 d = mm32(SL(8), oxm, SL(6), oyn, zero16());
                    store_T(SL(14), d, tmt, tnt, lane, ost, [](float v, int m, int n) { return (m < n) ? v : 0.f; });
                } else {
                    f32x16 d = mm32(SL(7), oxm, SL(10), oyn, zero16());
                    store_T(SL(15), d, tmt, tnt, lane, ost, [](float v, int m, int n) { return (m <= n) ? v : 0.f; });
                }
                if (w < 4) {
                    f32x16 d = mm32(SL(8), oxm, SL(10), oyn, zero16());
                    store_T(SL(16), d, tmt, tnt, lane, ost, [](float v, int m, int n) { return (m <= n) ? v : 0.f; });
                }
            }
            __syncthreads();
            auto ident = [](float v, int, int) { return v; };
            if (w < 4) { f32x16 d = mm32(SL(5), oxm, SL(4), oyn, zero16()); store_T(SL(6), d, tmt, tnt, lane, ost, ident); }
            else       { f32x16 d = mm32(SL(4), oxm, SL(5), oyn, zero16()); store_T(SL(7), d, tmt, tnt, lane, ost, ident); }
            __syncthreads();
            if (w < 4) { f32x16 d = mm32(SL(7), oxm, SL(6), oyn, zero16()); store_T(SL(4), d, tmt, tnt, lane, ost, ident);
                         racc = mm32(SL(7), oxm, SL(17), oyn, racc); store_T(SL(8), racc, tmt, tnt, lane, ost, ident); }
            else       { f32x16 d = mm32(SL(6), oxm, SL(7), oyn, zero16()); store_T(SL(5), d, tmt, tnt, lane, ost, ident); }
            __syncthreads();
            if (w < 4) { f32x16 d = mm32(SL(5), oxm, SL(4), oyn, zero16()); store_T(SL(6), d, tmt, tnt, lane, ost, ident);
                         racc = mm32(SL(5), oxm, SL(8), oyn, racc); store_T(SL(17), racc, tmt, tnt, lane, ost, ident); }
            else       { f32x16 d = mm32(SL(4), oxm, SL(5), oyn, zero16()); store_T(SL(7), d, tmt, tnt, lane, ost, ident); }
            __syncthreads();
            if (w < 4) { f32x16 d = mm32(SL(7), oxm, SL(6), oyn, zero16()); store_T(SL(4), d, tmt, tnt, lane, ost, ident);
                         racc = mm32(SL(7), oxm, SL(17), oyn, racc); store_T(SL(8), racc, tmt, tnt, lane, ost, ident); }
            else       { f32x16 d = mm32(SL(6), oxm, SL(7), oyn, zero16()); store_T(SL(5), d, tmt, tnt, lane, ost, ident); }
            __syncthreads();
            if (w < 4) { racc = mm32(SL(5), oxm, SL(8), oyn, racc); store_T(SL(17), racc, tmt, tnt, lane, ost, ident); }
            else       { f32x16 d = mm32(SL(4), oxm, SL(5), oyn, zero16()); store_T(SL(7), d, tmt, tnt, lane, ost, ident); }
            __syncthreads();
            if (w < 4) { racc = mm32(SL(7), oxm, SL(17), oyn, racc); store_T(SL(8), racc, tmt, tnt, lane, ost, ident); }
            else       { f32x16 d = mm32(SL(14), oxm, SL(13), oyn, zero16()); store_T(SL(6), d, tmt, tnt, lane, ost, ident); }
            __syncthreads();
            if (w < 4) { f32x16 d = mm32(SL(8), oxm, SL(9), oyn, zero16()); store_T(SL(4), d, tmt, tnt, lane, ost, ident); }
            else       { f32x16 d = mm32(SL(8), oxm, SL(6), oyn, zero16()); store_T(SL(5), d, tmt, tnt, lane, ost, [](float v, int, int) { return -v; }); }
            __syncthreads();
            {
                const int ln = lane & 31;
                if (w < 4) {
                    const f32x16 d = mm32(SL(4), oxm, SL(11), oyn, zero16());
                    const int j = tnt * 32 + ln; const float pc = PC[j];
                    bf16* dst = TC + item * 4096;
#pragma unroll
                    for (int g = 0; g < 4; ++g) {
                        const int jp0 = tmt * 32 + 8 * g + 4 * hh;
                        float v[4];
#pragma unroll
                        for (int r = 0; r < 4; ++r) v[r] = ((jp0 + r == j) ? pc : 0.f) - d[4 * g + r];
                        const int a = jp0 >> 4, qp = (jp0 & 15) >> 2, s_ = a >> 1, m16 = j >> 4, L = (qp << 4) | (j & 15);
                        u32x2 o; o.x = pk2(v[0], v[1]); o.y = pk2(v[2], v[3]);
                        *(u32x2*)(dst + ((m16 * 2 + s_) * 64 + L) * 8 + (a & 1) * 4) = o;
                    }
                    const f32x16 d2 = mm32(SL(4), oxm, SL(15), oyn, zero16());
                    const int tq_ = tnt * 32 + ln;
                    bf16* dq = QC + item * 4096;
#pragma unroll
                    for (int g = 0; g < 4; ++g) {
                        const int j0 = tmt * 32 + 8 * g + 4 * hh;
                        const u32x2 rv = *(const u32x2*)(SL(10) + ost[g]);
                        u32x2 o; o.x = pk2(bflo(rv.x) - d2[4 * g], bfhi(rv.x) - d2[4 * g + 1]); o.y = pk2(bflo(rv.y) - d2[4 * g + 2], bfhi(rv.y) - d2[4 * g + 3]);
                        *(u32x2*)(dq + tq_ * 64 + j0) = o;
                    }
                } else {
                    f32x16 d = mm32(SL(11), oxm, SL(5), oyn, zero16());
                    d = mm32(SL(12), oxm, SL(13), oyn, d);
                    const int i = tnt * 32 + ln;
                    bf16* dg = GC + item * 4096;
#pragma unroll
                    for (int g = 0; g < 4; ++g) {
                        const int j0 = tmt * 32 + 8 * g + 4 * hh;
                        const int m16 = j0 >> 4, qq = (j0 & 15) >> 2, L = (qq << 4) | (i & 15), iq = i >> 4;
                        u32x2 o; o.x = pk2(d[4 * g], d[4 * g + 1]); o.y = pk2(d[4 * g + 2], d[4 * g + 3]);
                        *(u32x2*)(dg + (iq * 64 + L) * 16 + m16 * 4) = o;
                    }
                    f32x16 d2 = mm32(SL(5), oxm, SL(15), oyn, zero16());
                    d2 = mm32(SL(13), oxm, SL(16), oyn, d2);
                    bf16* dol = OL + item * 4096;
#pragma unroll
                    for (int g = 0; g < 4; ++g) {
                        u32x2 o; o.x = pk2(d2[4 * g], d2[4 * g + 1]); o.y = pk2(d2[4 * g + 2], d2[4 * g + 3]);
                        *(u32x2*)(dol + (((tnt * 2 + tmt) * 4 + g) * 64 + lane) * 4) = o;
                    }
                }
            }
        }
    }
#undef SL
}

__device__ __forceinline__ void phase_scan(const Params& p, int chain) {
    const int lane = opaque_tid() & 63;
    const int b = chain / 48, h = (chain >> 2) % NH, iq = chain & 3;
    const int q = lane >> 4, il = lane & 15;
    const bf16* TC = (const bf16*)(p.ws + WS_TC); const bf16* GC = (const bf16*)(p.ws + WS_GC); bf16* S0 = (bf16*)(p.ws + WS_S0);
    const size_t item0 = (size_t)(b * (SEQ / 64)) * NH + h;
    constexpr int PD = 4;
    u32x4 tq[PD][8]; u32x4 gq[PD][2];
    f32x4 S[4];
#pragma unroll
    for (int m = 0; m < 4; ++m) S[m] = (f32x4){0.f, 0.f, 0.f, 0.f};
#define P2_LOAD(d, cc) do { const bf16* tb = TC + (item0 + (size_t)(cc) * NH) * 4096; const bf16* gb = GC + (item0 + (size_t)(cc) * NH) * 4096 + (iq * 64 + lane) * 16; \
        _Pragma("unroll") for (int x = 0; x < 8; ++x) tq[d][x] = *(const u32x4*)(tb + (x * 64 + lane) * 8); \
        gq[d][0] = *(const u32x4*)(gb); gq[d][1] = *(const u32x4*)(gb + 8); } while (0)
#pragma unroll
    for (int d = 0; d < PD; ++d) P2_LOAD(d, d);
    for (int c = 0; c < SEQ / 64; c += PD) {
#pragma unroll
        for (int d = 0; d < PD; ++d) {
            const int cc = c + d;
            u32x4 sb0, sb1;
            sb0.x = pk2(S[0][0], S[0][1]); sb0.y = pk2(S[0][2], S[0][3]); sb0.z = pk2(S[1][0], S[1][1]); sb0.w = pk2(S[1][2], S[1][3]);
            sb1.x = pk2(S[2][0], S[2][1]); sb1.y = pk2(S[2][2], S[2][3]); sb1.z = pk2(S[3][0], S[3][1]); sb1.w = pk2(S[3][2], S[3][3]);
            bf16* so = S0 + (item0 + (size_t)cc * NH) * 4096 + (iq * 16 + il) * 64 + 4 * q;
            *(u32x2*)(so) = (u32x2){sb0.x, sb0.y}; *(u32x2*)(so + 16) = (u32x2){sb0.z, sb0.w};
            *(u32x2*)(so + 32) = (u32x2){sb1.x, sb1.y}; *(u32x2*)(so + 48) = (u32x2){sb1.z, sb1.w};
            f32x4 gi[4];
            gi[0] = (f32x4){bflo(gq[d][0].x), bfhi(gq[d][0].x), bflo(gq[d][0].y), bfhi(gq[d][0].y)};
            gi[1] = (f32x4){bflo(gq[d][0].z), bfhi(gq[d][0].z), bflo(gq[d][0].w), bfhi(gq[d][0].w)};
            gi[2] = (f32x4){bflo(gq[d][1].x), bfhi(gq[d][1].x), bflo(gq[d][1].y), bfhi(gq[d][1].y)};
            gi[3] = (f32x4){bflo(gq[d][1].z), bfhi(gq[d][1].z), bflo(gq[d][1].w), bfhi(gq[d][1].w)};
            const bf16x8 b0 = __builtin_bit_cast(bf16x8, sb0), b1 = __builtin_bit_cast(bf16x8, sb1);
#pragma unroll
            for (int m = 0; m < 4; ++m) {
                S[m] = MFMA16(__builtin_bit_cast(bf16x8, tq[d][2 * m]), b0, gi[m]);
                S[m] = MFMA16(__builtin_bit_cast(bf16x8, tq[d][2 * m + 1]), b1, S[m]);
            }
            if (cc + PD < SEQ / 64) P2_LOAD(d, cc + PD);
        }
    }
#undef P2_LOAD
}

__device__ __forceinline__ void phase_rwkv_out(const Params& p, int bid, int nb) {
    const int tid = opaque_tid(), lane = tid & 63, w = tid >> 6, ln = lane & 31, hh = lane >> 5;
    const bf16* S0 = (const bf16*)(p.ws + WS_S0); const bf16* QC = (const bf16*)(p.ws + WS_QC); const bf16* OL = (const bf16*)(p.ws + WS_OL);
    const bf16* G1 = (const bf16*)((const unsigned char*)p.out + OUT_G1); const bf16* G2 = (const bf16*)((const unsigned char*)p.out + OUT_G2);
    bf16* mix = (bf16*)(p.ws + WS_MIXIN);
    const int ntask = BATCH * (SEQ / 64) * NH * 2;
    for (int task = bid * 8 + w; task < ntask; task += nb * 8) {
        const int item = task >> 1, nt = task & 1;
        const int h = item % NH, bc = item / NH;
        const int tok0 = bc * 64;
        f32x16 acc[2];
#pragma unroll
        for (int mt = 0; mt < 2; ++mt)
#pragma unroll
            for (int g = 0; g < 4; ++g) {
                const u32x2 v = *(const u32x2*)(OL + (size_t)item * 4096 + (((nt * 2 + mt) * 4 + g) * 64 + lane) * 4);
                acc[mt][4 * g] = bflo(v.x); acc[mt][4 * g + 1] = bfhi(v.x); acc[mt][4 * g + 2] = bflo(v.y); acc[mt][4 * g + 3] = bfhi(v.y);
            }
        const int t = nt * 32 + ln;
#pragma unroll
        for (int s = 0; s < 4; ++s) {
            const bf16x8 bq = *(const bf16x8*)(QC + (size_t)item * 4096 + t * 64 + 16 * s + 8 * hh);
#pragma unroll
            for (int mt = 0; mt < 2; ++mt) {
                const bf16x8 a = *(const bf16x8*)(S0 + (size_t)item * 4096 + (mt * 32 + ln) * 64 + 16 * s + 8 * hh);
                acc[mt] = MFMA32(a, bq, acc[mt]);
            }
        }
        float s1 = 0.f;
#pragma unroll
        for (int mt = 0; mt < 2; ++mt)
#pragma unroll
            for (int r = 0; r < 16; ++r) s1 += acc[mt][r];
        s1 += __shfl_xor(s1, 32);
        const float mean = s1 * (1.f / 64.f);
        float s2 = 0.f;
#pragma unroll
        for (int mt = 0; mt < 2; ++mt)
#pragma unroll
            for (int r = 0; r < 16; ++r) { acc[mt][r] -= mean; s2 += acc[mt][r] * acc[mt][r]; }
        s2 += __shfl_xor(s2, 32);
        const float rstd = rsqrtf(s2 * (1.f / 64.f) + LNX_EPS);
#pragma unroll
        for (int mt = 0; mt < 2; ++mt)
#pragma unroll
            for (int g = 0; g < 4; ++g) {
                const int i0 = mt * 32 + 8 * g + 4 * hh;
                const u32x2 a1 = *(const u32x2*)(G1 + (size_t)item * 4096 + t * 64 + i0), a2 = *(const u32x2*)(G2 + (size_t)item * 4096 + t * 64 + i0);
                u32x2 o;
                o.x = pk2(acc[mt][4 * g] * rstd * bflo(a1.x) + bflo(a2.x), acc[mt][4 * g + 1] * rstd * bfhi(a1.x) + bfhi(a2.x));
                o.y = pk2(acc[mt][4 * g + 2] * rstd * bflo(a1.y) + bflo(a2.y), acc[mt][4 * g + 3] * rstd * bfhi(a1.y) + bfhi(a2.y));
                *(u32x2*)(mix + (size_t)(tok0 + t) * DM + D_POOL + h * 64 + i0) = o;
            }
    }
}

struct EpiOut {
    const float* X; float* O; int row0, col0;
    __device__ __forceinline__ void operator()(const f32x4 (&acc)[8][4], int wr, int wc, int fr, int fq) const {
#pragma unroll
        for (int m = 0; m < 8; ++m) {
            const size_t off = (size_t)(row0 + wr * 128 + m * 16 + fr) * DM + col0 + wc * 64 + fq * 4;
#pragma unroll
            for (int n = 0; n < 4; ++n) { const f32x4 xv = *(const f32x4*)(X + off + n * 16); *(f32x4*)(O + off + n * 16) = xv * ALPHA + acc[m][n]; }
        }
    }
};
__device__ __forceinline__ void phase_outproj(const Params& p, unsigned char* lds, int bid, int nb) {
    const int tid = opaque_tid();
    const bf16* a = (const bf16*)(p.ws + WS_MIXIN); const bf16* wt = (const bf16*)(p.ws + WS_WOUT_T);
    for (int u = bid; u < 256; u += nb) {
        const int pm = u & 63, pn = u >> 6;
        unsigned arow[4], brow[4];
#pragma unroll
        for (int i = 0; i < 4; ++i) { const int pp = tid + NT * i, r = pp >> 3, s = pp & 7;
            arow[i] = (unsigned)((pm * 256 + r) * DM + s * 8); brow[i] = (unsigned)((pn * 256 + r) * DM + s * 8); }
        EpiOut e{p.in[0], p.out, pm * 256, pn * 256};
        gemm_unit(lds, a, arow, wt, brow, DM, e);
    }
}

__device__ __forceinline__ void phase_ln_router(const Params& p, unsigned char* lds, int bid, int nb) {
    const int tid = opaque_tid(), lane = tid & 63, w = tid >> 6;
    float* RT = (float*)lds;
    __syncthreads();
    {
        const f32x4* src = (const f32x4*)(p.ws + WS_RTT);
        f32x4 tmp[18];
#pragma unroll
        for (int i = 0; i < 18; ++i) tmp[i] = src[tid + i * NT];
#pragma unroll
        for (int i = 0; i < 18; ++i) ((f32x4*)RT)[tid + i * NT] = tmp[i];
    }
    __syncthreads();
    const float* g1 = p.in[16]; const float* b1 = p.in[17]; const float* rgb = p.in[19]; const float* reb = p.in[21];
    float* H = p.out; bf16* hb = (bf16*)(p.ws + WS_HB);
    unsigned* cnt = (unsigned*)(p.ws + WS_CTL);
    int* list = (int*)(p.ws + WS_LIST); float* lwt = (float*)(p.ws + WS_LWT);
    for (int row = bid * 8 + w; row < NTOK; row += nb * 8) {
        float* hr = H + (size_t)row * DM;
        f32x4 v[4]; float s = 0.f;
#pragma unroll
        for (int j = 0; j < 4; ++j) { v[j] = *(const f32x4*)(hr + j * 256 + lane * 4); s += (v[j].x + v[j].y) + (v[j].z + v[j].w); }
        const float mean = wave_sum(s) * (1.f / DM);
        float s2 = 0.f;
#pragma unroll
        for (int j = 0; j < 4; ++j) { v[j] = v[j] - mean; s2 += (v[j].x * v[j].x + v[j].y * v[j].y) + (v[j].z * v[j].z + v[j].w * v[j].w); }
        const float rstd = rsqrtf(wave_sum(s2) * (1.f / DM) + LN_EPS);
#pragma unroll
        for (int j = 0; j < 4; ++j) {
            const f32x4 g = *(const f32x4*)(g1 + j * 256 + lane * 4), bb = *(const f32x4*)(b1 + j * 256 + lane * 4);
            v[j] = v[j] * rstd * g + bb;
            *(f32x4*)(hr + j * 256 + lane * 4) = v[j];
            u32x2 o; o.x = pk2(v[j].x, v[j].y); o.y = pk2(v[j].z, v[j].w);
            *(u32x2*)(hb + (size_t)row * DM + j * 256 + lane * 4) = o;
        }
        float gl[4];
#pragma unroll
        for (int q = 0; q < 4; ++q) {
            float a = 0.f;
#pragma unroll
            for (int j = 0; j < 4; ++j) { const f32x4 r = *(const f32x4*)(RT + q * 1024 + j * 256 + lane * 4); a += v[j].x * r.x + v[j].y * r.y + v[j].z * r.z + v[j].w * r.w; }
            gl[q] = wave_sum(a) + rgb[q];
        }
        int gi = 0; float gm = gl[0];
#pragma unroll
        for (int q = 1; q < 4; ++q) if (gl[q] > gm) { gm = gl[q]; gi = q; }
        float den = 0.f;
#pragma unroll
        for (int q = 0; q < 4; ++q) den += __expf(gl[q] - gm);
        const float gp = 1.f / den;
        gi = __builtin_amdgcn_readfirstlane(gi);
        float el[8];
#pragma unroll
        for (int q = 0; q < 8; ++q) el[q] = 0.f;
#pragma unroll 1
        for (int q = 0; q < 8; ++q) {
            const float* rt = RT + (4 + gi * 8 + q) * 1024 + lane * 4;
            float a = 0.f;
#pragma unroll
            for (int j = 0; j < 4; ++j) { const f32x4 r = *(const f32x4*)(rt + j * 256); a += v[j].x * r.x + v[j].y * r.y + v[j].z * r.z + v[j].w * r.w; }
            a = wave_sum(a) + reb[gi * 8 + q];
#pragma unroll
            for (int qq = 0; qq < 8; ++qq) el[qq] = (qq == q) ? a : el[qq];
        }
        int i0 = 0; float m0 = el[0];
#pragma unroll
        for (int q = 1; q < 8; ++q) if (el[q] > m0) { m0 = el[q]; i0 = q; }
        int i1 = -1; float m1 = -3.0e38f;
#pragma unroll
        for (int q = 0; q < 8; ++q) if (q != i0 && el[q] > m1) { m1 = el[q]; i1 = q; }
        const float e1 = __expf(m1 - m0);
        const float w0 = gp / (1.f + e1), w1 = gp * e1 / (1.f + e1);
        if (lane == 0) {
            const int ex0 = gi * 8 + i0, ex1 = gi * 8 + i1;
            const unsigned p0 = atomicAdd(&cnt[ex0], 1u), p1 = atomicAdd(&cnt[ex1], 1u);
            list[ex0 * NTOK + p0] = row * 2; lwt[ex0 * NTOK + p0] = w0;
            list[ex1 * NTOK + p1] = row * 2 + 1; lwt[ex1 * NTOK + p1] = w1;
        }
    }
}

__device__ __forceinline__ float siluf_(float x) { return x / (1.f + __expf(-x)); }
struct EpiGU {
    bf16* O; int row0, ct;
    __device__ __forceinline__ void operator()(const f32x4 (&acc)[8][4], int wr, int wc, int fr, int fq) const {
#pragma unroll
        for (int m = 0; m < 8; ++m) {
            bf16* rp = O + (size_t)(row0 + wr * 128 + m * 16 + fr) * DE + ct * 128 + wc * 32 + fq * 4;
#pragma unroll
            for (int n = 0; n < 2; ++n) {
                const f32x4 g = acc[m][n], u = acc[m][n + 2];
                u32x2 v; v.x = pk2(siluf_(g[0]) * u[0], siluf_(g[1]) * u[1]); v.y = pk2(siluf_(g[2]) * u[2], siluf_(g[3]) * u[3]);
                *(u32x2*)(rp + n * 16) = v;
            }
        }
    }
};
struct EpiDown {
    bf16* YS; const int* list; const float* lwt; int pos0, nvalid, col0;
    __device__ __forceinline__ void operator()(const f32x4 (&acc)[8][4], int wr, int wc, int fr, int fq) const {
#pragma unroll
        for (int m = 0; m < 8; ++m) {
            const int r = wr * 128 + m * 16 + fr;
            if (r < nvalid) {
                const int ts = list[pos0 + r]; const float wt = lwt[pos0 + r];
                bf16* rp = YS + (size_t)ts * DM + col0 + wc * 64 + fq * 4;
#pragma unroll
                for (int n = 0; n < 4; ++n) { u32x2 v; v.x = pk2(acc[m][n][0] * wt, acc[m][n][1] * wt); v.y = pk2(acc[m][n][2] * wt, acc[m][n][3] * wt); *(u32x2*)(rp + n * 16) = v; }
            }
        }
    }
};
__device__ __forceinline__ bool find_tile(const unsigned* cnt, int tile, int& e, int& rt, int& hoff) {
    int acc = 0;
    for (int i = 0; i < NEXP; ++i) { const int nt = ((int)cnt[i] + 255) >> 8; if (tile < acc + nt) { e = i; rt = tile - acc; hoff = (acc + rt) * 256; return true; } acc += nt; }
    return false;
}
__device__ __forceinline__ void phase_gateup(const Params& p, unsigned char* lds, int bid, int nb) {
    const int tid = opaque_tid();
    const unsigned* cnt = (const unsigned*)(p.ws + WS_CTL);
    const int* list = (const int*)(p.ws + WS_LIST);
    const bf16* hb = (const bf16*)(p.ws + WS_HB);
    for (int u = bid;; u += nb) {
        const int tile = u >> 1, ct = u & 1; int e, rt, hoff;
        if (!find_tile(cnt, tile, e, rt, hoff)) break;
        const int nv = min(256, (int)cnt[e] - rt * 256);
        unsigned arow[4], brow[4];
        const bf16* wt = (const bf16*)(p.ws + WS_EGU) + (size_t)e * 512 * DM + (size_t)ct * 256 * DM;
#pragma unroll
        for (int i = 0; i < 4; ++i) { const int pp = tid + NT * i, r = pp >> 3, s = pp & 7;
            const int tok = r < nv ? (list[e * NTOK + rt * 256 + r] >> 1) : 0;
            arow[i] = (unsigned)(tok * DM + s * 8); brow[i] = (unsigned)(r * DM + s * 8); }
        EpiGU ep{(bf16*)(p.ws + WS_HID), hoff, ct};
        gemm_unit(lds, hb, arow, wt, brow, DM, ep);
    }
}
__device__ __forceinline__ void phase_down(const Params& p, unsigned char* lds, int bid, int nb) {
    const int tid = opaque_tid();
    const unsigned* cnt = (const unsigned*)(p.ws + WS_CTL);
    const bf16* hid = (const bf16*)(p.ws + WS_HID);
    for (int u = bid;; u += nb) {
        const int tile = u >> 2, ct = u & 3; int e, rt, hoff;
        if (!find_tile(cnt, tile, e, rt, hoff)) break;
        const int nv = min(256, (int)cnt[e] - rt * 256);
        unsigned arow[4], brow[4];
        const bf16* wt = (const bf16*)(p.ws + WS_EDN) + (size_t)e * DM * DE + (size_t)ct * 256 * DE;
#pragma unroll
        for (int i = 0; i < 4; ++i) { const int pp = tid + NT * i, r = pp >> 3, s = pp & 7;
            arow[i] = (unsigned)((hoff + r) * DE + s * 8); brow[i] = (unsigned)(r * DE + s * 8); }
        EpiDown ep{(bf16*)(p.ws + WS_YS), (const int*)(p.ws + WS_LIST) + e * NTOK, (const float*)(p.ws + WS_LWT) + e * NTOK, rt * 256, nv, ct * 256};
        gemm_unit(lds, hid, arow, wt, brow, DE, ep);
    }
}

__device__ __forceinline__ void phase_final(const Params& p, int bid, int nb) {
    const int tid = opaque_tid(), lane = tid & 63, w = tid >> 6;
    const float* g2 = p.in[25]; const float* b2 = p.in[26];
    const bf16* ys = (const bf16*)(p.ws + WS_YS);
    for (int row = bid * 8 + w; row < NTOK; row += nb * 8) {
        float* hr = p.out + (size_t)row * DM;
        f32x4 v[4]; float s = 0.f;
#pragma unroll
        for (int j = 0; j < 4; ++j) {
            const f32x4 hv = *(const f32x4*)(hr + j * 256 + lane * 4);
            const u32x2 y0 = *(const u32x2*)(ys + (size_t)row * 2 * DM + j * 256 + lane * 4), y1 = *(const u32x2*)(ys + (size_t)row * 2 * DM + DM + j * 256 + lane * 4);
            v[j].x = hv.x * ALPHA + (bflo(y0.x) + bflo(y1.x)); v[j].y = hv.y * ALPHA + (bfhi(y0.x) + bfhi(y1.x));
            v[j].z = hv.z * ALPHA + (bflo(y0.y) + bflo(y1.y)); v[j].w = hv.w * ALPHA + (bfhi(y0.y) + bfhi(y1.y));
            s += (v[j].x + v[j].y) + (v[j].z + v[j].w);
        }
        const float mean = wave_sum(s) * (1.f / DM);
        float s2 = 0.f;
#pragma unroll
        for (int j = 0; j < 4; ++j) { v[j] = v[j] - mean; s2 += (v[j].x * v[j].x + v[j].y * v[j].y) + (v[j].z * v[j].z + v[j].w * v[j].w); }
        const float rstd = rsqrtf(wave_sum(s2) * (1.f / DM) + LN_EPS);
#pragma unroll
        for (int j = 0; j < 4; ++j) {
            const f32x4 g = *(const f32x4*)(g2 + j * 256 + lane * 4), bb = *(const f32x4*)(b2 + j * 256 + lane * 4);
            *(f32x4*)(hr + j * 256 + lane * 4) = v[j] * rstd * g + bb;
        }
    }
}

#define LAS __attribute__((address_space(3)))
#define XB_TMO      128
#define XB_XCNT(j)  (256  + 64 * (j))
#define XB_XSUB(j)  (1280 + 64 * (j))
#define XB_XGEN(j)  (2304 + 64 * (j))
#define XB_TOP      3328
#define XB_TOPGEN   3392
#define XCD_BAR_WORDS 3456
#define XB_SPIN_CAP (1u << 18)
__device__ __forceinline__ unsigned xb_ld(unsigned* p)              { return __hip_atomic_load(p, __ATOMIC_RELAXED, __HIP_MEMORY_SCOPE_AGENT); }
__device__ __forceinline__ unsigned xb_add(unsigned* p, unsigned v) { return __hip_atomic_fetch_add(p, v, __ATOMIC_RELAXED, __HIP_MEMORY_SCOPE_AGENT); }
__device__ __forceinline__ unsigned xb_xcc_id() { return (unsigned)__builtin_amdgcn_s_getreg((3 << 11) | 20) & 0xFu; }
#define XB_SPIN(cond, bar) do { unsigned _sp = 0; while (cond) { __builtin_amdgcn_s_sleep(1); \
    if ((++_sp & 255u) == 0u) { if (xb_ld(&(bar)[XB_TMO])) break; if (_sp > XB_SPIN_CAP) { atomicAdd(&(bar)[XB_TMO], 1u); break; } } } } while (0)
struct XcdBarrier { unsigned* bar; unsigned x; volatile LAS unsigned* st; };
__device__ __forceinline__ XcdBarrier xcd_barrier_post(unsigned* bar, volatile LAS unsigned* st) {
    XcdBarrier b; b.bar = bar; b.x = xb_xcc_id(); b.st = st;
    if (threadIdx.x == 0) (void)xb_add(&bar[XB_XCNT(b.x)], 1u);
    return b;
}
__device__ __forceinline__ void xcd_barrier_complete(unsigned* bar, unsigned x, unsigned& nloc, unsigned& nx) {
    const unsigned G = gridDim.x * gridDim.y * gridDim.z;
    unsigned sum, cnt, mine, sp = 0u;
    for (;;) {
        sum = 0u; cnt = 0u; mine = 0u;
#pragma unroll
        for (unsigned j = 0; j < 16; ++j) { const unsigned c = xb_ld(&bar[XB_XCNT(j)]); sum += c; cnt += (c > 0u) ? 1u : 0u; mine = (j == x) ? c : mine; }
        if (sum == G) break;
        __builtin_amdgcn_s_sleep(1);
        if ((++sp & 255u) == 0u) { if (xb_ld(&bar[XB_TMO])) break; if (sp > XB_SPIN_CAP) { atomicAdd(&bar[XB_TMO], 1u); break; } }
    }
    nloc = mine > 0u ? mine : 1u; nx = cnt > 0u ? cnt : 1u;
}
__device__ __forceinline__ void xcd_barrier(const XcdBarrier& b) {
    asm volatile("s_waitcnt vmcnt(0)" ::: "memory");
    __syncthreads();
    if (threadIdx.x == 0) {
        unsigned* bar = b.bar;
        __builtin_amdgcn_s_waitcnt(0);
        unsigned nloc = b.st[0], nx = b.st[1];
        if (nloc == 0u) { xcd_barrier_complete(bar, b.x, nloc, nx); b.st[0] = nloc; b.st[1] = nx; }
        const unsigned old = xb_add(&bar[XB_XSUB(b.x)], 1u);
        const unsigned gen = old / nloc;
        if (old + 1u == (gen + 1u) * nloc) {
            __builtin_amdgcn_fence(__ATOMIC_RELEASE, "agent");
            asm volatile("s_waitcnt vmcnt(0)" ::: "memory");
            const unsigned og = xb_add(&bar[XB_TOP], 1u);
            const unsigned tg = og / nx;
            if (og + 1u == (tg + 1u) * nx) xb_add(&bar[XB_TOPGEN], 1u);
            else XB_SPIN(xb_ld(&bar[XB_TOPGEN]) == tg, bar);
            __builtin_amdgcn_fence(__ATOMIC_ACQUIRE, "agent");
            xb_add(&bar[XB_XGEN(b.x)], 1u);
            asm volatile("s_waitcnt vmcnt(0)" ::: "memory");
        } else {
            XB_SPIN(xb_ld(&bar[XB_XGEN(b.x)]) == gen, bar);
            __builtin_amdgcn_fence(__ATOMIC_ACQUIRE, "agent");
            asm volatile("s_waitcnt vmcnt(0)" ::: "memory");
        }
    }
    __syncthreads();
}

__global__ void __launch_bounds__(NT) fwd_kernel(Params p) {
    extern __shared__ __attribute__((aligned(16))) unsigned char lds[];
    cg::grid_group grid = cg::this_grid();
    const int bid = blockIdx.x, nb = gridDim.x;
    volatile LAS unsigned* bst = (volatile LAS unsigned*)(LAS unsigned char*)(lds + BAR_LDS_OFF);
    if (threadIdx.x < 2) bst[threadIdx.x] = 0u;
    __syncthreads();
    XcdBarrier xb = xcd_barrier_post((unsigned*)(p.ws + WS_CTL) + CW_BAR, bst);
#define GRID_BAR() xcd_barrier(xb)
    if (p.pad != 0) grid.sync();
    phase_convert(p, lds, bid, nb);
    GRID_BAR();
    phase_proj(p, lds, bid, nb);
    GRID_BAR();
    phase_prep(p, lds, bid, nb);
    phase_pool(p, lds, bid, nb);
    GRID_BAR();
    if (bid < 96) { if (threadIdx.x < 64) phase_scan(p, bid); }
    else phase_convert_experts(p, lds, bid - 96, nb - 96);
    GRID_BAR();
    phase_rwkv_out(p, bid, nb);
    GRID_BAR();
    phase_outproj(p, lds, bid, nb);
    GRID_BAR();
    phase_ln_router(p, lds, bid, nb);
    GRID_BAR();
    phase_gateup(p, lds, bid, nb);
    GRID_BAR();
    phase_down(p, lds, bid, nb);
    GRID_BAR();
    phase_final(p, bid, nb);
}

extern "C" void kernel_launch(void* const* d_in, const int* in_sizes, int n_in, void* d_out, int out_size, void* d_ws, size_t ws_size, hipStream_t stream) {
    static int grid_blocks = 0;
    if (!grid_blocks) {
        if (hipFuncSetAttribute((const void*)fwd_kernel, hipFuncAttributeMaxDynamicSharedMemorySize, LDS_BYTES) != hipSuccess) fprintf(stderr, "hipFuncSetAttribute failed\n");
        int dev = 0, cus = 0, per_cu = 0;
        (void)hipGetDevice(&dev);
        (void)hipDeviceGetAttribute(&cus, hipDeviceAttributeMultiprocessorCount, dev);
        (void)hipOccupancyMaxActiveBlocksPerMultiprocessor(&per_cu, (const void*)fwd_kernel, NT, LDS_BYTES);
        if (per_cu < 1) { fprintf(stderr, "occupancy query says %d blocks/CU\n", per_cu); per_cu = 1; }
        grid_blocks = cus;
        fprintf(stderr, "grid %d (cus %d, per_cu %d)\n", grid_blocks, cus, per_cu);
    }
    Params p{};
    for (int i = 0; i < 27; ++i) p.in[i] = (const float*)d_in[i];
    p.out = (float*)d_out; p.ws = (unsigned char*)d_ws;
    (void)hipMemsetAsync((char*)d_ws + WS_CTL, 0, 65536, stream);
    void* args[] = {&p};
    hipError_t e = hipLaunchCooperativeKernel((const void*)fwd_kernel, dim3(grid_blocks), dim3(NT), args, LDS_BYTES, stream);
    if (e != hipSuccess) fprintf(stderr, "cooperative launch failed: %s (grid %d)\n", hipGetErrorString(e), grid_blocks);
}
```

```cpp
#include <hip/hip_runtime.h>
#include <hip/hip_cooperative_groups.h>
#include <cstdio>
#include <cstdint>
namespace cg = cooperative_groups;

typedef unsigned short bf16;
typedef short bf16x8 __attribute__((ext_vector_type(8)));
typedef float f32x4 __attribute__((ext_vector_type(4)));
typedef unsigned u32x4 __attribute__((ext_vector_type(4)));
typedef unsigned u32x2 __attribute__((ext_vector_type(2)));
typedef float f32x16 __attribute__((ext_vector_type(16)));
typedef float f32x2 __attribute__((ext_vector_type(2)));
typedef __bf16 bf16x2_t __attribute__((ext_vector_type(2)));

constexpr int DM = 1024, BATCH = 2, SEQ = 8192, NTOK = BATCH * SEQ;
constexpr int D_POOL = 256, D_RWKV = 768, NH = 12, HS = 64;
constexpr int D_IN = 2816;
constexpr int C_R = 256, C_K = 1024, C_V = 1792, C_WD = 2560, C_AD = 2624, C_GD = 2688;
constexpr int NEXP = 32, DE = 256;
constexpr float LN_EPS = 1e-5f, LNX_EPS = 64e-5f;
constexpr float ALPHA = 1.189207115002721f;
constexpr int NT = 512;
constexpr int BAR_LDS_OFF = 147968;
constexpr int CW_BAR = 4096;
constexpr int CST_LDS_OFF = 148480;
constexpr int PREV_LDS_OFF = 151040;
constexpr int LDS_BYTES = 152576;

constexpr size_t MiB = 1u << 20;
constexpr size_t WS_CTL = 0;
constexpr size_t WS_WIN_T = 1 * MiB;
constexpr size_t WS_WOUT_T = 7 * MiB;
constexpr size_t WS_WUPT = 9 * MiB;
constexpr size_t WS_AUPT = 9 * MiB + 128 * 1024;
constexpr size_t WS_GUPT = 9 * MiB + 256 * 1024;
constexpr size_t WS_RTT = 9 * MiB + 512 * 1024;
constexpr size_t WS_PWT = 9 * MiB + 768 * 1024;
constexpr size_t WS_XB = 10 * MiB;
constexpr size_t WS_TC = 10 * MiB;
constexpr size_t WS_MIXIN = 42 * MiB;
constexpr size_t WS_PROJ = 74 * MiB;
constexpr size_t WS_EGU = 74 * MiB;
constexpr size_t WS_EDN = 106 * MiB;
constexpr size_t WS_S0 = 122 * MiB;
constexpr size_t WS_GC = 162 * MiB;
constexpr size_t WS_QC = 186 * MiB;
constexpr size_t WS_OL = 210 * MiB;
constexpr size_t OUT_G1 = 0;
constexpr size_t OUT_G2 = 24 * MiB;
constexpr size_t WS_YS = 122 * MiB;
constexpr size_t WS_HB = 186 * MiB;
constexpr size_t WS_LIST = 218 * MiB;
constexpr size_t WS_LWT = 220 * MiB;
constexpr size_t WS_HID = 222 * MiB;

struct Params {
    const float* in[27];
    float* out;
    unsigned char* ws;
    int phase;
    int pad;
};

__device__ __forceinline__ unsigned f2bf(float f) { unsigned u = __builtin_bit_cast(unsigned, f); return (u + 0x7fffu + ((u >> 16) & 1u)) >> 16; }
__device__ __forceinline__ unsigned pk2(float lo, float hi) { f32x2 v = {lo, hi}; bf16x2_t b = __builtin_convertvector(v, bf16x2_t); return __builtin_bit_cast(unsigned, b); }
__device__ __forceinline__ float bf2f(unsigned short b) { return __builtin_bit_cast(float, (unsigned)b << 16); }
__device__ __forceinline__ float bflo(unsigned u) { return __builtin_bit_cast(float, u << 16); }
__device__ __forceinline__ float bfhi(unsigned u) { return __builtin_bit_cast(float, u & 0xffff0000u); }
template <int CTRL> __device__ __forceinline__ float dppmov(float v) { return __builtin_bit_cast(float, __builtin_amdgcn_update_dpp(0, __builtin_bit_cast(int, v), CTRL, 0xf, 0xf, true)); }
__device__ __forceinline__ float wave_sum(float v) {
    v += dppmov<0xB1>(v);
    v += dppmov<0x4E>(v);
    v += dppmov<0x141>(v);
    v += dppmov<0x140>(v);
    const float s0 = __builtin_bit_cast(float, __builtin_amdgcn_readlane(__builtin_bit_cast(int, v), 0));
    const float s1 = __builtin_bit_cast(float, __builtin_amdgcn_readlane(__builtin_bit_cast(int, v), 16));
    const float s2 = __builtin_bit_cast(float, __builtin_amdgcn_readlane(__builtin_bit_cast(int, v), 32));
    const float s3 = __builtin_bit_cast(float, __builtin_amdgcn_readlane(__builtin_bit_cast(int, v), 48));
    return (s0 + s1) + (s2 + s3);
}
__device__ __forceinline__ int opaque_tid() { int t = threadIdx.x; asm volatile("" : "+v"(t)); return t; }
__device__ __forceinline__ float sigmoidf_(float x) { return 1.f / (1.f + __expf(-x)); }

template <class Epi>
__device__ __forceinline__ void gemm_unit(unsigned char* lds, const bf16* __restrict__ abase, const unsigned (&arow)[4], const bf16* __restrict__ bbase, const unsigned (&brow)[4], int K, Epi& epi) {
    const int tid = opaque_tid(), lane = tid & 63, w = tid >> 6, wr = w >> 2, wc = w & 3;
    const int srow = tid >> 3, sslot = tid & 7;
    const int st_off = srow * 128 + ((sslot ^ ((srow >> 1) & 7)) << 4);
    const int fr = lane & 15, fq = lane >> 4, x = fr >> 1;
    int offA[2], offB[2];
#pragma unroll
    for (int s = 0; s < 2; ++s) {
        const int slot = (s * 4 + fq) ^ x;
        offA[s] = (wr * 128 + fr) * 128 + (slot << 4);
        offB[s] = 32768 + (wc * 64 + fr) * 128 + (slot << 4);
    }
    f32x4 acc[8][4];
#pragma unroll
    for (int m = 0; m < 8; ++m)
#pragma unroll
        for (int n = 0; n < 4; ++n) acc[m][n] = (f32x4){0.f, 0.f, 0.f, 0.f};
    u32x4 ra[4], rb[4];
#pragma unroll
    for (int i = 0; i < 4; ++i) { ra[i] = *(const u32x4*)(abase + arow[i]); rb[i] = *(const u32x4*)(bbase + brow[i]); }
    __syncthreads();
#pragma unroll
    for (int i = 0; i < 4; ++i) { *(u32x4*)(lds + st_off + i * 8192) = ra[i]; *(u32x4*)(lds + 32768 + st_off + i * 8192) = rb[i]; }
    __syncthreads();
    const int KT = K >> 6;
    for (int kt = 0; kt < KT; ++kt) {
        unsigned char* cur = lds + (kt & 1) * 65536;
        unsigned char* nxt = lds + ((kt + 1) & 1) * 65536;
        if (kt + 1 < KT) {
#pragma unroll
            for (int i = 0; i < 4; ++i) { ra[i] = *(const u32x4*)(abase + arow[i] + (kt + 1) * 64); rb[i] = *(const u32x4*)(bbase + brow[i] + (kt + 1) * 64); }
        }
#pragma unroll
        for (int s = 0; s < 2; ++s) {
            bf16x8 bfr[4];
#pragma unroll
            for (int n = 0; n < 4; ++n) bfr[n] = *(const bf16x8*)(cur + offB[s] + n * 2048);
#pragma unroll
            for (int m = 0; m < 8; ++m) {
                const bf16x8 afr = *(const bf16x8*)(cur + offA[s] + m * 2048);
#pragma unroll
                for (int n = 0; n < 4; ++n) acc[m][n] = __builtin_amdgcn_mfma_f32_16x16x32_bf16(bfr[n], afr, acc[m][n], 0, 0, 0);
            }
        }
        if (kt + 1 < KT) {
#pragma unroll
            for (int i = 0; i < 4; ++i) { *(u32x4*)(nxt + st_off + i * 8192) = ra[i]; *(u32x4*)(nxt + 32768 + st_off + i * 8192) = rb[i]; }
        }
        __syncthreads();
    }
    epi(acc, wr, wc, fr, fq);
}

__device__ __forceinline__ int gu_row(int c, int half) { return ((c >> 7) << 8) + (((c >> 5) & 3) << 6) + (half << 5) + (c & 31); }
__device__ __forceinline__ void tr_tile(unsigned char* lds, const float* __restrict__ src, int ldsrc, int k0, int n0, bf16* __restrict__ dst, int ldd, int mode) {
    float* t = (float*)lds;
    const int tid = opaque_tid();
    __syncthreads();
#pragma unroll
    for (int i = 0; i < 8; ++i) { const int e = tid + i * NT, k = e >> 6, n = e & 63; t[k * 65 + n] = src[(size_t)(k0 + k) * ldsrc + n0 + n]; }
    __syncthreads();
    const int n = tid >> 3, kc = tid & 7;
    const float* s = t + (kc * 8) * 65 + n;
    u32x4 o; o.x = pk2(s[0], s[65]); o.y = pk2(s[2 * 65], s[3 * 65]); o.z = pk2(s[4 * 65], s[5 * 65]); o.w = pk2(s[6 * 65], s[7 * 65]);
    const int nn = n0 + n;
    const int drow = mode == 0 ? nn : gu_row(nn, mode - 1);
    *(u32x4*)(dst + (size_t)drow * ldd + k0 + kc * 8) = o;
}

__device__ __forceinline__ void phase_convert(const Params& p, unsigned char* lds, int bid, int nb) {
    const int tid = opaque_tid();
    {
        const float* x = p.in[0]; bf16* xb = (bf16*)(p.ws + WS_XB);
        const size_t n8 = (size_t)NTOK * DM / 8;
        for (size_t i = (size_t)bid * NT + tid; i < n8; i += (size_t)nb * NT) {
            const f32x4 a = *(const f32x4*)(x + i * 8), b = *(const f32x4*)(x + i * 8 + 4);
            u32x4 o; o.x = pk2(a.x, a.y); o.y = pk2(a.z, a.w); o.z = pk2(b.x, b.y); o.w = pk2(b.z, b.w);
            *(u32x4*)(xb + i * 8) = o;
        }
    }
    constexpr int T_WIN = (DM / 64) * (D_IN / 64);
    constexpr int T_WOUT = (DM / 64) * (DM / 64);
    constexpr int T_ALL = T_WIN + T_WOUT + 12 + 12 + 24 + 4;
    for (int it = bid; it < T_ALL; it += nb) {
        int r = it;
        if (r < T_WIN) { const int kb = r / (D_IN / 64), nbk = r % (D_IN / 64); tr_tile(lds, p.in[1], D_IN, kb * 64, nbk * 64, (bf16*)(p.ws + WS_WIN_T), DM, 0); continue; }
        r -= T_WIN;
        if (r < T_WOUT) { const int kb = r / (DM / 64), nbk = r % (DM / 64); tr_tile(lds, p.in[15], DM, kb * 64, nbk * 64, (bf16*)(p.ws + WS_WOUT_T), DM, 0); continue; }
        r -= T_WOUT;
        if (r < 12) { tr_tile(lds, p.in[6], D_RWKV, 0, r * 64, (bf16*)(p.ws + WS_WUPT), 64, 0); continue; }
        r -= 12;
        if (r < 12) { tr_tile(lds, p.in[8], D_RWKV, 0, r * 64, (bf16*)(p.ws + WS_AUPT), 64, 0); continue; }
        r -= 12;
        if (r < 24) { tr_tile(lds, p.in[9], D_RWKV, (r / 12) * 64, (r % 12) * 64, (bf16*)(p.ws + WS_GUPT), 128, 0); continue; }
        r -= 24;
        { tr_tile(lds, p.in[2] + r * 4096, 64, 0, 0, (bf16*)(p.ws + WS_PWT) + r * 4096, 64, 0); }
    }
    {
        float* rtt = (float*)(p.ws + WS_RTT); const float* rg = p.in[18]; const float* re = p.in[20];
        for (int e = bid * NT + tid; e < 36 * 1024; e += nb * NT) { const int j = e >> 10, k = e & 1023; rtt[e] = j < 4 ? rg[k * 4 + j] : re[k * 32 + (j - 4)]; }
    }
}
__device__ __forceinline__ void phase_convert_experts(const Params& p, unsigned char* lds, int bid, int nb) {
    constexpr int T_EG = NEXP * (DM / 64) * (DE / 64);
    constexpr int T_ED = NEXP * (DE / 64) * (DM / 64);
    constexpr int T_ALL = 2 * T_EG + T_ED;
    for (int it = bid; it < T_ALL; it += nb) {
        int r = it;
        if (r < 2 * T_EG) {
            const int half = r / T_EG; r -= half * T_EG;
            const int e = r / 64, q = r % 64, kb = q / 4, nbk = q % 4;
            tr_tile(lds, p.in[22 + half] + (size_t)e * DM * DE, DE, kb * 64, nbk * 64, (bf16*)(p.ws + WS_EGU) + (size_t)e * 512 * DM, DM, 1 + half); continue;
        }
        r -= 2 * T_EG;
        { const int e = r / 64, q = r % 64, kb = q / 16, nbk = q % 16;
          tr_tile(lds, p.in[24] + (size_t)e * DE * DM, DM, kb * 64, nbk * 64, (bf16*)(p.ws + WS_EDN) + (size_t)e * DM * DE, DE, 0); }
    }
}

struct EpiProj {
    bf16* O; int row0, col0;
    __device__ __forceinline__ void operator()(const f32x4 (&acc)[8][4], int wr, int wc, int fr, int fq) const {
#pragma unroll
        for (int m = 0; m < 8; ++m) {
            bf16* rp = O + (size_t)(row0 + wr * 128 + m * 16 + fr) * D_IN + col0 + wc * 64 + fq * 4;
#pragma unroll
            for (int n = 0; n < 4; ++n) { u32x2 v; v.x = pk2(acc[m][n][0], acc[m][n][1]); v.y = pk2(acc[m][n][2], acc[m][n][3]); *(u32x2*)(rp + n * 16) = v; }
        }
    }
};
__device__ __forceinline__ void phase_proj(const Params& p, unsigned char* lds, int bid, int nb) {
    const int tid = opaque_tid();
    const bf16* xb = (const bf16*)(p.ws + WS_XB); const bf16* wt = (const bf16*)(p.ws + WS_WIN_T);
    constexpr int NU = 64 * 11;
    for (int u = bid; u < NU; u += nb) {
        const int pm = u & 63, pn = u >> 6;
        unsigned arow[4], brow[4];
#pragma unroll
        for (int i = 0; i < 4; ++i) { const int pp = tid + NT * i, r = pp >> 3, s = pp & 7;
            arow[i] = (unsigned)((pm * 256 + r) * DM + s * 8); brow[i] = (unsigned)((pn * 256 + r) * DM + s * 8); }
        EpiProj e{(bf16*)(p.ws + WS_PROJ), pm * 256, pn * 256};
        gemm_unit(lds, xb, arow, wt, brow, DM, e);
    }
}

__device__ __forceinline__ int sw_off(int row, int col) { return row * 128 + ((((col >> 3) ^ ((row >> 1) & 7)) << 4) | ((col & 7) << 1)); }
__device__ __forceinline__ void phase_pool(const Params& p, unsigned char* lds, int bid, int nb) {
    const int tid = opaque_tid(), lane = tid & 63, w = __builtin_amdgcn_readfirstlane(tid >> 6);
    const bf16* proj = (const bf16*)(p.ws + WS_PROJ);
    bf16* mix = (bf16*)(p.ws + WS_MIXIN);
    const bf16* pwT = (const bf16*)(p.ws + WS_PWT); const float* ps = p.in[3];
    float* pbuf = (float*)lds;
    unsigned char* dslot = lds + 81920;
    for (int it = bid; it < NTOK / 64; it += nb) {
        const int tok0 = it * 64, t0 = tok0 % SEQ;
        __syncthreads();
#pragma unroll 2
        for (int e = tid; e < 79 * 64; e += NT) {
            const int r = e >> 6, c4 = e & 63; const int tt = t0 - 15 + r;
            float4 v = {0.f, 0.f, 0.f, 0.f};
            if (tt >= 0) { const u32x2 q = *(const u32x2*)(proj + (size_t)(tok0 - 15 + r) * D_IN + c4 * 4); v.x = bflo(q.x); v.y = bfhi(q.x); v.z = bflo(q.y); v.w = bfhi(q.y); }
            *(float4*)(pbuf + r * 256 + c4 * 4) = v;
        }
        __syncthreads();
#pragma unroll 2
        for (int e = tid; e < 64 * 64; e += NT) {
            const int t = e >> 6, c = (e & 63) * 4, g = c >> 6, win = 2 << g;
            const int cnt = min(t0 + t + 1, win);
            f32x4 sm = {0.f, 0.f, 0.f, 0.f};
            for (int j = 0; j < cnt; ++j) sm += *(const f32x4*)(pbuf + (t + 15 - j) * 256 + c);
            const f32x4 d = sm * (1.f / (float)cnt) - *(const f32x4*)(pbuf + (t + 15) * 256 + c);
            u32x2 o; o.x = pk2(d.x, d.y); o.y = pk2(d.z, d.w);
            *(u32x2*)(dslot + g * 8192 + sw_off(t, c & 63)) = o;
        }
        __syncthreads();
        {
            const int g = w >> 1, nt = w & 1, ln = lane & 31, hh = lane >> 5, t = nt * 32 + ln;
            f32x16 acc[2];
#pragma unroll
            for (int mt = 0; mt < 2; ++mt) for (int r = 0; r < 16; ++r) acc[mt][r] = 0.f;
#pragma unroll
            for (int s_ = 0; s_ < 4; ++s_) {
                const bf16x8 bd = *(const bf16x8*)(dslot + g * 8192 + sw_off(t, 16 * s_ + 8 * hh));
#pragma unroll
                for (int mt = 0; mt < 2; ++mt) {
                    const bf16x8 aw = *(const bf16x8*)(pwT + g * 4096 + (mt * 32 + ln) * 64 + 16 * s_ + 8 * hh);
                    acc[mt] = __builtin_amdgcn_mfma_f32_32x32x16_bf16(aw, bd, acc[mt], 0, 0, 0);
                }
            }
#pragma unroll
            for (int mt = 0; mt < 2; ++mt)
#pragma unroll
                for (int gg = 0; gg < 4; ++gg) {
                    const int d0 = mt * 32 + 8 * gg + 4 * hh;
                    const f32x4 sc = *(const f32x4*)(ps + g * 64 + d0);
                    u32x2 o; o.x = pk2(acc[mt][4 * gg] * sc.x, acc[mt][4 * gg + 1] * sc.y); o.y = pk2(acc[mt][4 * gg + 2] * sc.z, acc[mt][4 * gg + 3] * sc.w);
                    *(u32x2*)(mix + (size_t)(tok0 + t) * DM + g * 64 + d0) = o;
                }
        }
    }
}

constexpr int SLOTB = 8192;
#define MFMA32(a, b, c) __builtin_amdgcn_mfma_f32_32x32x16_bf16((a), (b), (c), 0, 0, 0)
#define MFMA16(a, b, c) __builtin_amdgcn_mfma_f32_16x16x32_bf16((a), (b), (c), 0, 0, 0)
__device__ __forceinline__ f32x16 mm32(const unsigned char* X, const int (&ox)[4], const unsigned char* Y, const int (&oy)[4], f32x16 acc) {
#pragma unroll
    for (int s = 0; s < 4; ++s) {
        const bf16x8 a = *(const bf16x8*)(X + ox[s]);
        const bf16x8 b = *(const bf16x8*)(Y + oy[s]);
        acc = MFMA32(a, b, acc);
    }
    return acc;
}
template <class F>
__device__ __forceinline__ void store_T(unsigned char* Z, const f32x16& d, int mt, int nt, int lane, const int (&ost)[4], F f) {
    const int n = nt * 32 + (lane & 31), h = lane >> 5;
#pragma unroll
    for (int g = 0; g < 4; ++g) {
        const int m0 = mt * 32 + 8 * g + 4 * h;
        u32x2 v; v.x = pk2(f(d[4 * g], m0, n), f(d[4 * g + 1], m0 + 1, n)); v.y = pk2(f(d[4 * g + 2], m0 + 2, n), f(d[4 * g + 3], m0 + 3, n));
        *(u32x2*)(Z + ost[g]) = v;
    }
}
__device__ __forceinline__ f32x16 zero16() { f32x16 z; for (int i = 0; i < 16; ++i) z[i] = 0.f; return z; }
__device__ __forceinline__ void st_b16(unsigned char* Z, int row, int col, float v) { *(unsigned short*)(Z + sw_off(row, col)) = (unsigned short)pk2(v, 0.f); }

__device__ __forceinline__ void phase_prep(const Params& p, unsigned char* lds, int bid, int nb) {
    const int tid = opaque_tid();
    const bf16* proj = (const bf16*)(p.ws + WS_PROJ);
    const float* mu = p.in[4]; const float* w0 = p.in[5]; const float* a0 = p.in[7];
    const float* k_k = p.in[10]; const float* k_a = p.in[11]; const float* r_k = p.in[12];
    const float* lnx_g = p.in[13]; const float* lnx_b = p.in[14];
    const bf16* wupT = (const bf16*)(p.ws + WS_WUPT); const bf16* aupT = (const bf16*)(p.ws + WS_AUPT); const bf16* gupT = (const bf16*)(p.ws + WS_GUPT);
    bf16* TC = (bf16*)(p.ws + WS_TC); bf16* GC = (bf16*)(p.ws + WS_GC); bf16* QC = (bf16*)(p.ws + WS_QC); bf16* OL = (bf16*)(p.ws + WS_OL);
    bf16* G1 = (bf16*)((unsigned char*)p.out + OUT_G1); bf16* G2 = (bf16*)((unsigned char*)p.out + OUT_G2);
#define SL(i) (lds + (i) * SLOTB)
    float* PC = (float*)(lds + 18 * SLOTB);
    float* CST = (float*)(lds + CST_LDS_OFF);
    unsigned char* PREV = lds + PREV_LDS_OFF;
    u32x4 pf[8];
    const int prow = tid >> 3, pchunk = tid & 7;
    const int pst = prow * 128 + ((pchunk ^ ((prow >> 1) & 7)) << 4);
    const unsigned pgo = (unsigned)(prow * (D_IN * 2) + pchunk * 16), pgg = (unsigned)(prow * 256 + pchunk * 16);
#define PREP_PREFETCH(hn, tok0_, has_prev) do { \
        const unsigned char* pb_ = (const unsigned char*)(proj + (size_t)(tok0_) * D_IN + C_R + (hn) * 64); \
        pf[0] = *(const u32x4*)(pb_ + pgo); pf[1] = *(const u32x4*)(pb_ + 2 * D_RWKV + pgo); pf[2] = *(const u32x4*)(pb_ + 4 * D_RWKV + pgo); \
        int tl_ = tid; asm volatile("" : "+v"(tl_)); \
        pf[3] = ((const u32x4*)(wupT + (hn) * 4096))[tl_]; \
        pf[4] = ((const u32x4*)(aupT + (hn) * 4096))[tl_]; \
        const unsigned char* gb_ = (const unsigned char*)(gupT + (hn) * 8192); \
        pf[5] = *(const u32x4*)(gb_ + pgg); pf[6] = *(const u32x4*)(gb_ + 128 + pgg); \
        pf[7] = (u32x4){0u, 0u, 0u, 0u}; \
        if (tid < 160) { const int arr_ = tl_ >> 4, c4_ = (tl_ & 15) * 4; \
            const float* src_ = arr_ < 3 ? mu + arr_ * D_RWKV : (arr_ == 3 ? w0 : (arr_ == 4 ? a0 : (arr_ == 5 ? k_k : (arr_ == 6 ? k_a : (arr_ == 7 ? r_k : (arr_ == 8 ? lnx_g : lnx_b)))))); \
            pf[7] = *(const u32x4*)(src_ + (hn) * 64 + c4_); } \
        else if (tid < 184 && (has_prev)) { const int x_ = (tl_ - 160) >> 3, ch_ = (tl_ - 160) & 7; \
            pf[7] = *(const u32x4*)(pb_ - 2 * D_IN + x_ * 2 * D_RWKV + ch_ * 16); } \
    } while (0)
#define PREP_STAGE() do { \
        *(u32x4*)(SL(6) + pst) = pf[0]; *(u32x4*)(SL(7) + pst) = pf[1]; *(u32x4*)(SL(8) + pst) = pf[2]; \
        *(u32x4*)(SL(9) + pst) = pf[3]; *(u32x4*)(SL(10) + pst) = pf[4]; *(u32x4*)(SL(11) + pst) = pf[5]; *(u32x4*)(SL(12) + pst) = pf[6]; \
        if (tid < 160) *(u32x4*)((unsigned char*)CST + tid * 16) = pf[7]; \
        else if (tid < 184) *(u32x4*)(PREV + (tid - 160) * 16) = pf[7]; \
    } while (0)
    for (int it = bid; it < BATCH * (SEQ / 64); it += nb) {
        const int b = it / (SEQ / 64), c = it % (SEQ / 64), tok0 = b * SEQ + c * 64;
        PREP_PREFETCH(0, tok0, c > 0);
        __syncthreads();
#pragma unroll
        for (int e = tid; e < 64 * 32; e += NT) {
            const int tt = e >> 5, k8 = (e & 31) * 8;
            const bf16* cur = proj + (size_t)(tok0 + tt) * D_IN + C_WD + k8;
            const u32x4 cv = *(const u32x4*)cur;
            u32x4 pv = {0u, 0u, 0u, 0u};
            if (c * 64 + tt > 0) pv = *(const u32x4*)(cur - D_IN);
            const f32x4 m0 = *(const f32x4*)(mu + C_WD - D_POOL + k8), m1 = *(const f32x4*)(mu + C_WD - D_POOL + k8 + 4);
            float z[8];
            z[0] = bflo(cv.x) + (bflo(pv.x) - bflo(cv.x)) * m0.x; z[1] = bfhi(cv.x) + (bfhi(pv.x) - bfhi(cv.x)) * m0.y;
            z[2] = bflo(cv.y) + (bflo(pv.y) - bflo(cv.y)) * m0.z; z[3] = bfhi(cv.y) + (bfhi(pv.y) - bfhi(cv.y)) * m0.w;
            z[4] = bflo(cv.z) + (bflo(pv.z) - bflo(cv.z)) * m1.x; z[5] = bfhi(cv.z) + (bfhi(pv.z) - bfhi(cv.z)) * m1.y;
            z[6] = bflo(cv.w) + (bflo(pv.w) - bflo(cv.w)) * m1.z; z[7] = bfhi(cv.w) + (bfhi(pv.w) - bfhi(cv.w)) * m1.w;
            if (k8 < 64) { for (int j = 0; j < 8; ++j) z[j] = 1.f - 2.f / (1.f + __expf(2.f * z[j])); }
            else if (k8 >= 128) { for (int j = 0; j < 8; ++j) z[j] = sigmoidf_(z[j]); }
            u32x4 o; o.x = pk2(z[0], z[1]); o.y = pk2(z[2], z[3]); o.z = pk2(z[4], z[5]); o.w = pk2(z[6], z[7]);
            *(u32x4*)(SL(k8 >> 6) + sw_off(tt, k8 & 63)) = o;
        }
#pragma unroll 1
        for (int h = 0; h < NH; ++h) {
            const size_t item = ((size_t)(b * (SEQ / 64) + c)) * NH + h;
            int tid_ = tid; asm volatile("" : "+v"(tid_));
            const int lane = tid_ & 63, w = __builtin_amdgcn_readfirstlane(tid_ >> 6);
            const int ts = w & 3, tl = lane & 15, q = lane >> 4, t = ts * 16 + tl;
            const int tmt = (w >> 1) & 1, tnt = w & 1, hh = lane >> 5;
            int offT[4], offR[4], offL[2], offM[2];
        #pragma unroll
            for (int r = 0; r < 4; ++r) { offT[r] = sw_off(4 * q + r, t); offR[r] = sw_off(t, r * 16 + 4 * q); }
        #pragma unroll
            for (int ks = 0; ks < 2; ++ks) { offL[ks] = sw_off(t, 32 * ks + 8 * q); offM[ks] = sw_off(tl, 32 * ks + 8 * q); }
            int oxm[4], oyn[4], ost[4];
        #pragma unroll
            for (int s_ = 0; s_ < 4; ++s_) { oxm[s_] = sw_off(tmt * 32 + (lane & 31), 16 * s_ + 8 * hh); oyn[s_] = sw_off(tnt * 32 + (lane & 31), 16 * s_ + 8 * hh); ost[s_] = sw_off(tnt * 32 + (lane & 31), tmt * 32 + 8 * s_ + 4 * hh); }
            int offRp[4];
#pragma unroll
            for (int r = 0; r < 4; ++r) offRp[r] = sw_off((t + 63) & 63, r * 16 + 4 * q);
            __syncthreads();
            PREP_STAGE();
            if (h + 1 < NH) PREP_PREFETCH(h + 1, tok0, c > 0);
            __syncthreads();
            if (w < 4) {
                float lw[16], kap[16], bv[16], kn[16], rm[16];
                float vm[16];
                float nsq = 0.f, bon = 0.f;
                {
                    f32x4 accw[4], acca[4];
#pragma unroll
                    for (int m = 0; m < 4; ++m) { accw[m] = (f32x4){0.f, 0.f, 0.f, 0.f}; acca[m] = accw[m]; }
#pragma unroll
                    for (int ks = 0; ks < 2; ++ks) {
                        const bf16x8 bw = *(const bf16x8*)(SL(0) + offL[ks]);
                        const bf16x8 ba = *(const bf16x8*)(SL(1) + offL[ks]);
#pragma unroll
                        for (int m = 0; m < 4; ++m) {
                            const bf16x8 aw = *(const bf16x8*)(SL(9) + offM[ks] + m * 2048);
                            const bf16x8 aa = *(const bf16x8*)(SL(10) + offM[ks] + m * 2048);
                            accw[m] = MFMA16(aw, bw, accw[m]); acca[m] = MFMA16(aa, ba, acca[m]);
                        }
                    }
                    const bool hp = (c * 64 + t) > 0;
#pragma unroll
                    for (int m = 0; m < 4; ++m) {
                        const int ch0 = m * 16 + 4 * q;
                        float zz[3][4];
#pragma unroll
                        for (int x = 0; x < 3; ++x) {
                            const u32x2 cv = *(const u32x2*)(SL(6 + x) + offR[m]);
                            u32x2 pv = *(const u32x2*)(tl + ts > 0 ? SL(6 + x) + offRp[m] : PREV + x * 128 + ch0 * 2);
                            if (!hp) pv = (u32x2){0u, 0u};
                            const f32x4 mm = *(const f32x4*)(CST + x * 64 + ch0);
                            zz[x][0] = bflo(cv.x) + (bflo(pv.x) - bflo(cv.x)) * mm.x; zz[x][1] = bfhi(cv.x) + (bfhi(pv.x) - bfhi(cv.x)) * mm.y;
                            zz[x][2] = bflo(cv.y) + (bflo(pv.y) - bflo(cv.y)) * mm.z; zz[x][3] = bfhi(cv.y) + (bfhi(pv.y) - bfhi(cv.y)) * mm.w;
                        }
                        const f32x4 w0v = *(const f32x4*)(CST + 3 * 64 + ch0), a0v = *(const f32x4*)(CST + 4 * 64 + ch0), kkv = *(const f32x4*)(CST + 5 * 64 + ch0), kav = *(const f32x4*)(CST + 6 * 64 + ch0), rkv = *(const f32x4*)(CST + 7 * 64 + ch0);
#pragma unroll
                        for (int r = 0; r < 4; ++r) {
                            const int e = m * 4 + r;
                            const float xx = w0v[r] + accw[m][r];
                            const float sp = (-xx > 20.f) ? -xx : __logf(1.f + __expf(-xx));
                            lw[e] = -__expf(-sp - 0.5f);
                            const float av = sigmoidf_(a0v[r] + acca[m][r]);
                            rm[e] = zz[0][r]; vm[e] = zz[2][r];
                            kap[e] = zz[1][r] * kkv[r]; nsq += kap[e] * kap[e];
                            kn[e] = zz[1][r] * (1.f + (av - 1.f) * kav[r]);
                            bon += rm[e] * kn[e] * rkv[r];
                            bv[e] = av;
                        }
                        __builtin_amdgcn_sched_barrier(0);
                    }
                }
                nsq += __shfl_xor(nsq, 16); nsq += __shfl_xor(nsq, 32);
                bon += __shfl_xor(bon, 16); bon += __shfl_xor(bon, 32);
                const float inv = 1.f / fmaxf(sqrtf(nsq), 1e-12f);
#pragma unroll
                for (int m = 0; m < 4; ++m) {
#pragma unroll
                    for (int r = 0; r < 4; ++r) {
                        const int e = m * 4 + r;
                        kap[e] *= inv; bv[e] *= kap[e];
                        const unsigned hi = pk2(lw[e], 0.f) & 0xffffu; const float hif = __builtin_bit_cast(float, hi << 16);
                        *(unsigned short*)(SL(4) + offT[r] + m * 2048) = (unsigned short)hi;
                        *(unsigned short*)(SL(5) + offT[r] + m * 2048) = (unsigned short)pk2(lw[e] - hif, 0.f);
                        *(unsigned short*)(SL(13) + offT[r] + m * 2048) = (unsigned short)pk2(vm[e], 0.f);
                    }
                }
                {
                    f32x4 accg[4];
#pragma unroll
                    for (int m = 0; m < 4; ++m) accg[m] = (f32x4){0.f, 0.f, 0.f, 0.f};
#pragma unroll
                    for (int ks = 0; ks < 4; ++ks) {
                        const bf16x8 bg = *(const bf16x8*)(SL(2 + (ks >> 1)) + offL[ks & 1]);
#pragma unroll
                        for (int m = 0; m < 4; ++m) {
                            const bf16x8 ag = *(const bf16x8*)(SL(11 + (ks >> 1)) + offM[ks & 1] + m * 2048);
                            accg[m] = MFMA16(ag, bg, accg[m]);
                        }
                    }
#pragma unroll
                    for (int m = 0; m < 4; ++m) {
                        const int ch0 = m * 16 + 4 * q;
                        const f32x4 lg = *(const f32x4*)(CST + 8 * 64 + ch0), lb = *(const f32x4*)(CST + 9 * 64 + ch0);
                        u32x2 v1, v2;
                        v1.x = pk2(lg[0] * accg[m][0], lg[1] * accg[m][1]); v1.y = pk2(lg[2] * accg[m][2], lg[3] * accg[m][3]);
                        v2.x = pk2((lb[0] + bon * vm[m * 4]) * accg[m][0], (lb[1] + bon * vm[m * 4 + 1]) * accg[m][1]);
                        v2.y = pk2((lb[2] + bon * vm[m * 4 + 2]) * accg[m][2], (lb[3] + bon * vm[m * 4 + 3]) * accg[m][3]);
                        *(u32x2*)(G1 + item * 4096 + t * 64 + ch0) = v1;
                        *(u32x2*)(G2 + item * 4096 + t * 64 + ch0) = v2;
                    }
                }
                __syncthreads();
                f32x4 La[4], Ta[4];
#pragma unroll
                for (int m = 0; m < 4; ++m) { La[m] = (f32x4){0.f, 0.f, 0.f, 0.f}; Ta[m] = La[m]; }
#pragma unroll
                for (int ks = 0; ks < 2; ++ks) {
                    bf16x8 btri, bone;
#pragma unroll
                    for (int e = 0; e < 8; ++e) { const int s_ = 32 * ks + 8 * q + e; btri[e] = (short)((s_ <= t) ? 0x3F80 : 0); bone[e] = (short)0x3F80; }
#pragma unroll
                    for (int m = 0; m < 4; ++m) {
                        const bf16x8 ah = *(const bf16x8*)(SL(4) + offM[ks] + m * 2048);
                        const bf16x8 al = *(const bf16x8*)(SL(5) + offM[ks] + m * 2048);
                        La[m] = MFMA16(ah, btri, La[m]); La[m] = MFMA16(al, btri, La[m]);
                        Ta[m] = MFMA16(ah, bone, Ta[m]); Ta[m] = MFMA16(al, bone, Ta[m]);
                    }
                }
                __syncthreads();
#pragma unroll
                for (int m = 0; m < 4; ++m) {
                    const int ch0 = m * 16 + 4 * q;
                    float kt[4], rt[4], bt[4], kkt[4];
#pragma unroll
                    for (int r = 0; r < 4; ++r) {
                        const int e = m * 4 + r;
                        const float L = La[m][r], Lt = Ta[m][r];
                        const float eL = __expf(L), em = __expf(-L), eh = __expf(Lt - L), ex = __expf(L - lw[e]);
                        kt[r] = kap[e] * ex; rt[r] = rm[e] * eL; bt[r] = bv[e] * em; kkt[r] = kn[e] * em;
                        *(unsigned short*)(SL(9) + offT[r] + m * 2048) = (unsigned short)pk2(kt[r], 0.f);
                        *(unsigned short*)(SL(11) + offT[r] + m * 2048) = (unsigned short)pk2(bv[e] * eh, 0.f);
                        *(unsigned short*)(SL(12) + offT[r] + m * 2048) = (unsigned short)pk2(kn[e] * eh, 0.f);
                        if (t == 0) PC[ch0 + r] = __expf(Lt);
                    }
                    u32x2 v;
                    v.x = pk2(kt[0], kt[1]); v.y = pk2(kt[2], kt[3]); *(u32x2*)(SL(6) + offR[m]) = v;
                    v.x = pk2(bt[0], bt[1]); v.y = pk2(bt[2], bt[3]); *(u32x2*)(SL(7) + offR[m]) = v;
                    v.x = pk2(kkt[0], kkt[1]); v.y = pk2(kkt[2], kkt[3]); *(u32x2*)(SL(8) + offR[m]) = v;
                    v.x = pk2(rt[0], rt[1]); v.y = pk2(rt[2], rt[3]); *(u32x2*)(SL(10) + offR[m]) = v;
                }
            } else {
                __syncthreads();
                __syncthreads();
            }
            __syncthreads();
            f32x16 racc = zero16();
            {
                if (w < 4) {
                    f32x16 d = mm32(SL(7), oxm, SL(6), oyn, zero16());
                    const int tq_ = tnt * 32 + (lane & 31);
#pragma unroll
                    for (int r = 0; r < 16; ++r) { const int s_ = tmt * 32 + (r & 3) + 8 * (r >> 2) + 4 * hh; const float v = (s_ < tq_) ? d[r] : 0.f; d[r] = v; racc[r] = ((s_ == tq_) ? 1.f : 0.f) - v; }
                    store_T(SL(4), d, tmt, tnt, lane, ost, [](float v, int, int) { return v; });
                    store_T(SL(17), racc, tmt, tnt, lane, ost, [](float v, int, int) { return v; });
                } else {
                    f32x16 d = mm32(SL(6), oxm, SL(7), oyn, zero16());
                    store_T(SL(5), d, tmt, tnt, lane, ost, [](float v, int m, int n) { return (n < m) ? v : 0.f; });
                }
                if (w < 4) {
                    f32x16 d = mm32(SL(8), oxm, SL(6), oyn, zero16());
                    store_T(SL(14), d, tmt, tnt, lane, ost, [](float v, int m, int n) { return (m < n) ? v : 0.f; });
                } else {
                    f32x16 d = mm32(SL(7), oxm, SL(10), oyn, zero16());
                    store_T(SL(15), d, tmt, tnt, lane, ost, [](float v, int m, int n) { return (m <= n) ? v : 0.f; });
                }
                if (w < 4) {
                    f32x16 d = mm32(SL(8), oxm, SL(10), oyn, zero16());
                    store_T(SL(16), d, tmt, tnt, lane, ost, [](float v, int m, int n) { return (m <= n) ? v : 0.f; });
                }
            }
            __syncthreads();
            auto ident = [](float v, int, int) { return v; };
            if (w < 4) { f32x16 d = mm32(SL(5), oxm, SL(4), oyn, zero16()); store_T(SL(6), d, tmt, tnt, lane, ost, ident); }
            else       { f32x16 d = mm32(SL(4), oxm, SL(5), oyn, zero16()); store_T(SL(7), d, tmt, tnt, lane, ost, ident); }
            __syncthreads();
            if (w < 4) { f32x16 d = mm32(SL(7), oxm, SL(6), oyn, zero16()); store_T(SL(4), d, tmt, tnt, lane, ost, ident);
                         racc = mm32(SL(7), oxm, SL(17), oyn, racc); store_T(SL(8), racc, tmt, tnt, lane, ost, ident); }
            else       { f32x16 d = mm32(SL(6), oxm, SL(7), oyn, zero16()); store_T(SL(5), d, tmt, tnt, lane, ost, ident); }
            __syncthreads();
            if (w < 4) { f32x16 d = mm32(SL(5), oxm, SL(4), oyn, zero16()); store_T(SL(6), d, tmt, tnt, lane, ost, ident);
                         racc = mm32(SL(5), oxm, SL(8), oyn, racc); store_T(SL(17), racc, tmt, tnt, lane, ost, ident); }
            else       { f32x16 d = mm32(SL(4), oxm, SL(5), oyn, zero16()); store_T(SL(7), d, tmt, tnt, lane, ost, ident); }
            __syncthreads();
            if (w < 4) { f32x16 d = mm32(SL(7), oxm, SL(6), oyn, zero16()); store_T(SL(4), d, tmt, tnt, lane, ost, ident);
                         racc = mm32(SL(7), oxm, SL(17), oyn, racc); store_T(SL(8), racc, tmt, tnt, lane, ost, ident); }
            else       { f32x16 d = mm32(SL(6), oxm, SL(7), oyn, zero16()); store_T(SL(5), d, tmt, tnt, lane, ost, ident); }
            __syncthreads();
            if (w < 4) { racc = mm32(SL(5), oxm, SL(8), oyn, racc); store_T(SL(17), racc, tmt, tnt, lane, ost, ident); }
            else       { f32x16 d = mm32(SL(4), oxm, SL(5), oyn, zero16()); store_T(SL(7), d, tmt, tnt, lane, ost, ident); }
            __syncthreads();
            if (w < 4) { racc = mm32(SL(7), oxm, SL(17), oyn, racc); store_T(SL(8), racc, tmt, tnt, lane, ost, ident); }
            else       { f32x16 d = mm32(SL(14), oxm, SL(13), oyn, zero16()); store_T(SL(6), d, tmt, tnt, lane, ost, ident); }
            __syncthreads();
            if (w < 4) { f32x16 d = mm32(SL(8), oxm, SL(9), oyn, zero16()); store_T(SL(4), d, tmt, tnt, lane, ost, ident); }
            else       { f32x16 d = mm32(SL(8), oxm, SL(6), oyn, zero16()); store_T(SL(5), d, tmt, tnt, lane, ost, [](float v, int, int) { return -v; }); }
            __syncthreads();
            {
                const int ln = lane & 31;
                if (w < 4) {
                    const f32x16 d = mm32(SL(4), oxm, SL(11), oyn, zero16());
                    const int j = tnt * 32 + ln; const float pc = PC[j];
                    bf16* dst = TC + item * 4096;
#pragma unroll
                    for (int g = 0; g < 4; ++g) {
                        const int jp0 = tmt * 32 + 8 * g + 4 * hh;
                        float v[4];
#pragma unroll
                        for (int r = 0; r < 4; ++r) v[r] = ((jp0 + r == j) ? pc : 0.f) - d[4 * g + r];
                        const int a = jp0 >> 4, qp = (jp0 & 15) >> 2, s_ = a >> 1, m16 = j >> 4, L = (qp << 4) | (j & 15);
                        u32x2 o; o.x = pk2(v[0], v[1]); o.y = pk2(v[2], v[3]);
                        *(u32x2*)(dst + ((m16 * 2 + s_) * 64 + L) * 8 + (a & 1) * 4) = o;
                    }
                    const f32x16 d2 = mm32(SL(4), oxm, SL(15), oyn, zero16());
                    const int tq_ = tnt * 32 + ln;
                    bf16* dq = QC + item * 4096;
#pragma unroll
                    for (int g = 0; g < 4; ++g) {
                        const int j0 = tmt * 32 + 8 * g + 4 * hh;
                        const u32x2 rv = *(const u32x2*)(SL(10) + ost[g]);
                        u32x2 o; o.x = pk2(bflo(rv.x) - d2[4 * g], bfhi(rv.x) - d2[4 * g + 1]); o.y = pk2(bflo(rv.y) - d2[4 * g + 2], bfhi(rv.y) - d2[4 * g + 3]);
                        *(u32x2*)(dq + tq_ * 64 + j0) = o;
                    }
                } else {
                    f32x16 d = mm32(SL(11), oxm, SL(5), oyn, zero16());
                    d = mm32(SL(12), oxm, SL(13), oyn, d);
                    const int i = tnt * 32 + ln;
                    bf16* dg = GC + item * 4096;
#pragma unroll
                    for (int g = 0; g < 4; ++g) {
                        const int j0 = tmt * 32 + 8 * g + 4 * hh;
                        const int m16 = j0 >> 4, qq = (j0 & 15) >> 2, L = (qq << 4) | (i & 15), iq = i >> 4;
                        u32x2 o; o.x = pk2(d[4 * g], d[4 * g + 1]); o.y = pk2(d[4 * g + 2], d[4 * g + 3]);
                        *(u32x2*)(dg + (iq * 64 + L) * 16 + m16 * 4) = o;
                    }
                    f32x16 d2 = mm32(SL(5), oxm, SL(15), oyn, zero16());
                    d2 = mm32(SL(13), oxm, SL(16), oyn, d2);
                    bf16* dol = OL + item * 4096;
#pragma unroll
                    for (int g = 0; g < 4; ++g) {
                        u32x2 o; o.x = pk2(d2[4 * g], d2[4 * g + 1]); o.y = pk2(d2[4 * g + 2], d2[4 * g + 3]);
                        *(u32x2*)(dol + (((tnt * 2 + tmt) * 4 + g) * 64 + lane) * 4) = o;
                    }
                }
            }
        }
    }
#undef SL
}

__device__ __forceinline__ void phase_scan(const Params& p, int chain) {
    const int lane = opaque_tid() & 63;
    const int b = chain / 48, h = (chain >> 2) % NH, iq = chain & 3;
    const int q = lane >> 4, il = lane & 15;
    const bf16* TC = (const bf16*)(p.ws + WS_TC); const bf16* GC = (const bf16*)(p.ws + WS_GC); bf16* S0 = (bf16*)(p.ws + WS_S0);
    const size_t item0 = (size_t)(b * (SEQ / 64)) * NH + h;
    constexpr int PD = 4;
    u32x4 tq[PD][8]; u32x4 gq[PD][2];
    f32x4 S[4];
#pragma unroll
    for (int m = 0; m < 4; ++m) S[m] = (f32x4){0.f, 0.f, 0.f, 0.f};
#define P2_LOAD(d, cc) do { const bf16* tb = TC + (item0 + (size_t)(cc) * NH) * 4096; const bf16* gb = GC + (item0 + (size_t)(cc) * NH) * 4096 + (iq * 64 + lane) * 16; \
        _Pragma("unroll") for (int x = 0; x < 8; ++x) tq[d][x] = *(const u32x4*)(tb + (x * 64 + lane) * 8); \
        gq[d][0] = *(const u32x4*)(gb); gq[d][1] = *(const u32x4*)(gb + 8); } while (0)
#pragma unroll
    for (int d = 0; d < PD; ++d) P2_LOAD(d, d);
    for (int c = 0; c < SEQ / 64; c += PD) {
#pragma unroll
        for (int d = 0; d < PD; ++d) {
            const int cc = c + d;
            u32x4 sb0, sb1;
            sb0.x = pk2(S[0][0], S[0][1]); sb0.y = pk2(S[0][2], S[0][3]); sb0.z = pk2(S[1][0], S[1][1]); sb0.w = pk2(S[1][2], S[1][3]);
            sb1.x = pk2(S[2][0], S[2][1]); sb1.y = pk2(S[2][2], S[2][3]); sb1.z = pk2(S[3][0], S[3][1]); sb1.w = pk2(S[3][2], S[3][3]);
            bf16* so = S0 + (item0 + (size_t)cc * NH) * 4096 + (iq * 16 + il) * 64 + 4 * q;
            *(u32x2*)(so) = (u32x2){sb0.x, sb0.y}; *(u32x2*)(so + 16) = (u32x2){sb0.z, sb0.w};
            *(u32x2*)(so + 32) = (u32x2){sb1.x, sb1.y}; *(u32x2*)(so + 48) = (u32x2){sb1.z, sb1.w};
            f32x4 gi[4];
            gi[0] = (f32x4){bflo(gq[d][0].x), bfhi(gq[d][0].x), bflo(gq[d][0].y), bfhi(gq[d][0].y)};
            gi[1] = (f32x4){bflo(gq[d][0].z), bfhi(gq[d][0].z), bflo(gq[d][0].w), bfhi(gq[d][0].w)};
            gi[2] = (f32x4){bflo(gq[d][1].x), bfhi(gq[d][1].x), bflo(gq[d][1].y), bfhi(gq[d][1].y)};
            gi[3] = (f32x4){bflo(gq[d][1].z), bfhi(gq[d][1].z), bflo(gq[d][1].w), bfhi(gq[d][1].w)};
            const bf16x8 b0 = __builtin_bit_cast(bf16x8, sb0), b1 = __builtin_bit_cast(bf16x8, sb1);
#pragma unroll
            for (int m = 0; m < 4; ++m) {
                S[m] = MFMA16(__builtin_bit_cast(bf16x8, tq[d][2 * m]), b0, gi[m]);
                S[m] = MFMA16(__builtin_bit_cast(bf16x8, tq[d][2 * m + 1]), b1, S[m]);
            }
            if (cc + PD < SEQ / 64) P2_LOAD(d, cc + PD);
        }
    }
#undef P2_LOAD
}

__device__ __forceinline__ void phase_rwkv_out(const Params& p, int bid, int nb) {
    const int tid = opaque_tid(), lane = tid & 63, w = tid >> 6, ln = lane & 31, hh = lane >> 5;
    const bf16* S0 = (const bf16*)(p.ws + WS_S0); const bf16* QC = (const bf16*)(p.ws + WS_QC); const bf16* OL = (const bf16*)(p.ws + WS_OL);
    const bf16* G1 = (const bf16*)((const unsigned char*)p.out + OUT_G1); const bf16* G2 = (const bf16*)((const unsigned char*)p.out + OUT_G2);
    bf16* mix = (bf16*)(p.ws + WS_MIXIN);
    const int ntask = BATCH * (SEQ / 64) * NH * 2;
    for (int task = bid * 8 + w; task < ntask; task += nb * 8) {
        const int item = task >> 1, nt = task & 1;
        const int h = item % NH, bc = item / NH;
        const int tok0 = bc * 64;
        f32x16 acc[2];
#pragma unroll
        for (int mt = 0; mt < 2; ++mt)
#pragma unroll
            for (int g = 0; g < 4; ++g) {
                const u32x2 v = *(const u32x2*)(OL + (size_t)item * 4096 + (((nt * 2 + mt) * 4 + g) * 64 + lane) * 4);
                acc[mt][4 * g] = bflo(v.x); acc[mt][4 * g + 1] = bfhi(v.x); acc[mt][4 * g + 2] = bflo(v.y); acc[mt][4 * g + 3] = bfhi(v.y);
            }
        const int t = nt * 32 + ln;
#pragma unroll
        for (int s = 0; s < 4; ++s) {
            const bf16x8 bq = *(const bf16x8*)(QC + (size_t)item * 4096 + t * 64 + 16 * s + 8 * hh);
#pragma unroll
            for (int mt = 0; mt < 2; ++mt) {
                const bf16x8 a = *(const bf16x8*)(S0 + (size_t)item * 4096 + (mt * 32 + ln) * 64 + 16 * s + 8 * hh);
                acc[mt] = MFMA32(a, bq, acc[mt]);
            }
        }
        float s1 = 0.f;
#pragma unroll
        for (int mt = 0; mt < 2; ++mt)
#pragma unroll
            for (int r = 0; r < 16; ++r) s1 += acc[mt][r];
        s1 += __shfl_xor(s1, 32);
        const float mean = s1 * (1.f / 64.f);
        float s2 = 0.f;
#pragma unroll
        for (int mt = 0; mt < 2; ++mt)
#pragma unroll
            for (int r = 0; r < 16; ++r) { acc[mt][r] -= mean; s2 += acc[mt][r] * acc[mt][r]; }
        s2 += __shfl_xor(s2, 32);
        const float rstd = rsqrtf(s2 * (1.f / 64.f) + LNX_EPS);
#pragma unroll
        for (int mt = 0; mt < 2; ++mt)
#pragma unroll
            for (int g = 0; g < 4; ++g) {
                const int i0 = mt * 32 + 8 * g + 4 * hh;
                const u32x2 a1 = *(const u32x2*)(G1 + (size_t)item * 4096 + t * 64 + i0), a2 = *(const u32x2*)(G2 + (size_t)item * 4096 + t * 64 + i0);
                u32x2 o;
                o.x = pk2(acc[mt][4 * g] * rstd * bflo(a1.x) + bflo(a2.x), acc[mt][4 * g + 1] * rstd * bfhi(a1.x) + bfhi(a2.x));
                o.y = pk2(acc[mt][4 * g + 2] * rstd * bflo(a1.y) + bflo(a2.y), acc[mt][4 * g + 3] * rstd * bfhi(a1.y) + bfhi(a2.y));
                *(u32x2*)(mix + (size_t)(tok0 + t) * DM + D_POOL + h * 64 + i0) = o;
            }
    }
}

struct EpiOut {
    const float* X; float* O; int row0, col0;
    __device__ __forceinline__ void operator()(const f32x4 (&acc)[8][4], int wr, int wc, int fr, int fq) const {
#pragma unroll
        for (int m = 0; m < 8; ++m) {
            const size_t off = (size_t)(row0 + wr * 128 + m * 16 + fr) * DM + col0 + wc * 64 + fq * 4;
#pragma unroll
            for (int n = 0; n < 4; ++n) { const f32x4 xv = *(const f32x4*)(X + off + n * 16); *(f32x4*)(O + off + n * 16) = xv * ALPHA + acc[m][n]; }
        }
    }
};
__device__ __forceinline__ void phase_outproj(const Params& p, unsigned char* lds, int bid, int nb) {
    const int tid = opaque_tid();
    const bf16* a = (const bf16*)(p.ws + WS_MIXIN); const bf16* wt = (const bf16*)(p.ws + WS_WOUT_T);
    for (int u = bid; u < 256; u += nb) {
        const int pm = u & 63, pn = u >> 6;
        unsigned arow[4], brow[4];
#pragma unroll
        for (int i = 0; i < 4; ++i) { const int pp = tid + NT * i, r = pp >> 3, s = pp & 7;
            arow[i] = (unsigned)((pm * 256 + r) * DM + s * 8); brow[i] = (unsigned)((pn * 256 + r) * DM + s * 8); }
        EpiOut e{p.in[0], p.out, pm * 256, pn * 256};
        gemm_unit(lds, a, arow, wt, brow, DM, e);
    }
}

__device__ __forceinline__ void phase_ln_router(const Params& p, unsigned char* lds, int bid, int nb) {
    const int tid = opaque_tid(), lane = tid & 63, w = __builtin_amdgcn_readfirstlane(tid >> 6);
    float* RT = (float*)lds;
    unsigned* LCNT = (unsigned*)(lds + 147456);
    int* LENT = (int*)(lds + 147456 + 128);
    (void)LENT;
    __syncthreads();
    {
        const f32x4* src = (const f32x4*)(p.ws + WS_RTT);
        f32x4 tmp[18];
#pragma unroll
        for (int i = 0; i < 18; ++i) tmp[i] = src[tid + i * NT];
#pragma unroll
        for (int i = 0; i < 18; ++i) ((f32x4*)RT)[tid + i * NT] = tmp[i];
    }
    const float* g1 = p.in[16]; const float* b1 = p.in[17]; const float* rgb = p.in[19]; const float* reb = p.in[21];
    float* H = p.out; bf16* hb = (bf16*)(p.ws + WS_HB);
    unsigned* cnt = (unsigned*)(p.ws + WS_CTL);
    int* list = (int*)(p.ws + WS_LIST); float* lwt = (float*)(p.ws + WS_LWT);
    const int rows_per_wg = NTOK / nb;
    const int rpw = rows_per_wg / 8;
    const int row0 = bid * rows_per_wg + w * rpw;
    if (tid < 32) LCNT[tid] = 0u;
    __syncthreads();
    int my_e0 = 0, my_e1 = 0, my_r0 = 0, my_r1 = 0; float my_w0 = 0.f, my_w1 = 0.f;
    f32x4 nx[4];
#pragma unroll
    for (int j = 0; j < 4; ++j) nx[j] = *(const f32x4*)(H + (size_t)row0 * DM + j * 256 + lane * 4);
    for (int ri = 0; ri < rpw; ++ri) {
        const int row = row0 + ri;
        float* hr = H + (size_t)row * DM;
        f32x4 v[4]; float s = 0.f;
#pragma unroll
        for (int j = 0; j < 4; ++j) { v[j] = nx[j]; s += (v[j].x + v[j].y) + (v[j].z + v[j].w); }
        if (ri + 1 < rpw) {
#pragma unroll
            for (int j = 0; j < 4; ++j) nx[j] = *(const f32x4*)(hr + DM + j * 256 + lane * 4);
        }
        const float mean = wave_sum(s) * (1.f / DM);
        float s2 = 0.f;
#pragma unroll
        for (int j = 0; j < 4; ++j) { v[j] = v[j] - mean; s2 += (v[j].x * v[j].x + v[j].y * v[j].y) + (v[j].z * v[j].z + v[j].w * v[j].w); }
        const float rstd = rsqrtf(wave_sum(s2) * (1.f / DM) + LN_EPS);
#pragma unroll
        for (int j = 0; j < 4; ++j) {
            const f32x4 g = *(const f32x4*)(g1 + j * 256 + lane * 4), bb = *(const f32x4*)(b1 + j * 256 + lane * 4);
            v[j] = v[j] * rstd * g + bb;
            *(f32x4*)(hr + j * 256 + lane * 4) = v[j];
            u32x2 o; o.x = pk2(v[j].x, v[j].y); o.y = pk2(v[j].z, v[j].w);
            *(u32x2*)(hb + (size_t)row * DM + j * 256 + lane * 4) = o;
        }
        float gl[4];
#pragma unroll
        for (int q = 0; q < 4; ++q) {
            float a = 0.f;
#pragma unroll
            for (int j = 0; j < 4; ++j) { const f32x4 r = *(const f32x4*)(RT + q * 1024 + j * 256 + lane * 4); a += v[j].x * r.x + v[j].y * r.y + v[j].z * r.z + v[j].w * r.w; }
            gl[q] = a;
        }
#pragma unroll
        for (int q = 0; q < 4; ++q) gl[q] = wave_sum(gl[q]) + rgb[q];
        int gi = 0; float gm = gl[0];
#pragma unroll
        for (int q = 1; q < 4; ++q) if (gl[q] > gm) { gm = gl[q]; gi = q; }
        float den = 0.f;
#pragma unroll
        for (int q = 0; q < 4; ++q) den += __expf(gl[q] - gm);
        const float gp = 1.f / den;
        gi = __builtin_amdgcn_readfirstlane(gi);
        float el[8];
        const float* rtg = RT + (4 + gi * 8) * 1024 + lane * 4;
#pragma unroll
        for (int hq = 0; hq < 2; ++hq) {
            float part[4];
#pragma unroll
            for (int q = 0; q < 4; ++q) {
                float a = 0.f;
#pragma unroll
                for (int j = 0; j < 4; ++j) { const f32x4 r = *(const f32x4*)(rtg + (hq * 4 + q) * 1024 + j * 256); a += v[j].x * r.x + v[j].y * r.y + v[j].z * r.z + v[j].w * r.w; }
                part[q] = a;
            }
#pragma unroll
            for (int q = 0; q < 4; ++q) el[hq * 4 + q] = wave_sum(part[q]) + reb[gi * 8 + hq * 4 + q];
        }
        int i0 = 0; float m0 = el[0];
#pragma unroll
        for (int q = 1; q < 8; ++q) if (el[q] > m0) { m0 = el[q]; i0 = q; }
        int i1 = -1; float m1 = -3.0e38f;
#pragma unroll
        for (int q = 0; q < 8; ++q) if (q != i0 && el[q] > m1) { m1 = el[q]; i1 = q; }
        const float e1 = __expf(m1 - m0);
        const float w0 = gp / (1.f + e1), w1 = gp * e1 / (1.f + e1);
        if (lane == ri) {
            my_e0 = gi * 8 + i0; my_e1 = gi * 8 + i1; my_w0 = w0; my_w1 = w1;
            my_r0 = (int)atomicAdd(&LCNT[my_e0], 1u); my_r1 = (int)atomicAdd(&LCNT[my_e1], 1u);
        }
    }
    __syncthreads();
    if (tid < 32) { const unsigned c = LCNT[tid]; LCNT[tid] = c ? atomicAdd(&cnt[tid], c) : 0u; }
    __syncthreads();
    if (lane < rpw) {
        const int row = row0 + lane;
        const int p0 = (int)LCNT[my_e0] + my_r0, p1 = (int)LCNT[my_e1] + my_r1;
        list[my_e0 * NTOK + p0] = row * 2; lwt[my_e0 * NTOK + p0] = my_w0;
        list[my_e1 * NTOK + p1] = row * 2 + 1; lwt[my_e1 * NTOK + p1] = my_w1;
    }
}

__device__ __forceinline__ float siluf_(float x) { return x / (1.f + __expf(-x)); }
struct EpiGU {
    bf16* O; int row0, ct;
    __device__ __forceinline__ void operator()(const f32x4 (&acc)[8][4], int wr, int wc, int fr, int fq) const {
#pragma unroll
        for (int m = 0; m < 8; ++m) {
            bf16* rp = O + (size_t)(row0 + wr * 128 + m * 16 + fr) * DE + ct * 128 + wc * 32 + fq * 4;
#pragma unroll
            for (int n = 0; n < 2; ++n) {
                const f32x4 g = acc[m][n], u = acc[m][n + 2];
                u32x2 v; v.x = pk2(siluf_(g[0]) * u[0], siluf_(g[1]) * u[1]); v.y = pk2(siluf_(g[2]) * u[2], siluf_(g[3]) * u[3]);
                *(u32x2*)(rp + n * 16) = v;
            }
        }
    }
};
struct EpiDown {
    bf16* YS; const int* list; const float* lwt; int pos0, nvalid, col0;
    __device__ __forceinline__ void operator()(const f32x4 (&acc)[8][4], int wr, int wc, int fr, int fq) const {
#pragma unroll
        for (int m = 0; m < 8; ++m) {
            const int r = wr * 128 + m * 16 + fr;
            if (r < nvalid) {
                const int ts = list[pos0 + r]; const float wt = lwt[pos0 + r];
                bf16* rp = YS + (size_t)ts * DM + col0 + wc * 64 + fq * 4;
#pragma unroll
                for (int n = 0; n < 4; ++n) { u32x2 v; v.x = pk2(acc[m][n][0] * wt, acc[m][n][1] * wt); v.y = pk2(acc[m][n][2] * wt, acc[m][n][3] * wt); *(u32x2*)(rp + n * 16) = v; }
            }
        }
    }
};
__device__ __forceinline__ bool find_tile(const unsigned* cnt, int tile, int& e, int& rt, int& hoff) {
    int acc = 0;
    for (int i = 0; i < NEXP; ++i) { const int nt = ((int)cnt[i] + 255) >> 8; if (tile < acc + nt) { e = i; rt = tile - acc; hoff = (acc + rt) * 256; return true; } acc += nt; }
    return false;
}
__device__ __forceinline__ void phase_gateup(const Params& p, unsigned char* lds, int bid, int nb) {
    const int tid = opaque_tid();
    const unsigned* cnt = (const unsigned*)(p.ws + WS_CTL);
    const int* list = (const int*)(p.ws + WS_LIST);
    const bf16* hb = (const bf16*)(p.ws + WS_HB);
    for (int u = bid;; u += nb) {
        const int tile = u >> 1, ct = u & 1; int e, rt, hoff;
        if (!find_tile(cnt, tile, e, rt, hoff)) break;
        const int nv = min(256, (int)cnt[e] - rt * 256);
        unsigned arow[4], brow[4];
        const bf16* wt = (const bf16*)(p.ws + WS_EGU) + (size_t)e * 512 * DM + (size_t)ct * 256 * DM;
#pragma unroll
        for (int i = 0; i < 4; ++i) { const int pp = tid + NT * i, r = pp >> 3, s = pp & 7;
            const int tok = r < nv ? (list[e * NTOK + rt * 256 + r] >> 1) : 0;
            arow[i] = (unsigned)(tok * DM + s * 8); brow[i] = (unsigned)(r * DM + s * 8); }
        EpiGU ep{(bf16*)(p.ws + WS_HID), hoff, ct};
        gemm_unit(lds, hb, arow, wt, brow, DM, ep);
    }
}
__device__ __forceinline__ void phase_down(const Params& p, unsigned char* lds, int bid, int nb) {
    const int tid = opaque_tid();
    const unsigned* cnt = (const unsigned*)(p.ws + WS_CTL);
    const bf16* hid = (const bf16*)(p.ws + WS_HID);
    for (int u = bid;; u += nb) {
        const int tile = u >> 2, ct = u & 3; int e, rt, hoff;
        if (!find_tile(cnt, tile, e, rt, hoff)) break;
        const int nv = min(256, (int)cnt[e] - rt * 256);
        unsigned arow[4], brow[4];
        const bf16* wt = (const bf16*)(p.ws + WS_EDN) + (size_t)e * DM * DE + (size_t)ct * 256 * DE;
#pragma unroll
        for (int i = 0; i < 4; ++i) { const int pp = tid + NT * i, r = pp >> 3, s = pp & 7;
            arow[i] = (unsigned)((hoff + r) * DE + s * 8); brow[i] = (unsigned)(r * DE + s * 8); }
        EpiDown ep{(bf16*)(p.ws + WS_YS), (const int*)(p.ws + WS_LIST) + e * NTOK, (const float*)(p.ws + WS_LWT) + e * NTOK, rt * 256, nv, ct * 256};
        gemm_unit(lds, hid, arow, wt, brow, DE, ep);
    }
}

__device__ __forceinline__ void phase_final(const Params& p, int bid, int nb) {
    const int tid = opaque_tid(), lane = tid & 63, w = tid >> 6;
    const float* g2 = p.in[25]; const float* b2 = p.in[26];
    const bf16* ys = (const bf16*)(p.ws + WS_YS);
    for (int row = bid * 8 + w; row < NTOK; row += nb * 8) {
        float* hr = p.out + (size_t)row * DM;
        f32x4 v[4]; float s = 0.f;
#pragma unroll
        for (int j = 0; j < 4; ++j) {
            const f32x4 hv = *(const f32x4*)(hr + j * 256 + lane * 4);
            const u32x2 y0 = *(const u32x2*)(ys + (size_t)row * 2 * DM + j * 256 + lane * 4), y1 = *(const u32x2*)(ys + (size_t)row * 2 * DM + DM + j * 256 + lane * 4);
            v[j].x = hv.x * ALPHA + (bflo(y0.x) + bflo(y1.x)); v[j].y = hv.y * ALPHA + (bfhi(y0.x) + bfhi(y1.x));
            v[j].z = hv.z * ALPHA + (bflo(y0.y) + bflo(y1.y)); v[j].w = hv.w * ALPHA + (bfhi(y0.y) + bfhi(y1.y));
            s += (v[j].x + v[j].y) + (v[j].z + v[j].w);
        }
        const float mean = wave_sum(s) * (1.f / DM);
        float s2 = 0.f;
#pragma unroll
        for (int j = 0; j < 4; ++j) { v[j] = v[j] - mean; s2 += (v[j].x * v[j].x + v[j].y * v[j].y) + (v[j].z * v[j].z + v[j].w * v[j].w); }
        const float rstd = rsqrtf(wave_sum(s2) * (1.f / DM) + LN_EPS);
#pragma unroll
        for (int j = 0; j < 4; ++j) {
            const f32x4 g = *(const f32x4*)(g2 + j * 256 + lane * 4), bb = *(const f32x4*)(b2 + j * 256 + lane * 4);
            *(f32x4*)(hr + j * 256 + lane * 4) = v[j] * rstd * g + bb;
        }
    }
}

#define LAS __attribute__((address_space(3)))
#define XB_TMO      128
#define XB_XCNT(j)  (256  + 64 * (j))
#define XB_XSUB(j)  (1280 + 64 * (j))
#define XB_XGEN(j)  (2304 + 64 * (j))
#define XB_TOP      3328
#define XB_TOPGEN   3392
#define XCD_BAR_WORDS 3456
#define XB_SPIN_CAP (1u << 18)
__device__ __forceinline__ unsigned xb_ld(unsigned* p)              { return __hip_atomic_load(p, __ATOMIC_RELAXED, __HIP_MEMORY_SCOPE_AGENT); }
__device__ __forceinline__ unsigned xb_add(unsigned* p, unsigned v) { return __hip_atomic_fetch_add(p, v, __ATOMIC_RELAXED, __HIP_MEMORY_SCOPE_AGENT); }
__device__ __forceinline__ unsigned xb_xcc_id() { return (unsigned)__builtin_amdgcn_s_getreg((3 << 11) | 20) & 0xFu; }
#define XB_SPIN(cond, bar) do { unsigned _sp = 0; while (cond) { __builtin_amdgcn_s_sleep(1); \
    if ((++_sp & 255u) == 0u) { if (xb_ld(&(bar)[XB_TMO])) break; if (_sp > XB_SPIN_CAP) { atomicAdd(&(bar)[XB_TMO], 1u); break; } } } } while (0)
struct XcdBarrier { unsigned* bar; unsigned x; volatile LAS unsigned* st; };
__device__ __forceinline__ XcdBarrier xcd_barrier_post(unsigned* bar, volatile LAS unsigned* st) {
    XcdBarrier b; b.bar = bar; b.x = xb_xcc_id(); b.st = st;
    if (threadIdx.x == 0) (void)xb_add(&bar[XB_XCNT(b.x)], 1u);
    return b;
}
__device__ __forceinline__ void xcd_barrier_complete(unsigned* bar, unsigned x, unsigned& nloc, unsigned& nx) {
    const unsigned G = gridDim.x * gridDim.y * gridDim.z;
    unsigned sum, cnt, mine, sp = 0u;
    for (;;) {
        sum = 0u; cnt = 0u; mine = 0u;
#pragma unroll
        for (unsigned j = 0; j < 16; ++j) { const unsigned c = xb_ld(&bar[XB_XCNT(j)]); sum += c; cnt += (c > 0u) ? 1u : 0u; mine = (j == x) ? c : mine; }
        if (sum == G) break;
        __builtin_amdgcn_s_sleep(1);
        if ((++sp & 255u) == 0u) { if (xb_ld(&bar[XB_TMO])) break; if (sp > XB_SPIN_CAP) { atomicAdd(&bar[XB_TMO], 1u); break; } }
    }
    nloc = mine > 0u ? mine : 1u; nx = cnt > 0u ? cnt : 1u;
}
__device__ __forceinline__ void xcd_barrier(const XcdBarrier& b) {
    asm volatile("s_waitcnt vmcnt(0)" ::: "memory");
    __syncthreads();
    if (threadIdx.x == 0) {
        unsigned* bar = b.bar;
        __builtin_amdgcn_s_waitcnt(0);
        unsigned nloc = b.st[0], nx = b.st[1];
        if (nloc == 0u) { xcd_barrier_complete(bar, b.x, nloc, nx); b.st[0] = nloc; b.st[1] = nx; }
        const unsigned old = xb_add(&bar[XB_XSUB(b.x)], 1u);
        const unsigned gen = old / nloc;
        if (old + 1u == (gen + 1u) * nloc) {
            __builtin_amdgcn_fence(__ATOMIC_RELEASE, "agent");
            asm volatile("s_waitcnt vmcnt(0)" ::: "memory");
            const unsigned og = xb_add(&bar[XB_TOP], 1u);
            const unsigned tg = og / nx;
            if (og + 1u == (tg + 1u) * nx) xb_add(&bar[XB_TOPGEN], 1u);
            else XB_SPIN(xb_ld(&bar[XB_TOPGEN]) == tg, bar);
            __builtin_amdgcn_fence(__ATOMIC_ACQUIRE, "agent");
            xb_add(&bar[XB_XGEN(b.x)], 1u);
            asm volatile("s_waitcnt vmcnt(0)" ::: "memory");
        } else {
            XB_SPIN(xb_ld(&bar[XB_XGEN(b.x)]) == gen, bar);
            __builtin_amdgcn_fence(__ATOMIC_ACQUIRE, "agent");
            asm volatile("s_waitcnt vmcnt(0)" ::: "memory");
        }
    }
    __syncthreads();
}

__global__ void __launch_bounds__(NT) fwd_kernel(Params p) {
    extern __shared__ __attribute__((aligned(16))) unsigned char lds[];
    cg::grid_group grid = cg::this_grid();
    const int bid = blockIdx.x, nb = gridDim.x;
    volatile LAS unsigned* bst = (volatile LAS unsigned*)(LAS unsigned char*)(lds + BAR_LDS_OFF);
    if (threadIdx.x < 2) bst[threadIdx.x] = 0u;
    __syncthreads();
    XcdBarrier xb = xcd_barrier_post((unsigned*)(p.ws + WS_CTL) + CW_BAR, bst);
#define GRID_BAR() xcd_barrier(xb)
    if (p.pad != 0) grid.sync();
    phase_convert(p, lds, bid, nb);
    GRID_BAR();
    phase_proj(p, lds, bid, nb);
    GRID_BAR();
    phase_prep(p, lds, bid, nb);
    phase_pool(p, lds, bid, nb);
    GRID_BAR();
    if (bid < 96) { if (threadIdx.x < 64) phase_scan(p, bid); }
    else phase_convert_experts(p, lds, bid - 96, nb - 96);
    GRID_BAR();
    phase_rwkv_out(p, bid, nb);
    GRID_BAR();
    phase_outproj(p, lds, bid, nb);
    GRID_BAR();
    phase_ln_router(p, lds, bid, nb);
    GRID_BAR();
    phase_gateup(p, lds, bid, nb);
    GRID_BAR();
    phase_down(p, lds, bid, nb);
    GRID_BAR();
    phase_final(p, bid, nb);
}

extern "C" void kernel_launch(void* const* d_in, const int* in_sizes, int n_in, void* d_out, int out_size, void* d_ws, size_t ws_size, hipStream_t stream) {
    static int grid_blocks = 0;
    if (!grid_blocks) {
        if (hipFuncSetAttribute((const void*)fwd_kernel, hipFuncAttributeMaxDynamicSharedMemorySize, LDS_BYTES) != hipSuccess) fprintf(stderr, "hipFuncSetAttribute failed\n");
        int dev = 0, cus = 0, per_cu = 0;
        (void)hipGetDevice(&dev);
        (void)hipDeviceGetAttribute(&cus, hipDeviceAttributeMultiprocessorCount, dev);
        (void)hipOccupancyMaxActiveBlocksPerMultiprocessor(&per_cu, (const void*)fwd_kernel, NT, LDS_BYTES);
        if (per_cu < 1) { fprintf(stderr, "occupancy query says %d blocks/CU\n", per_cu); per_cu = 1; }
        grid_blocks = cus;
        fprintf(stderr, "grid %d (cus %d, per_cu %d)\n", grid_blocks, cus, per_cu);
    }
    Params p{};
    for (int i = 0; i < 27; ++i) p.in[i] = (const float*)d_in[i];
    p.out = (float*)d_out; p.ws = (unsigned char*)d_ws;
    (void)hipMemsetAsync((char*)d_ws + WS_CTL, 0, 65536, stream);
    void* args[] = {&p};
    hipError_t e = hipLaunchCooperativeKernel((const void*)fwd_kernel, dim3(grid_blocks), dim3(NT), args, LDS_BYTES, stream);
    if (e != hipSuccess) fprintf(stderr, "cooperative launch failed: %s (grid %d)\n", hipGetErrorString(e), grid_blocks);
}
```

```cpp
#include <hip/hip_runtime.h>
#include <hip/hip_cooperative_groups.h>
#include <cstdio>
#include <cstdint>
namespace cg = cooperative_groups;

typedef unsigned short bf16;
typedef short bf16x8 __attribute__((ext_vector_type(8)));
typedef float f32x4 __attribute__((ext_vector_type(4)));
typedef unsigned u32x4 __attribute__((ext_vector_type(4)));
typedef unsigned u32x2 __attribute__((ext_vector_type(2)));
typedef float f32x16 __attribute__((ext_vector_type(16)));
typedef float f32x2 __attribute__((ext_vector_type(2)));
typedef __bf16 bf16x2_t __attribute__((ext_vector_type(2)));

constexpr int DM = 1024, BATCH = 2, SEQ = 8192, NTOK = BATCH * SEQ;
constexpr int D_POOL = 256, D_RWKV = 768, NH = 12, HS = 64;
constexpr int D_IN = 2816;
constexpr int C_R = 256, C_K = 1024, C_V = 1792, C_WD = 2560, C_AD = 2624, C_GD = 2688;
constexpr int NEXP = 32, DE = 256;
constexpr float LN_EPS = 1e-5f, LNX_EPS = 64e-5f;
constexpr float ALPHA = 1.189207115002721f;
constexpr int NT = 512;
constexpr int BAR_LDS_OFF = 147968;
constexpr int CW_BAR = 4096;
constexpr int CST_LDS_OFF = 148480;
constexpr int PREV_LDS_OFF = 151040;
constexpr int LDS_BYTES = 152576;

constexpr size_t MiB = 1u << 20;
constexpr size_t WS_CTL = 0;
constexpr size_t WS_WIN_T = 1 * MiB;
constexpr size_t WS_WOUT_T = 7 * MiB;
constexpr size_t WS_WUPT = 9 * MiB;
constexpr size_t WS_AUPT = 9 * MiB + 128 * 1024;
constexpr size_t WS_GUPT = 9 * MiB + 256 * 1024;
constexpr size_t WS_RTT = 9 * MiB + 512 * 1024;
constexpr size_t WS_PWT = 9 * MiB + 768 * 1024;
constexpr size_t WS_XB = 10 * MiB;
constexpr size_t WS_TC = 10 * MiB;
constexpr size_t WS_MIXIN = 42 * MiB;
constexpr size_t WS_PROJ = 74 * MiB;
constexpr size_t WS_EGU = 74 * MiB;
constexpr size_t WS_EDN = 106 * MiB;
constexpr size_t WS_S0 = 122 * MiB;
constexpr size_t WS_GC = 162 * MiB;
constexpr size_t WS_QC = 186 * MiB;
constexpr size_t WS_OL = 210 * MiB;
constexpr size_t OUT_G1 = 0;
constexpr size_t OUT_G2 = 24 * MiB;
constexpr size_t WS_YS = 122 * MiB;
constexpr size_t WS_HB = 186 * MiB;
constexpr size_t WS_LIST = 218 * MiB;
constexpr size_t WS_LWT = 220 * MiB;
constexpr size_t WS_HID = 222 * MiB;

struct Params {
    const float* in[27];
    float* out;
    unsigned char* ws;
    int phase;
    int pad;
};

__device__ __forceinline__ unsigned f2bf(float f) { unsigned u = __builtin_bit_cast(unsigned, f); return (u + 0x7fffu + ((u >> 16) & 1u)) >> 16; }
__device__ __forceinline__ unsigned pk2(float lo, float hi) { f32x2 v = {lo, hi}; bf16x2_t b = __builtin_convertvector(v, bf16x2_t); return __builtin_bit_cast(unsigned, b); }
__device__ __forceinline__ float bf2f(unsigned short b) { return __builtin_bit_cast(float, (unsigned)b << 16); }
__device__ __forceinline__ float bflo(unsigned u) { return __builtin_bit_cast(float, u << 16); }
__device__ __forceinline__ float bfhi(unsigned u) { return __builtin_bit_cast(float, u & 0xffff0000u); }
template <int CTRL> __device__ __forceinline__ float dppmov(float v) { return __builtin_bit_cast(float, __builtin_amdgcn_update_dpp(0, __builtin_bit_cast(int, v), CTRL, 0xf, 0xf, true)); }
__device__ __forceinline__ float wave_sum(float v) {
    v += dppmov<0xB1>(v);
    v += dppmov<0x4E>(v);
    v += dppmov<0x141>(v);
    v += dppmov<0x140>(v);
    const float s0 = __builtin_bit_cast(float, __builtin_amdgcn_readlane(__builtin_bit_cast(int, v), 0));
    const float s1 = __builtin_bit_cast(float, __builtin_amdgcn_readlane(__builtin_bit_cast(int, v), 16));
    const float s2 = __builtin_bit_cast(float, __builtin_amdgcn_readlane(__builtin_bit_cast(int, v), 32));
    const float s3 = __builtin_bit_cast(float, __builtin_amdgcn_readlane(__builtin_bit_cast(int, v), 48));
    return (s0 + s1) + (s2 + s3);
}
__device__ __forceinline__ int opaque_tid() { int t = threadIdx.x; asm volatile("" : "+v"(t)); return t; }
__device__ __forceinline__ float sigmoidf_(float x) { return 1.f / (1.f + __expf(-x)); }

template <class Epi>
__device__ __forceinline__ void gemm_unit(unsigned char* lds, const bf16* __restrict__ abase, const unsigned (&arow)[4], const bf16* __restrict__ bbase, const unsigned (&brow)[4], int K, Epi& epi) {
    const int tid = opaque_tid(), lane = tid & 63, w = tid >> 6, wr = w >> 2, wc = w & 3;
    const int srow = tid >> 3, sslot = tid & 7;
    const int st_off = srow * 128 + ((sslot ^ ((srow >> 1) & 7)) << 4);
    const int fr = lane & 15, fq = lane >> 4, x = fr >> 1;
    int offA[2], offB[2];
#pragma unroll
    for (int s = 0; s < 2; ++s) {
        const int slot = (s * 4 + fq) ^ x;
        offA[s] = (wr * 128 + fr) * 128 + (slot << 4);
        offB[s] = 32768 + (wc * 64 + fr) * 128 + (slot << 4);
    }
    f32x4 acc[8][4];
#pragma unroll
    for (int m = 0; m < 8; ++m)
#pragma unroll
        for (int n = 0; n < 4; ++n) acc[m][n] = (f32x4){0.f, 0.f, 0.f, 0.f};
    u32x4 ra[4], rb[4];
#pragma unroll
    for (int i = 0; i < 4; ++i) { ra[i] = *(const u32x4*)(abase + arow[i]); rb[i] = *(const u32x4*)(bbase + brow[i]); }
    __syncthreads();
#pragma unroll
    for (int i = 0; i < 4; ++i) { *(u32x4*)(lds + st_off + i * 8192) = ra[i]; *(u32x4*)(lds + 32768 + st_off + i * 8192) = rb[i]; }
    __syncthreads();
    const int KT = K >> 6;
    for (int kt = 0; kt < KT; ++kt) {
        unsigned char* cur = lds + (kt & 1) * 65536;
        unsigned char* nxt = lds + ((kt + 1) & 1) * 65536;
        if (kt + 1 < KT) {
#pragma unroll
            for (int i = 0; i < 4; ++i) { ra[i] = *(const u32x4*)(abase + arow[i] + (kt + 1) * 64); rb[i] = *(const u32x4*)(bbase + brow[i] + (kt + 1) * 64); }
        }
#pragma unroll
        for (int s = 0; s < 2; ++s) {
            bf16x8 bfr[4];
#pragma unroll
            for (int n = 0; n < 4; ++n) bfr[n] = *(const bf16x8*)(cur + offB[s] + n * 2048);
#pragma unroll
            for (int m = 0; m < 8; ++m) {
                const bf16x8 afr = *(const bf16x8*)(cur + offA[s] + m * 2048);
#pragma unroll
                for (int n = 0; n < 4; ++n) acc[m][n] = __builtin_amdgcn_mfma_f32_16x16x32_bf16(bfr[n], afr, acc[m][n], 0, 0, 0);
            }
        }
        if (kt + 1 < KT) {
#pragma unroll
            for (int i = 0; i < 4; ++i) { *(u32x4*)(nxt + st_off + i * 8192) = ra[i]; *(u32x4*)(nxt + 32768 + st_off + i * 8192) = rb[i]; }
        }
        __syncthreads();
    }
    epi(acc, wr, wc, fr, fq);
}

__device__ __forceinline__ int gu_row(int c, int half) { return ((c >> 7) << 8) + (((c >> 5) & 3) << 6) + (half << 5) + (c & 31); }
__device__ __forceinline__ void tr_tile(unsigned char* lds, const float* __restrict__ src, int ldsrc, int k0, int n0, bf16* __restrict__ dst, int ldd, int mode) {
    float* t = (float*)lds;
    const int tid = opaque_tid();
    __syncthreads();
#pragma unroll
    for (int i = 0; i < 8; ++i) { const int e = tid + i * NT, k = e >> 6, n = e & 63; t[k * 65 + n] = src[(size_t)(k0 + k) * ldsrc + n0 + n]; }
    __syncthreads();
    const int n = tid >> 3, kc = tid & 7;
    const float* s = t + (kc * 8) * 65 + n;
    u32x4 o; o.x = pk2(s[0], s[65]); o.y = pk2(s[2 * 65], s[3 * 65]); o.z = pk2(s[4 * 65], s[5 * 65]); o.w = pk2(s[6 * 65], s[7 * 65]);
    const int nn = n0 + n;
    const int drow = mode == 0 ? nn : gu_row(nn, mode - 1);
    *(u32x4*)(dst + (size_t)drow * ldd + k0 + kc * 8) = o;
}

__device__ __forceinline__ void phase_convert(const Params& p, unsigned char* lds, int bid, int nb) {
    const int tid = opaque_tid();
    {
        const float* x = p.in[0]; bf16* xb = (bf16*)(p.ws + WS_XB);
        const size_t n8 = (size_t)NTOK * DM / 8;
        for (size_t i = (size_t)bid * NT + tid; i < n8; i += (size_t)nb * NT) {
            const f32x4 a = *(const f32x4*)(x + i * 8), b = *(const f32x4*)(x + i * 8 + 4);
            u32x4 o; o.x = pk2(a.x, a.y); o.y = pk2(a.z, a.w); o.z = pk2(b.x, b.y); o.w = pk2(b.z, b.w);
            *(u32x4*)(xb + i * 8) = o;
        }
    }
    constexpr int T_WIN = (DM / 64) * (D_IN / 64);
    constexpr int T_WOUT = (DM / 64) * (DM / 64);
    constexpr int T_ALL = T_WIN + T_WOUT + 12 + 12 + 24 + 4;
    for (int it = bid; it < T_ALL; it += nb) {
        int r = it;
        if (r < T_WIN) { const int kb = r / (D_IN / 64), nbk = r % (D_IN / 64); tr_tile(lds, p.in[1], D_IN, kb * 64, nbk * 64, (bf16*)(p.ws + WS_WIN_T), DM, 0); continue; }
        r -= T_WIN;
        if (r < T_WOUT) { const int kb = r / (DM / 64), nbk = r % (DM / 64); tr_tile(lds, p.in[15], DM, kb * 64, nbk * 64, (bf16*)(p.ws + WS_WOUT_T), DM, 0); continue; }
        r -= T_WOUT;
        if (r < 12) { tr_tile(lds, p.in[6], D_RWKV, 0, r * 64, (bf16*)(p.ws + WS_WUPT), 64, 0); continue; }
        r -= 12;
        if (r < 12) { tr_tile(lds, p.in[8], D_RWKV, 0, r * 64, (bf16*)(p.ws + WS_AUPT), 64, 0); continue; }
        r -= 12;
        if (r < 24) { tr_tile(lds, p.in[9], D_RWKV, (r / 12) * 64, (r % 12) * 64, (bf16*)(p.ws + WS_GUPT), 128, 0); continue; }
        r -= 24;
        { tr_tile(lds, p.in[2] + r * 4096, 64, 0, 0, (bf16*)(p.ws + WS_PWT) + r * 4096, 64, 0); }
    }
    {
        float* rtt = (float*)(p.ws + WS_RTT); const float* rg = p.in[18]; const float* re = p.in[20];
        for (int e = bid * NT + tid; e < 36 * 1024; e += nb * NT) { const int j = e >> 10, k = e & 1023; rtt[e] = j < 4 ? rg[k * 4 + j] : re[k * 32 + (j - 4)]; }
    }
}
__device__ __forceinline__ void phase_convert_experts(const Params& p, unsigned char* lds, int bid, int nb) {
    constexpr int T_EG = NEXP * (DM / 64) * (DE / 64);
    constexpr int T_ED = NEXP * (DE / 64) * (DM / 64);
    constexpr int T_ALL = 2 * T_EG + T_ED;
    for (int it = bid; it < T_ALL; it += nb) {
        int r = it;
        if (r < 2 * T_EG) {
            const int half = r / T_EG; r -= half * T_EG;
            const int e = r / 64, q = r % 64, kb = q / 4, nbk = q % 4;
            tr_tile(lds, p.in[22 + half] + (size_t)e * DM * DE, DE, kb * 64, nbk * 64, (bf16*)(p.ws + WS_EGU) + (size_t)e * 512 * DM, DM, 1 + half); continue;
        }
        r -= 2 * T_EG;
        { const int e = r / 64, q = r % 64, kb = q / 16, nbk = q % 16;
          tr_tile(lds, p.in[24] + (size_t)e * DE * DM, DM, kb * 64, nbk * 64, (bf16*)(p.ws + WS_EDN) + (size_t)e * DM * DE, DE, 0); }
    }
}

struct EpiProj {
    bf16* O; int row0, col0;
    __device__ __forceinline__ void operator()(const f32x4 (&acc)[8][4], int wr, int wc, int fr, int fq) const {
#pragma unroll
        for (int m = 0; m < 8; ++m) {
            bf16* rp = O + (size_t)(row0 + wr * 128 + m * 16 + fr) * D_IN + col0 + wc * 64 + fq * 4;
#pragma unroll
            for (int n = 0; n < 4; ++n) { u32x2 v; v.x = pk2(acc[m][n][0], acc[m][n][1]); v.y = pk2(acc[m][n][2], acc[m][n][3]); *(u32x2*)(rp + n * 16) = v; }
        }
    }
};
__device__ __forceinline__ void phase_proj(const Params& p, unsigned char* lds, int bid, int nb) {
    const int tid = opaque_tid();
    const bf16* xb = (const bf16*)(p.ws + WS_XB); const bf16* wt = (const bf16*)(p.ws + WS_WIN_T);
    constexpr int NU = 64 * 11;
    for (int u = bid; u < NU; u += nb) {
        const int pm = u & 63, pn = u >> 6;
        unsigned arow[4], brow[4];
#pragma unroll
        for (int i = 0; i < 4; ++i) { const int pp = tid + NT * i, r = pp >> 3, s = pp & 7;
            arow[i] = (unsigned)((pm * 256 + r) * DM + s * 8); brow[i] = (unsigned)((pn * 256 + r) * DM + s * 8); }
        EpiProj e{(bf16*)(p.ws + WS_PROJ), pm * 256, pn * 256};
        gemm_unit(lds, xb, arow, wt, brow, DM, e);
    }
}

__device__ __forceinline__ int sw_off(int row, int col) { return row * 128 + ((((col >> 3) ^ ((row >> 1) & 7)) << 4) | ((col & 7) << 1)); }
__device__ __forceinline__ void phase_pool(const Params& p, unsigned char* lds, int bid, int nb) {
    const int tid = opaque_tid(), lane = tid & 63, w = __builtin_amdgcn_readfirstlane(tid >> 6);
    const bf16* proj = (const bf16*)(p.ws + WS_PROJ);
    bf16* mix = (bf16*)(p.ws + WS_MIXIN);
    const bf16* pwT = (const bf16*)(p.ws + WS_PWT); const float* ps = p.in[3];
    float* pbuf = (float*)lds;
    unsigned char* dslot = lds + 81920;
    for (int it = bid; it < NTOK / 64; it += nb) {
        const int tok0 = it * 64, t0 = tok0 % SEQ;
        __syncthreads();
#pragma unroll 2
        for (int e = tid; e < 79 * 64; e += NT) {
            const int r = e >> 6, c4 = e & 63; const int tt = t0 - 15 + r;
            float4 v = {0.f, 0.f, 0.f, 0.f};
            if (tt >= 0) { const u32x2 q = *(const u32x2*)(proj + (size_t)(tok0 - 15 + r) * D_IN + c4 * 4); v.x = bflo(q.x); v.y = bfhi(q.x); v.z = bflo(q.y); v.w = bfhi(q.y); }
            *(float4*)(pbuf + r * 256 + c4 * 4) = v;
        }
        __syncthreads();
#pragma unroll 2
        for (int e = tid; e < 64 * 64; e += NT) {
            const int t = e >> 6, c = (e & 63) * 4, g = c >> 6, win = 2 << g;
            const int cnt = min(t0 + t + 1, win);
            f32x4 sm = {0.f, 0.f, 0.f, 0.f};
            for (int j = 0; j < cnt; ++j) sm += *(const f32x4*)(pbuf + (t + 15 - j) * 256 + c);
            const f32x4 d = sm * (1.f / (float)cnt) - *(const f32x4*)(pbuf + (t + 15) * 256 + c);
            u32x2 o; o.x = pk2(d.x, d.y); o.y = pk2(d.z, d.w);
            *(u32x2*)(dslot + g * 8192 + sw_off(t, c & 63)) = o;
        }
        __syncthreads();
        {
            const int g = w >> 1, nt = w & 1, ln = lane & 31, hh = lane >> 5, t = nt * 32 + ln;
            f32x16 acc[2];
#pragma unroll
            for (int mt = 0; mt < 2; ++mt) for (int r = 0; r < 16; ++r) acc[mt][r] = 0.f;
#pragma unroll
            for (int s_ = 0; s_ < 4; ++s_) {
                const bf16x8 bd = *(const bf16x8*)(dslot + g * 8192 + sw_off(t, 16 * s_ + 8 * hh));
#pragma unroll
                for (int mt = 0; mt < 2; ++mt) {
                    const bf16x8 aw = *(const bf16x8*)(pwT + g * 4096 + (mt * 32 + ln) * 64 + 16 * s_ + 8 * hh);
                    acc[mt] = __builtin_amdgcn_mfma_f32_32x32x16_bf16(aw, bd, acc[mt], 0, 0, 0);
                }
            }
#pragma unroll
            for (int mt = 0; mt < 2; ++mt)
#pragma unroll
                for (int gg = 0; gg < 4; ++gg) {
                    const int d0 = mt * 32 + 8 * gg + 4 * hh;
                    const f32x4 sc = *(const f32x4*)(ps + g * 64 + d0);
                    u32x2 o; o.x = pk2(acc[mt][4 * gg] * sc.x, acc[mt][4 * gg + 1] * sc.y); o.y = pk2(acc[mt][4 * gg + 2] * sc.z, acc[mt][4 * gg + 3] * sc.w);
                    *(u32x2*)(mix + (size_t)(tok0 + t) * DM + g * 64 + d0) = o;
                }
        }
    }
}

constexpr int SLOTB = 8192;
#define MFMA32(a, b, c) __builtin_amdgcn_mfma_f32_32x32x16_bf16((a), (b), (c), 0, 0, 0)
#define MFMA16(a, b, c) __builtin_amdgcn_mfma_f32_16x16x32_bf16((a), (b), (c), 0, 0, 0)
__device__ __forceinline__ f32x16 mm32(const unsigned char* X, const int (&ox)[4], const unsigned char* Y, const int (&oy)[4], f32x16 acc) {
#pragma unroll
    for (int s = 0; s < 4; ++s) {
        const bf16x8 a = *(const bf16x8*)(X + ox[s]);
        const bf16x8 b = *(const bf16x8*)(Y + oy[s]);
        acc = MFMA32(a, b, acc);
    }
    return acc;
}
template <class F>
__device__ __forceinline__ void store_T(unsigned char* Z, const f32x16& d, int mt, int nt, int lane, const int (&ost)[4], F f) {
    const int n = nt * 32 + (lane & 31), h = lane >> 5;
#pragma unroll
    for (int g = 0; g < 4; ++g) {
        const int m0 = mt * 32 + 8 * g + 4 * h;
        u32x2 v; v.x = pk2(f(d[4 * g], m0, n), f(d[4 * g + 1], m0 + 1, n)); v.y = pk2(f(d[4 * g + 2], m0 + 2, n), f(d[4 * g + 3], m0 + 3, n));
        *(u32x2*)(Z + ost[g]) = v;
    }
}
__device__ __forceinline__ f32x16 zero16() { f32x16 z; for (int i = 0; i < 16; ++i) z[i] = 0.f; return z; }
__device__ __forceinline__ void st_b16(unsigned char* Z, int row, int col, float v) { *(unsigned short*)(Z + sw_off(row, col)) = (unsigned short)pk2(v, 0.f); }

__device__ __forceinline__ void phase_prep(const Params& p, unsigned char* lds, int bid, int nb) {
    const int tid = opaque_tid();
    const bf16* proj = (const bf16*)(p.ws + WS_PROJ);
    const float* mu = p.in[4]; const float* w0 = p.in[5]; const float* a0 = p.in[7];
    const float* k_k = p.in[10]; const float* k_a = p.in[11]; const float* r_k = p.in[12];
    const float* lnx_g = p.in[13]; const float* lnx_b = p.in[14];
    const bf16* wupT = (const bf16*)(p.ws + WS_WUPT); const bf16* aupT = (const bf16*)(p.ws + WS_AUPT); const bf16* gupT = (const bf16*)(p.ws + WS_GUPT);
    bf16* TC = (bf16*)(p.ws + WS_TC); bf16* GC = (bf16*)(p.ws + WS_GC); bf16* QC = (bf16*)(p.ws + WS_QC); bf16* OL = (bf16*)(p.ws + WS_OL);
    bf16* G1 = (bf16*)((unsigned char*)p.out + OUT_G1); bf16* G2 = (bf16*)((unsigned char*)p.out + OUT_G2);
#define SL(i) (lds + (i) * SLOTB)
    float* PC = (float*)(lds + 18 * SLOTB);
    float* CST = (float*)(lds + CST_LDS_OFF);
    unsigned char* PREV = lds + PREV_LDS_OFF;
    float* NSB = (float*)(lds + PREV_LDS_OFF + 384);
    u32x4 pf[8];
    const int prow = tid >> 3, pchunk = tid & 7;
    const int pst = prow * 128 + ((pchunk ^ ((prow >> 1) & 7)) << 4);
    const unsigned pgo = (unsigned)(prow * (D_IN * 2) + pchunk * 16), pgg = (unsigned)(prow * 256 + pchunk * 16);
#define PREP_PREFETCH(hn, tok0_, has_prev) do { \
        const unsigned char* pb_ = (const unsigned char*)(proj + (size_t)(tok0_) * D_IN + C_R + (hn) * 64); \
        pf[0] = *(const u32x4*)(pb_ + pgo); pf[1] = *(const u32x4*)(pb_ + 2 * D_RWKV + pgo); pf[2] = *(const u32x4*)(pb_ + 4 * D_RWKV + pgo); \
        int tl_ = tid; asm volatile("" : "+v"(tl_)); \
        pf[3] = ((const u32x4*)(wupT + (hn) * 4096))[tl_]; \
        pf[4] = ((const u32x4*)(aupT + (hn) * 4096))[tl_]; \
        const unsigned char* gb_ = (const unsigned char*)(gupT + (hn) * 8192); \
        pf[5] = *(const u32x4*)(gb_ + pgg); pf[6] = *(const u32x4*)(gb_ + 128 + pgg); \
        pf[7] = (u32x4){0u, 0u, 0u, 0u}; \
        if (tid < 160) { const int arr_ = tl_ >> 4, c4_ = (tl_ & 15) * 4; \
            const float* src_ = arr_ < 3 ? mu + arr_ * D_RWKV : (arr_ == 3 ? w0 : (arr_ == 4 ? a0 : (arr_ == 5 ? k_k : (arr_ == 6 ? k_a : (arr_ == 7 ? r_k : (arr_ == 8 ? lnx_g : lnx_b)))))); \
            pf[7] = *(const u32x4*)(src_ + (hn) * 64 + c4_); } \
        else if (tid < 184 && (has_prev)) { const int x_ = (tl_ - 160) >> 3, ch_ = (tl_ - 160) & 7; \
            pf[7] = *(const u32x4*)(pb_ - 2 * D_IN + x_ * 2 * D_RWKV + ch_ * 16); } \
    } while (0)
#define PREP_STAGE() do { \
        *(u32x4*)(SL(6) + pst) = pf[0]; *(u32x4*)(SL(7) + pst) = pf[1]; *(u32x4*)(SL(8) + pst) = pf[2]; \
        *(u32x4*)(SL(9) + pst) = pf[3]; *(u32x4*)(SL(10) + pst) = pf[4]; *(u32x4*)(SL(11) + pst) = pf[5]; *(u32x4*)(SL(12) + pst) = pf[6]; \
        if (tid < 160) *(u32x4*)((unsigned char*)CST + tid * 16) = pf[7]; \
        else if (tid < 184) *(u32x4*)(PREV + (tid - 160) * 16) = pf[7]; \
    } while (0)
    for (int it = bid; it < BATCH * (SEQ / 64); it += nb) {
        const int b = it / (SEQ / 64), c = it % (SEQ / 64), tok0 = b * SEQ + c * 64;
        PREP_PREFETCH(0, tok0, c > 0);
        __syncthreads();
#pragma unroll
        for (int e = tid; e < 64 * 32; e += NT) {
            const int tt = e >> 5, k8 = (e & 31) * 8;
            const bf16* cur = proj + (size_t)(tok0 + tt) * D_IN + C_WD + k8;
            const u32x4 cv = *(const u32x4*)cur;
            u32x4 pv = {0u, 0u, 0u, 0u};
            if (c * 64 + tt > 0) pv = *(const u32x4*)(cur - D_IN);
            const f32x4 m0 = *(const f32x4*)(mu + C_WD - D_POOL + k8), m1 = *(const f32x4*)(mu + C_WD - D_POOL + k8 + 4);
            float z[8];
            z[0] = bflo(cv.x) + (bflo(pv.x) - bflo(cv.x)) * m0.x; z[1] = bfhi(cv.x) + (bfhi(pv.x) - bfhi(cv.x)) * m0.y;
            z[2] = bflo(cv.y) + (bflo(pv.y) - bflo(cv.y)) * m0.z; z[3] = bfhi(cv.y) + (bfhi(pv.y) - bfhi(cv.y)) * m0.w;
            z[4] = bflo(cv.z) + (bflo(pv.z) - bflo(cv.z)) * m1.x; z[5] = bfhi(cv.z) + (bfhi(pv.z) - bfhi(cv.z)) * m1.y;
            z[6] = bflo(cv.w) + (bflo(pv.w) - bflo(cv.w)) * m1.z; z[7] = bfhi(cv.w) + (bfhi(pv.w) - bfhi(cv.w)) * m1.w;
            if (k8 < 64) { for (int j = 0; j < 8; ++j) z[j] = 1.f - 2.f / (1.f + __expf(2.f * z[j])); }
            else if (k8 >= 128) { for (int j = 0; j < 8; ++j) z[j] = sigmoidf_(z[j]); }
            u32x4 o; o.x = pk2(z[0], z[1]); o.y = pk2(z[2], z[3]); o.z = pk2(z[4], z[5]); o.w = pk2(z[6], z[7]);
            *(u32x4*)(SL(k8 >> 6) + sw_off(tt, k8 & 63)) = o;
        }
#pragma unroll 1
        for (int h = 0; h < NH; ++h) {
            const size_t item = ((size_t)(b * (SEQ / 64) + c)) * NH + h;
            int tid_ = tid; asm volatile("" : "+v"(tid_));
            const int lane = tid_ & 63, w = __builtin_amdgcn_readfirstlane(tid_ >> 6);
            const int ts = w & 3, tl = lane & 15, q = lane >> 4, t = ts * 16 + tl;
            const int tmt = (w >> 1) & 1, tnt = w & 1, hh = lane >> 5;
            int offT[4], offL[2], offM[2];
        #pragma unroll
            for (int r = 0; r < 4; ++r) { offT[r] = sw_off(4 * q + r, t); }
        #pragma unroll
            for (int ks = 0; ks < 2; ++ks) { offL[ks] = sw_off(t, 32 * ks + 8 * q); offM[ks] = sw_off(tl, 32 * ks + 8 * q); }
            int oxm[4], oyn[4], ost[4];
        #pragma unroll
            for (int s_ = 0; s_ < 4; ++s_) { oxm[s_] = sw_off(tmt * 32 + (lane & 31), 16 * s_ + 8 * hh); oyn[s_] = sw_off(tnt * 32 + (lane & 31), 16 * s_ + 8 * hh); ost[s_] = sw_off(tnt * 32 + (lane & 31), tmt * 32 + 8 * s_ + 4 * hh); }
            __syncthreads();
            PREP_STAGE();
            if (h + 1 < NH) PREP_PREFETCH(h + 1, tok0, c > 0);
            __syncthreads();
            {
                const int cg = w >> 2;
                float lw[8], kap[8], bv[8], kn[8], rm[8], vm[8];
                float nsq = 0.f, bon = 0.f;
                {
                    f32x4 accw[2], acca[2];
#pragma unroll
                    for (int mi = 0; mi < 2; ++mi) { accw[mi] = (f32x4){0.f, 0.f, 0.f, 0.f}; acca[mi] = accw[mi]; }
#pragma unroll
                    for (int ks = 0; ks < 2; ++ks) {
                        const bf16x8 bw = *(const bf16x8*)(SL(0) + offL[ks]);
                        const bf16x8 ba = *(const bf16x8*)(SL(1) + offL[ks]);
#pragma unroll
                        for (int mi = 0; mi < 2; ++mi) {
                            const int m = 2 * cg + mi;
                            const bf16x8 aw = *(const bf16x8*)(SL(9) + offM[ks] + m * 2048);
                            const bf16x8 aa = *(const bf16x8*)(SL(10) + offM[ks] + m * 2048);
                            accw[mi] = MFMA16(aw, bw, accw[mi]); acca[mi] = MFMA16(aa, ba, acca[mi]);
                        }
                    }
                    const bool hp = (c * 64 + t) > 0;
#pragma unroll
                    for (int mi = 0; mi < 2; ++mi) {
                        const int m = 2 * cg + mi;
                        const int ch0 = m * 16 + 4 * q;
                        const int oR = sw_off(t, ch0), oRp = sw_off((t + 63) & 63, ch0);
                        float zz[3][4];
#pragma unroll
                        for (int x = 0; x < 3; ++x) {
                            const u32x2 cv = *(const u32x2*)(SL(6 + x) + oR);
                            u32x2 pv = *(const u32x2*)(t > 0 ? SL(6 + x) + oRp : PREV + x * 128 + ch0 * 2);
                            if (!hp) pv = (u32x2){0u, 0u};
                            const f32x4 mm = *(const f32x4*)(CST + x * 64 + ch0);
                            zz[x][0] = bflo(cv.x) + (bflo(pv.x) - bflo(cv.x)) * mm.x; zz[x][1] = bfhi(cv.x) + (bfhi(pv.x) - bfhi(cv.x)) * mm.y;
                            zz[x][2] = bflo(cv.y) + (bflo(pv.y) - bflo(cv.y)) * mm.z; zz[x][3] = bfhi(cv.y) + (bfhi(pv.y) - bfhi(cv.y)) * mm.w;
                        }
                        const f32x4 w0v = *(const f32x4*)(CST + 3 * 64 + ch0), a0v = *(const f32x4*)(CST + 4 * 64 + ch0), kkv = *(const f32x4*)(CST + 5 * 64 + ch0), kav = *(const f32x4*)(CST + 6 * 64 + ch0), rkv = *(const f32x4*)(CST + 7 * 64 + ch0);
#pragma unroll
                        for (int r = 0; r < 4; ++r) {
                            const int e = mi * 4 + r;
                            const float xx = w0v[r] + accw[mi][r];
                            const float sp = (-xx > 20.f) ? -xx : __logf(1.f + __expf(-xx));
                            lw[e] = -__expf(-sp - 0.5f);
                            const float av = sigmoidf_(a0v[r] + acca[mi][r]);
                            rm[e] = zz[0][r]; vm[e] = zz[2][r];
                            kap[e] = zz[1][r] * kkv[r]; nsq += kap[e] * kap[e];
                            kn[e] = zz[1][r] * (1.f + (av - 1.f) * kav[r]);
                            bon += rm[e] * kn[e] * rkv[r];
                            bv[e] = av;
                        }
                    }
                }
                nsq += __shfl_xor(nsq, 16); nsq += __shfl_xor(nsq, 32);
                bon += __shfl_xor(bon, 16); bon += __shfl_xor(bon, 32);
                if (q == 0) { NSB[cg * 64 + t] = nsq; NSB[128 + cg * 64 + t] = bon; }
                __syncthreads();
                nsq = NSB[t] + NSB[64 + t]; bon = NSB[128 + t] + NSB[192 + t];
                const float inv = 1.f / fmaxf(sqrtf(nsq), 1e-12f);
#pragma unroll
                for (int mi = 0; mi < 2; ++mi) {
                    const int m = 2 * cg + mi;
#pragma unroll
                    for (int r = 0; r < 4; ++r) {
                        const int e = mi * 4 + r;
                        kap[e] *= inv; bv[e] *= kap[e];
                        const unsigned hi = pk2(lw[e], 0.f) & 0xffffu; const float hif = __builtin_bit_cast(float, hi << 16);
                        *(unsigned short*)(SL(4) + offT[r] + m * 2048) = (unsigned short)hi;
                        *(unsigned short*)(SL(5) + offT[r] + m * 2048) = (unsigned short)pk2(lw[e] - hif, 0.f);
                        *(unsigned short*)(SL(13) + offT[r] + m * 2048) = (unsigned short)pk2(vm[e], 0.f);
                    }
                }
                {
                    f32x4 accg[2];
#pragma unroll
                    for (int mi = 0; mi < 2; ++mi) accg[mi] = (f32x4){0.f, 0.f, 0.f, 0.f};
#pragma unroll
                    for (int ks = 0; ks < 4; ++ks) {
                        const bf16x8 bg = *(const bf16x8*)(SL(2 + (ks >> 1)) + offL[ks & 1]);
#pragma unroll
                        for (int mi = 0; mi < 2; ++mi) {
                            const bf16x8 ag = *(const bf16x8*)(SL(11 + (ks >> 1)) + offM[ks & 1] + (2 * cg + mi) * 2048);
                            accg[mi] = MFMA16(ag, bg, accg[mi]);
                        }
                    }
#pragma unroll
                    for (int mi = 0; mi < 2; ++mi) {
                        const int ch0 = (2 * cg + mi) * 16 + 4 * q;
                        const f32x4 lg = *(const f32x4*)(CST + 8 * 64 + ch0), lb = *(const f32x4*)(CST + 9 * 64 + ch0);
                        u32x2 v1, v2;
                        v1.x = pk2(lg[0] * accg[mi][0], lg[1] * accg[mi][1]); v1.y = pk2(lg[2] * accg[mi][2], lg[3] * accg[mi][3]);
                        v2.x = pk2((lb[0] + bon * vm[mi * 4]) * accg[mi][0], (lb[1] + bon * vm[mi * 4 + 1]) * accg[mi][1]);
                        v2.y = pk2((lb[2] + bon * vm[mi * 4 + 2]) * accg[mi][2], (lb[3] + bon * vm[mi * 4 + 3]) * accg[mi][3]);
                        *(u32x2*)(G1 + item * 4096 + t * 64 + ch0) = v1;
                        *(u32x2*)(G2 + item * 4096 + t * 64 + ch0) = v2;
                    }
                }
                __syncthreads();
                f32x4 La[2], Ta[2];
#pragma unroll
                for (int mi = 0; mi < 2; ++mi) { La[mi] = (f32x4){0.f, 0.f, 0.f, 0.f}; Ta[mi] = La[mi]; }
#pragma unroll
                for (int ks = 0; ks < 2; ++ks) {
                    bf16x8 btri, bone;
#pragma unroll
                    for (int e = 0; e < 8; ++e) { const int s_ = 32 * ks + 8 * q + e; btri[e] = (short)((s_ <= t) ? 0x3F80 : 0); bone[e] = (short)0x3F80; }
#pragma unroll
                    for (int mi = 0; mi < 2; ++mi) {
                        const int m = 2 * cg + mi;
                        const bf16x8 ah = *(const bf16x8*)(SL(4) + offM[ks] + m * 2048);
                        const bf16x8 al = *(const bf16x8*)(SL(5) + offM[ks] + m * 2048);
                        La[mi] = MFMA16(ah, btri, La[mi]); La[mi] = MFMA16(al, btri, La[mi]);
                        Ta[mi] = MFMA16(ah, bone, Ta[mi]); Ta[mi] = MFMA16(al, bone, Ta[mi]);
                    }
                }
                __syncthreads();
#pragma unroll
                for (int mi = 0; mi < 2; ++mi) {
                    const int m = 2 * cg + mi;
                    const int ch0 = m * 16 + 4 * q;
                    float kt[4], rt[4], bt[4], kkt[4];
#pragma unroll
                    for (int r = 0; r < 4; ++r) {
                        const int e = mi * 4 + r;
                        const float L = La[mi][r], Lt = Ta[mi][r];
                        const float eL = __expf(L), em = __expf(-L), eh = __expf(Lt - L), ex = __expf(L - lw[e]);
                        kt[r] = kap[e] * ex; rt[r] = rm[e] * eL; bt[r] = bv[e] * em; kkt[r] = kn[e] * em;
                        *(unsigned short*)(SL(9) + offT[r] + m * 2048) = (unsigned short)pk2(kt[r], 0.f);
                        *(unsigned short*)(SL(11) + offT[r] + m * 2048) = (unsigned short)pk2(bv[e] * eh, 0.f);
                        *(unsigned short*)(SL(12) + offT[r] + m * 2048) = (unsigned short)pk2(kn[e] * eh, 0.f);
                        if (t == 0) PC[ch0 + r] = __expf(Lt);
                    }
                    const int oR = sw_off(t, ch0);
                    u32x2 v;
                    v.x = pk2(kt[0], kt[1]); v.y = pk2(kt[2], kt[3]); *(u32x2*)(SL(6) + oR) = v;
                    v.x = pk2(bt[0], bt[1]); v.y = pk2(bt[2], bt[3]); *(u32x2*)(SL(7) + oR) = v;
                    v.x = pk2(kkt[0], kkt[1]); v.y = pk2(kkt[2], kkt[3]); *(u32x2*)(SL(8) + oR) = v;
                    v.x = pk2(rt[0], rt[1]); v.y = pk2(rt[2], rt[3]); *(u32x2*)(SL(10) + oR) = v;
                }
            }
            __syncthreads();
            f32x16 racc = zero16();
            {
                if (w < 4) {
                    f32x16 d = mm32(SL(7), oxm, SL(6), oyn, zero16());
                    const int tq_ = tnt * 32 + (lane & 31);
#pragma unroll
                    for (int r = 0; r < 16; ++r) { const int s_ = tmt * 32 + (r & 3) + 8 * (r >> 2) + 4 * hh; const float v = (s_ < tq_) ? d[r] : 0.f; d[r] = v; racc[r] = ((s_ == tq_) ? 1.f : 0.f) - v; }
                    store_T(SL(4), d, tmt, tnt, lane, ost, [](float v, int, int) { return v; });
                    store_T(SL(17), racc, tmt, tnt, lane, ost, [](float v, int, int) { return v; });
                } else {
                    f32x16 d = mm32(SL(6), oxm, SL(7), oyn, zero16());
                    store_T(SL(5), d, tmt, tnt, lane, ost, [](float v, int m, int n) { return (n < m) ? v : 0.f; });
                }
                if (w < 4) {
                    f32x16 d = mm32(SL(8), oxm, SL(6), oyn, zero16());
                    store_T(SL(14), d, tmt, tnt, lane, ost, [](float v, int m, int n) { return (m < n) ? v : 0.f; });
                } else {
                    f32x16 d = mm32(SL(7), oxm, SL(10), oyn, zero16());
                    store_T(SL(15), d, tmt, tnt, lane, ost, [](float v, int m, int n) { return (m <= n) ? v : 0.f; });
                }
                if (w < 4) {
                    f32x16 d = mm32(SL(8), oxm, SL(10), oyn, zero16());
                    store_T(SL(16), d, tmt, tnt, lane, ost, [](float v, int m, int n) { return (m <= n) ? v : 0.f; });
                }
            }
            __syncthreads();
            auto ident = [](float v, int, int) { return v; };
            if (w < 4) { f32x16 d = mm32(SL(5), oxm, SL(4), oyn, zero16()); store_T(SL(6), d, tmt, tnt, lane, ost, ident); }
            else       { f32x16 d = mm32(SL(4), oxm, SL(5), oyn, zero16()); store_T(SL(7), d, tmt, tnt, lane, ost, ident); }
            __syncthreads();
            if (w < 4) { f32x16 d = mm32(SL(7), oxm, SL(6), oyn, zero16()); store_T(SL(4), d, tmt, tnt, lane, ost, ident);
                         racc = mm32(SL(7), oxm, SL(17), oyn, racc); store_T(SL(8), racc, tmt, tnt, lane, ost, ident); }
            else       { f32x16 d = mm32(SL(6), oxm, SL(7), oyn, zero16()); store_T(SL(5), d, tmt, tnt, lane, ost, ident); }
            __syncthreads();
            if (w < 4) { f32x16 d = mm32(SL(5), oxm, SL(4), oyn, zero16()); store_T(SL(6), d, tmt, tnt, lane, ost, ident);
                         racc = mm32(SL(5), oxm, SL(8), oyn, racc); store_T(SL(17), racc, tmt, tnt, lane, ost, ident); }
            else       { f32x16 d = mm32(SL(4), oxm, SL(5), oyn, zero16()); store_T(SL(7), d, tmt, tnt, lane, ost, ident); }
            __syncthreads();
            if (w < 4) { f32x16 d = mm32(SL(7), oxm, SL(6), oyn, zero16()); store_T(SL(4), d, tmt, tnt, lane, ost, ident);
                         racc = mm32(SL(7), oxm, SL(17), oyn, racc); store_T(SL(8), racc, tmt, tnt, lane, ost, ident); }
            else       { f32x16 d = mm32(SL(6), oxm, SL(7), oyn, zero16()); store_T(SL(5), d, tmt, tnt, lane, ost, ident); }
            __syncthreads();
            if (w < 4) { racc = mm32(SL(5), oxm, SL(8), oyn, racc); store_T(SL(17), racc, tmt, tnt, lane, ost, ident); }
            else       { f32x16 d = mm32(SL(4), oxm, SL(5), oyn, zero16()); store_T(SL(7), d, tmt, tnt, lane, ost, ident); }
            __syncthreads();
            if (w < 4) { racc = mm32(SL(7), oxm, SL(17), oyn, racc); store_T(SL(8), racc, tmt, tnt, lane, ost, ident); }
            else       { f32x16 d = mm32(SL(14), oxm, SL(13), oyn, zero16()); store_T(SL(6), d, tmt, tnt, lane, ost, ident); }
            __syncthreads();
            if (w < 4) { f32x16 d = mm32(SL(8), oxm, SL(9), oyn, zero16()); store_T(SL(4), d, tmt, tnt, lane, ost, ident); }
            else       { f32x16 d = mm32(SL(8), oxm, SL(6), oyn, zero16()); store_T(SL(5), d, tmt, tnt, lane, ost, [](float v, int, int) { return -v; }); }
            __syncthreads();
            {
                const int ln = lane & 31;
                if (w < 4) {
                    const f32x16 d = mm32(SL(4), oxm, SL(11), oyn, zero16());
                    const int j = tnt * 32 + ln; const float pc = PC[j];
                    bf16* dst = TC + item * 4096;
#pragma unroll
                    for (int g = 0; g < 4; ++g) {
                        const int jp0 = tmt * 32 + 8 * g + 4 * hh;
                        float v[4];
#pragma unroll
                        for (int r = 0; r < 4; ++r) v[r] = ((jp0 + r == j) ? pc : 0.f) - d[4 * g + r];
                        const int a = jp0 >> 4, qp = (jp0 & 15) >> 2, s_ = a >> 1, m16 = j >> 4, L = (qp << 4) | (j & 15);
                        u32x2 o; o.x = pk2(v[0], v[1]); o.y = pk2(v[2], v[3]);
                        *(u32x2*)(dst + ((m16 * 2 + s_) * 64 + L) * 8 + (a & 1) * 4) = o;
                    }
                    const f32x16 d2 = mm32(SL(4), oxm, SL(15), oyn, zero16());
                    const int tq_ = tnt * 32 + ln;
                    bf16* dq = QC + item * 4096;
#pragma unroll
                    for (int g = 0; g < 4; ++g) {
                        const int j0 = tmt * 32 + 8 * g + 4 * hh;
                        const u32x2 rv = *(const u32x2*)(SL(10) + ost[g]);
                        u32x2 o; o.x = pk2(bflo(rv.x) - d2[4 * g], bfhi(rv.x) - d2[4 * g + 1]); o.y = pk2(bflo(rv.y) - d2[4 * g + 2], bfhi(rv.y) - d2[4 * g + 3]);
                        *(u32x2*)(dq + tq_ * 64 + j0) = o;
                    }
                } else {
                    f32x16 d = mm32(SL(11), oxm, SL(5), oyn, zero16());
                    d = mm32(SL(12), oxm, SL(13), oyn, d);
                    const int i = tnt * 32 + ln;
                    bf16* dg = GC + item * 4096;
#pragma unroll
                    for (int g = 0; g < 4; ++g) {
                        const int j0 = tmt * 32 + 8 * g + 4 * hh;
                        const int m16 = j0 >> 4, qq = (j0 & 15) >> 2, L = (qq << 4) | (i & 15), iq = i >> 4;
                        u32x2 o; o.x = pk2(d[4 * g], d[4 * g + 1]); o.y = pk2(d[4 * g + 2], d[4 * g + 3]);
                        *(u32x2*)(dg + (iq * 64 + L) * 16 + m16 * 4) = o;
                    }
                    f32x16 d2 = mm32(SL(5), oxm, SL(15), oyn, zero16());
                    d2 = mm32(SL(13), oxm, SL(16), oyn, d2);
                    bf16* dol = OL + item * 4096;
#pragma unroll
                    for (int g = 0; g < 4; ++g) {
                        u32x2 o; o.x = pk2(d2[4 * g], d2[4 * g + 1]); o.y = pk2(d2[4 * g + 2], d2[4 * g + 3]);
                        *(u32x2*)(dol + (((tnt * 2 + tmt) * 4 + g) * 64 + lane) * 4) = o;
                    }
                }
            }
        }
    }
#undef SL
}

__device__ __forceinline__ void phase_scan(const Params& p, int chain) {
    const int lane = opaque_tid() & 63;
    const int b = chain / 48, h = (chain >> 2) % NH, iq = chain & 3;
    const int q = lane >> 4, il = lane & 15;
    const bf16* TC = (const bf16*)(p.ws + WS_TC); const bf16* GC = (const bf16*)(p.ws + WS_GC); bf16* S0 = (bf16*)(p.ws + WS_S0);
    const size_t item0 = (size_t)(b * (SEQ / 64)) * NH + h;
    constexpr int PD = 4;
    u32x4 tq[PD][8]; u32x4 gq[PD][2];
    f32x4 S[4];
#pragma unroll
    for (int m = 0; m < 4; ++m) S[m] = (f32x4){0.f, 0.f, 0.f, 0.f};
#define P2_LOAD(d, cc) do { const bf16* tb = TC + (item0 + (size_t)(cc) * NH) * 4096; const bf16* gb = GC + (item0 + (size_t)(cc) * NH) * 4096 + (iq * 64 + lane) * 16; \
        _Pragma("unroll") for (int x = 0; x < 8; ++x) tq[d][x] = *(const u32x4*)(tb + (x * 64 + lane) * 8); \
        gq[d][0] = *(const u32x4*)(gb); gq[d][1] = *(const u32x4*)(gb + 8); } while (0)
#pragma unroll
    for (int d = 0; d < PD; ++d) P2_LOAD(d, d);
    for (int c = 0; c < SEQ / 64; c += PD) {
#pragma unroll
        for (int d = 0; d < PD; ++d) {
            const int cc = c + d;
            u32x4 sb0, sb1;
            sb0.x = pk2(S[0][0], S[0][1]); sb0.y = pk2(S[0][2], S[0][3]); sb0.z = pk2(S[1][0], S[1][1]); sb0.w = pk2(S[1][2], S[1][3]);
            sb1.x = pk2(S[2][0], S[2][1]); sb1.y = pk2(S[2][2], S[2][3]); sb1.z = pk2(S[3][0], S[3][1]); sb1.w = pk2(S[3][2], S[3][3]);
            bf16* so = S0 + (item0 + (size_t)cc * NH) * 4096 + (iq * 16 + il) * 64 + 4 * q;
            *(u32x2*)(so) = (u32x2){sb0.x, sb0.y}; *(u32x2*)(so + 16) = (u32x2){sb0.z, sb0.w};
            *(u32x2*)(so + 32) = (u32x2){sb1.x, sb1.y}; *(u32x2*)(so + 48) = (u32x2){sb1.z, sb1.w};
            f32x4 gi[4];
            gi[0] = (f32x4){bflo(gq[d][0].x), bfhi(gq[d][0].x), bflo(gq[d][0].y), bfhi(gq[d][0].y)};
            gi[1] = (f32x4){bflo(gq[d][0].z), bfhi(gq[d][0].z), bflo(gq[d][0].w), bfhi(gq[d][0].w)};
            gi[2] = (f32x4){bflo(gq[d][1].x), bfhi(gq[d][1].x), bflo(gq[d][1].y), bfhi(gq[d][1].y)};
            gi[3] = (f32x4){bflo(gq[d][1].z), bfhi(gq[d][1].z), bflo(gq[d][1].w), bfhi(gq[d][1].w)};
            const bf16x8 b0 = __builtin_bit_cast(bf16x8, sb0), b1 = __builtin_bit_cast(bf16x8, sb1);
#pragma unroll
            for (int m = 0; m < 4; ++m) {
                S[m] = MFMA16(__builtin_bit_cast(bf16x8, tq[d][2 * m]), b0, gi[m]);
                S[m] = MFMA16(__builtin_bit_cast(bf16x8, tq[d][2 * m + 1]), b1, S[m]);
            }
            if (cc + PD < SEQ / 64) P2_LOAD(d, cc + PD);
        }
    }
#undef P2_LOAD
}

__device__ __forceinline__ void phase_rwkv_out(const Params& p, int bid, int nb) {
    const int tid = opaque_tid(), lane = tid & 63, w = tid >> 6, ln = lane & 31, hh = lane >> 5;
    const bf16* S0 = (const bf16*)(p.ws + WS_S0); const bf16* QC = (const bf16*)(p.ws + WS_QC); const bf16* OL = (const bf16*)(p.ws + WS_OL);
    const bf16* G1 = (const bf16*)((const unsigned char*)p.out + OUT_G1); const bf16* G2 = (const bf16*)((const unsigned char*)p.out + OUT_G2);
    bf16* mix = (bf16*)(p.ws + WS_MIXIN);
    const int ntask = BATCH * (SEQ / 64) * NH * 2;
    for (int task = bid * 8 + w; task < ntask; task += nb * 8) {
        const int item = task >> 1, nt = task & 1;
        const int h = item % NH, bc = item / NH;
        const int tok0 = bc * 64;
        f32x16 acc[2];
#pragma unroll
        for (int mt = 0; mt < 2; ++mt)
#pragma unroll
            for (int g = 0; g < 4; ++g) {
                const u32x2 v = *(const u32x2*)(OL + (size_t)item * 4096 + (((nt * 2 + mt) * 4 + g) * 64 + lane) * 4);
                acc[mt][4 * g] = bflo(v.x); acc[mt][4 * g + 1] = bfhi(v.x); acc[mt][4 * g + 2] = bflo(v.y); acc[mt][4 * g + 3] = bfhi(v.y);
            }
        const int t = nt * 32 + ln;
#pragma unroll
        for (int s = 0; s < 4; ++s) {
            const bf16x8 bq = *(const bf16x8*)(QC + (size_t)item * 4096 + t * 64 + 16 * s + 8 * hh);
#pragma unroll
            for (int mt = 0; mt < 2; ++mt) {
                const bf16x8 a = *(const bf16x8*)(S0 + (size_t)item * 4096 + (mt * 32 + ln) * 64 + 16 * s + 8 * hh);
                acc[mt] = MFMA32(a, bq, acc[mt]);
            }
        }
        float s1 = 0.f;
#pragma unroll
        for (int mt = 0; mt < 2; ++mt)
#pragma unroll
            for (int r = 0; r < 16; ++r) s1 += acc[mt][r];
        s1 += __shfl_xor(s1, 32);
        const float mean = s1 * (1.f / 64.f);
        float s2 = 0.f;
#pragma unroll
        for (int mt = 0; mt < 2; ++mt)
#pragma unroll
            for (int r = 0; r < 16; ++r) { acc[mt][r] -= mean; s2 += acc[mt][r] * acc[mt][r]; }
        s2 += __shfl_xor(s2, 32);
        const float rstd = rsqrtf(s2 * (1.f / 64.f) + LNX_EPS);
#pragma unroll
        for (int mt = 0; mt < 2; ++mt)
#pragma unroll
            for (int g = 0; g < 4; ++g) {
                const int i0 = mt * 32 + 8 * g + 4 * hh;
                const u32x2 a1 = *(const u32x2*)(G1 + (size_t)item * 4096 + t * 64 + i0), a2 = *(const u32x2*)(G2 + (size_t)item * 4096 + t * 64 + i0);
                u32x2 o;
                o.x = pk2(acc[mt][4 * g] * rstd * bflo(a1.x) + bflo(a2.x), acc[mt][4 * g + 1] * rstd * bfhi(a1.x) + bfhi(a2.x));
                o.y = pk2(acc[mt][4 * g + 2] * rstd * bflo(a1.y) + bflo(a2.y), acc[mt][4 * g + 3] * rstd * bfhi(a1.y) + bfhi(a2.y));
                *(u32x2*)(mix + (size_t)(tok0 + t) * DM + D_POOL + h * 64 + i0) = o;
            }
    }
}

struct EpiOut {
    const float* X; float* O; int row0, col0;
    __device__ __forceinline__ void operator()(const f32x4 (&acc)[8][4], int wr, int wc, int fr, int fq) const {
#pragma unroll
        for (int m = 0; m < 8; ++m) {
            const size_t off = (size_t)(row0 + wr * 128 + m * 16 + fr) * DM + col0 + wc * 64 + fq * 4;
#pragma unroll
            for (int n = 0; n < 4; ++n) { const f32x4 xv = *(const f32x4*)(X + off + n * 16); *(f32x4*)(O + off + n * 16) = xv * ALPHA + acc[m][n]; }
        }
    }
};
__device__ __forceinline__ void phase_outproj(const Params& p, unsigned char* lds, int bid, int nb) {
    const int tid = opaque_tid();
    const bf16* a = (const bf16*)(p.ws + WS_MIXIN); const bf16* wt = (const bf16*)(p.ws + WS_WOUT_T);
    for (int u = bid; u < 256; u += nb) {
        const int pm = u & 63, pn = u >> 6;
        unsigned arow[4], brow[4];
#pragma unroll
        for (int i = 0; i < 4; ++i) { const int pp = tid + NT * i, r = pp >> 3, s = pp & 7;
            arow[i] = (unsigned)((pm * 256 + r) * DM + s * 8); brow[i] = (unsigned)((pn * 256 + r) * DM + s * 8); }
        EpiOut e{p.in[0], p.out, pm * 256, pn * 256};
        gemm_unit(lds, a, arow, wt, brow, DM, e);
    }
}

__device__ __forceinline__ void phase_ln_router(const Params& p, unsigned char* lds, int bid, int nb) {
    const int tid = opaque_tid(), lane = tid & 63, w = __builtin_amdgcn_readfirstlane(tid >> 6);
    float* RT = (float*)lds;
    unsigned* LCNT = (unsigned*)(lds + 147456);
    int* LENT = (int*)(lds + 147456 + 128);
    (void)LENT;
    __syncthreads();
    {
        const f32x4* src = (const f32x4*)(p.ws + WS_RTT);
        f32x4 tmp[18];
#pragma unroll
        for (int i = 0; i < 18; ++i) tmp[i] = src[tid + i * NT];
#pragma unroll
        for (int i = 0; i < 18; ++i) ((f32x4*)RT)[tid + i * NT] = tmp[i];
    }
    const float* g1 = p.in[16]; const float* b1 = p.in[17]; const float* rgb = p.in[19]; const float* reb = p.in[21];
    float* H = p.out; bf16* hb = (bf16*)(p.ws + WS_HB);
    unsigned* cnt = (unsigned*)(p.ws + WS_CTL);
    int* list = (int*)(p.ws + WS_LIST); float* lwt = (float*)(p.ws + WS_LWT);
    const int rows_per_wg = NTOK / nb;
    const int rpw = rows_per_wg / 8;
    const int row0 = bid * rows_per_wg + w * rpw;
    if (tid < 32) LCNT[tid] = 0u;
    __syncthreads();
    int my_e0 = 0, my_e1 = 0, my_r0 = 0, my_r1 = 0; float my_w0 = 0.f, my_w1 = 0.f;
    f32x4 nx[4];
#pragma unroll
    for (int j = 0; j < 4; ++j) nx[j] = *(const f32x4*)(H + (size_t)row0 * DM + j * 256 + lane * 4);
    for (int ri = 0; ri < rpw; ++ri) {
        const int row = row0 + ri;
        float* hr = H + (size_t)row * DM;
        f32x4 v[4]; float s = 0.f;
#pragma unroll
        for (int j = 0; j < 4; ++j) { v[j] = nx[j]; s += (v[j].x + v[j].y) + (v[j].z + v[j].w); }
        if (ri + 1 < rpw) {
#pragma unroll
            for (int j = 0; j < 4; ++j) nx[j] = *(const f32x4*)(hr + DM + j * 256 + lane * 4);
        }
        const float mean = wave_sum(s) * (1.f / DM);
        float s2 = 0.f;
#pragma unroll
        for (int j = 0; j < 4; ++j) { v[j] = v[j] - mean; s2 += (v[j].x * v[j].x + v[j].y * v[j].y) + (v[j].z * v[j].z + v[j].w * v[j].w); }
        const float rstd = rsqrtf(wave_sum(s2) * (1.f / DM) + LN_EPS);
#pragma unroll
        for (int j = 0; j < 4; ++j) {
            const f32x4 g = *(const f32x4*)(g1 + j * 256 + lane * 4), bb = *(const f32x4*)(b1 + j * 256 + lane * 4);
            v[j] = v[j] * rstd * g + bb;
            u32x2 o; o.x = pk2(v[j].x, v[j].y); o.y = pk2(v[j].z, v[j].w);
            *(u32x2*)(hb + (size_t)row * DM + j * 256 + lane * 4) = o;
        }
        float gl[4];
#pragma unroll
        for (int q = 0; q < 4; ++q) {
            float a = 0.f;
#pragma unroll
            for (int j = 0; j < 4; ++j) { const f32x4 r = *(const f32x4*)(RT + q * 1024 + j * 256 + lane * 4); a += v[j].x * r.x + v[j].y * r.y + v[j].z * r.z + v[j].w * r.w; }
            gl[q] = a;
        }
#pragma unroll
        for (int q = 0; q < 4; ++q) gl[q] = wave_sum(gl[q]) + rgb[q];
        int gi = 0; float gm = gl[0];
#pragma unroll
        for (int q = 1; q < 4; ++q) if (gl[q] > gm) { gm = gl[q]; gi = q; }
        float den = 0.f;
#pragma unroll
        for (int q = 0; q < 4; ++q) den += __expf(gl[q] - gm);
        const float gp = 1.f / den;
        gi = __builtin_amdgcn_readfirstlane(gi);
        float el[8];
        const float* rtg = RT + (4 + gi * 8) * 1024 + lane * 4;
#pragma unroll
        for (int hq = 0; hq < 2; ++hq) {
            float part[4];
#pragma unroll
            for (int q = 0; q < 4; ++q) {
                float a = 0.f;
#pragma unroll
                for (int j = 0; j < 4; ++j) { const f32x4 r = *(const f32x4*)(rtg + (hq * 4 + q) * 1024 + j * 256); a += v[j].x * r.x + v[j].y * r.y + v[j].z * r.z + v[j].w * r.w; }
                part[q] = a;
            }
#pragma unroll
            for (int q = 0; q < 4; ++q) el[hq * 4 + q] = wave_sum(part[q]) + reb[gi * 8 + hq * 4 + q];
        }
        int i0 = 0; float m0 = el[0];
#pragma unroll
        for (int q = 1; q < 8; ++q) if (el[q] > m0) { m0 = el[q]; i0 = q; }
        int i1 = -1; float m1 = -3.0e38f;
#pragma unroll
        for (int q = 0; q < 8; ++q) if (q != i0 && el[q] > m1) { m1 = el[q]; i1 = q; }
        const float e1 = __expf(m1 - m0);
        const float w0 = gp / (1.f + e1), w1 = gp * e1 / (1.f + e1);
        if (lane == ri) {
            my_e0 = gi * 8 + i0; my_e1 = gi * 8 + i1; my_w0 = w0; my_w1 = w1;
            my_r0 = (int)atomicAdd(&LCNT[my_e0], 1u); my_r1 = (int)atomicAdd(&LCNT[my_e1], 1u);
        }
    }
    __syncthreads();
    if (tid < 32) { const unsigned c = LCNT[tid]; LCNT[tid] = c ? atomicAdd(&cnt[tid], c) : 0u; }
    __syncthreads();
    if (lane < rpw) {
        const int row = row0 + lane;
        const int p0 = (int)LCNT[my_e0] + my_r0, p1 = (int)LCNT[my_e1] + my_r1;
        list[my_e0 * NTOK + p0] = row * 2; lwt[my_e0 * NTOK + p0] = my_w0;
        list[my_e1 * NTOK + p1] = row * 2 + 1; lwt[my_e1 * NTOK + p1] = my_w1;
    }
}

__device__ __forceinline__ float siluf_(float x) { return x / (1.f + __expf(-x)); }
struct EpiGU {
    bf16* O; int row0, ct;
    __device__ __forceinline__ void operator()(const f32x4 (&acc)[8][4], int wr, int wc, int fr, int fq) const {
#pragma unroll
        for (int m = 0; m < 8; ++m) {
            bf16* rp = O + (size_t)(row0 + wr * 128 + m * 16 + fr) * DE + ct * 128 + wc * 32 + fq * 4;
#pragma unroll
            for (int n = 0; n < 2; ++n) {
                const f32x4 g = acc[m][n], u = acc[m][n + 2];
                u32x2 v; v.x = pk2(siluf_(g[0]) * u[0], siluf_(g[1]) * u[1]); v.y = pk2(siluf_(g[2]) * u[2], siluf_(g[3]) * u[3]);
                *(u32x2*)(rp + n * 16) = v;
            }
        }
    }
};
struct EpiDown {
    bf16* YS; const int* list; const float* lwt; int pos0, nvalid, col0;
    __device__ __forceinline__ void operator()(const f32x4 (&acc)[8][4], int wr, int wc, int fr, int fq) const {
#pragma unroll
        for (int m = 0; m < 8; ++m) {
            const int r = wr * 128 + m * 16 + fr;
            if (r < nvalid) {
                const int ts = list[pos0 + r]; const float wt = lwt[pos0 + r];
                bf16* rp = YS + (size_t)ts * DM + col0 + wc * 64 + fq * 4;
#pragma unroll
                for (int n = 0; n < 4; ++n) { u32x2 v; v.x = pk2(acc[m][n][0] * wt, acc[m][n][1] * wt); v.y = pk2(acc[m][n][2] * wt, acc[m][n][3] * wt); *(u32x2*)(rp + n * 16) = v; }
            }
        }
    }
};
__device__ __forceinline__ bool find_tile(const unsigned* cnt, int tile, int& e, int& rt, int& hoff) {
    int acc = 0;
    for (int i = 0; i < NEXP; ++i) { const int nt = ((int)cnt[i] + 255) >> 8; if (tile < acc + nt) { e = i; rt = tile - acc; hoff = (acc + rt) * 256; return true; } acc += nt; }
    return false;
}
__device__ __forceinline__ void phase_gateup(const Params& p, unsigned char* lds, int bid, int nb) {
    const int tid = opaque_tid();
    const unsigned* cnt = (const unsigned*)(p.ws + WS_CTL);
    const int* list = (const int*)(p.ws + WS_LIST);
    const bf16* hb = (const bf16*)(p.ws + WS_HB);
    for (int u = bid;; u += nb) {
        const int tile = u >> 1, ct = u & 1; int e, rt, hoff;
        if (!find_tile(cnt, tile, e, rt, hoff)) break;
        const int nv = min(256, (int)cnt[e] - rt * 256);
        unsigned arow[4], brow[4];
        const bf16* wt = (const bf16*)(p.ws + WS_EGU) + (size_t)e * 512 * DM + (size_t)ct * 256 * DM;
#pragma unroll
        for (int i = 0; i < 4; ++i) { const int pp = tid + NT * i, r = pp >> 3, s = pp & 7;
            const int tok = r < nv ? (list[e * NTOK + rt * 256 + r] >> 1) : 0;
            arow[i] = (unsigned)(tok * DM + s * 8); brow[i] = (unsigned)(r * DM + s * 8); }
        EpiGU ep{(bf16*)(p.ws + WS_HID), hoff, ct};
        gemm_unit(lds, hb, arow, wt, brow, DM, ep);
    }
}
__device__ __forceinline__ void phase_down(const Params& p, unsigned char* lds, int bid, int nb) {
    const int tid = opaque_tid();
    const unsigned* cnt = (const unsigned*)(p.ws + WS_CTL);
    const bf16* hid = (const bf16*)(p.ws + WS_HID);
    for (int u = bid;; u += nb) {
        const int tile = u >> 2, ct = u & 3; int e, rt, hoff;
        if (!find_tile(cnt, tile, e, rt, hoff)) break;
        const int nv = min(256, (int)cnt[e] - rt * 256);
        unsigned arow[4], brow[4];
        const bf16* wt = (const bf16*)(p.ws + WS_EDN) + (size_t)e * DM * DE + (size_t)ct * 256 * DE;
#pragma unroll
        for (int i = 0; i < 4; ++i) { const int pp = tid + NT * i, r = pp >> 3, s = pp & 7;
            arow[i] = (unsigned)((hoff + r) * DE + s * 8); brow[i] = (unsigned)(r * DE + s * 8); }
        EpiDown ep{(bf16*)(p.ws + WS_YS), (const int*)(p.ws + WS_LIST) + e * NTOK, (const float*)(p.ws + WS_LWT) + e * NTOK, rt * 256, nv, ct * 256};
        gemm_unit(lds, hid, arow, wt, brow, DE, ep);
    }
}

__device__ __forceinline__ void phase_final(const Params& p, int bid, int nb) {
    const int tid = opaque_tid(), lane = tid & 63, w = tid >> 6;
    const float* g2 = p.in[25]; const float* b2 = p.in[26];
    const bf16* ys = (const bf16*)(p.ws + WS_YS); const bf16* hb = (const bf16*)(p.ws + WS_HB);
    for (int row = bid * 8 + w; row < NTOK; row += nb * 8) {
        float* hr = p.out + (size_t)row * DM;
        f32x4 v[4]; float s = 0.f;
#pragma unroll
        for (int j = 0; j < 4; ++j) {
            const u32x2 hq = *(const u32x2*)(hb + (size_t)row * DM + j * 256 + lane * 4);
            const f32x4 hv = {bflo(hq.x), bfhi(hq.x), bflo(hq.y), bfhi(hq.y)};
            const u32x2 y0 = *(const u32x2*)(ys + (size_t)row * 2 * DM + j * 256 + lane * 4), y1 = *(const u32x2*)(ys + (size_t)row * 2 * DM + DM + j * 256 + lane * 4);
            v[j].x = hv.x * ALPHA + (bflo(y0.x) + bflo(y1.x)); v[j].y = hv.y * ALPHA + (bfhi(y0.x) + bfhi(y1.x));
            v[j].z = hv.z * ALPHA + (bflo(y0.y) + bflo(y1.y)); v[j].w = hv.w * ALPHA + (bfhi(y0.y) + bfhi(y1.y));
            s += (v[j].x + v[j].y) + (v[j].z + v[j].w);
        }
        const float mean = wave_sum(s) * (1.f / DM);
        float s2 = 0.f;
#pragma unroll
        for (int j = 0; j < 4; ++j) { v[j] = v[j] - mean; s2 += (v[j].x * v[j].x + v[j].y * v[j].y) + (v[j].z * v[j].z + v[j].w * v[j].w); }
        const float rstd = rsqrtf(wave_sum(s2) * (1.f / DM) + LN_EPS);
#pragma unroll
        for (int j = 0; j < 4; ++j) {
            const f32x4 g = *(const f32x4*)(g2 + j * 256 + lane * 4), bb = *(const f32x4*)(b2 + j * 256 + lane * 4);
            *(f32x4*)(hr + j * 256 + lane * 4) = v[j] * rstd * g + bb;
        }
    }
}

#define LAS __attribute__((address_space(3)))
#define XB_TMO      128
#define XB_XCNT(j)  (256  + 64 * (j))
#define XB_XSUB(j)  (1280 + 64 * (j))
#define XB_XGEN(j)  (2304 + 64 * (j))
#define XB_TOP      3328
#define XB_TOPGEN   3392
#define XCD_BAR_WORDS 3456
#define XB_SPIN_CAP (1u << 18)
__device__ __forceinline__ unsigned xb_ld(unsigned* p)              { return __hip_atomic_load(p, __ATOMIC_RELAXED, __HIP_MEMORY_SCOPE_AGENT); }
__device__ __forceinline__ unsigned xb_add(unsigned* p, unsigned v) { return __hip_atomic_fetch_add(p, v, __ATOMIC_RELAXED, __HIP_MEMORY_SCOPE_AGENT); }
__device__ __forceinline__ unsigned xb_xcc_id() { return (unsigned)__builtin_amdgcn_s_getreg((3 << 11) | 20) & 0xFu; }
#define XB_SPIN(cond, bar) do { unsigned _sp = 0; while (cond) { __builtin_amdgcn_s_sleep(1); \
    if ((++_sp & 255u) == 0u) { if (xb_ld(&(bar)[XB_TMO])) break; if (_sp > XB_SPIN_CAP) { atomicAdd(&(bar)[XB_TMO], 1u); break; } } } } while (0)
struct XcdBarrier { unsigned* bar; unsigned x; volatile LAS unsigned* st; };
__device__ __forceinline__ XcdBarrier xcd_barrier_post(unsigned* bar, volatile LAS unsigned* st) {
    XcdBarrier b; b.bar = bar; b.x = xb_xcc_id(); b.st = st;
    if (threadIdx.x == 0) (void)xb_add(&bar[XB_XCNT(b.x)], 1u);
    return b;
}
__device__ __forceinline__ void xcd_barrier_complete(unsigned* bar, unsigned x, unsigned& nloc, unsigned& nx) {
    const unsigned G = gridDim.x * gridDim.y * gridDim.z;
    unsigned sum, cnt, mine, sp = 0u;
    for (;;) {
        sum = 0u; cnt = 0u; mine = 0u;
#pragma unroll
        for (unsigned j = 0; j < 16; ++j) { const unsigned c = xb_ld(&bar[XB_XCNT(j)]); sum += c; cnt += (c > 0u) ? 1u : 0u; mine = (j == x) ? c : mine; }
        if (sum == G) break;
        __builtin_amdgcn_s_sleep(1);
        if ((++sp & 255u) == 0u) { if (xb_ld(&bar[XB_TMO])) break; if (sp > XB_SPIN_CAP) { atomicAdd(&bar[XB_TMO], 1u); break; } }
    }
    nloc = mine > 0u ? mine : 1u; nx = cnt > 0u ? cnt : 1u;
}
__device__ __forceinline__ void xcd_barrier(const XcdBarrier& b) {
    asm volatile("s_waitcnt vmcnt(0)" ::: "memory");
    __syncthreads();
    if (threadIdx.x == 0) {
        unsigned* bar = b.bar;
        __builtin_amdgcn_s_waitcnt(0);
        unsigned nloc = b.st[0], nx = b.st[1];
        if (nloc == 0u) { xcd_barrier_complete(bar, b.x, nloc, nx); b.st[0] = nloc; b.st[1] = nx; }
        const unsigned old = xb_add(&bar[XB_XSUB(b.x)], 1u);
        const unsigned gen = old / nloc;
        if (old + 1u == (gen + 1u) * nloc) {
            __builtin_amdgcn_fence(__ATOMIC_RELEASE, "agent");
            asm volatile("s_waitcnt vmcnt(0)" ::: "memory");
            const unsigned og = xb_add(&bar[XB_TOP], 1u);
            const unsigned tg = og / nx;
            if (og + 1u == (tg + 1u) * nx) xb_add(&bar[XB_TOPGEN], 1u);
            else XB_SPIN(xb_ld(&bar[XB_TOPGEN]) == tg, bar);
            __builtin_amdgcn_fence(__ATOMIC_ACQUIRE, "agent");
            xb_add(&bar[XB_XGEN(b.x)], 1u);
            asm volatile("s_waitcnt vmcnt(0)" ::: "memory");
        } else {
            XB_SPIN(xb_ld(&bar[XB_XGEN(b.x)]) == gen, bar);
            __builtin_amdgcn_fence(__ATOMIC_ACQUIRE, "agent");
            asm volatile("s_waitcnt vmcnt(0)" ::: "memory");
        }
    }
    __syncthreads();
}

__global__ void __launch_bounds__(NT) fwd_kernel(Params p) {
    extern __shared__ __attribute__((aligned(16))) unsigned char lds[];
    cg::grid_group grid = cg::this_grid();
    const int bid = blockIdx.x, nb = gridDim.x;
    volatile LAS unsigned* bst = (volatile LAS unsigned*)(LAS unsigned char*)(lds + BAR_LDS_OFF);
    if (threadIdx.x < 2) bst[threadIdx.x] = 0u;
    __syncthreads();
    XcdBarrier xb = xcd_barrier_post((unsigned*)(p.ws + WS_CTL) + CW_BAR, bst);
#define GRID_BAR() xcd_barrier(xb)
    if (p.pad != 0) grid.sync();
    phase_convert(p, lds, bid, nb);
    GRID_BAR();
    phase_proj(p, lds, bid, nb);
    GRID_BAR();
    phase_prep(p, lds, bid, nb);
    phase_pool(p, lds, bid, nb);
    GRID_BAR();
    if (bid < 96) { if (threadIdx.x < 64) phase_scan(p, bid); }
    else phase_convert_experts(p, lds, bid - 96, nb - 96);
    GRID_BAR();
    phase_rwkv_out(p, bid, nb);
    GRID_BAR();
    phase_outproj(p, lds, bid, nb);
    GRID_BAR();
    phase_ln_router(p, lds, bid, nb);
    GRID_BAR();
    phase_gateup(p, lds, bid, nb);
    GRID_BAR();
    phase_down(p, lds, bid, nb);
    GRID_BAR();
    phase_final(p, bid, nb);
}

extern "C" void kernel_launch(void* const* d_in, const int* in_sizes, int n_in, void* d_out, int out_size, void* d_ws, size_t ws_size, hipStream_t stream) {
    static int grid_blocks = 0;
    if (!grid_blocks) {
        if (hipFuncSetAttribute((const void*)fwd_kernel, hipFuncAttributeMaxDynamicSharedMemorySize, LDS_BYTES) != hipSuccess) fprintf(stderr, "hipFuncSetAttribute failed\n");
        int dev = 0, cus = 0, per_cu = 0;
        (void)hipGetDevice(&dev);
        (void)hipDeviceGetAttribute(&cus, hipDeviceAttributeMultiprocessorCount, dev);
        (void)hipOccupancyMaxActiveBlocksPerMultiprocessor(&per_cu, (const void*)fwd_kernel, NT, LDS_BYTES);
        if (per_cu < 1) { fprintf(stderr, "occupancy query says %d blocks/CU\n", per_cu); per_cu = 1; }
        grid_blocks = cus >= 256 ? 256 : cus;
        fprintf(stderr, "grid %d (cus %d, per_cu %d)\n", grid_blocks, cus, per_cu);
    }
    Params p{};
    for (int i = 0; i < 27; ++i) p.in[i] = (const float*)d_in[i];
    p.out = (float*)d_out; p.ws = (unsigned char*)d_ws;
    (void)hipMemsetAsync((char*)d_ws + WS_CTL, 0, 65536, stream);
    void* args[] = {&p};
    hipError_t e = hipLaunchCooperativeKernel((const void*)fwd_kernel, dim3(grid_blocks), dim3(NT), args, LDS_BYTES, stream);
    if (e != hipSuccess) fprintf(stderr, "cooperative launch failed: %s (grid %d)\n", hipGetErrorString(e), grid_blocks);
}
```

```cpp
#include <hip/hip_runtime.h>
#include <hip/hip_cooperative_groups.h>
#include <cstdio>
#include <cstdint>
namespace cg = cooperative_groups;

typedef unsigned short bf16;
typedef short bf16x8 __attribute__((ext_vector_type(8)));
typedef float f32x4 __attribute__((ext_vector_type(4)));
typedef unsigned u32x4 __attribute__((ext_vector_type(4)));
typedef unsigned u32x2 __attribute__((ext_vector_type(2)));
typedef float f32x16 __attribute__((ext_vector_type(16)));
typedef float f32x2 __attribute__((ext_vector_type(2)));
typedef __bf16 bf16x2_t __attribute__((ext_vector_type(2)));

constexpr int DM = 1024, BATCH = 2, SEQ = 8192, NTOK = BATCH * SEQ;
constexpr int D_POOL = 256, D_RWKV = 768, NH = 12, HS = 64;
constexpr int D_IN = 2816;
constexpr int C_R = 256, C_K = 1024, C_V = 1792, C_WD = 2560, C_AD = 2624, C_GD = 2688;
constexpr int NEXP = 32, DE = 256;
constexpr float LN_EPS = 1e-5f, LNX_EPS = 64e-5f;
constexpr float ALPHA = 1.189207115002721f;
constexpr int NT = 512;
constexpr int BAR_LDS_OFF = 163776;
constexpr int CW_BAR = 4096;
constexpr int CST_LDS_OFF = 148480;
constexpr int PREV_LDS_OFF = 151040;
constexpr int LDS_BYTES = 163840;

constexpr size_t MiB = 1u << 20;
constexpr size_t WS_CTL = 0;
constexpr size_t WS_WIN_T = 1 * MiB;
constexpr size_t WS_WOUT_T = 7 * MiB;
constexpr size_t WS_WUPT = 9 * MiB;
constexpr size_t WS_AUPT = 9 * MiB + 128 * 1024;
constexpr size_t WS_GUPT = 9 * MiB + 256 * 1024;
constexpr size_t WS_RTT = 9 * MiB + 512 * 1024;
constexpr size_t WS_PWT = 9 * MiB + 768 * 1024;
constexpr size_t WS_XB = 10 * MiB;
constexpr size_t WS_TC = 10 * MiB;
constexpr size_t WS_MIXIN = 42 * MiB;
constexpr size_t WS_PROJ = 74 * MiB;
constexpr size_t WS_EGU = 74 * MiB;
constexpr size_t WS_EDN = 106 * MiB;
constexpr size_t WS_S0 = 122 * MiB;
constexpr size_t WS_GC = 162 * MiB;
constexpr size_t WS_QC = 186 * MiB;
constexpr size_t WS_OL = 210 * MiB;
constexpr size_t OUT_G1 = 0;
constexpr size_t OUT_G2 = 24 * MiB;
constexpr size_t WS_YS = 122 * MiB;
constexpr size_t WS_HB = 186 * MiB;
constexpr size_t WS_LIST = 218 * MiB;
constexpr size_t WS_LWT = 220 * MiB;
constexpr size_t WS_HID = 222 * MiB;

struct Params {
    const float* in[27];
    float* out;
    unsigned char* ws;
    int phase;
    int pad;
};

__device__ __forceinline__ unsigned f2bf(float f) { unsigned u = __builtin_bit_cast(unsigned, f); return (u + 0x7fffu + ((u >> 16) & 1u)) >> 16; }
__device__ __forceinline__ unsigned pk2(float lo, float hi) { f32x2 v = {lo, hi}; bf16x2_t b = __builtin_convertvector(v, bf16x2_t); return __builtin_bit_cast(unsigned, b); }
__device__ __forceinline__ float bf2f(unsigned short b) { return __builtin_bit_cast(float, (unsigned)b << 16); }
__device__ __forceinline__ float bflo(unsigned u) { return __builtin_bit_cast(float, u << 16); }
__device__ __forceinline__ float bfhi(unsigned u) { return __builtin_bit_cast(float, u & 0xffff0000u); }
template <int CTRL> __device__ __forceinline__ float dppmov(float v) { return __builtin_bit_cast(float, __builtin_amdgcn_update_dpp(0, __builtin_bit_cast(int, v), CTRL, 0xf, 0xf, true)); }
__device__ __forceinline__ float wave_sum(float v) {
    v += dppmov<0xB1>(v);
    v += dppmov<0x4E>(v);
    v += dppmov<0x141>(v);
    v += dppmov<0x140>(v);
    const float s0 = __builtin_bit_cast(float, __builtin_amdgcn_readlane(__builtin_bit_cast(int, v), 0));
    const float s1 = __builtin_bit_cast(float, __builtin_amdgcn_readlane(__builtin_bit_cast(int, v), 16));
    const float s2 = __builtin_bit_cast(float, __builtin_amdgcn_readlane(__builtin_bit_cast(int, v), 32));
    const float s3 = __builtin_bit_cast(float, __builtin_amdgcn_readlane(__builtin_bit_cast(int, v), 48));
    return (s0 + s1) + (s2 + s3);
}
__device__ __forceinline__ int opaque_tid() { int t = threadIdx.x; asm volatile("" : "+v"(t)); return t; }
__device__ __forceinline__ float sigmoidf_(float x) { return 1.f / (1.f + __expf(-x)); }

template <class Epi>
__device__ __forceinline__ void gemm_unit(unsigned char* lds, const bf16* __restrict__ abase, const unsigned (&arow)[4], const bf16* __restrict__ bbase, const unsigned (&brow)[4], int K, Epi& epi) {
    const int tid = opaque_tid(), lane = tid & 63, w = tid >> 6, wr = w >> 2, wc = w & 3;
    const int srow = tid >> 3, sslot = tid & 7;
    const int st_off = srow * 128 + ((sslot ^ ((srow >> 1) & 7)) << 4);
    const int fr = lane & 15, fq = lane >> 4, x = fr >> 1;
    int offA[2], offB[2];
#pragma unroll
    for (int s = 0; s < 2; ++s) {
        const int slot = (s * 4 + fq) ^ x;
        offA[s] = (wr * 128 + fr) * 128 + (slot << 4);
        offB[s] = 32768 + (wc * 64 + fr) * 128 + (slot << 4);
    }
    f32x4 acc[8][4];
#pragma unroll
    for (int m = 0; m < 8; ++m)
#pragma unroll
        for (int n = 0; n < 4; ++n) acc[m][n] = (f32x4){0.f, 0.f, 0.f, 0.f};
    u32x4 ra[4], rb[4];
#pragma unroll
    for (int i = 0; i < 4; ++i) { ra[i] = *(const u32x4*)(abase + arow[i]); rb[i] = *(const u32x4*)(bbase + brow[i]); }
    __syncthreads();
#pragma unroll
    for (int i = 0; i < 4; ++i) { *(u32x4*)(lds + st_off + i * 8192) = ra[i]; *(u32x4*)(lds + 32768 + st_off + i * 8192) = rb[i]; }
    __syncthreads();
    const int KT = K >> 6;
    for (int kt = 0; kt < KT; ++kt) {
        unsigned char* cur = lds + (kt & 1) * 65536;
        unsigned char* nxt = lds + ((kt + 1) & 1) * 65536;
        if (kt + 1 < KT) {
#pragma unroll
            for (int i = 0; i < 4; ++i) { ra[i] = *(const u32x4*)(abase + arow[i] + (kt + 1) * 64); rb[i] = *(const u32x4*)(bbase + brow[i] + (kt + 1) * 64); }
        }
#pragma unroll
        for (int s = 0; s < 2; ++s) {
            bf16x8 bfr[4];
#pragma unroll
            for (int n = 0; n < 4; ++n) bfr[n] = *(const bf16x8*)(cur + offB[s] + n * 2048);
#pragma unroll
            for (int m = 0; m < 8; ++m) {
                const bf16x8 afr = *(const bf16x8*)(cur + offA[s] + m * 2048);
#pragma unroll
                for (int n = 0; n < 4; ++n) acc[m][n] = __builtin_amdgcn_mfma_f32_16x16x32_bf16(bfr[n], afr, acc[m][n], 0, 0, 0);
            }
        }
        if (kt + 1 < KT) {
#pragma unroll
            for (int i = 0; i < 4; ++i) { *(u32x4*)(nxt + st_off + i * 8192) = ra[i]; *(u32x4*)(nxt + 32768 + st_off + i * 8192) = rb[i]; }
        }
        __syncthreads();
    }
    epi(acc, wr, wc, fr, fq);
}

namespace pg8 {
#define PG8_LAS __attribute__((address_space(3)))
typedef unsigned short bf16_t;
typedef short bf16x8 __attribute__((ext_vector_type(8)));
typedef float f32x4 __attribute__((ext_vector_type(4)));
typedef unsigned u32x4 __attribute__((ext_vector_type(4)));
constexpr int BM = 256, BK = 64, HALF = 128, HTB = HALF * BK * 2  , STAGE_BYTES = 8 * HTB, NXCD = 8, WGM = 8;

__host__ __device__ __forceinline__ int lds_byte(int r, int c) { const int st = (r >> 4) * 2 + (c >> 5), rr = r & 15, cc = c & 31, ob = rr * 64 + cc * 2; return st * 1024 + (ob ^ (((ob >> 9) & 1) << 5)); }
__host__ __device__ __forceinline__ void stage_rc(int b, int& R, int& C) { const int st = b / 1024, sb = b % 1024, swz = sb ^ (((sb >> 9) & 1) << 5); R = (st >> 1) * 16 + swz / 64; C = (st & 1) * 32 + (swz % 64) / 2; }
__host__ __device__ __forceinline__ int perm32(int rho) { const int n = rho >> 4, i = rho & 15; return 8 * (i >> 2) + 4 * n + (i & 3); }

struct Unit { int pm, pn; };
struct Gemm { const bf16_t* A; const bf16_t* Bt; int M, N, K; };

struct StaticOrder {
    int nM, nN, nwg, G, c;
    __host__ __device__ void init(int M, int N, int G_, int c_) { nM = M / BM; nN = N / BM; nwg = nM * nN; G = G_; c = c_; }
    __host__ __device__ bool next(int i, Unit& u) const {
        const long L = (long)i * G + c; if (L >= nwg) return false;
        int wgid = (int)L; { const int q = nwg / NXCD, r = nwg % NXCD, xcd = wgid % NXCD, off = wgid / NXCD; wgid = (xcd < r ? xcd * (q + 1) : r * (q + 1) + (xcd - r) * q) + off; }
        const int nig = WGM * nN, gid = wgid / nig, fm = gid * WGM, gsz = (nM - fm) < WGM ? (nM - fm) : WGM;
        u.pm = fm + ((wgid % nig) % gsz); u.pn = (wgid % nig) / gsz; return true;
    }
    __device__ __forceinline__ void a_ready(const Unit&) const {}
    __device__ __forceinline__ void done(const Unit&) const {}
};

__device__ __forceinline__ unsigned cvt_pk_bf16(float lo, float hi) { unsigned r; asm volatile("v_cvt_pk_bf16_f32 %0, %1, %2" : "=v"(r) : "v"(lo), "v"(hi)); return r; }
struct EpiProjBf16 {
    static constexpr bool PERM = true, AFTER_DRAIN = false;
    bf16_t* O; int ldc;
    __device__ __forceinline__ void operator()(const f32x4 (&acc)[2][2][4][2], const Unit& u, int wr, int wc, int fr, int fq) const {
        const int row0 = u.pm * BM + wr * 64 + fr; const int col0 = u.pn * BM + wc * 32 + 8 * fq;
#pragma unroll
        for (int ai = 0; ai < 2; ++ai)
#pragma unroll
            for (int m = 0; m < 4; ++m) { bf16_t* rowp = O + (size_t)(row0 + ai * HALF + m * 16) * ldc + col0;
#pragma unroll
                for (int bj = 0; bj < 2; ++bj) { const f32x4 v0 = acc[ai][bj][m][0], v1 = acc[ai][bj][m][1];
                    u32x4 w; w.x = cvt_pk_bf16(v0[0], v0[1]); w.y = cvt_pk_bf16(v0[2], v0[3]); w.z = cvt_pk_bf16(v1[0], v1[1]); w.w = cvt_pk_bf16(v1[2], v1[3]);
                    *(u32x4*)(rowp + bj * HALF) = w; } }
    }
};
struct EpiResF32 {
    static constexpr bool PERM = false, AFTER_DRAIN = false;
    const float* X; float* C; int ldc; float alpha;
    __device__ __forceinline__ void operator()(const f32x4 (&acc)[2][2][4][2], const Unit& u, int wr, int wc, int fr, int fq) const {
        const int row0 = u.pm * BM + wr * 64 + fr, col0 = u.pn * BM + wc * 32 + 4 * fq;
#pragma unroll
        for (int ai = 0; ai < 2; ++ai)
#pragma unroll
            for (int m = 0; m < 4; ++m) { const size_t off = (size_t)(row0 + ai * HALF + m * 16) * ldc + col0;
#pragma unroll
                for (int bj = 0; bj < 2; ++bj)
#pragma unroll
                    for (int n = 0; n < 2; ++n) { const f32x4 xv = *(const f32x4*)(X + off + bj * HALF + n * 16); *(f32x4*)(C + off + bj * HALF + n * 16) = xv * alpha + acc[ai][bj][m][n]; } }
    }
};
template <class Epi, class Sched>
__device__ __forceinline__ void gemm_phase(PG8_LAS unsigned char* lds, const Gemm g, const Sched& S, const Epi& E) {
    const int tid = opaque_tid(), wid = __builtin_amdgcn_readfirstlane(tid >> 6), lane = tid & 63, wr = wid >> 2, wc = wid & 3, fr = lane & 15, fq = lane >> 4;
    const int K = g.K, nt = K / BK;
    unsigned voffA[2], voffB[2];
#pragma unroll
    for (int i = 0; i < 2; ++i) { int R, C; stage_rc(tid * 16 + i * 8192, R, C); const int Rb = Epi::PERM ? ((R & ~31) + perm32(R & 31)) : R;
        voffA[i] = (unsigned)(R * K + C) * 2u; voffB[i] = (unsigned)(Rb * K + C) * 2u; }
    const size_t kstep = (size_t)(BK * 2);
    const size_t hstep = (size_t)HALF * K * 2;
    const size_t tstep = 2 * hstep;
    const unsigned ldsw = (unsigned)wid * 1024u;
    const int aoff = lds_byte(wr * 64 + fr, fq * 8), boff = lds_byte(wc * 32 + fr, fq * 8);
#define PG8_SA(b, h) (((b) * 2 + (h)) * HTB)
#define PG8_SB(b, h) ((4 + (b) * 2 + (h)) * HTB)
#define PG8_STAGE(bufoff, gbase, voff) do { _Pragma("unroll") for (int _i = 0; _i < 2; ++_i) \
        __builtin_amdgcn_global_load_lds((const unsigned*)((const char*)(gbase) + (voff)[_i]), (PG8_LAS unsigned*)(lds + (bufoff) + ldsw + _i * 8192), 16, 0, 0); } while (0)
#define PG8_LDA(dst, b, h) do { _Pragma("unroll") for (int m = 0; m < 4; ++m) _Pragma("unroll") for (int k = 0; k < 2; ++k) dst[m][k] = *(const PG8_LAS bf16x8*)(lds + PG8_SA(b, h) + aoff + m * 2048 + k * 1024); } while (0)
#define PG8_LDB(dst, b, h) do { _Pragma("unroll") for (int n = 0; n < 2; ++n) _Pragma("unroll") for (int k = 0; k < 2; ++k) dst[n][k] = *(const PG8_LAS bf16x8*)(lds + PG8_SB(b, h) + boff + n * 2048 + k * 1024); } while (0)
#define PG8_MMA(ai, bj, At, Bt) do { __builtin_amdgcn_s_setprio(1); _Pragma("unroll") for (int m = 0; m < 4; ++m) _Pragma("unroll") for (int n = 0; n < 2; ++n) _Pragma("unroll") for (int k = 0; k < 2; ++k) \
        acc[ai][bj][m][n] = __builtin_amdgcn_mfma_f32_16x16x32_bf16(Bt[n][k], At[m][k], acc[ai][bj][m][n], 0, 0, 0); __builtin_amdgcn_s_setprio(0); } while (0)
#define PG8_WAIT_V(n) asm volatile("s_waitcnt vmcnt(" #n ")" ::: "memory")
#define PG8_WAIT_L(n) asm volatile("s_waitcnt lgkmcnt(" #n ")" ::: "memory")
#define PG8_BAR __builtin_amdgcn_s_barrier()
#define PG8_SCHED __builtin_amdgcn_sched_barrier(0)
    Unit cur, nxt; int ui = 0;
    if (!S.next(0, cur)) return;
    f32x4 acc[2][2][4][2];
#pragma unroll
    for (int a = 0; a < 2; ++a)
#pragma unroll
        for (int b = 0; b < 2; ++b)
#pragma unroll
            for (int m = 0; m < 4; ++m)
#pragma unroll
                for (int n = 0; n < 2; ++n) acc[a][b][m][n] = (f32x4){0.f, 0.f, 0.f, 0.f};
    bf16x8 At[4][2], B0[2][2], B1[2][2];
    const char* cA = (const char*)g.A + (size_t)cur.pm * tstep; const char* cB = (const char*)g.Bt + (size_t)cur.pn * tstep;
    S.a_ready(cur);
    PG8_STAGE(PG8_SB(0, 0), cB, voffB); PG8_STAGE(PG8_SA(0, 0), cA, voffA); PG8_STAGE(PG8_SB(0, 1), cB + hstep, voffB); PG8_STAGE(PG8_SA(0, 1), cA + hstep, voffA);
    if (wr == 1) PG8_BAR;
    PG8_WAIT_V(4); PG8_BAR;
    PG8_STAGE(PG8_SB(1, 0), cB + kstep, voffB); PG8_STAGE(PG8_SA(1, 0), cA + kstep, voffA); PG8_STAGE(PG8_SB(1, 1), cB + hstep + kstep, voffB);
    PG8_WAIT_V(6); PG8_BAR;
    for (;;) {
        const bool has_next = S.next(ui + 1, nxt);
        const char* nA = has_next ? (const char*)g.A + (size_t)nxt.pm * tstep : cA; const char* nB = has_next ? (const char*)g.Bt + (size_t)nxt.pn * tstep : cB;
        for (int t = 0; t < nt; t += 2) {
            const bool last = (t == nt - 2);
            const char* a1 = cA + (size_t)(t + 1) * kstep;
            const char* a2 = last ? nA : cA + (size_t)(t + 2) * kstep; const char* b2 = last ? nB : cB + (size_t)(t + 2) * kstep;
            const char* a3 = a2 + kstep; const char* b3 = b2 + kstep;
            if (last && has_next) S.a_ready(nxt);
            PG8_LDB(B0, 0, 0); PG8_SCHED; PG8_LDA(At, 0, 0); PG8_STAGE(PG8_SA(1, 1), a1 + hstep, voffA);
            PG8_WAIT_L(8); PG8_BAR; PG8_WAIT_L(0); PG8_MMA(0, 0, At, B0); PG8_BAR; PG8_SCHED;
            PG8_LDB(B1, 0, 1); PG8_STAGE(PG8_SB(0, 0), b2, voffB);
            PG8_BAR; PG8_WAIT_L(0); PG8_MMA(0, 1, At, B1); PG8_BAR;
            PG8_LDA(At, 0, 1); PG8_STAGE(PG8_SA(0, 0), a2, voffA);
            PG8_BAR; PG8_WAIT_L(0); PG8_MMA(1, 0, At, B0); PG8_BAR; PG8_SCHED;
            PG8_STAGE(PG8_SB(0, 1), b2 + hstep, voffB);
            PG8_WAIT_V(6); PG8_BAR; PG8_MMA(1, 1, At, B1); PG8_BAR;
            PG8_LDB(B0, 1, 0); PG8_SCHED; PG8_LDA(At, 1, 0); PG8_STAGE(PG8_SA(0, 1), a2 + hstep, voffA);
            PG8_WAIT_L(8); PG8_BAR; PG8_WAIT_L(0); PG8_MMA(0, 0, At, B0); PG8_BAR; PG8_SCHED;
            PG8_LDB(B1, 1, 1); PG8_STAGE(PG8_SB(1, 0), b3, voffB);
            PG8_BAR; PG8_WAIT_L(0); PG8_MMA(0, 1, At, B1); PG8_BAR;
            PG8_LDA(At, 1, 1); PG8_STAGE(PG8_SA(1, 0), a3, voffA);
            PG8_BAR; PG8_WAIT_L(0); PG8_MMA(1, 0, At, B0); PG8_BAR; PG8_SCHED;
            PG8_STAGE(PG8_SB(1, 1), b3 + hstep, voffB);
            PG8_WAIT_V(6); PG8_BAR; PG8_MMA(1, 1, At, B1); PG8_BAR;
        }
            if constexpr (!Epi::AFTER_DRAIN) { E(acc, cur, wr, wc, fr, fq); S.done(cur); }
            if (!has_next) break;
#pragma unroll
        for (int a = 0; a < 2; ++a)
#pragma unroll
            for (int b = 0; b < 2; ++b)
#pragma unroll
                for (int m = 0; m < 4; ++m)
#pragma unroll
                    for (int n = 0; n < 2; ++n) acc[a][b][m][n] = (f32x4){0.f, 0.f, 0.f, 0.f};
        cur = nxt; cA = nA; cB = nB; ++ui;
    }
    PG8_WAIT_V(0);
    if (wr == 0) PG8_BAR;
    PG8_BAR;
    if constexpr (Epi::AFTER_DRAIN) { E.fused(acc, cur, wr, wc, fr, fq, lds, wid, lane); S.done(cur); }
#undef PG8_SA
#undef PG8_SB
#undef PG8_STAGE
#undef PG8_LDA
#undef PG8_LDB
#undef PG8_MMA
#undef PG8_WAIT_V
#undef PG8_WAIT_L
#undef PG8_BAR
#undef PG8_SCHED
}
}

__device__ __forceinline__ int gu_row(int c, int half) { return ((c >> 7) << 8) + (((c >> 5) & 3) << 6) + (half << 5) + (c & 31); }
__device__ __forceinline__ void tr_tile(unsigned char* lds, const float* __restrict__ src, int ldsrc, int k0, int n0, bf16* __restrict__ dst, int ldd, int mode) {
    float* t = (float*)lds;
    const int tid = opaque_tid();
    __syncthreads();
#pragma unroll
    for (int i = 0; i < 8; ++i) { const int e = tid + i * NT, k = e >> 6, n = e & 63; t[k * 65 + n] = src[(size_t)(k0 + k) * ldsrc + n0 + n]; }
    __syncthreads();
    const int n = tid >> 3, kc = tid & 7;
    const float* s = t + (kc * 8) * 65 + n;
    u32x4 o; o.x = pk2(s[0], s[65]); o.y = pk2(s[2 * 65], s[3 * 65]); o.z = pk2(s[4 * 65], s[5 * 65]); o.w = pk2(s[6 * 65], s[7 * 65]);
    const int nn = n0 + n;
    const int drow = mode == 0 ? nn : gu_row(nn, mode - 1);
    *(u32x4*)(dst + (size_t)drow * ldd + k0 + kc * 8) = o;
}

__device__ __forceinline__ void phase_convert(const Params& p, unsigned char* lds, int bid, int nb) {
    const int tid = opaque_tid();
    {
        const float* x = p.in[0]; bf16* xb = (bf16*)(p.ws + WS_XB);
        const size_t n8 = (size_t)NTOK * DM / 8;
        for (size_t i = (size_t)bid * NT + tid; i < n8; i += (size_t)nb * NT) {
            const f32x4 a = *(const f32x4*)(x + i * 8), b = *(const f32x4*)(x + i * 8 + 4);
            u32x4 o; o.x = pk2(a.x, a.y); o.y = pk2(a.z, a.w); o.z = pk2(b.x, b.y); o.w = pk2(b.z, b.w);
            *(u32x4*)(xb + i * 8) = o;
        }
    }
    constexpr int T_WIN = (DM / 64) * (D_IN / 64);
    constexpr int T_WOUT = (DM / 64) * (DM / 64);
    constexpr int T_ALL = T_WIN + T_WOUT + 12 + 12 + 24 + 4;
    for (int it = bid; it < T_ALL; it += nb) {
        int r = it;
        if (r < T_WIN) { const int kb = r / (D_IN / 64), nbk = r % (D_IN / 64); tr_tile(lds, p.in[1], D_IN, kb * 64, nbk * 64, (bf16*)(p.ws + WS_WIN_T), DM, 0); continue; }
        r -= T_WIN;
        if (r < T_WOUT) { const int kb = r / (DM / 64), nbk = r % (DM / 64); tr_tile(lds, p.in[15], DM, kb * 64, nbk * 64, (bf16*)(p.ws + WS_WOUT_T), DM, 0); continue; }
        r -= T_WOUT;
        if (r < 12) { tr_tile(lds, p.in[6], D_RWKV, 0, r * 64, (bf16*)(p.ws + WS_WUPT), 64, 0); continue; }
        r -= 12;
        if (r < 12) { tr_tile(lds, p.in[8], D_RWKV, 0, r * 64, (bf16*)(p.ws + WS_AUPT), 64, 0); continue; }
        r -= 12;
        if (r < 24) { tr_tile(lds, p.in[9], D_RWKV, (r / 12) * 64, (r % 12) * 64, (bf16*)(p.ws + WS_GUPT), 128, 0); continue; }
        r -= 24;
        { tr_tile(lds, p.in[2] + r * 4096, 64, 0, 0, (bf16*)(p.ws + WS_PWT) + r * 4096, 64, 0); }
    }
    {
        float* rtt = (float*)(p.ws + WS_RTT); const float* rg = p.in[18]; const float* re = p.in[20];
        for (int e = bid * NT + tid; e < 36 * 1024; e += nb * NT) { const int j = e >> 10, k = e & 1023; rtt[e] = j < 4 ? rg[k * 4 + j] : re[k * 32 + (j - 4)]; }
    }
}
__device__ __forceinline__ void phase_convert_experts(const Params& p, unsigned char* lds, int bid, int nb) {
    constexpr int T_EG = NEXP * (DM / 64) * (DE / 64);
    constexpr int T_ED = NEXP * (DE / 64) * (DM / 64);
    constexpr int T_ALL = 2 * T_EG + T_ED;
    for (int it = bid; it < T_ALL; it += nb) {
        int r = it;
        if (r < 2 * T_EG) {
            const int half = r / T_EG; r -= half * T_EG;
            const int e = r / 64, q = r % 64, kb = q / 4, nbk = q % 4;
            tr_tile(lds, p.in[22 + half] + (size_t)e * DM * DE, DE, kb * 64, nbk * 64, (bf16*)(p.ws + WS_EGU) + (size_t)e * 512 * DM, DM, 1 + half); continue;
        }
        r -= 2 * T_EG;
        { const int e = r / 64, q = r % 64, kb = q / 16, nbk = q % 16;
          tr_tile(lds, p.in[24] + (size_t)e * DE * DM, DM, kb * 64, nbk * 64, (bf16*)(p.ws + WS_EDN) + (size_t)e * DM * DE, DE, 0); }
    }
}

struct EpiProj {
    bf16* O; int row0, col0;
    __device__ __forceinline__ void operator()(const f32x4 (&acc)[8][4], int wr, int wc, int fr, int fq) const {
#pragma unroll
        for (int m = 0; m < 8; ++m) {
            bf16* rp = O + (size_t)(row0 + wr * 128 + m * 16 + fr) * D_IN + col0 + wc * 64 + fq * 4;
#pragma unroll
            for (int n = 0; n < 4; ++n) { u32x2 v; v.x = pk2(acc[m][n][0], acc[m][n][1]); v.y = pk2(acc[m][n][2], acc[m][n][3]); *(u32x2*)(rp + n * 16) = v; }
        }
    }
};
__device__ __forceinline__ void phase_proj(const Params& p, unsigned char* lds, int bid, int nb) {
    pg8::Gemm g{(const pg8::bf16_t*)(p.ws + WS_XB), (const pg8::bf16_t*)(p.ws + WS_WIN_T), NTOK, D_IN, DM};
    pg8::StaticOrder S; S.init(NTOK, D_IN, nb, bid);
    pg8::EpiProjBf16 E{(pg8::bf16_t*)(p.ws + WS_PROJ), D_IN};
    pg8::gemm_phase<pg8::EpiProjBf16, pg8::StaticOrder>((PG8_LAS unsigned char*)lds, g, S, E);
}

__device__ __forceinline__ int sw_off(int row, int col) { return row * 128 + ((((col >> 3) ^ ((row >> 1) & 7)) << 4) | ((col & 7) << 1)); }
__device__ __forceinline__ void phase_pool(const Params& p, unsigned char* lds, int bid, int nb) {
    const int tid = opaque_tid(), lane = tid & 63, w = __builtin_amdgcn_readfirstlane(tid >> 6);
    const bf16* proj = (const bf16*)(p.ws + WS_PROJ);
    bf16* mix = (bf16*)(p.ws + WS_MIXIN);
    const bf16* pwT = (const bf16*)(p.ws + WS_PWT); const float* ps = p.in[3];
    float* pbuf = (float*)lds;
    unsigned char* dslot = lds + 81920;
    for (int it = bid; it < NTOK / 64; it += nb) {
        const int tok0 = it * 64, t0 = tok0 % SEQ;
        __syncthreads();
#pragma unroll 2
        for (int e = tid; e < 79 * 64; e += NT) {
            const int r = e >> 6, c4 = e & 63; const int tt = t0 - 15 + r;
            float4 v = {0.f, 0.f, 0.f, 0.f};
            if (tt >= 0) { const u32x2 q = *(const u32x2*)(proj + (size_t)(tok0 - 15 + r) * D_IN + c4 * 4); v.x = bflo(q.x); v.y = bfhi(q.x); v.z = bflo(q.y); v.w = bfhi(q.y); }
            *(float4*)(pbuf + r * 256 + c4 * 4) = v;
        }
        __syncthreads();
#pragma unroll 2
        for (int e = tid; e < 64 * 64; e += NT) {
            const int t = e >> 6, c = (e & 63) * 4, g = c >> 6, win = 2 << g;
            const int cnt = min(t0 + t + 1, win);
            f32x4 sm = {0.f, 0.f, 0.f, 0.f};
            for (int j = 0; j < cnt; ++j) sm += *(const f32x4*)(pbuf + (t + 15 - j) * 256 + c);
            const f32x4 d = sm * (1.f / (float)cnt) - *(const f32x4*)(pbuf + (t + 15) * 256 + c);
            u32x2 o; o.x = pk2(d.x, d.y); o.y = pk2(d.z, d.w);
            *(u32x2*)(dslot + g * 8192 + sw_off(t, c & 63)) = o;
        }
        __syncthreads();
        {
            const int g = w >> 1, nt = w & 1, ln = lane & 31, hh = lane >> 5, t = nt * 32 + ln;
            f32x16 acc[2];
#pragma unroll
            for (int mt = 0; mt < 2; ++mt) for (int r = 0; r < 16; ++r) acc[mt][r] = 0.f;
#pragma unroll
            for (int s_ = 0; s_ < 4; ++s_) {
                const bf16x8 bd = *(const bf16x8*)(dslot + g * 8192 + sw_off(t, 16 * s_ + 8 * hh));
#pragma unroll
                for (int mt = 0; mt < 2; ++mt) {
                    const bf16x8 aw = *(const bf16x8*)(pwT + g * 4096 + (mt * 32 + ln) * 64 + 16 * s_ + 8 * hh);
                    acc[mt] = __builtin_amdgcn_mfma_f32_32x32x16_bf16(aw, bd, acc[mt], 0, 0, 0);
                }
            }
#pragma unroll
            for (int mt = 0; mt < 2; ++mt)
#pragma unroll
                for (int gg = 0; gg < 4; ++gg) {
                    const int d0 = mt * 32 + 8 * gg + 4 * hh;
                    const f32x4 sc = *(const f32x4*)(ps + g * 64 + d0);
                    u32x2 o; o.x = pk2(acc[mt][4 * gg] * sc.x, acc[mt][4 * gg + 1] * sc.y); o.y = pk2(acc[mt][4 * gg + 2] * sc.z, acc[mt][4 * gg + 3] * sc.w);
                    *(u32x2*)(mix + (size_t)(tok0 + t) * DM + g * 64 + d0) = o;
                }
        }
    }
}

constexpr int SLOTB = 8192;
#define MFMA32(a, b, c) __builtin_amdgcn_mfma_f32_32x32x16_bf16((a), (b), (c), 0, 0, 0)
#define MFMA16(a, b, c) __builtin_amdgcn_mfma_f32_16x16x32_bf16((a), (b), (c), 0, 0, 0)
__device__ __forceinline__ f32x16 mm32(const unsigned char* X, const int (&ox)[4], const unsigned char* Y, const int (&oy)[4], f32x16 acc) {
#pragma unroll
    for (int s = 0; s < 4; ++s) {
        const bf16x8 a = *(const bf16x8*)(X + ox[s]);
        const bf16x8 b = *(const bf16x8*)(Y + oy[s]);
        acc = MFMA32(a, b, acc);
    }
    return acc;
}
template <class F>
__device__ __forceinline__ void store_T(unsigned char* Z, const f32x16& d, int mt, int nt, int lane, const int (&ost)[4], F f) {
    const int n = nt * 32 + (lane & 31), h = lane >> 5;
#pragma unroll
    for (int g = 0; g < 4; ++g) {
        const int m0 = mt * 32 + 8 * g + 4 * h;
        u32x2 v; v.x = pk2(f(d[4 * g], m0, n), f(d[4 * g + 1], m0 + 1, n)); v.y = pk2(f(d[4 * g + 2], m0 + 2, n), f(d[4 * g + 3], m0 + 3, n));
        *(u32x2*)(Z + ost[g]) = v;
    }
}
__device__ __forceinline__ f32x16 zero16() { f32x16 z; for (int i = 0; i < 16; ++i) z[i] = 0.f; return z; }
__device__ __forceinline__ void st_b16(unsigned char* Z, int row, int col, float v) { *(unsigned short*)(Z + sw_off(row, col)) = (unsigned short)pk2(v, 0.f); }

__device__ __forceinline__ void phase_prep(const Params& p, unsigned char* lds, int bid, int nb) {
    const int tid = opaque_tid();
    const bf16* proj = (const bf16*)(p.ws + WS_PROJ);
    const float* mu = p.in[4]; const float* w0 = p.in[5]; const float* a0 = p.in[7];
    const float* k_k = p.in[10]; const float* k_a = p.in[11]; const float* r_k = p.in[12];
    const float* lnx_g = p.in[13]; const float* lnx_b = p.in[14];
    const bf16* wupT = (const bf16*)(p.ws + WS_WUPT); const bf16* aupT = (const bf16*)(p.ws + WS_AUPT); const bf16* gupT = (const bf16*)(p.ws + WS_GUPT);
    bf16* TC = (bf16*)(p.ws + WS_TC); bf16* GC = (bf16*)(p.ws + WS_GC); bf16* QC = (bf16*)(p.ws + WS_QC); bf16* OL = (bf16*)(p.ws + WS_OL);
    bf16* G1 = (bf16*)((unsigned char*)p.out + OUT_G1); bf16* G2 = (bf16*)((unsigned char*)p.out + OUT_G2);
#define SL(i) (lds + (i) * SLOTB)
    float* PC = (float*)(lds + 18 * SLOTB);
    float* CST = (float*)(lds + CST_LDS_OFF);
    unsigned char* PREV = lds + PREV_LDS_OFF;
    float* NSB = (float*)(lds + PREV_LDS_OFF + 384);
    u32x4 pf[8];
    const int prow = tid >> 3, pchunk = tid & 7;
    const int pst = prow * 128 + ((pchunk ^ ((prow >> 1) & 7)) << 4);
    const unsigned pgo = (unsigned)(prow * (D_IN * 2) + pchunk * 16), pgg = (unsigned)(prow * 256 + pchunk * 16);
#define PREP_PREFETCH(hn, tok0_, has_prev) do { \
        const unsigned char* pb_ = (const unsigned char*)(proj + (size_t)(tok0_) * D_IN + C_R + (hn) * 64); \
        pf[0] = *(const u32x4*)(pb_ + pgo); pf[1] = *(const u32x4*)(pb_ + 2 * D_RWKV + pgo); pf[2] = *(const u32x4*)(pb_ + 4 * D_RWKV + pgo); \
        int tl_ = tid; asm volatile("" : "+v"(tl_)); \
        pf[3] = ((const u32x4*)(wupT + (hn) * 4096))[tl_]; \
        pf[4] = ((const u32x4*)(aupT + (hn) * 4096))[tl_]; \
        const unsigned char* gb_ = (const unsigned char*)(gupT + (hn) * 8192); \
        pf[5] = *(const u32x4*)(gb_ + pgg); pf[6] = *(const u32x4*)(gb_ + 128 + pgg); \
        pf[7] = (u32x4){0u, 0u, 0u, 0u}; \
        if (tid < 160) { const int arr_ = tl_ >> 4, c4_ = (tl_ & 15) * 4; \
            const float* src_ = arr_ < 3 ? mu + arr_ * D_RWKV : (arr_ == 3 ? w0 : (arr_ == 4 ? a0 : (arr_ == 5 ? k_k : (arr_ == 6 ? k_a : (arr_ == 7 ? r_k : (arr_ == 8 ? lnx_g : lnx_b)))))); \
            pf[7] = *(const u32x4*)(src_ + (hn) * 64 + c4_); } \
        else if (tid < 184 && (has_prev)) { const int x_ = (tl_ - 160) >> 3, ch_ = (tl_ - 160) & 7; \
            pf[7] = *(const u32x4*)(pb_ - 2 * D_IN + x_ * 2 * D_RWKV + ch_ * 16); } \
    } while (0)
#define PREP_STAGE() do { \
        *(u32x4*)(SL(6) + pst) = pf[0]; *(u32x4*)(SL(7) + pst) = pf[1]; *(u32x4*)(SL(8) + pst) = pf[2]; \
        *(u32x4*)(SL(9) + pst) = pf[3]; *(u32x4*)(SL(10) + pst) = pf[4]; *(u32x4*)(SL(11) + pst) = pf[5]; *(u32x4*)(SL(12) + pst) = pf[6]; \
        if (tid < 160) *(u32x4*)((unsigned char*)CST + tid * 16) = pf[7]; \
        else if (tid < 184) *(u32x4*)(PREV + (tid - 160) * 16) = pf[7]; \
    } while (0)
    for (int it = bid; it < BATCH * (SEQ / 64); it += nb) {
        const int b = it / (SEQ / 64), c = it % (SEQ / 64), tok0 = b * SEQ + c * 64;
        PREP_PREFETCH(0, tok0, c > 0);
        __syncthreads();
#pragma unroll
        for (int e = tid; e < 64 * 32; e += NT) {
            const int tt = e >> 5, k8 = (e & 31) * 8;
            const bf16* cur = proj + (size_t)(tok0 + tt) * D_IN + C_WD + k8;
            const u32x4 cv = *(const u32x4*)cur;
            u32x4 pv = {0u, 0u, 0u, 0u};
            if (c * 64 + tt > 0) pv = *(const u32x4*)(cur - D_IN);
            const f32x4 m0 = *(const f32x4*)(mu + C_WD - D_POOL + k8), m1 = *(const f32x4*)(mu + C_WD - D_POOL + k8 + 4);
            float z[8];
            z[0] = bflo(cv.x) + (bflo(pv.x) - bflo(cv.x)) * m0.x; z[1] = bfhi(cv.x) + (bfhi(pv.x) - bfhi(cv.x)) * m0.y;
            z[2] = bflo(cv.y) + (bflo(pv.y) - bflo(cv.y)) * m0.z; z[3] = bfhi(cv.y) + (bfhi(pv.y) - bfhi(cv.y)) * m0.w;
            z[4] = bflo(cv.z) + (bflo(pv.z) - bflo(cv.z)) * m1.x; z[5] = bfhi(cv.z) + (bfhi(pv.z) - bfhi(cv.z)) * m1.y;
            z[6] = bflo(cv.w) + (bflo(pv.w) - bflo(cv.w)) * m1.z; z[7] = bfhi(cv.w) + (bfhi(pv.w) - bfhi(cv.w)) * m1.w;
            if (k8 < 64) { for (int j = 0; j < 8; ++j) z[j] = 1.f - 2.f / (1.f + __expf(2.f * z[j])); }
            else if (k8 >= 128) { for (int j = 0; j < 8; ++j) z[j] = sigmoidf_(z[j]); }
            u32x4 o; o.x = pk2(z[0], z[1]); o.y = pk2(z[2], z[3]); o.z = pk2(z[4], z[5]); o.w = pk2(z[6], z[7]);
            *(u32x4*)(SL(k8 >> 6) + sw_off(tt, k8 & 63)) = o;
        }
#pragma unroll 1
        for (int h = 0; h < NH; ++h) {
            const size_t item = ((size_t)(b * (SEQ / 64) + c)) * NH + h;
            int tid_ = tid; asm volatile("" : "+v"(tid_));
            const int lane = tid_ & 63, w = __builtin_amdgcn_readfirstlane(tid_ >> 6);
            const int ts = w & 3, tl = lane & 15, q = lane >> 4, t = ts * 16 + tl;
            const int tmt = (w >> 1) & 1, tnt = w & 1, hh = lane >> 5;
            int offT[4], offL[2], offM[2];
        #pragma unroll
            for (int r = 0; r < 4; ++r) { offT[r] = sw_off(4 * q + r, t); }
        #pragma unroll
            for (int ks = 0; ks < 2; ++ks) { offL[ks] = sw_off(t, 32 * ks + 8 * q); offM[ks] = sw_off(tl, 32 * ks + 8 * q); }
            int oxm[4], oyn[4], ost[4];
        #pragma unroll
            for (int s_ = 0; s_ < 4; ++s_) { oxm[s_] = sw_off(tmt * 32 + (lane & 31), 16 * s_ + 8 * hh); oyn[s_] = sw_off(tnt * 32 + (lane & 31), 16 * s_ + 8 * hh); ost[s_] = sw_off(tnt * 32 + (lane & 31), tmt * 32 + 8 * s_ + 4 * hh); }
            __syncthreads();
            PREP_STAGE();
            if (h + 1 < NH) PREP_PREFETCH(h + 1, tok0, c > 0);
            __syncthreads();
            {
                const int cg = w >> 2;
                float lw[8], kap[8], bv[8], kn[8], rm[8], vm[8];
                float nsq = 0.f, bon = 0.f;
                {
                    f32x4 accw[2], acca[2];
#pragma unroll
                    for (int mi = 0; mi < 2; ++mi) { accw[mi] = (f32x4){0.f, 0.f, 0.f, 0.f}; acca[mi] = accw[mi]; }
#pragma unroll
                    for (int ks = 0; ks < 2; ++ks) {
                        const bf16x8 bw = *(const bf16x8*)(SL(0) + offL[ks]);
                        const bf16x8 ba = *(const bf16x8*)(SL(1) + offL[ks]);
#pragma unroll
                        for (int mi = 0; mi < 2; ++mi) {
                            const int m = 2 * cg + mi;
                            const bf16x8 aw = *(const bf16x8*)(SL(9) + offM[ks] + m * 2048);
                            const bf16x8 aa = *(const bf16x8*)(SL(10) + offM[ks] + m * 2048);
                            accw[mi] = MFMA16(aw, bw, accw[mi]); acca[mi] = MFMA16(aa, ba, acca[mi]);
                        }
                    }
                    const bool hp = (c * 64 + t) > 0;
#pragma unroll
                    for (int mi = 0; mi < 2; ++mi) {
                        const int m = 2 * cg + mi;
                        const int ch0 = m * 16 + 4 * q;
                        const int oR = sw_off(t, ch0), oRp = sw_off((t + 63) & 63, ch0);
                        float zz[3][4];
#pragma unroll
                        for (int x = 0; x < 3; ++x) {
                            const u32x2 cv = *(const u32x2*)(SL(6 + x) + oR);
                            u32x2 pv = *(const u32x2*)(t > 0 ? SL(6 + x) + oRp : PREV + x * 128 + ch0 * 2);
                            if (!hp) pv = (u32x2){0u, 0u};
                            const f32x4 mm = *(const f32x4*)(CST + x * 64 + ch0);
                            zz[x][0] = bflo(cv.x) + (bflo(pv.x) - bflo(cv.x)) * mm.x; zz[x][1] = bfhi(cv.x) + (bfhi(pv.x) - bfhi(cv.x)) * mm.y;
                            zz[x][2] = bflo(cv.y) + (bflo(pv.y) - bflo(cv.y)) * mm.z; zz[x][3] = bfhi(cv.y) + (bfhi(pv.y) - bfhi(cv.y)) * mm.w;
                        }
                        const f32x4 w0v = *(const f32x4*)(CST + 3 * 64 + ch0), a0v = *(const f32x4*)(CST + 4 * 64 + ch0), kkv = *(const f32x4*)(CST + 5 * 64 + ch0), kav = *(const f32x4*)(CST + 6 * 64 + ch0), rkv = *(const f32x4*)(CST + 7 * 64 + ch0);
#pragma unroll
                        for (int r = 0; r < 4; ++r) {
                            const int e = mi * 4 + r;
                            const float xx = w0v[r] + accw[mi][r];
                            const float sp = (-xx > 20.f) ? -xx : __logf(1.f + __expf(-xx));
                            lw[e] = -__expf(-sp - 0.5f);
                            const float av = sigmoidf_(a0v[r] + acca[mi][r]);
                            rm[e] = zz[0][r]; vm[e] = zz[2][r];
                            kap[e] = zz[1][r] * kkv[r]; nsq += kap[e] * kap[e];
                            kn[e] = zz[1][r] * (1.f + (av - 1.f) * kav[r]);
                            bon += rm[e] * kn[e] * rkv[r];
                            bv[e] = av;
                        }
                    }
                }
                nsq += __shfl_xor(nsq, 16); nsq += __shfl_xor(nsq, 32);
                bon += __shfl_xor(bon, 16); bon += __shfl_xor(bon, 32);
                if (q == 0) { NSB[cg * 64 + t] = nsq; NSB[128 + cg * 64 + t] = bon; }
                __syncthreads();
                nsq = NSB[t] + NSB[64 + t]; bon = NSB[128 + t] + NSB[192 + t];
                const float inv = 1.f / fmaxf(sqrtf(nsq), 1e-12f);
#pragma unroll
                for (int mi = 0; mi < 2; ++mi) {
                    const int m = 2 * cg + mi;
#pragma unroll
                    for (int r = 0; r < 4; ++r) {
                        const int e = mi * 4 + r;
                        kap[e] *= inv; bv[e] *= kap[e];
                        const unsigned hi = pk2(lw[e], 0.f) & 0xffffu; const float hif = __builtin_bit_cast(float, hi << 16);
                        *(unsigned short*)(SL(4) + offT[r] + m * 2048) = (unsigned short)hi;
                        *(unsigned short*)(SL(5) + offT[r] + m * 2048) = (unsigned short)pk2(lw[e] - hif, 0.f);
                        *(unsigned short*)(SL(13) + offT[r] + m * 2048) = (unsigned short)pk2(vm[e], 0.f);
                    }
                }
                {
                    f32x4 accg[2];
#pragma unroll
                    for (int mi = 0; mi < 2; ++mi) accg[mi] = (f32x4){0.f, 0.f, 0.f, 0.f};
#pragma unroll
                    for (int ks = 0; ks < 4; ++ks) {
                        const bf16x8 bg = *(const bf16x8*)(SL(2 + (ks >> 1)) + offL[ks & 1]);
#pragma unroll
                        for (int mi = 0; mi < 2; ++mi) {
                            const bf16x8 ag = *(const bf16x8*)(SL(11 + (ks >> 1)) + offM[ks & 1] + (2 * cg + mi) * 2048);
                            accg[mi] = MFMA16(ag, bg, accg[mi]);
                        }
                    }
#pragma unroll
                    for (int mi = 0; mi < 2; ++mi) {
                        const int ch0 = (2 * cg + mi) * 16 + 4 * q;
                        const f32x4 lg = *(const f32x4*)(CST + 8 * 64 + ch0), lb = *(const f32x4*)(CST + 9 * 64 + ch0);
                        u32x2 v1, v2;
                        v1.x = pk2(lg[0] * accg[mi][0], lg[1] * accg[mi][1]); v1.y = pk2(lg[2] * accg[mi][2], lg[3] * accg[mi][3]);
                        v2.x = pk2((lb[0] + bon * vm[mi * 4]) * accg[mi][0], (lb[1] + bon * vm[mi * 4 + 1]) * accg[mi][1]);
                        v2.y = pk2((lb[2] + bon * vm[mi * 4 + 2]) * accg[mi][2], (lb[3] + bon * vm[mi * 4 + 3]) * accg[mi][3]);
                        *(u32x2*)(G1 + item * 4096 + t * 64 + ch0) = v1;
                        *(u32x2*)(G2 + item * 4096 + t * 64 + ch0) = v2;
                    }
                }
                __syncthreads();
                f32x4 La[2], Ta[2];
#pragma unroll
                for (int mi = 0; mi < 2; ++mi) { La[mi] = (f32x4){0.f, 0.f, 0.f, 0.f}; Ta[mi] = La[mi]; }
#pragma unroll
                for (int ks = 0; ks < 2; ++ks) {
                    bf16x8 btri, bone;
#pragma unroll
                    for (int e = 0; e < 8; ++e) { const int s_ = 32 * ks + 8 * q + e; btri[e] = (short)((s_ <= t) ? 0x3F80 : 0); bone[e] = (short)0x3F80; }
#pragma unroll
                    for (int mi = 0; mi < 2; ++mi) {
                        const int m = 2 * cg + mi;
                        const bf16x8 ah = *(const bf16x8*)(SL(4) + offM[ks] + m * 2048);
                        const bf16x8 al = *(const bf16x8*)(SL(5) + offM[ks] + m * 2048);
                        La[mi] = MFMA16(ah, btri, La[mi]); La[mi] = MFMA16(al, btri, La[mi]);
                        Ta[mi] = MFMA16(ah, bone, Ta[mi]); Ta[mi] = MFMA16(al, bone, Ta[mi]);
                    }
                }
                __syncthreads();
#pragma unroll
                for (int mi = 0; mi < 2; ++mi) {
                    const int m = 2 * cg + mi;
                    const int ch0 = m * 16 + 4 * q;
                    float kt[4], rt[4], bt[4], kkt[4];
#pragma unroll
                    for (int r = 0; r < 4; ++r) {
                        const int e = mi * 4 + r;
                        const float L = La[mi][r], Lt = Ta[mi][r];
                        const float eL = __expf(L), em = __expf(-L), eh = __expf(Lt - L), ex = __expf(L - lw[e]);
                        kt[r] = kap[e] * ex; rt[r] = rm[e] * eL; bt[r] = bv[e] * em; kkt[r] = kn[e] * em;
                        *(unsigned short*)(SL(9) + offT[r] + m * 2048) = (unsigned short)pk2(kt[r], 0.f);
                        *(unsigned short*)(SL(11) + offT[r] + m * 2048) = (unsigned short)pk2(bv[e] * eh, 0.f);
                        *(unsigned short*)(SL(12) + offT[r] + m * 2048) = (unsigned short)pk2(kn[e] * eh, 0.f);
                        if (t == 0) PC[ch0 + r] = __expf(Lt);
                    }
                    const int oR = sw_off(t, ch0);
                    u32x2 v;
                    v.x = pk2(kt[0], kt[1]); v.y = pk2(kt[2], kt[3]); *(u32x2*)(SL(6) + oR) = v;
                    v.x = pk2(bt[0], bt[1]); v.y = pk2(bt[2], bt[3]); *(u32x2*)(SL(7) + oR) = v;
                    v.x = pk2(kkt[0], kkt[1]); v.y = pk2(kkt[2], kkt[3]); *(u32x2*)(SL(8) + oR) = v;
                    v.x = pk2(rt[0], rt[1]); v.y = pk2(rt[2], rt[3]); *(u32x2*)(SL(10) + oR) = v;
                }
            }
            __syncthreads();
            f32x16 racc = zero16();
            {
                if (w < 4) {
                    f32x16 d = mm32(SL(7), oxm, SL(6), oyn, zero16());
                    const int tq_ = tnt * 32 + (lane & 31);
#pragma unroll
                    for (int r = 0; r < 16; ++r) { const int s_ = tmt * 32 + (r & 3) + 8 * (r >> 2) + 4 * hh; const float v = (s_ < tq_) ? d[r] : 0.f; d[r] = v; racc[r] = ((s_ == tq_) ? 1.f : 0.f) - v; }
                    store_T(SL(4), d, tmt, tnt, lane, ost, [](float v, int, int) { return v; });
                    store_T(SL(17), racc, tmt, tnt, lane, ost, [](float v, int, int) { return v; });
                } else {
                    f32x16 d = mm32(SL(6), oxm, SL(7), oyn, zero16());
                    store_T(SL(5), d, tmt, tnt, lane, ost, [](float v, int m, int n) { return (n < m) ? v : 0.f; });
                }
                if (w < 4) {
                    f32x16 d = mm32(SL(8), oxm, SL(6), oyn, zero16());
                    store_T(SL(14), d, tmt, tnt, lane, ost, [](float v, int m, int n) { return (m < n) ? v : 0.f; });
                } else {
                    f32x16 d = mm32(SL(7), oxm, SL(10), oyn, zero16());
                    store_T(SL(15), d, tmt, tnt, lane, ost, [](float v, int m, int n) { return (m <= n) ? v : 0.f; });
                }
                if (w < 4) {
                    f32x16 d = mm32(SL(8), oxm, SL(10), oyn, zero16());
                    store_T(SL(16), d, tmt, tnt, lane, ost, [](float v, int m, int n) { return (m <= n) ? v : 0.f; });
                }
            }
            __syncthreads();
            auto ident = [](float v, int, int) { return v; };
            if (w < 4) { f32x16 d = mm32(SL(5), oxm, SL(4), oyn, zero16()); store_T(SL(6), d, tmt, tnt, lane, ost, ident); }
            else       { f32x16 d = mm32(SL(4), oxm, SL(5), oyn, zero16()); store_T(SL(7), d, tmt, tnt, lane, ost, ident); }
            __syncthreads();
            if (w < 4) { f32x16 d = mm32(SL(7), oxm, SL(6), oyn, zero16()); store_T(SL(4), d, tmt, tnt, lane, ost, ident);
                         racc = mm32(SL(7), oxm, SL(17), oyn, racc); store_T(SL(8), racc, tmt, tnt, lane, ost, ident); }
            else       { f32x16 d = mm32(SL(6), oxm, SL(7), oyn, zero16()); store_T(SL(5), d, tmt, tnt, lane, ost, ident); }
            __syncthreads();
            if (w < 4) { f32x16 d = mm32(SL(5), oxm, SL(4), oyn, zero16()); store_T(SL(6), d, tmt, tnt, lane, ost, ident);
                         racc = mm32(SL(5), oxm, SL(8), oyn, racc); store_T(SL(17), racc, tmt, tnt, lane, ost, ident); }
            else       { f32x16 d = mm32(SL(4), oxm, SL(5), oyn, zero16()); store_T(SL(7), d, tmt, tnt, lane, ost, ident); }
            __syncthreads();
            if (w < 4) { f32x16 d = mm32(SL(7), oxm, SL(6), oyn, zero16()); store_T(SL(4), d, tmt, tnt, lane, ost, ident);
                         racc = mm32(SL(7), oxm, SL(17), oyn, racc); store_T(SL(8), racc, tmt, tnt, lane, ost, ident); }
            else       { f32x16 d = mm32(SL(6), oxm, SL(7), oyn, zero16()); store_T(SL(5), d, tmt, tnt, lane, ost, ident); }
            __syncthreads();
            if (w < 4) { racc = mm32(SL(5), oxm, SL(8), oyn, racc); store_T(SL(17), racc, tmt, tnt, lane, ost, ident); }
            else       { f32x16 d = mm32(SL(4), oxm, SL(5), oyn, zero16()); store_T(SL(7), d, tmt, tnt, lane, ost, ident); }
            __syncthreads();
            if (w < 4) { racc = mm32(SL(7), oxm, SL(17), oyn, racc); store_T(SL(8), racc, tmt, tnt, lane, ost, ident); }
            else       { f32x16 d = mm32(SL(14), oxm, SL(13), oyn, zero16()); store_T(SL(6), d, tmt, tnt, lane, ost, ident); }
            __syncthreads();
            if (w < 4) { f32x16 d = mm32(SL(8), oxm, SL(9), oyn, zero16()); store_T(SL(4), d, tmt, tnt, lane, ost, ident); }
            else       { f32x16 d = mm32(SL(8), oxm, SL(6), oyn, zero16()); store_T(SL(5), d, tmt, tnt, lane, ost, [](float v, int, int) { return -v; }); }
            __syncthreads();
            {
                const int ln = lane & 31;
                if (w < 4) {
                    const f32x16 d = mm32(SL(4), oxm, SL(11), oyn, zero16());
                    const int j = tnt * 32 + ln; const float pc = PC[j];
                    bf16* dst = TC + item * 4096;
#pragma unroll
                    for (int g = 0; g < 4; ++g) {
                        const int jp0 = tmt * 32 + 8 * g + 4 * hh;
                        float v[4];
#pragma unroll
                        for (int r = 0; r < 4; ++r) v[r] = ((jp0 + r == j) ? pc : 0.f) - d[4 * g + r];
                        const int a = jp0 >> 4, qp = (jp0 & 15) >> 2, s_ = a >> 1, m16 = j >> 4, L = (qp << 4) | (j & 15);
                        u32x2 o; o.x = pk2(v[0], v[1]); o.y = pk2(v[2], v[3]);
                        *(u32x2*)(dst + ((m16 * 2 + s_) * 64 + L) * 8 + (a & 1) * 4) = o;
                    }
                    const f32x16 d2 = mm32(SL(4), oxm, SL(15), oyn, zero16());
                    const int tq_ = tnt * 32 + ln;
                    bf16* dq = QC + item * 4096;
#pragma unroll
                    for (int g = 0; g < 4; ++g) {
                        const int j0 = tmt * 32 + 8 * g + 4 * hh;
                        const u32x2 rv = *(const u32x2*)(SL(10) + ost[g]);
                        u32x2 o; o.x = pk2(bflo(rv.x) - d2[4 * g], bfhi(rv.x) - d2[4 * g + 1]); o.y = pk2(bflo(rv.y) - d2[4 * g + 2], bfhi(rv.y) - d2[4 * g + 3]);
                        *(u32x2*)(dq + tq_ * 64 + j0) = o;
                    }
                } else {
                    f32x16 d = mm32(SL(11), oxm, SL(5), oyn, zero16());
                    d = mm32(SL(12), oxm, SL(13), oyn, d);
                    const int i = tnt * 32 + ln;
                    bf16* dg = GC + item * 4096;
#pragma unroll
                    for (int g = 0; g < 4; ++g) {
                        const int j0 = tmt * 32 + 8 * g + 4 * hh;
                        const int m16 = j0 >> 4, qq = (j0 & 15) >> 2, L = (qq << 4) | (i & 15), iq = i >> 4;
                        u32x2 o; o.x = pk2(d[4 * g], d[4 * g + 1]); o.y = pk2(d[4 * g + 2], d[4 * g + 3]);
                        *(u32x2*)(dg + (iq * 64 + L) * 16 + m16 * 4) = o;
                    }
                    f32x16 d2 = mm32(SL(5), oxm, SL(15), oyn, zero16());
                    d2 = mm32(SL(13), oxm, SL(16), oyn, d2);
                    bf16* dol = OL + item * 4096;
#pragma unroll
                    for (int g = 0; g < 4; ++g) {
                        u32x2 o; o.x = pk2(d2[4 * g], d2[4 * g + 1]); o.y = pk2(d2[4 * g + 2], d2[4 * g + 3]);
                        *(u32x2*)(dol + (((tnt * 2 + tmt) * 4 + g) * 64 + lane) * 4) = o;
                    }
                }
            }
        }
    }
#undef SL
}

__device__ __forceinline__ void phase_scan(const Params& p, int chain) {
    const int lane = opaque_tid() & 63;
    const int b = chain / 48, h = (chain >> 2) % NH, iq = chain & 3;
    const int q = lane >> 4, il = lane & 15;
    const bf16* TC = (const bf16*)(p.ws + WS_TC); const bf16* GC = (const bf16*)(p.ws + WS_GC); bf16* S0 = (bf16*)(p.ws + WS_S0);
    const size_t item0 = (size_t)(b * (SEQ / 64)) * NH + h;
    constexpr int PD = 4;
    u32x4 tq[PD][8]; u32x4 gq[PD][2];
    f32x4 S[4];
#pragma unroll
    for (int m = 0; m < 4; ++m) S[m] = (f32x4){0.f, 0.f, 0.f, 0.f};
#define P2_LOAD(d, cc) do { const bf16* tb = TC + (item0 + (size_t)(cc) * NH) * 4096; const bf16* gb = GC + (item0 + (size_t)(cc) * NH) * 4096 + (iq * 64 + lane) * 16; \
        _Pragma("unroll") for (int x = 0; x < 8; ++x) tq[d][x] = *(const u32x4*)(tb + (x * 64 + lane) * 8); \
        gq[d][0] = *(const u32x4*)(gb); gq[d][1] = *(const u32x4*)(gb + 8); } while (0)
#pragma unroll
    for (int d = 0; d < PD; ++d) P2_LOAD(d, d);
    for (int c = 0; c < SEQ / 64; c += PD) {
#pragma unroll
        for (int d = 0; d < PD; ++d) {
            const int cc = c + d;
            u32x4 sb0, sb1;
            sb0.x = pk2(S[0][0], S[0][1]); sb0.y = pk2(S[0][2], S[0][3]); sb0.z = pk2(S[1][0], S[1][1]); sb0.w = pk2(S[1][2], S[1][3]);
            sb1.x = pk2(S[2][0], S[2][1]); sb1.y = pk2(S[2][2], S[2][3]); sb1.z = pk2(S[3][0], S[3][1]); sb1.w = pk2(S[3][2], S[3][3]);
            bf16* so = S0 + (item0 + (size_t)cc * NH) * 4096 + (iq * 16 + il) * 64 + 4 * q;
            *(u32x2*)(so) = (u32x2){sb0.x, sb0.y}; *(u32x2*)(so + 16) = (u32x2){sb0.z, sb0.w};
            *(u32x2*)(so + 32) = (u32x2){sb1.x, sb1.y}; *(u32x2*)(so + 48) = (u32x2){sb1.z, sb1.w};
            f32x4 gi[4];
            gi[0] = (f32x4){bflo(gq[d][0].x), bfhi(gq[d][0].x), bflo(gq[d][0].y), bfhi(gq[d][0].y)};
            gi[1] = (f32x4){bflo(gq[d][0].z), bfhi(gq[d][0].z), bflo(gq[d][0].w), bfhi(gq[d][0].w)};
            gi[2] = (f32x4){bflo(gq[d][1].x), bfhi(gq[d][1].x), bflo(gq[d][1].y), bfhi(gq[d][1].y)};
            gi[3] = (f32x4){bflo(gq[d][1].z), bfhi(gq[d][1].z), bflo(gq[d][1].w), bfhi(gq[d][1].w)};
            const bf16x8 b0 = __builtin_bit_cast(bf16x8, sb0), b1 = __builtin_bit_cast(bf16x8, sb1);
#pragma unroll
            for (int m = 0; m < 4; ++m) {
                S[m] = MFMA16(__builtin_bit_cast(bf16x8, tq[d][2 * m]), b0, gi[m]);
                S[m] = MFMA16(__builtin_bit_cast(bf16x8, tq[d][2 * m + 1]), b1, S[m]);
            }
            if (cc + PD < SEQ / 64) P2_LOAD(d, cc + PD);
        }
    }
#undef P2_LOAD
}

__device__ __forceinline__ void phase_rwkv_out(const Params& p, int bid, int nb) {
    const int tid = opaque_tid(), lane = tid & 63, w = tid >> 6, ln = lane & 31, hh = lane >> 5;
    const bf16* S0 = (const bf16*)(p.ws + WS_S0); const bf16* QC = (const bf16*)(p.ws + WS_QC); const bf16* OL = (const bf16*)(p.ws + WS_OL);
    const bf16* G1 = (const bf16*)((const unsigned char*)p.out + OUT_G1); const bf16* G2 = (const bf16*)((const unsigned char*)p.out + OUT_G2);
    bf16* mix = (bf16*)(p.ws + WS_MIXIN);
    const int ntask = BATCH * (SEQ / 64) * NH * 2;
    for (int task = bid * 8 + w; task < ntask; task += nb * 8) {
        const int item = task >> 1, nt = task & 1;
        const int h = item % NH, bc = item / NH;
        const int tok0 = bc * 64;
        f32x16 acc[2];
#pragma unroll
        for (int mt = 0; mt < 2; ++mt)
#pragma unroll
            for (int g = 0; g < 4; ++g) {
                const u32x2 v = *(const u32x2*)(OL + (size_t)item * 4096 + (((nt * 2 + mt) * 4 + g) * 64 + lane) * 4);
                acc[mt][4 * g] = bflo(v.x); acc[mt][4 * g + 1] = bfhi(v.x); acc[mt][4 * g + 2] = bflo(v.y); acc[mt][4 * g + 3] = bfhi(v.y);
            }
        const int t = nt * 32 + ln;
#pragma unroll
        for (int s = 0; s < 4; ++s) {
            const bf16x8 bq = *(const bf16x8*)(QC + (size_t)item * 4096 + t * 64 + 16 * s + 8 * hh);
#pragma unroll
            for (int mt = 0; mt < 2; ++mt) {
                const bf16x8 a = *(const bf16x8*)(S0 + (size_t)item * 4096 + (mt * 32 + ln) * 64 + 16 * s + 8 * hh);
                acc[mt] = MFMA32(a, bq, acc[mt]);
            }
        }
        float s1 = 0.f;
#pragma unroll
        for (int mt = 0; mt < 2; ++mt)
#pragma unroll
            for (int r = 0; r < 16; ++r) s1 += acc[mt][r];
        s1 += __shfl_xor(s1, 32);
        const float mean = s1 * (1.f / 64.f);
        float s2 = 0.f;
#pragma unroll
        for (int mt = 0; mt < 2; ++mt)
#pragma unroll
            for (int r = 0; r < 16; ++r) { acc[mt][r] -= mean; s2 += acc[mt][r] * acc[mt][r]; }
        s2 += __shfl_xor(s2, 32);
        const float rstd = rsqrtf(s2 * (1.f / 64.f) + LNX_EPS);
#pragma unroll
        for (int mt = 0; mt < 2; ++mt)
#pragma unroll
            for (int g = 0; g < 4; ++g) {
                const int i0 = mt * 32 + 8 * g + 4 * hh;
                const u32x2 a1 = *(const u32x2*)(G1 + (size_t)item * 4096 + t * 64 + i0), a2 = *(const u32x2*)(G2 + (size_t)item * 4096 + t * 64 + i0);
                u32x2 o;
                o.x = pk2(acc[mt][4 * g] * rstd * bflo(a1.x) + bflo(a2.x), acc[mt][4 * g + 1] * rstd * bfhi(a1.x) + bfhi(a2.x));
                o.y = pk2(acc[mt][4 * g + 2] * rstd * bflo(a1.y) + bflo(a2.y), acc[mt][4 * g + 3] * rstd * bfhi(a1.y) + bfhi(a2.y));
                *(u32x2*)(mix + (size_t)(tok0 + t) * DM + D_POOL + h * 64 + i0) = o;
            }
    }
}

struct EpiOut {
    const float* X; float* O; int row0, col0;
    __device__ __forceinline__ void operator()(const f32x4 (&acc)[8][4], int wr, int wc, int fr, int fq) const {
#pragma unroll
        for (int m = 0; m < 8; ++m) {
            const size_t off = (size_t)(row0 + wr * 128 + m * 16 + fr) * DM + col0 + wc * 64 + fq * 4;
#pragma unroll
            for (int n = 0; n < 4; ++n) { const f32x4 xv = *(const f32x4*)(X + off + n * 16); *(f32x4*)(O + off + n * 16) = xv * ALPHA + acc[m][n]; }
        }
    }
};
__device__ __forceinline__ void phase_outproj(const Params& p, unsigned char* lds, int bid, int nb) {
    pg8::Gemm g{(const pg8::bf16_t*)(p.ws + WS_MIXIN), (const pg8::bf16_t*)(p.ws + WS_WOUT_T), NTOK, DM, DM};
    pg8::StaticOrder S; S.init(NTOK, DM, nb, bid);
    pg8::EpiResF32 E{p.in[0], p.out, DM, ALPHA};
    pg8::gemm_phase<pg8::EpiResF32, pg8::StaticOrder>((PG8_LAS unsigned char*)lds, g, S, E);
}

__device__ __forceinline__ void phase_ln_router(const Params& p, unsigned char* lds, int bid, int nb) {
    const int tid = opaque_tid(), lane = tid & 63, w = __builtin_amdgcn_readfirstlane(tid >> 6);
    float* RT = (float*)lds;
    unsigned* LCNT = (unsigned*)(lds + 147456);
    int* LENT = (int*)(lds + 147456 + 128);
    (void)LENT;
    __syncthreads();
    {
        const f32x4* src = (const f32x4*)(p.ws + WS_RTT);
        f32x4 tmp[18];
#pragma unroll
        for (int i = 0; i < 18; ++i) tmp[i] = src[tid + i * NT];
#pragma unroll
        for (int i = 0; i < 18; ++i) ((f32x4*)RT)[tid + i * NT] = tmp[i];
    }
    const float* g1 = p.in[16]; const float* b1 = p.in[17]; const float* rgb = p.in[19]; const float* reb = p.in[21];
    float* H = p.out; bf16* hb = (bf16*)(p.ws + WS_HB);
    unsigned* cnt = (unsigned*)(p.ws + WS_CTL);
    int* list = (int*)(p.ws + WS_LIST); float* lwt = (float*)(p.ws + WS_LWT);
    const int rows_per_wg = NTOK / nb;
    const int rpw = rows_per_wg / 8;
    const int row0 = bid * rows_per_wg + w * rpw;
    if (tid < 32) LCNT[tid] = 0u;
    __syncthreads();
    int my_e0 = 0, my_e1 = 0, my_r0 = 0, my_r1 = 0; float my_w0 = 0.f, my_w1 = 0.f;
    f32x4 nx[4];
#pragma unroll
    for (int j = 0; j < 4; ++j) nx[j] = *(const f32x4*)(H + (size_t)row0 * DM + j * 256 + lane * 4);
    for (int ri = 0; ri < rpw; ++ri) {
        const int row = row0 + ri;
        float* hr = H + (size_t)row * DM;
        f32x4 v[4]; float s = 0.f;
#pragma unroll
        for (int j = 0; j < 4; ++j) { v[j] = nx[j]; s += (v[j].x + v[j].y) + (v[j].z + v[j].w); }
        if (ri + 1 < rpw) {
#pragma unroll
            for (int j = 0; j < 4; ++j) nx[j] = *(const f32x4*)(hr + DM + j * 256 + lane * 4);
        }
        const float mean = wave_sum(s) * (1.f / DM);
        float s2 = 0.f;
#pragma unroll
        for (int j = 0; j < 4; ++j) { v[j] = v[j] - mean; s2 += (v[j].x * v[j].x + v[j].y * v[j].y) + (v[j].z * v[j].z + v[j].w * v[j].w); }
        const float rstd = rsqrtf(wave_sum(s2) * (1.f / DM) + LN_EPS);
#pragma unroll
        for (int j = 0; j < 4; ++j) {
            const f32x4 g = *(const f32x4*)(g1 + j * 256 + lane * 4), bb = *(const f32x4*)(b1 + j * 256 + lane * 4);
            v[j] = v[j] * rstd * g + bb;
            u32x2 o; o.x = pk2(v[j].x, v[j].y); o.y = pk2(v[j].z, v[j].w);
            *(u32x2*)(hb + (size_t)row * DM + j * 256 + lane * 4) = o;
        }
        float gl[4];
#pragma unroll
        for (int q = 0; q < 4; ++q) {
            float a = 0.f;
#pragma unroll
            for (int j = 0; j < 4; ++j) { const f32x4 r = *(const f32x4*)(RT + q * 1024 + j * 256 + lane * 4); a += v[j].x * r.x + v[j].y * r.y + v[j].z * r.z + v[j].w * r.w; }
            gl[q] = a;
        }
#pragma unroll
        for (int q = 0; q < 4; ++q) gl[q] = wave_sum(gl[q]) + rgb[q];
        int gi = 0; float gm = gl[0];
#pragma unroll
        for (int q = 1; q < 4; ++q) if (gl[q] > gm) { gm = gl[q]; gi = q; }
        float den = 0.f;
#pragma unroll
        for (int q = 0; q < 4; ++q) den += __expf(gl[q] - gm);
        const float gp = 1.f / den;
        gi = __builtin_amdgcn_readfirstlane(gi);
        float el[8];
        const float* rtg = RT + (4 + gi * 8) * 1024 + lane * 4;
#pragma unroll
        for (int hq = 0; hq < 2; ++hq) {
            float part[4];
#pragma unroll
            for (int q = 0; q < 4; ++q) {
                float a = 0.f;
#pragma unroll
                for (int j = 0; j < 4; ++j) { const f32x4 r = *(const f32x4*)(rtg + (hq * 4 + q) * 1024 + j * 256); a += v[j].x * r.x + v[j].y * r.y + v[j].z * r.z + v[j].w * r.w; }
                part[q] = a;
            }
#pragma unroll
            for (int q = 0; q < 4; ++q) el[hq * 4 + q] = wave_sum(part[q]) + reb[gi * 8 + hq * 4 + q];
        }
        int i0 = 0; float m0 = el[0];
#pragma unroll
        for (int q = 1; q < 8; ++q) if (el[q] > m0) { m0 = el[q]; i0 = q; }
        int i1 = -1; float m1 = -3.0e38f;
#pragma unroll
        for (int q = 0; q < 8; ++q) if (q != i0 && el[q] > m1) { m1 = el[q]; i1 = q; }
        const float e1 = __expf(m1 - m0);
        const float w0 = gp / (1.f + e1), w1 = gp * e1 / (1.f + e1);
        if (lane == ri) {
            my_e0 = gi * 8 + i0; my_e1 = gi * 8 + i1; my_w0 = w0; my_w1 = w1;
            my_r0 = (int)atomicAdd(&LCNT[my_e0], 1u); my_r1 = (int)atomicAdd(&LCNT[my_e1], 1u);
        }
    }
    __syncthreads();
    if (tid < 32) { const unsigned c = LCNT[tid]; LCNT[tid] = c ? atomicAdd(&cnt[tid], c) : 0u; }
    __syncthreads();
    if (lane < rpw) {
        const int row = row0 + lane;
        const int p0 = (int)LCNT[my_e0] + my_r0, p1 = (int)LCNT[my_e1] + my_r1;
        list[my_e0 * NTOK + p0] = row * 2; lwt[my_e0 * NTOK + p0] = my_w0;
        list[my_e1 * NTOK + p1] = row * 2 + 1; lwt[my_e1 * NTOK + p1] = my_w1;
    }
}

__device__ __forceinline__ float siluf_(float x) { return x / (1.f + __expf(-x)); }
constexpr int MOE_MR = 144, MOE_MT = 9;
constexpr int MOE_BUFB = 41984, MOE_BOFF = 9216, MOE_HID = 83968, MOE_ROW = 157696;
__device__ __forceinline__ int key64(int row) { return (0x78 >> (2 * ((row >> 2) & 3))) & 3; }
#define GLDS16(gptr, ldsptr) __builtin_amdgcn_global_load_lds((const __attribute__((address_space(1))) unsigned*)(gptr), (__attribute__((address_space(3))) unsigned*)(ldsptr), 16, 0, 0)
__device__ __forceinline__ void phase_moe(const Params& p, unsigned char* lds, int bid, int nb) {
    const int tid0 = opaque_tid();
    const unsigned* cnt = (const unsigned*)(p.ws + WS_CTL);
    const bf16* hb = (const bf16*)(p.ws + WS_HB);
    bf16* YS = (bf16*)(p.ws + WS_YS);
    int* ROWTS = (int*)(lds + MOE_ROW); float* ROWWT = (float*)(lds + MOE_ROW + 576);
    for (int u0 = bid; u0 < NEXP * 8; u0 += nb) {
        const int u = (nb == 256) ? ((u0 & 7) * 32 + (u0 >> 3)) : u0;
        int tid = tid0; asm volatile("" : "+v"(tid));
        const int lane = tid & 63, wv = __builtin_amdgcn_readfirstlane(tid >> 6);
        const int fr = lane & 15, fq = lane >> 4;
        const int srow = tid >> 2, schunk = (tid & 3) ^ key64(srow);
        const int offA = fr * 64 + ((fq ^ key64(fr)) << 4);
        const int offB = MOE_BOFF + (wv * 64 + fr) * 64 + ((fq ^ key64(fr)) << 4);
        const int e = u >> 3, part = u & 7;
        const int ce = (int)cnt[e], hrows = (ce + 7) >> 3;
        const int rbeg = part * hrows, rend = min(ce, rbeg + hrows);
        const int* lst = (const int*)(p.ws + WS_LIST) + e * NTOK; const float* lw_ = (const float*)(p.ws + WS_LWT) + e * NTOK;
        const bf16* wgu = (const bf16*)(p.ws + WS_EGU) + (size_t)e * 512 * DM;
        const bf16* wdn = (const bf16*)(p.ws + WS_EDN) + (size_t)e * DM * DE;
        for (int r0 = rbeg; r0 < rend; r0 += MOE_MR) {
            const int nrows = min(MOE_MR, rend - r0), mt = (nrows + 15) >> 4;
            __syncthreads();
            if (tid < MOE_MR) { const bool ok = tid < nrows; ROWTS[tid] = ok ? lst[r0 + tid] : lst[r0]; ROWWT[tid] = ok ? lw_[r0 + tid] : 0.f; }
            __syncthreads();
            const bool a2 = wv == 0;
            const unsigned aoff0 = (unsigned)((ROWTS[srow] >> 1) * DM + schunk * 8);
            const unsigned aoff1 = (unsigned)((ROWTS[a2 ? 128 + srow : 0] >> 1) * DM + schunk * 8);
            f32x4 acc[MOE_MT][4];
#pragma unroll
            for (int m = 0; m < MOE_MT; ++m)
#pragma unroll
                for (int n = 0; n < 4; ++n) acc[m][n] = (f32x4){0.f, 0.f, 0.f, 0.f};
            {
                const unsigned boff = (unsigned)(srow * DM + schunk * 8);
#define MOE_STAGE1(buf_, k_) do { unsigned char* sb_ = lds + (buf_) * MOE_BUFB + wv * 1024; \
                    GLDS16(hb + aoff0 + (k_), sb_); if (a2) GLDS16(hb + aoff1 + (k_), sb_ + 8192); \
                    _Pragma("unroll") for (int i = 0; i < 4; ++i) GLDS16(wgu + boff + i * 128 * DM + (k_), sb_ + MOE_BOFF + i * 8192); } while (0)
                MOE_STAGE1(0, 0);
                MOE_STAGE1(1, 32);
#pragma unroll 1
                for (int kt = 0; kt < DM / 32; ++kt) {
                    if (kt + 1 < DM / 32) { if (a2) asm volatile("s_waitcnt vmcnt(6)" ::: "memory"); else asm volatile("s_waitcnt vmcnt(5)" ::: "memory"); }
                    else asm volatile("s_waitcnt vmcnt(0)" ::: "memory");
                    __builtin_amdgcn_s_barrier();
                    asm volatile("" ::: "memory");
                    const int b0 = kt % 3;
                    if (kt + 2 < DM / 32) MOE_STAGE1((kt + 2) % 3, (kt + 2) * 32);
                    const unsigned char* cur = lds + b0 * MOE_BUFB;
                    bf16x8 bfr[4];
#pragma unroll
                    for (int n = 0; n < 4; ++n) bfr[n] = *(const bf16x8*)(cur + offB + n * 1024);
#pragma unroll
                    for (int m = 0; m < MOE_MT; ++m) {
                        if (m < mt) {
                            const bf16x8 afr = *(const bf16x8*)(cur + offA + m * 1024);
#pragma unroll
                            for (int n = 0; n < 4; ++n) acc[m][n] = MFMA16(bfr[n], afr, acc[m][n]);
                        }
                    }
                }
                __syncthreads();
#undef MOE_STAGE1
            }
            const unsigned doff = (unsigned)(srow * DE + schunk * 8);
#define MOE_STAGE2(buf_, it_) do { unsigned char* sb_ = lds + (buf_) * MOE_BUFB + wv * 1024 + MOE_BOFF; const bf16* g_ = wdn + doff + (size_t)(((it_) >> 3) * 512) * DE + ((it_) & 7) * 32; \
                    _Pragma("unroll") for (int i = 0; i < 4; ++i) GLDS16(g_ + i * 128 * DE, sb_ + i * 8192); } while (0)
            MOE_STAGE2(0, 0);
#pragma unroll
            for (int m = 0; m < MOE_MT; ++m) {
                if (m < mt) {
                    const int row = m * 16 + fr;
#pragma unroll
                    for (int n = 0; n < 2; ++n) {
                        const f32x4 g = acc[m][n], uu = acc[m][n + 2];
                        const int hcol = wv * 32 + n * 16 + fq * 4;
                        u32x2 v; v.x = pk2(siluf_(g[0]) * uu[0], siluf_(g[1]) * uu[1]); v.y = pk2(siluf_(g[2]) * uu[2], siluf_(g[3]) * uu[3]);
                        *(u32x2*)(lds + MOE_HID + row * 512 + (((hcol >> 3) ^ (row & 15)) << 4) + (hcol & 7) * 2) = v;
                    }
                }
            }
            int hoff4[4];
#pragma unroll
            for (int sp = 0; sp < 4; ++sp) hoff4[sp] = MOE_HID + fr * 512 + (((sp * 4 + fq) ^ fr) << 4);
            __syncthreads();
#pragma unroll 1
            for (int np = 0; np < 2; ++np) {
#pragma unroll
                for (int m = 0; m < MOE_MT; ++m)
#pragma unroll
                    for (int n = 0; n < 4; ++n) acc[m][n] = (f32x4){0.f, 0.f, 0.f, 0.f};
#pragma unroll 1
                for (int kt = 0; kt < DE / 32; ++kt) {
                    const int it_ = np * 8 + kt;
                    const unsigned char* cur = lds + (it_ & 1) * MOE_BUFB;
                    if (it_ + 1 < 16) MOE_STAGE2((it_ + 1) & 1, it_ + 1);
                    bf16x8 bfr[4];
#pragma unroll
                    for (int n = 0; n < 4; ++n) bfr[n] = *(const bf16x8*)(cur + offB + n * 1024);
                    const int ho = hoff4[kt & 3] + (kt >> 2) * 256;
#pragma unroll
                    for (int m = 0; m < MOE_MT; ++m) {
                        if (m < mt) {
                            const bf16x8 afr = *(const bf16x8*)(lds + ho + m * 8192);
#pragma unroll
                            for (int n = 0; n < 4; ++n) acc[m][n] = MFMA16(bfr[n], afr, acc[m][n]);
                        }
                    }
                    __syncthreads();
                }
#pragma unroll
                for (int m = 0; m < MOE_MT; ++m) {
                    const int r = m * 16 + fr;
                    if (r < nrows) {
                        const int ts = ROWTS[r]; const float wt = ROWWT[r];
                        bf16* rp = YS + (size_t)ts * DM + np * 512 + wv * 64 + fq * 4;
#pragma unroll
                        for (int n = 0; n < 4; ++n) { u32x2 v; v.x = pk2(acc[m][n][0] * wt, acc[m][n][1] * wt); v.y = pk2(acc[m][n][2] * wt, acc[m][n][3] * wt); *(u32x2*)(rp + n * 16) = v; }
                    }
                }
            }
#undef MOE_STAGE2
        }
    }
}

__device__ __forceinline__ void phase_final(const Params& p, int bid, int nb) {
    const int tid = opaque_tid(), lane = tid & 63, w = tid >> 6;
    const float* g2 = p.in[25]; const float* b2 = p.in[26];
    const bf16* ys = (const bf16*)(p.ws + WS_YS); const bf16* hb = (const bf16*)(p.ws + WS_HB);
    for (int row = bid * 8 + w; row < NTOK; row += nb * 8) {
        float* hr = p.out + (size_t)row * DM;
        f32x4 v[4]; float s = 0.f;
#pragma unroll
        for (int j = 0; j < 4; ++j) {
            const u32x2 hq = *(const u32x2*)(hb + (size_t)row * DM + j * 256 + lane * 4);
            const f32x4 hv = {bflo(hq.x), bfhi(hq.x), bflo(hq.y), bfhi(hq.y)};
            const u32x2 y0 = *(const u32x2*)(ys + (size_t)row * 2 * DM + j * 256 + lane * 4), y1 = *(const u32x2*)(ys + (size_t)row * 2 * DM + DM + j * 256 + lane * 4);
            v[j].x = hv.x * ALPHA + (bflo(y0.x) + bflo(y1.x)); v[j].y = hv.y * ALPHA + (bfhi(y0.x) + bfhi(y1.x));
            v[j].z = hv.z * ALPHA + (bflo(y0.y) + bflo(y1.y)); v[j].w = hv.w * ALPHA + (bfhi(y0.y) + bfhi(y1.y));
            s += (v[j].x + v[j].y) + (v[j].z + v[j].w);
        }
        const float mean = wave_sum(s) * (1.f / DM);
        float s2 = 0.f;
#pragma unroll
        for (int j = 0; j < 4; ++j) { v[j] = v[j] - mean; s2 += (v[j].x * v[j].x + v[j].y * v[j].y) + (v[j].z * v[j].z + v[j].w * v[j].w); }
        const float rstd = rsqrtf(wave_sum(s2) * (1.f / DM) + LN_EPS);
#pragma unroll
        for (int j = 0; j < 4; ++j) {
            const f32x4 g = *(const f32x4*)(g2 + j * 256 + lane * 4), bb = *(const f32x4*)(b2 + j * 256 + lane * 4);
            *(f32x4*)(hr + j * 256 + lane * 4) = v[j] * rstd * g + bb;
        }
    }
}

#define LAS __attribute__((address_space(3)))
#define XB_TMO      128
#define XB_XCNT(j)  (256  + 64 * (j))
#define XB_XSUB(j)  (1280 + 64 * (j))
#define XB_XGEN(j)  (2304 + 64 * (j))
#define XB_TOP      3328
#define XB_TOPGEN   3392
#define XCD_BAR_WORDS 3456
#define XB_SPIN_CAP (1u << 18)
__device__ __forceinline__ unsigned xb_ld(unsigned* p)              { return __hip_atomic_load(p, __ATOMIC_RELAXED, __HIP_MEMORY_SCOPE_AGENT); }
__device__ __forceinline__ unsigned xb_add(unsigned* p, unsigned v) { return __hip_atomic_fetch_add(p, v, __ATOMIC_RELAXED, __HIP_MEMORY_SCOPE_AGENT); }
__device__ __forceinline__ unsigned xb_xcc_id() { return (unsigned)__builtin_amdgcn_s_getreg((3 << 11) | 20) & 0xFu; }
#define XB_SPIN(cond, bar) do { unsigned _sp = 0; while (cond) { __builtin_amdgcn_s_sleep(1); \
    if ((++_sp & 255u) == 0u) { if (xb_ld(&(bar)[XB_TMO])) break; if (_sp > XB_SPIN_CAP) { atomicAdd(&(bar)[XB_TMO], 1u); break; } } } } while (0)
struct XcdBarrier { unsigned* bar; unsigned x; volatile LAS unsigned* st; };
__device__ __forceinline__ XcdBarrier xcd_barrier_post(unsigned* bar, volatile LAS unsigned* st) {
    XcdBarrier b; b.bar = bar; b.x = xb_xcc_id(); b.st = st;
    if (threadIdx.x == 0) (void)xb_add(&bar[XB_XCNT(b.x)], 1u);
    return b;
}
__device__ __forceinline__ void xcd_barrier_complete(unsigned* bar, unsigned x, unsigned& nloc, unsigned& nx) {
    const unsigned G = gridDim.x * gridDim.y * gridDim.z;
    unsigned sum, cnt, mine, sp = 0u;
    for (;;) {
        sum = 0u; cnt = 0u; mine = 0u;
#pragma unroll
        for (unsigned j = 0; j < 16; ++j) { const unsigned c = xb_ld(&bar[XB_XCNT(j)]); sum += c; cnt += (c > 0u) ? 1u : 0u; mine = (j == x) ? c : mine; }
        if (sum == G) break;
        __builtin_amdgcn_s_sleep(1);
        if ((++sp & 255u) == 0u) { if (xb_ld(&bar[XB_TMO])) break; if (sp > XB_SPIN_CAP) { atomicAdd(&bar[XB_TMO], 1u); break; } }
    }
    nloc = mine > 0u ? mine : 1u; nx = cnt > 0u ? cnt : 1u;
}
__device__ __forceinline__ void xcd_barrier(const XcdBarrier& b) {
    asm volatile("s_waitcnt vmcnt(0)" ::: "memory");
    __syncthreads();
    if (threadIdx.x == 0) {
        unsigned* bar = b.bar;
        __builtin_amdgcn_s_waitcnt(0);
        unsigned nloc = b.st[0], nx = b.st[1];
        if (nloc == 0u) { xcd_barrier_complete(bar, b.x, nloc, nx); b.st[0] = nloc; b.st[1] = nx; }
        const unsigned old = xb_add(&bar[XB_XSUB(b.x)], 1u);
        const unsigned gen = old / nloc;
        if (old + 1u == (gen + 1u) * nloc) {
            __builtin_amdgcn_fence(__ATOMIC_RELEASE, "agent");
            asm volatile("s_waitcnt vmcnt(0)" ::: "memory");
            const unsigned og = xb_add(&bar[XB_TOP], 1u);
            const unsigned tg = og / nx;
            if (og + 1u == (tg + 1u) * nx) xb_add(&bar[XB_TOPGEN], 1u);
            else XB_SPIN(xb_ld(&bar[XB_TOPGEN]) == tg, bar);
            __builtin_amdgcn_fence(__ATOMIC_ACQUIRE, "agent");
            xb_add(&bar[XB_XGEN(b.x)], 1u);
            asm volatile("s_waitcnt vmcnt(0)" ::: "memory");
        } else {
            XB_SPIN(xb_ld(&bar[XB_XGEN(b.x)]) == gen, bar);
            __builtin_amdgcn_fence(__ATOMIC_ACQUIRE, "agent");
            asm volatile("s_waitcnt vmcnt(0)" ::: "memory");
        }
    }
    __syncthreads();
}

__global__ void __launch_bounds__(NT) fwd_kernel(Params p) {
    extern __shared__ __attribute__((aligned(16))) unsigned char lds[];
    cg::grid_group grid = cg::this_grid();
    const int bid = blockIdx.x, nb = gridDim.x;
    volatile LAS unsigned* bst = (volatile LAS unsigned*)(LAS unsigned char*)(lds + BAR_LDS_OFF);
    if (threadIdx.x < 2) bst[threadIdx.x] = 0u;
    __syncthreads();
    XcdBarrier xb = xcd_barrier_post((unsigned*)(p.ws + WS_CTL) + CW_BAR, bst);
#define GRID_BAR() xcd_barrier(xb)
    if (p.pad != 0) grid.sync();
    phase_convert(p, lds, bid, nb);
    GRID_BAR();
    phase_proj(p, lds, bid, nb);
    GRID_BAR();
    phase_prep(p, lds, bid, nb);
    phase_pool(p, lds, bid, nb);
    GRID_BAR();
    if (bid < 96) { if (threadIdx.x < 64) phase_scan(p, bid); }
    else phase_convert_experts(p, lds, bid - 96, nb - 96);
    GRID_BAR();
    phase_rwkv_out(p, bid, nb);
    GRID_BAR();
    phase_outproj(p, lds, bid, nb);
    GRID_BAR();
    phase_ln_router(p, lds, bid, nb);
    GRID_BAR();
    phase_moe(p, lds, bid, nb);
    GRID_BAR();
    phase_final(p, bid, nb);
}

extern "C" void kernel_launch(void* const* d_in, const int* in_sizes, int n_in, void* d_out, int out_size, void* d_ws, size_t ws_size, hipStream_t stream) {
    static int grid_blocks = 0;
    if (!grid_blocks) {
        if (hipFuncSetAttribute((const void*)fwd_kernel, hipFuncAttributeMaxDynamicSharedMemorySize, LDS_BYTES) != hipSuccess) fprintf(stderr, "hipFuncSetAttribute failed\n");
        int dev = 0, cus = 0, per_cu = 0;
        (void)hipGetDevice(&dev);
        (void)hipDeviceGetAttribute(&cus, hipDeviceAttributeMultiprocessorCount, dev);
        (void)hipOccupancyMaxActiveBlocksPerMultiprocessor(&per_cu, (const void*)fwd_kernel, NT, LDS_BYTES);
        if (per_cu < 1) { fprintf(stderr, "occupancy query says %d blocks/CU\n", per_cu); per_cu = 1; }
        grid_blocks = cus >= 256 ? 256 : cus;
        fprintf(stderr, "grid %d (cus %d, per_cu %d)\n", grid_blocks, cus, per_cu);
    }
    Params p{};
    for (int i = 0; i < 27; ++i) p.in[i] = (const float*)d_in[i];
    p.out = (float*)d_out; p.ws = (unsigned char*)d_ws;
    (void)hipMemsetAsync((char*)d_ws + WS_CTL, 0, 65536, stream);
    void* args[] = {&p};
    hipError_t e = hipLaunchCooperativeKernel((const void*)fwd_kernel, dim3(grid_blocks), dim3(NT), args, LDS_BYTES, stream);
    if (e != hipSuccess) fprintf(stderr, "cooperative launch failed: %s (grid %d)\n", hipGetErrorString(e), grid_blocks);
}
```

```cpp
#include <hip/hip_runtime.h>
#include <hip/hip_cooperative_groups.h>
#include <cstdio>
#include <cstdint>
namespace cg = cooperative_groups;

typedef unsigned short bf16;
typedef short bf16x8 __attribute__((ext_vector_type(8)));
typedef float f32x4 __attribute__((ext_vector_type(4)));
typedef unsigned u32x4 __attribute__((ext_vector_type(4)));
typedef unsigned u32x2 __attribute__((ext_vector_type(2)));
typedef float f32x16 __attribute__((ext_vector_type(16)));
typedef float f32x2 __attribute__((ext_vector_type(2)));
typedef __bf16 bf16x2_t __attribute__((ext_vector_type(2)));

constexpr int DM = 1024, BATCH = 2, SEQ = 8192, NTOK = BATCH * SEQ;
constexpr int D_POOL = 256, D_RWKV = 768, NH = 12, HS = 64;
constexpr int D_IN = 2816;
constexpr int C_R = 256, C_K = 1024, C_V = 1792, C_WD = 2560, C_AD = 2624, C_GD = 2688;
constexpr int NEXP = 32, DE = 256;
constexpr float LN_EPS = 1e-5f, LNX_EPS = 64e-5f;
constexpr float ALPHA = 1.189207115002721f;
constexpr int NT = 512;
constexpr int BAR_LDS_OFF = 163776;
constexpr int CW_BAR = 4096;
constexpr int CST_LDS_OFF = 148480;
constexpr int PREV_LDS_OFF = 151040;
constexpr int LDS_BYTES = 163840;

constexpr size_t MiB = 1u << 20;
constexpr size_t WS_CTL = 0;
constexpr size_t WS_WIN_T = 1 * MiB;
constexpr size_t WS_WOUT_T = 7 * MiB;
constexpr size_t WS_WUPT = 9 * MiB;
constexpr size_t WS_AUPT = 9 * MiB + 128 * 1024;
constexpr size_t WS_GUPT = 9 * MiB + 256 * 1024;
constexpr size_t WS_RTT = 9 * MiB + 512 * 1024;
constexpr size_t WS_PWT = 9 * MiB + 768 * 1024;
constexpr size_t WS_XB = 10 * MiB;
constexpr size_t WS_TC = 10 * MiB;
constexpr size_t WS_MIXIN = 42 * MiB;
constexpr size_t WS_PROJ = 74 * MiB;
constexpr size_t WS_EGU = 74 * MiB;
constexpr size_t WS_EDN = 106 * MiB;
constexpr size_t WS_S0 = 122 * MiB;
constexpr size_t WS_GC = 162 * MiB;
constexpr size_t WS_QC = 186 * MiB;
constexpr size_t WS_OL = 210 * MiB;
constexpr size_t OUT_G1 = 0;
constexpr size_t OUT_G2 = 24 * MiB;
constexpr size_t WS_YS = 122 * MiB;
constexpr size_t WS_HB = 186 * MiB;
constexpr size_t WS_LIST = 218 * MiB;
constexpr size_t WS_LWT = 220 * MiB;
constexpr size_t WS_HID = 222 * MiB;

struct Params {
    const float* in[27];
    float* out;
    unsigned char* ws;
    int phase;
    int pad;
};

#define LAS __attribute__((address_space(3)))
__device__ __forceinline__ unsigned f2bf(float f) { unsigned u = __builtin_bit_cast(unsigned, f); return (u + 0x7fffu + ((u >> 16) & 1u)) >> 16; }
__device__ __forceinline__ unsigned pk2(float lo, float hi) { f32x2 v = {lo, hi}; bf16x2_t b = __builtin_convertvector(v, bf16x2_t); return __builtin_bit_cast(unsigned, b); }
__device__ __forceinline__ float bf2f(unsigned short b) { return __builtin_bit_cast(float, (unsigned)b << 16); }
__device__ __forceinline__ float bflo(unsigned u) { return __builtin_bit_cast(float, u << 16); }
__device__ __forceinline__ float bfhi(unsigned u) { return __builtin_bit_cast(float, u & 0xffff0000u); }
template <int CTRL> __device__ __forceinline__ float dppmov(float v) { return __builtin_bit_cast(float, __builtin_amdgcn_update_dpp(0, __builtin_bit_cast(int, v), CTRL, 0xf, 0xf, true)); }
__device__ __forceinline__ float wave_sum(float v) {
    v += dppmov<0xB1>(v);
    v += dppmov<0x4E>(v);
    v += dppmov<0x141>(v);
    v += dppmov<0x140>(v);
    const float s0 = __builtin_bit_cast(float, __builtin_amdgcn_readlane(__builtin_bit_cast(int, v), 0));
    const float s1 = __builtin_bit_cast(float, __builtin_amdgcn_readlane(__builtin_bit_cast(int, v), 16));
    const float s2 = __builtin_bit_cast(float, __builtin_amdgcn_readlane(__builtin_bit_cast(int, v), 32));
    const float s3 = __builtin_bit_cast(float, __builtin_amdgcn_readlane(__builtin_bit_cast(int, v), 48));
    return (s0 + s1) + (s2 + s3);
}
__device__ __forceinline__ int opaque_tid() { int t = threadIdx.x; asm volatile("" : "+v"(t)); return t; }
__device__ __forceinline__ float sigmoidf_(float x) { return 1.f / (1.f + __expf(-x)); }

template <class Epi>
__device__ __forceinline__ void gemm_unit(unsigned char* lds, const bf16* __restrict__ abase, const unsigned (&arow)[4], const bf16* __restrict__ bbase, const unsigned (&brow)[4], int K, Epi& epi) {
    const int tid = opaque_tid(), lane = tid & 63, w = tid >> 6, wr = w >> 2, wc = w & 3;
    const int srow = tid >> 3, sslot = tid & 7;
    const int st_off = srow * 128 + ((sslot ^ ((srow >> 1) & 7)) << 4);
    const int fr = lane & 15, fq = lane >> 4, x = fr >> 1;
    int offA[2], offB[2];
#pragma unroll
    for (int s = 0; s < 2; ++s) {
        const int slot = (s * 4 + fq) ^ x;
        offA[s] = (wr * 128 + fr) * 128 + (slot << 4);
        offB[s] = 32768 + (wc * 64 + fr) * 128 + (slot << 4);
    }
    f32x4 acc[8][4];
#pragma unroll
    for (int m = 0; m < 8; ++m)
#pragma unroll
        for (int n = 0; n < 4; ++n) acc[m][n] = (f32x4){0.f, 0.f, 0.f, 0.f};
    u32x4 ra[4], rb[4];
#pragma unroll
    for (int i = 0; i < 4; ++i) { ra[i] = *(const u32x4*)(abase + arow[i]); rb[i] = *(const u32x4*)(bbase + brow[i]); }
    __syncthreads();
#pragma unroll
    for (int i = 0; i < 4; ++i) { *(u32x4*)(lds + st_off + i * 8192) = ra[i]; *(u32x4*)(lds + 32768 + st_off + i * 8192) = rb[i]; }
    __syncthreads();
    const int KT = K >> 6;
    for (int kt = 0; kt < KT; ++kt) {
        unsigned char* cur = lds + (kt & 1) * 65536;
        unsigned char* nxt = lds + ((kt + 1) & 1) * 65536;
        if (kt + 1 < KT) {
#pragma unroll
            for (int i = 0; i < 4; ++i) { ra[i] = *(const u32x4*)(abase + arow[i] + (kt + 1) * 64); rb[i] = *(const u32x4*)(bbase + brow[i] + (kt + 1) * 64); }
        }
#pragma unroll
        for (int s = 0; s < 2; ++s) {
            bf16x8 bfr[4];
#pragma unroll
            for (int n = 0; n < 4; ++n) bfr[n] = *(const bf16x8*)(cur + offB[s] + n * 2048);
#pragma unroll
            for (int m = 0; m < 8; ++m) {
                const bf16x8 afr = *(const bf16x8*)(cur + offA[s] + m * 2048);
#pragma unroll
                for (int n = 0; n < 4; ++n) acc[m][n] = __builtin_amdgcn_mfma_f32_16x16x32_bf16(bfr[n], afr, acc[m][n], 0, 0, 0);
            }
        }
        if (kt + 1 < KT) {
#pragma unroll
            for (int i = 0; i < 4; ++i) { *(u32x4*)(nxt + st_off + i * 8192) = ra[i]; *(u32x4*)(nxt + 32768 + st_off + i * 8192) = rb[i]; }
        }
        __syncthreads();
    }
    epi(acc, wr, wc, fr, fq);
}

namespace pg8 {
#define PG8_LAS __attribute__((address_space(3)))
typedef unsigned short bf16_t;
typedef short bf16x8 __attribute__((ext_vector_type(8)));
typedef float f32x4 __attribute__((ext_vector_type(4)));
typedef unsigned u32x4 __attribute__((ext_vector_type(4)));
constexpr int BM = 256, BK = 64, HALF = 128, HTB = HALF * BK * 2  , STAGE_BYTES = 8 * HTB, NXCD = 8, WGM = 8;

__host__ __device__ __forceinline__ int lds_byte(int r, int c) { const int st = (r >> 4) * 2 + (c >> 5), rr = r & 15, cc = c & 31, ob = rr * 64 + cc * 2; return st * 1024 + (ob ^ (((ob >> 9) & 1) << 5)); }
__host__ __device__ __forceinline__ void stage_rc(int b, int& R, int& C) { const int st = b / 1024, sb = b % 1024, swz = sb ^ (((sb >> 9) & 1) << 5); R = (st >> 1) * 16 + swz / 64; C = (st & 1) * 32 + (swz % 64) / 2; }
__host__ __device__ __forceinline__ int perm32(int rho) { const int n = rho >> 4, i = rho & 15; return 8 * (i >> 2) + 4 * n + (i & 3); }

struct Unit { int pm, pn; };
struct Gemm { const bf16_t* A; const bf16_t* Bt; int M, N, K; };

struct StaticOrder {
    int nM, nN, nwg, G, c;
    __host__ __device__ void init(int M, int N, int G_, int c_) { nM = M / BM; nN = N / BM; nwg = nM * nN; G = G_; c = c_; }
    __host__ __device__ bool next(int i, Unit& u) const {
        const long L = (long)i * G + c; if (L >= nwg) return false;
        int wgid = (int)L; { const int q = nwg / NXCD, r = nwg % NXCD, xcd = wgid % NXCD, off = wgid / NXCD; wgid = (xcd < r ? xcd * (q + 1) : r * (q + 1) + (xcd - r) * q) + off; }
        const int nig = WGM * nN, gid = wgid / nig, fm = gid * WGM, gsz = (nM - fm) < WGM ? (nM - fm) : WGM;
        u.pm = fm + ((wgid % nig) % gsz); u.pn = (wgid % nig) / gsz; return true;
    }
    __device__ __forceinline__ void a_ready(const Unit&) const {}
    __device__ __forceinline__ void done(const Unit&) const {}
};

__device__ __forceinline__ unsigned cvt_pk_bf16(float lo, float hi) { unsigned r; asm volatile("v_cvt_pk_bf16_f32 %0, %1, %2" : "=v"(r) : "v"(lo), "v"(hi)); return r; }
struct EpiProjBf16 {
    static constexpr bool PERM = true, AFTER_DRAIN = false;
    bf16_t* O; int ldc;
    __device__ __forceinline__ void operator()(const f32x4 (&acc)[2][2][4][2], const Unit& u, int wr, int wc, int fr, int fq) const {
        const int row0 = u.pm * BM + wr * 64 + fr; const int col0 = u.pn * BM + wc * 32 + 8 * fq;
#pragma unroll
        for (int ai = 0; ai < 2; ++ai)
#pragma unroll
            for (int m = 0; m < 4; ++m) { bf16_t* rowp = O + (size_t)(row0 + ai * HALF + m * 16) * ldc + col0;
#pragma unroll
                for (int bj = 0; bj < 2; ++bj) { const f32x4 v0 = acc[ai][bj][m][0], v1 = acc[ai][bj][m][1];
                    u32x4 w; w.x = cvt_pk_bf16(v0[0], v0[1]); w.y = cvt_pk_bf16(v0[2], v0[3]); w.z = cvt_pk_bf16(v1[0], v1[1]); w.w = cvt_pk_bf16(v1[2], v1[3]);
                    *(u32x4*)(rowp + bj * HALF) = w; } }
    }
};
struct EpiResF32 {
    static constexpr bool PERM = false, AFTER_DRAIN = false;
    const float* X; float* C; int ldc; float alpha;
    __device__ __forceinline__ void operator()(const f32x4 (&acc)[2][2][4][2], const Unit& u, int wr, int wc, int fr, int fq) const {
        const int row0 = u.pm * BM + wr * 64 + fr, col0 = u.pn * BM + wc * 32 + 4 * fq;
#pragma unroll
        for (int ai = 0; ai < 2; ++ai)
#pragma unroll
            for (int m = 0; m < 4; ++m) { const size_t off = (size_t)(row0 + ai * HALF + m * 16) * ldc + col0;
#pragma unroll
                for (int bj = 0; bj < 2; ++bj)
#pragma unroll
                    for (int n = 0; n < 2; ++n) { const f32x4 xv = *(const f32x4*)(X + off + bj * HALF + n * 16); *(f32x4*)(C + off + bj * HALF + n * 16) = xv * alpha + acc[ai][bj][m][n]; } }
    }
};
template <class Epi, class Sched>
__device__ __forceinline__ void gemm_phase(PG8_LAS unsigned char* lds, const Gemm g, const Sched& S, const Epi& E) {
    const int tid = opaque_tid(), wid = __builtin_amdgcn_readfirstlane(tid >> 6), lane = tid & 63, wr = wid >> 2, wc = wid & 3, fr = lane & 15, fq = lane >> 4;
    const int K = g.K, nt = K / BK;
    unsigned voffA[2], voffB[2];
#pragma unroll
    for (int i = 0; i < 2; ++i) { int R, C; stage_rc(tid * 16 + i * 8192, R, C); const int Rb = Epi::PERM ? ((R & ~31) + perm32(R & 31)) : R;
        voffA[i] = (unsigned)(R * K + C) * 2u; voffB[i] = (unsigned)(Rb * K + C) * 2u; }
    const size_t kstep = (size_t)(BK * 2);
    const size_t hstep = (size_t)HALF * K * 2;
    const size_t tstep = 2 * hstep;
    const unsigned ldsw = (unsigned)wid * 1024u;
    const int aoff = lds_byte(wr * 64 + fr, fq * 8), boff = lds_byte(wc * 32 + fr, fq * 8);
#define PG8_SA(b, h) (((b) * 2 + (h)) * HTB)
#define PG8_SB(b, h) ((4 + (b) * 2 + (h)) * HTB)
#define PG8_STAGE(bufoff, gbase, voff) do { _Pragma("unroll") for (int _i = 0; _i < 2; ++_i) \
        __builtin_amdgcn_global_load_lds((const unsigned*)((const char*)(gbase) + (voff)[_i]), (PG8_LAS unsigned*)(lds + (bufoff) + ldsw + _i * 8192), 16, 0, 0); } while (0)
#define PG8_LDA(dst, b, h) do { _Pragma("unroll") for (int m = 0; m < 4; ++m) _Pragma("unroll") for (int k = 0; k < 2; ++k) dst[m][k] = *(const PG8_LAS bf16x8*)(lds + PG8_SA(b, h) + aoff + m * 2048 + k * 1024); } while (0)
#define PG8_LDB(dst, b, h) do { _Pragma("unroll") for (int n = 0; n < 2; ++n) _Pragma("unroll") for (int k = 0; k < 2; ++k) dst[n][k] = *(const PG8_LAS bf16x8*)(lds + PG8_SB(b, h) + boff + n * 2048 + k * 1024); } while (0)
#define PG8_MMA(ai, bj, At, Bt) do { __builtin_amdgcn_s_setprio(1); _Pragma("unroll") for (int m = 0; m < 4; ++m) _Pragma("unroll") for (int n = 0; n < 2; ++n) _Pragma("unroll") for (int k = 0; k < 2; ++k) \
        acc[ai][bj][m][n] = __builtin_amdgcn_mfma_f32_16x16x32_bf16(Bt[n][k], At[m][k], acc[ai][bj][m][n], 0, 0, 0); __builtin_amdgcn_s_setprio(0); } while (0)
#define PG8_WAIT_V(n) asm volatile("s_waitcnt vmcnt(" #n ")" ::: "memory")
#define PG8_WAIT_L(n) asm volatile("s_waitcnt lgkmcnt(" #n ")" ::: "memory")
#define PG8_BAR __builtin_amdgcn_s_barrier()
#define PG8_SCHED __builtin_amdgcn_sched_barrier(0)
    Unit cur, nxt; int ui = 0;
    if (!S.next(0, cur)) return;
    f32x4 acc[2][2][4][2];
#pragma unroll
    for (int a = 0; a < 2; ++a)
#pragma unroll
        for (int b = 0; b < 2; ++b)
#pragma unroll
            for (int m = 0; m < 4; ++m)
#pragma unroll
                for (int n = 0; n < 2; ++n) acc[a][b][m][n] = (f32x4){0.f, 0.f, 0.f, 0.f};
    bf16x8 At[4][2], B0[2][2], B1[2][2];
    const char* cA = (const char*)g.A + (size_t)cur.pm * tstep; const char* cB = (const char*)g.Bt + (size_t)cur.pn * tstep;
    S.a_ready(cur);
    PG8_STAGE(PG8_SB(0, 0), cB, voffB); PG8_STAGE(PG8_SA(0, 0), cA, voffA); PG8_STAGE(PG8_SB(0, 1), cB + hstep, voffB); PG8_STAGE(PG8_SA(0, 1), cA + hstep, voffA);
    if (wr == 1) PG8_BAR;
    PG8_WAIT_V(4); PG8_BAR;
    PG8_STAGE(PG8_SB(1, 0), cB + kstep, voffB); PG8_STAGE(PG8_SA(1, 0), cA + kstep, voffA); PG8_STAGE(PG8_SB(1, 1), cB + hstep + kstep, voffB);
    PG8_WAIT_V(6); PG8_BAR;
    for (;;) {
        const bool has_next = S.next(ui + 1, nxt);
        const char* nA = has_next ? (const char*)g.A + (size_t)nxt.pm * tstep : cA; const char* nB = has_next ? (const char*)g.Bt + (size_t)nxt.pn * tstep : cB;
        for (int t = 0; t < nt; t += 2) {
            const bool last = (t == nt - 2);
            const char* a1 = cA + (size_t)(t + 1) * kstep;
            const char* a2 = last ? nA : cA + (size_t)(t + 2) * kstep; const char* b2 = last ? nB : cB + (size_t)(t + 2) * kstep;
            const char* a3 = a2 + kstep; const char* b3 = b2 + kstep;
            if (last && has_next) S.a_ready(nxt);
            PG8_LDB(B0, 0, 0); PG8_SCHED; PG8_LDA(At, 0, 0); PG8_STAGE(PG8_SA(1, 1), a1 + hstep, voffA);
            PG8_WAIT_L(8); PG8_BAR; PG8_WAIT_L(0); PG8_MMA(0, 0, At, B0); PG8_BAR; PG8_SCHED;
            PG8_LDB(B1, 0, 1); PG8_STAGE(PG8_SB(0, 0), b2, voffB);
            PG8_BAR; PG8_WAIT_L(0); PG8_MMA(0, 1, At, B1); PG8_BAR;
            PG8_LDA(At, 0, 1); PG8_STAGE(PG8_SA(0, 0), a2, voffA);
            PG8_BAR; PG8_WAIT_L(0); PG8_MMA(1, 0, At, B0); PG8_BAR; PG8_SCHED;
            PG8_STAGE(PG8_SB(0, 1), b2 + hstep, voffB);
            PG8_WAIT_V(6); PG8_BAR; PG8_MMA(1, 1, At, B1); PG8_BAR;
            PG8_LDB(B0, 1, 0); PG8_SCHED; PG8_LDA(At, 1, 0); PG8_STAGE(PG8_SA(0, 1), a2 + hstep, voffA);
            PG8_WAIT_L(8); PG8_BAR; PG8_WAIT_L(0); PG8_MMA(0, 0, At, B0); PG8_BAR; PG8_SCHED;
            PG8_LDB(B1, 1, 1); PG8_STAGE(PG8_SB(1, 0), b3, voffB);
            PG8_BAR; PG8_WAIT_L(0); PG8_MMA(0, 1, At, B1); PG8_BAR;
            PG8_LDA(At, 1, 1); PG8_STAGE(PG8_SA(1, 0), a3, voffA);
            PG8_BAR; PG8_WAIT_L(0); PG8_MMA(1, 0, At, B0); PG8_BAR; PG8_SCHED;
            PG8_STAGE(PG8_SB(1, 1), b3 + hstep, voffB);
            PG8_WAIT_V(6); PG8_BAR; PG8_MMA(1, 1, At, B1); PG8_BAR;
        }
            if constexpr (!Epi::AFTER_DRAIN) { E(acc, cur, wr, wc, fr, fq); S.done(cur); }
            if (!has_next) break;
#pragma unroll
        for (int a = 0; a < 2; ++a)
#pragma unroll
            for (int b = 0; b < 2; ++b)
#pragma unroll
                for (int m = 0; m < 4; ++m)
#pragma unroll
                    for (int n = 0; n < 2; ++n) acc[a][b][m][n] = (f32x4){0.f, 0.f, 0.f, 0.f};
        cur = nxt; cA = nA; cB = nB; ++ui;
    }
    PG8_WAIT_V(0);
    if (wr == 0) PG8_BAR;
    PG8_BAR;
    if constexpr (Epi::AFTER_DRAIN) { E.fused(acc, cur, wr, wc, fr, fq, lds, wid, lane); S.done(cur); }
#undef PG8_SA
#undef PG8_SB
#undef PG8_STAGE
#undef PG8_LDA
#undef PG8_LDB
#undef PG8_MMA
#undef PG8_WAIT_V
#undef PG8_WAIT_L
#undef PG8_BAR
#undef PG8_SCHED
}
}

__device__ __forceinline__ int gu_row(int c, int half) { return ((c >> 7) << 8) + (((c >> 5) & 3) << 6) + (half << 5) + (c & 31); }
__device__ __forceinline__ void tr_tile(unsigned char* lds, const float* __restrict__ src, int ldsrc, int k0, int n0, bf16* __restrict__ dst, int ldd, int mode) {
    float* t = (float*)lds;
    const int tid = opaque_tid();
    __syncthreads();
#pragma unroll
    for (int i = 0; i < 8; ++i) { const int e = tid + i * NT, k = e >> 6, n = e & 63; t[k * 65 + n] = src[(size_t)(k0 + k) * ldsrc + n0 + n]; }
    __syncthreads();
    const int n = tid >> 3, kc = tid & 7;
    const float* s = t + (kc * 8) * 65 + n;
    u32x4 o; o.x = pk2(s[0], s[65]); o.y = pk2(s[2 * 65], s[3 * 65]); o.z = pk2(s[4 * 65], s[5 * 65]); o.w = pk2(s[6 * 65], s[7 * 65]);
    const int nn = n0 + n;
    const int drow = mode == 0 ? nn : gu_row(nn, mode - 1);
    *(u32x4*)(dst + (size_t)drow * ldd + k0 + kc * 8) = o;
}

__device__ __forceinline__ void phase_convert(const Params& p, unsigned char* lds, int bid, int nb) {
    const int tid = opaque_tid();
    {
        const float* x = p.in[0]; bf16* xb = (bf16*)(p.ws + WS_XB);
        const size_t n8 = (size_t)NTOK * DM / 8;
        for (size_t i = (size_t)bid * NT + tid; i < n8; i += (size_t)nb * NT) {
            const f32x4 a = *(const f32x4*)(x + i * 8), b = *(const f32x4*)(x + i * 8 + 4);
            u32x4 o; o.x = pk2(a.x, a.y); o.y = pk2(a.z, a.w); o.z = pk2(b.x, b.y); o.w = pk2(b.z, b.w);
            *(u32x4*)(xb + i * 8) = o;
        }
    }
    constexpr int T_WIN = (DM / 64) * (D_IN / 64);
    constexpr int T_WOUT = (DM / 64) * (DM / 64);
    constexpr int T_ALL = T_WIN + T_WOUT + 12 + 12 + 24 + 4;
    for (int it = bid; it < T_ALL; it += nb) {
        int r = it;
        if (r < T_WIN) { const int kb = r / (D_IN / 64), nbk = r % (D_IN / 64); tr_tile(lds, p.in[1], D_IN, kb * 64, nbk * 64, (bf16*)(p.ws + WS_WIN_T), DM, 0); continue; }
        r -= T_WIN;
        if (r < T_WOUT) { const int kb = r / (DM / 64), nbk = r % (DM / 64); tr_tile(lds, p.in[15], DM, kb * 64, nbk * 64, (bf16*)(p.ws + WS_WOUT_T), DM, 0); continue; }
        r -= T_WOUT;
        if (r < 12) { tr_tile(lds, p.in[6], D_RWKV, 0, r * 64, (bf16*)(p.ws + WS_WUPT), 64, 0); continue; }
        r -= 12;
        if (r < 12) { tr_tile(lds, p.in[8], D_RWKV, 0, r * 64, (bf16*)(p.ws + WS_AUPT), 64, 0); continue; }
        r -= 12;
        if (r < 24) { tr_tile(lds, p.in[9], D_RWKV, (r / 12) * 64, (r % 12) * 64, (bf16*)(p.ws + WS_GUPT), 128, 0); continue; }
        r -= 24;
        { tr_tile(lds, p.in[2] + r * 4096, 64, 0, 0, (bf16*)(p.ws + WS_PWT) + r * 4096, 64, 0); }
    }
    {
        float* rtt = (float*)(p.ws + WS_RTT); const float* rg = p.in[18]; const float* re = p.in[20];
        for (int e = bid * NT + tid; e < 36 * 1024; e += nb * NT) { const int j = e >> 10, k = e & 1023; rtt[e] = j < 4 ? rg[k * 4 + j] : re[k * 32 + (j - 4)]; }
    }
}
__device__ __forceinline__ void phase_convert_experts(const Params& p, unsigned char* lds, int bid, int nb) {
    constexpr int T_EG = NEXP * (DM / 64) * (DE / 64);
    constexpr int T_ED = NEXP * (DE / 64) * (DM / 64);
    constexpr int T_ALL = 2 * T_EG + T_ED;
    for (int it = bid; it < T_ALL; it += nb) {
        int r = it;
        if (r < 2 * T_EG) {
            const int half = r / T_EG; r -= half * T_EG;
            const int e = r / 64, q = r % 64, kb = q / 4, nbk = q % 4;
            tr_tile(lds, p.in[22 + half] + (size_t)e * DM * DE, DE, kb * 64, nbk * 64, (bf16*)(p.ws + WS_EGU) + (size_t)e * 512 * DM, DM, 1 + half); continue;
        }
        r -= 2 * T_EG;
        { const int e = r / 64, q = r % 64, kb = q / 16, nbk = q % 16;
          tr_tile(lds, p.in[24] + (size_t)e * DE * DM, DM, kb * 64, nbk * 64, (bf16*)(p.ws + WS_EDN) + (size_t)e * DM * DE, DE, 0); }
    }
}

struct EpiProj {
    bf16* O; int row0, col0;
    __device__ __forceinline__ void operator()(const f32x4 (&acc)[8][4], int wr, int wc, int fr, int fq) const {
#pragma unroll
        for (int m = 0; m < 8; ++m) {
            bf16* rp = O + (size_t)(row0 + wr * 128 + m * 16 + fr) * D_IN + col0 + wc * 64 + fq * 4;
#pragma unroll
            for (int n = 0; n < 4; ++n) { u32x2 v; v.x = pk2(acc[m][n][0], acc[m][n][1]); v.y = pk2(acc[m][n][2], acc[m][n][3]); *(u32x2*)(rp + n * 16) = v; }
        }
    }
};
__device__ __forceinline__ void phase_proj(const Params& p, unsigned char* lds, int bid, int nb) {
    pg8::Gemm g{(const pg8::bf16_t*)(p.ws + WS_XB), (const pg8::bf16_t*)(p.ws + WS_WIN_T), NTOK, D_IN, DM};
    pg8::StaticOrder S; S.init(NTOK, D_IN, nb, bid);
    pg8::EpiProjBf16 E{(pg8::bf16_t*)(p.ws + WS_PROJ), D_IN};
    pg8::gemm_phase<pg8::EpiProjBf16, pg8::StaticOrder>((PG8_LAS unsigned char*)lds, g, S, E);
}

__device__ __forceinline__ int sw_off(int row, int col) { return row * 128 + ((((col >> 3) ^ ((row >> 1) & 7)) << 4) | ((col & 7) << 1)); }
__device__ __forceinline__ void phase_pool(const Params& p, unsigned char* lds, int bid, int nb) {
    const int tid = opaque_tid(), lane = tid & 63, w = __builtin_amdgcn_readfirstlane(tid >> 6);
    const bf16* proj = (const bf16*)(p.ws + WS_PROJ);
    bf16* mix = (bf16*)(p.ws + WS_MIXIN);
    const bf16* pwT = (const bf16*)(p.ws + WS_PWT); const float* ps = p.in[3];
    float* pbuf = (float*)lds;
    unsigned char* dslot = lds + 81920;
    for (int it = bid; it < NTOK / 64; it += nb) {
        const int tok0 = it * 64, t0 = tok0 % SEQ;
        __syncthreads();
#pragma unroll 2
        for (int e = tid; e < 79 * 64; e += NT) {
            const int r = e >> 6, c4 = e & 63; const int tt = t0 - 15 + r;
            float4 v = {0.f, 0.f, 0.f, 0.f};
            if (tt >= 0) { const u32x2 q = *(const u32x2*)(proj + (size_t)(tok0 - 15 + r) * D_IN + c4 * 4); v.x = bflo(q.x); v.y = bfhi(q.x); v.z = bflo(q.y); v.w = bfhi(q.y); }
            *(float4*)(pbuf + r * 256 + c4 * 4) = v;
        }
        __syncthreads();
#pragma unroll 2
        for (int e = tid; e < 64 * 64; e += NT) {
            const int t = e >> 6, c = (e & 63) * 4, g = c >> 6, win = 2 << g;
            const int cnt = min(t0 + t + 1, win);
            f32x4 sm = {0.f, 0.f, 0.f, 0.f};
            for (int j = 0; j < cnt; ++j) sm += *(const f32x4*)(pbuf + (t + 15 - j) * 256 + c);
            const f32x4 d = sm * (1.f / (float)cnt) - *(const f32x4*)(pbuf + (t + 15) * 256 + c);
            u32x2 o; o.x = pk2(d.x, d.y); o.y = pk2(d.z, d.w);
            *(u32x2*)(dslot + g * 8192 + sw_off(t, c & 63)) = o;
        }
        __syncthreads();
        {
            const int g = w >> 1, nt = w & 1, ln = lane & 31, hh = lane >> 5, t = nt * 32 + ln;
            f32x16 acc[2];
#pragma unroll
            for (int mt = 0; mt < 2; ++mt) for (int r = 0; r < 16; ++r) acc[mt][r] = 0.f;
#pragma unroll
            for (int s_ = 0; s_ < 4; ++s_) {
                const bf16x8 bd = *(const bf16x8*)(dslot + g * 8192 + sw_off(t, 16 * s_ + 8 * hh));
#pragma unroll
                for (int mt = 0; mt < 2; ++mt) {
                    const bf16x8 aw = *(const bf16x8*)(pwT + g * 4096 + (mt * 32 + ln) * 64 + 16 * s_ + 8 * hh);
                    acc[mt] = __builtin_amdgcn_mfma_f32_32x32x16_bf16(aw, bd, acc[mt], 0, 0, 0);
                }
            }
#pragma unroll
            for (int mt = 0; mt < 2; ++mt)
#pragma unroll
                for (int gg = 0; gg < 4; ++gg) {
                    const int d0 = mt * 32 + 8 * gg + 4 * hh;
                    const f32x4 sc = *(const f32x4*)(ps + g * 64 + d0);
                    u32x2 o; o.x = pk2(acc[mt][4 * gg] * sc.x, acc[mt][4 * gg + 1] * sc.y); o.y = pk2(acc[mt][4 * gg + 2] * sc.z, acc[mt][4 * gg + 3] * sc.w);
                    *(u32x2*)(mix + (size_t)(tok0 + t) * DM + g * 64 + d0) = o;
                }
        }
    }
}

constexpr int SLOTB = 8192;
#define MFMA32(a, b, c) __builtin_amdgcn_mfma_f32_32x32x16_bf16((a), (b), (c), 0, 0, 0)
#define MFMA16(a, b, c) __builtin_amdgcn_mfma_f32_16x16x32_bf16((a), (b), (c), 0, 0, 0)
__device__ __forceinline__ f32x16 mm32(const unsigned char* X, const int (&ox)[4], const unsigned char* Y, const int (&oy)[4], f32x16 acc) {
#pragma unroll
    for (int s = 0; s < 4; ++s) {
        const bf16x8 a = *(const bf16x8*)(X + ox[s]);
        const bf16x8 b = *(const bf16x8*)(Y + oy[s]);
        acc = MFMA32(a, b, acc);
    }
    return acc;
}
template <class F>
__device__ __forceinline__ void store_T(unsigned char* Z, const f32x16& d, int mt, int nt, int lane, const int (&ost)[4], F f) {
    const int n = nt * 32 + (lane & 31), h = lane >> 5;
#pragma unroll
    for (int g = 0; g < 4; ++g) {
        const int m0 = mt * 32 + 8 * g + 4 * h;
        u32x2 v; v.x = pk2(f(d[4 * g], m0, n), f(d[4 * g + 1], m0 + 1, n)); v.y = pk2(f(d[4 * g + 2], m0 + 2, n), f(d[4 * g + 3], m0 + 3, n));
        *(u32x2*)(Z + ost[g]) = v;
    }
}
__device__ __forceinline__ f32x16 zero16() { f32x16 z; for (int i = 0; i < 16; ++i) z[i] = 0.f; return z; }
__device__ __forceinline__ void st_b16(unsigned char* Z, int row, int col, float v) { *(unsigned short*)(Z + sw_off(row, col)) = (unsigned short)pk2(v, 0.f); }

__device__ __forceinline__ void phase_prep(const Params& p, unsigned char* lds, int bid, int nb) {
    const int tid = opaque_tid();
    const bf16* proj = (const bf16*)(p.ws + WS_PROJ);
    const float* mu = p.in[4]; const float* w0 = p.in[5]; const float* a0 = p.in[7];
    const float* k_k = p.in[10]; const float* k_a = p.in[11]; const float* r_k = p.in[12];
    const float* lnx_g = p.in[13]; const float* lnx_b = p.in[14];
    const bf16* wupT = (const bf16*)(p.ws + WS_WUPT); const bf16* aupT = (const bf16*)(p.ws + WS_AUPT); const bf16* gupT = (const bf16*)(p.ws + WS_GUPT);
    bf16* TC = (bf16*)(p.ws + WS_TC); bf16* GC = (bf16*)(p.ws + WS_GC); bf16* QC = (bf16*)(p.ws + WS_QC); bf16* OL = (bf16*)(p.ws + WS_OL);
    bf16* G1 = (bf16*)((unsigned char*)p.out + OUT_G1); bf16* G2 = (bf16*)((unsigned char*)p.out + OUT_G2);
#define SL(i) (lds + (i) * SLOTB)
    float* PC = (float*)(lds + 18 * SLOTB);
    float* CST = (float*)(lds + CST_LDS_OFF);
    unsigned char* PREV = lds + PREV_LDS_OFF;
    float* NSB = (float*)(lds + PREV_LDS_OFF + 384);
    u32x4 pf[8];
    const int prow = tid >> 3, pchunk = tid & 7;
    const int pst = prow * 128 + ((pchunk ^ ((prow >> 1) & 7)) << 4);
    const unsigned pgo = (unsigned)(prow * (D_IN * 2) + pchunk * 16), pgg = (unsigned)(prow * 256 + pchunk * 16);
#define PREP_PREFETCH(hn, tok0_, has_prev) do { \
        const unsigned char* pb_ = (const unsigned char*)(proj + (size_t)(tok0_) * D_IN + C_R + (hn) * 64); \
        pf[0] = *(const u32x4*)(pb_ + pgo); pf[1] = *(const u32x4*)(pb_ + 2 * D_RWKV + pgo); pf[2] = *(const u32x4*)(pb_ + 4 * D_RWKV + pgo); \
        int tl_ = tid; asm volatile("" : "+v"(tl_)); \
        pf[3] = ((const u32x4*)(wupT + (hn) * 4096))[tl_]; \
        pf[4] = ((const u32x4*)(aupT + (hn) * 4096))[tl_]; \
        const unsigned char* gb_ = (const unsigned char*)(gupT + (hn) * 8192); \
        pf[5] = *(const u32x4*)(gb_ + pgg); pf[6] = *(const u32x4*)(gb_ + 128 + pgg); \
        pf[7] = (u32x4){0u, 0u, 0u, 0u}; \
        if (tid < 160) { const int arr_ = tl_ >> 4, c4_ = (tl_ & 15) * 4; \
            const float* src_ = arr_ < 3 ? mu + arr_ * D_RWKV : (arr_ == 3 ? w0 : (arr_ == 4 ? a0 : (arr_ == 5 ? k_k : (arr_ == 6 ? k_a : (arr_ == 7 ? r_k : (arr_ == 8 ? lnx_g : lnx_b)))))); \
            pf[7] = *(const u32x4*)(src_ + (hn) * 64 + c4_); } \
        else if (tid < 184 && (has_prev)) { const int x_ = (tl_ - 160) >> 3, ch_ = (tl_ - 160) & 7; \
            pf[7] = *(const u32x4*)(pb_ - 2 * D_IN + x_ * 2 * D_RWKV + ch_ * 16); } \
    } while (0)
#define PREP_STAGE() do { \
        *(u32x4*)(SL(6) + pst) = pf[0]; *(u32x4*)(SL(7) + pst) = pf[1]; *(u32x4*)(SL(8) + pst) = pf[2]; \
        *(u32x4*)(SL(9) + pst) = pf[3]; *(u32x4*)(SL(10) + pst) = pf[4]; *(u32x4*)(SL(11) + pst) = pf[5]; *(u32x4*)(SL(12) + pst) = pf[6]; \
        if (tid < 160) *(u32x4*)((unsigned char*)CST + tid * 16) = pf[7]; \
        else if (tid < 184) *(u32x4*)(PREV + (tid - 160) * 16) = pf[7]; \
    } while (0)
    for (int it = bid; it < BATCH * (SEQ / 64); it += nb) {
        const int b = it / (SEQ / 64), c = it % (SEQ / 64), tok0 = b * SEQ + c * 64;
        PREP_PREFETCH(0, tok0, c > 0);
        __syncthreads();
#pragma unroll
        for (int e = tid; e < 64 * 32; e += NT) {
            const int tt = e >> 5, k8 = (e & 31) * 8;
            const bf16* cur = proj + (size_t)(tok0 + tt) * D_IN + C_WD + k8;
            const u32x4 cv = *(const u32x4*)cur;
            u32x4 pv = {0u, 0u, 0u, 0u};
            if (c * 64 + tt > 0) pv = *(const u32x4*)(cur - D_IN);
            const f32x4 m0 = *(const f32x4*)(mu + C_WD - D_POOL + k8), m1 = *(const f32x4*)(mu + C_WD - D_POOL + k8 + 4);
            float z[8];
            z[0] = bflo(cv.x) + (bflo(pv.x) - bflo(cv.x)) * m0.x; z[1] = bfhi(cv.x) + (bfhi(pv.x) - bfhi(cv.x)) * m0.y;
            z[2] = bflo(cv.y) + (bflo(pv.y) - bflo(cv.y)) * m0.z; z[3] = bfhi(cv.y) + (bfhi(pv.y) - bfhi(cv.y)) * m0.w;
            z[4] = bflo(cv.z) + (bflo(pv.z) - bflo(cv.z)) * m1.x; z[5] = bfhi(cv.z) + (bfhi(pv.z) - bfhi(cv.z)) * m1.y;
            z[6] = bflo(cv.w) + (bflo(pv.w) - bflo(cv.w)) * m1.z; z[7] = bfhi(cv.w) + (bfhi(pv.w) - bfhi(cv.w)) * m1.w;
            if (k8 < 64) { for (int j = 0; j < 8; ++j) z[j] = 1.f - 2.f / (1.f + __expf(2.f * z[j])); }
            else if (k8 >= 128) { for (int j = 0; j < 8; ++j) z[j] = sigmoidf_(z[j]); }
            u32x4 o; o.x = pk2(z[0], z[1]); o.y = pk2(z[2], z[3]); o.z = pk2(z[4], z[5]); o.w = pk2(z[6], z[7]);
            *(u32x4*)(SL(k8 >> 6) + sw_off(tt, k8 & 63)) = o;
        }
#pragma unroll 1
        for (int h = 0; h < NH; ++h) {
            const size_t item = ((size_t)(b * (SEQ / 64) + c)) * NH + h;
            int tid_ = tid; asm volatile("" : "+v"(tid_));
            const int lane = tid_ & 63, w = __builtin_amdgcn_readfirstlane(tid_ >> 6);
            const int ts = w & 3, tl = lane & 15, q = lane >> 4, t = ts * 16 + tl;
            const int tmt = (w >> 1) & 1, tnt = w & 1, hh = lane >> 5;
            int offT[4], offL[2], offM[2];
        #pragma unroll
            for (int r = 0; r < 4; ++r) { offT[r] = sw_off(4 * q + r, t); }
        #pragma unroll
            for (int ks = 0; ks < 2; ++ks) { offL[ks] = sw_off(t, 32 * ks + 8 * q); offM[ks] = sw_off(tl, 32 * ks + 8 * q); }
            int oxm[4], oyn[4], ost[4];
        #pragma unroll
            for (int s_ = 0; s_ < 4; ++s_) { oxm[s_] = sw_off(tmt * 32 + (lane & 31), 16 * s_ + 8 * hh); oyn[s_] = sw_off(tnt * 32 + (lane & 31), 16 * s_ + 8 * hh); ost[s_] = sw_off(tnt * 32 + (lane & 31), tmt * 32 + 8 * s_ + 4 * hh); }
            __syncthreads();
            PREP_STAGE();
            if (h + 1 < NH) PREP_PREFETCH(h + 1, tok0, c > 0);
            __syncthreads();
            {
                const int cg = w >> 2;
                float lw[8], kap[8], bv[8], kn[8], rm[8], vm[8];
                float nsq = 0.f, bon = 0.f;
                {
                    f32x4 accw[2], acca[2];
#pragma unroll
                    for (int mi = 0; mi < 2; ++mi) { accw[mi] = (f32x4){0.f, 0.f, 0.f, 0.f}; acca[mi] = accw[mi]; }
#pragma unroll
                    for (int ks = 0; ks < 2; ++ks) {
                        const bf16x8 bw = *(const bf16x8*)(SL(0) + offL[ks]);
                        const bf16x8 ba = *(const bf16x8*)(SL(1) + offL[ks]);
#pragma unroll
                        for (int mi = 0; mi < 2; ++mi) {
                            const int m = 2 * cg + mi;
                            const bf16x8 aw = *(const bf16x8*)(SL(9) + offM[ks] + m * 2048);
                            const bf16x8 aa = *(const bf16x8*)(SL(10) + offM[ks] + m * 2048);
                            accw[mi] = MFMA16(aw, bw, accw[mi]); acca[mi] = MFMA16(aa, ba, acca[mi]);
                        }
                    }
                    const bool hp = (c * 64 + t) > 0;
#pragma unroll
                    for (int mi = 0; mi < 2; ++mi) {
                        const int m = 2 * cg + mi;
                        const int ch0 = m * 16 + 4 * q;
                        const int oR = sw_off(t, ch0), oRp = sw_off((t + 63) & 63, ch0);
                        float zz[3][4];
#pragma unroll
                        for (int x = 0; x < 3; ++x) {
                            const u32x2 cv = *(const u32x2*)(SL(6 + x) + oR);
                            u32x2 pv = *(const u32x2*)(t > 0 ? SL(6 + x) + oRp : PREV + x * 128 + ch0 * 2);
                            if (!hp) pv = (u32x2){0u, 0u};
                            const f32x4 mm = *(const f32x4*)(CST + x * 64 + ch0);
                            zz[x][0] = bflo(cv.x) + (bflo(pv.x) - bflo(cv.x)) * mm.x; zz[x][1] = bfhi(cv.x) + (bfhi(pv.x) - bfhi(cv.x)) * mm.y;
                            zz[x][2] = bflo(cv.y) + (bflo(pv.y) - bflo(cv.y)) * mm.z; zz[x][3] = bfhi(cv.y) + (bfhi(pv.y) - bfhi(cv.y)) * mm.w;
                        }
                        const f32x4 w0v = *(const f32x4*)(CST + 3 * 64 + ch0), a0v = *(const f32x4*)(CST + 4 * 64 + ch0), kkv = *(const f32x4*)(CST + 5 * 64 + ch0), kav = *(const f32x4*)(CST + 6 * 64 + ch0), rkv = *(const f32x4*)(CST + 7 * 64 + ch0);
#pragma unroll
                        for (int r = 0; r < 4; ++r) {
                            const int e = mi * 4 + r;
                            const float xx = w0v[r] + accw[mi][r];
                            const float sp = (-xx > 20.f) ? -xx : __logf(1.f + __expf(-xx));
                            lw[e] = -__expf(-sp - 0.5f);
                            const float av = sigmoidf_(a0v[r] + acca[mi][r]);
                            rm[e] = zz[0][r]; vm[e] = zz[2][r];
                            kap[e] = zz[1][r] * kkv[r]; nsq += kap[e] * kap[e];
                            kn[e] = zz[1][r] * (1.f + (av - 1.f) * kav[r]);
                            bon += rm[e] * kn[e] * rkv[r];
                            bv[e] = av;
                        }
                    }
                }
                nsq += __shfl_xor(nsq, 16); nsq += __shfl_xor(nsq, 32);
                bon += __shfl_xor(bon, 16); bon += __shfl_xor(bon, 32);
                if (q == 0) { NSB[cg * 64 + t] = nsq; NSB[128 + cg * 64 + t] = bon; }
                __syncthreads();
                nsq = NSB[t] + NSB[64 + t]; bon = NSB[128 + t] + NSB[192 + t];
                const float inv = 1.f / fmaxf(sqrtf(nsq), 1e-12f);
#pragma unroll
                for (int mi = 0; mi < 2; ++mi) {
                    const int m = 2 * cg + mi;
#pragma unroll
                    for (int r = 0; r < 4; ++r) {
                        const int e = mi * 4 + r;
                        kap[e] *= inv; bv[e] *= kap[e];
                        const unsigned hi = pk2(lw[e], 0.f) & 0xffffu; const float hif = __builtin_bit_cast(float, hi << 16);
                        *(unsigned short*)(SL(4) + offT[r] + m * 2048) = (unsigned short)hi;
                        *(unsigned short*)(SL(5) + offT[r] + m * 2048) = (unsigned short)pk2(lw[e] - hif, 0.f);
                        *(unsigned short*)(SL(13) + offT[r] + m * 2048) = (unsigned short)pk2(vm[e], 0.f);
                    }
                }
                {
                    f32x4 accg[2];
#pragma unroll
                    for (int mi = 0; mi < 2; ++mi) accg[mi] = (f32x4){0.f, 0.f, 0.f, 0.f};
#pragma unroll
                    for (int ks = 0; ks < 4; ++ks) {
                        const bf16x8 bg = *(const bf16x8*)(SL(2 + (ks >> 1)) + offL[ks & 1]);
#pragma unroll
                        for (int mi = 0; mi < 2; ++mi) {
                            const bf16x8 ag = *(const bf16x8*)(SL(11 + (ks >> 1)) + offM[ks & 1] + (2 * cg + mi) * 2048);
                            accg[mi] = MFMA16(ag, bg, accg[mi]);
                        }
                    }
#pragma unroll
                    for (int mi = 0; mi < 2; ++mi) {
                        const int ch0 = (2 * cg + mi) * 16 + 4 * q;
                        const f32x4 lg = *(const f32x4*)(CST + 8 * 64 + ch0), lb = *(const f32x4*)(CST + 9 * 64 + ch0);
                        u32x2 v1, v2;
                        v1.x = pk2(lg[0] * accg[mi][0], lg[1] * accg[mi][1]); v1.y = pk2(lg[2] * accg[mi][2], lg[3] * accg[mi][3]);
                        v2.x = pk2((lb[0] + bon * vm[mi * 4]) * accg[mi][0], (lb[1] + bon * vm[mi * 4 + 1]) * accg[mi][1]);
                        v2.y = pk2((lb[2] + bon * vm[mi * 4 + 2]) * accg[mi][2], (lb[3] + bon * vm[mi * 4 + 3]) * accg[mi][3]);
                        *(u32x2*)(G1 + item * 4096 + t * 64 + ch0) = v1;
                        *(u32x2*)(G2 + item * 4096 + t * 64 + ch0) = v2;
                    }
                }
                __syncthreads();
                f32x4 La[2], Ta[2];
#pragma unroll
                for (int mi = 0; mi < 2; ++mi) { La[mi] = (f32x4){0.f, 0.f, 0.f, 0.f}; Ta[mi] = La[mi]; }
#pragma unroll
                for (int ks = 0; ks < 2; ++ks) {
                    bf16x8 btri, bone;
#pragma unroll
                    for (int e = 0; e < 8; ++e) { const int s_ = 32 * ks + 8 * q + e; btri[e] = (short)((s_ <= t) ? 0x3F80 : 0); bone[e] = (short)0x3F80; }
#pragma unroll
                    for (int mi = 0; mi < 2; ++mi) {
                        const int m = 2 * cg + mi;
                        const bf16x8 ah = *(const bf16x8*)(SL(4) + offM[ks] + m * 2048);
                        const bf16x8 al = *(const bf16x8*)(SL(5) + offM[ks] + m * 2048);
                        La[mi] = MFMA16(ah, btri, La[mi]); La[mi] = MFMA16(al, btri, La[mi]);
                        Ta[mi] = MFMA16(ah, bone, Ta[mi]); Ta[mi] = MFMA16(al, bone, Ta[mi]);
                    }
                }
                __syncthreads();
#pragma unroll
                for (int mi = 0; mi < 2; ++mi) {
                    const int m = 2 * cg + mi;
                    const int ch0 = m * 16 + 4 * q;
                    float kt[4], rt[4], bt[4], kkt[4];
#pragma unroll
                    for (int r = 0; r < 4; ++r) {
                        const int e = mi * 4 + r;
                        const float L = La[mi][r], Lt = Ta[mi][r];
                        const float eL = __expf(L), em = __expf(-L), eh = __expf(Lt - L), ex = __expf(L - lw[e]);
                        kt[r] = kap[e] * ex; rt[r] = rm[e] * eL; bt[r] = bv[e] * em; kkt[r] = kn[e] * em;
                        *(unsigned short*)(SL(9) + offT[r] + m * 2048) = (unsigned short)pk2(kt[r], 0.f);
                        *(unsigned short*)(SL(11) + offT[r] + m * 2048) = (unsigned short)pk2(bv[e] * eh, 0.f);
                        *(unsigned short*)(SL(12) + offT[r] + m * 2048) = (unsigned short)pk2(kn[e] * eh, 0.f);
                        if (t == 0) PC[ch0 + r] = __expf(Lt);
                    }
                    const int oR = sw_off(t, ch0);
                    u32x2 v;
                    v.x = pk2(kt[0], kt[1]); v.y = pk2(kt[2], kt[3]); *(u32x2*)(SL(6) + oR) = v;
                    v.x = pk2(bt[0], bt[1]); v.y = pk2(bt[2], bt[3]); *(u32x2*)(SL(7) + oR) = v;
                    v.x = pk2(kkt[0], kkt[1]); v.y = pk2(kkt[2], kkt[3]); *(u32x2*)(SL(8) + oR) = v;
                    v.x = pk2(rt[0], rt[1]); v.y = pk2(rt[2], rt[3]); *(u32x2*)(SL(10) + oR) = v;
                }
            }
            __syncthreads();
            f32x16 racc = zero16();
            {
                if (w < 4) {
                    f32x16 d = mm32(SL(7), oxm, SL(6), oyn, zero16());
                    const int tq_ = tnt * 32 + (lane & 31);
#pragma unroll
                    for (int r = 0; r < 16; ++r) { const int s_ = tmt * 32 + (r & 3) + 8 * (r >> 2) + 4 * hh; const float v = (s_ < tq_) ? d[r] : 0.f; d[r] = v; racc[r] = ((s_ == tq_) ? 1.f : 0.f) - v; }
                    store_T(SL(4), d, tmt, tnt, lane, ost, [](float v, int, int) { return v; });
                    store_T(SL(17), racc, tmt, tnt, lane, ost, [](float v, int, int) { return v; });
                } else {
                    f32x16 d = mm32(SL(6), oxm, SL(7), oyn, zero16());
                    store_T(SL(5), d, tmt, tnt, lane, ost, [](float v, int m, int n) { return (n < m) ? v : 0.f; });
                }
                if (w < 4) {
                    f32x16 d = mm32(SL(8), oxm, SL(6), oyn, zero16());
                    store_T(SL(14), d, tmt, tnt, lane, ost, [](float v, int m, int n) { return (m < n) ? v : 0.f; });
                } else {
                    f32x16 d = mm32(SL(7), oxm, SL(10), oyn, zero16());
                    store_T(SL(15), d, tmt, tnt, lane, ost, [](float v, int m, int n) { return (m <= n) ? v : 0.f; });
                }
                if (w < 4) {
                    f32x16 d = mm32(SL(8), oxm, SL(10), oyn, zero16());
                    store_T(SL(16), d, tmt, tnt, lane, ost, [](float v, int m, int n) { return (m <= n) ? v : 0.f; });
                }
            }
            __syncthreads();
            auto ident = [](float v, int, int) { return v; };
            if (w < 4) { f32x16 d = mm32(SL(5), oxm, SL(4), oyn, zero16()); store_T(SL(6), d, tmt, tnt, lane, ost, ident); }
            else       { f32x16 d = mm32(SL(4), oxm, SL(5), oyn, zero16()); store_T(SL(7), d, tmt, tnt, lane, ost, ident); }
            __syncthreads();
            if (w < 4) { f32x16 d = mm32(SL(7), oxm, SL(6), oyn, zero16()); store_T(SL(4), d, tmt, tnt, lane, ost, ident);
                         racc = mm32(SL(7), oxm, SL(17), oyn, racc); store_T(SL(8), racc, tmt, tnt, lane, ost, ident); }
            else       { f32x16 d = mm32(SL(6), oxm, SL(7), oyn, zero16()); store_T(SL(5), d, tmt, tnt, lane, ost, ident); }
            __syncthreads();
            if (w < 4) { f32x16 d = mm32(SL(5), oxm, SL(4), oyn, zero16()); store_T(SL(6), d, tmt, tnt, lane, ost, ident);
                         racc = mm32(SL(5), oxm, SL(8), oyn, racc); store_T(SL(17), racc, tmt, tnt, lane, ost, ident); }
            else       { f32x16 d = mm32(SL(4), oxm, SL(5), oyn, zero16()); store_T(SL(7), d, tmt, tnt, lane, ost, ident); }
            __syncthreads();
            if (w < 4) { f32x16 d = mm32(SL(7), oxm, SL(6), oyn, zero16()); store_T(SL(4), d, tmt, tnt, lane, ost, ident);
                         racc = mm32(SL(7), oxm, SL(17), oyn, racc); store_T(SL(8), racc, tmt, tnt, lane, ost, ident); }
            else       { f32x16 d = mm32(SL(6), oxm, SL(7), oyn, zero16()); store_T(SL(5), d, tmt, tnt, lane, ost, ident); }
            __syncthreads();
            if (w < 4) { racc = mm32(SL(5), oxm, SL(8), oyn, racc); store_T(SL(17), racc, tmt, tnt, lane, ost, ident); }
            else       { f32x16 d = mm32(SL(4), oxm, SL(5), oyn, zero16()); store_T(SL(7), d, tmt, tnt, lane, ost, ident); }
            __syncthreads();
            if (w < 4) { racc = mm32(SL(7), oxm, SL(17), oyn, racc); store_T(SL(8), racc, tmt, tnt, lane, ost, ident); }
            else       { f32x16 d = mm32(SL(14), oxm, SL(13), oyn, zero16()); store_T(SL(6), d, tmt, tnt, lane, ost, ident); }
            __syncthreads();
            if (w < 4) { f32x16 d = mm32(SL(8), oxm, SL(9), oyn, zero16()); store_T(SL(4), d, tmt, tnt, lane, ost, ident); }
            else       { f32x16 d = mm32(SL(8), oxm, SL(6), oyn, zero16()); store_T(SL(5), d, tmt, tnt, lane, ost, [](float v, int, int) { return -v; }); }
            __syncthreads();
            {
                const int ln = lane & 31;
                if (w < 4) {
                    const f32x16 d = mm32(SL(4), oxm, SL(11), oyn, zero16());
                    const int j = tnt * 32 + ln; const float pc = PC[j];
                    bf16* dst = TC + item * 4096;
#pragma unroll
                    for (int g = 0; g < 4; ++g) {
                        const int jp0 = tmt * 32 + 8 * g + 4 * hh;
                        float v[4];
#pragma unroll
                        for (int r = 0; r < 4; ++r) v[r] = ((jp0 + r == j) ? pc : 0.f) - d[4 * g + r];
                        const int a = jp0 >> 4, qp = (jp0 & 15) >> 2, s_ = a >> 1, m16 = j >> 4, L = (qp << 4) | (j & 15);
                        u32x2 o; o.x = pk2(v[0], v[1]); o.y = pk2(v[2], v[3]);
                        *(u32x2*)(dst + ((m16 * 2 + s_) * 64 + L) * 8 + (a & 1) * 4) = o;
                    }
                    const f32x16 d2 = mm32(SL(4), oxm, SL(15), oyn, zero16());
                    const int tq_ = tnt * 32 + ln;
                    bf16* dq = QC + item * 4096;
#pragma unroll
                    for (int g = 0; g < 4; ++g) {
                        const int j0 = tmt * 32 + 8 * g + 4 * hh;
                        const u32x2 rv = *(const u32x2*)(SL(10) + ost[g]);
                        u32x2 o; o.x = pk2(bflo(rv.x) - d2[4 * g], bfhi(rv.x) - d2[4 * g + 1]); o.y = pk2(bflo(rv.y) - d2[4 * g + 2], bfhi(rv.y) - d2[4 * g + 3]);
                        *(u32x2*)(dq + tq_ * 64 + j0) = o;
                    }
                } else {
                    f32x16 d = mm32(SL(11), oxm, SL(5), oyn, zero16());
                    d = mm32(SL(12), oxm, SL(13), oyn, d);
                    const int i = tnt * 32 + ln;
                    bf16* dg = GC + item * 4096;
#pragma unroll
                    for (int g = 0; g < 4; ++g) {
                        const int j0 = tmt * 32 + 8 * g + 4 * hh;
                        const int m16 = j0 >> 4, qq = (j0 & 15) >> 2, L = (qq << 4) | (i & 15), iq = i >> 4;
                        u32x2 o; o.x = pk2(d[4 * g], d[4 * g + 1]); o.y = pk2(d[4 * g + 2], d[4 * g + 3]);
                        *(u32x2*)(dg + (iq * 64 + L) * 16 + m16 * 4) = o;
                    }
                    f32x16 d2 = mm32(SL(5), oxm, SL(15), oyn, zero16());
                    d2 = mm32(SL(13), oxm, SL(16), oyn, d2);
                    bf16* dol = OL + item * 4096;
#pragma unroll
                    for (int g = 0; g < 4; ++g) {
                        u32x2 o; o.x = pk2(d2[4 * g], d2[4 * g + 1]); o.y = pk2(d2[4 * g + 2], d2[4 * g + 3]);
                        *(u32x2*)(dol + (((tnt * 2 + tmt) * 4 + g) * 64 + lane) * 4) = o;
                    }
                }
            }
        }
    }
#undef SL
}

constexpr int SC_NS = 14, SC_SLOT = 10240, SC_FLAGS = SC_NS * SC_SLOT;
__device__ __forceinline__ void phase_scan(const Params& p, unsigned char* lds, int chain) {
    const int tid = opaque_tid(), lane = tid & 63, wv = __builtin_amdgcn_readfirstlane(tid >> 6);
    const int b = chain / 48, h = (chain >> 2) % NH, iq = chain & 3;
    const unsigned char* TCb = p.ws + WS_TC; const unsigned char* GCb = p.ws + WS_GC + iq * 2048; bf16* S0 = (bf16*)(p.ws + WS_S0);
    const size_t item0 = (size_t)(b * (SEQ / 64)) * NH + h;
    volatile LAS unsigned* flg = (volatile LAS unsigned*)(LAS unsigned char*)(lds + SC_FLAGS);
    constexpr int NSTEP = SEQ / 64;
    if (tid < 16) flg[tid] = 0u;
    __syncthreads();
    if (wv > 0) {
        u32x4 ra[10], rb[10];
#define SC_LOAD(dst, st) do { const unsigned char* tb_ = TCb + (item0 + (size_t)(st) * NH) * 8192; const unsigned char* gb_ = GCb + (item0 + (size_t)(st) * NH) * 8192; \
        _Pragma("unroll") for (int x = 0; x < 8; ++x) dst[x] = *(const u32x4*)(tb_ + x * 1024 + lane * 16); \
        dst[8] = *(const u32x4*)(gb_ + lane * 32); dst[9] = *(const u32x4*)(gb_ + lane * 32 + 16); } while (0)
        int st = wv - 1;
        SC_LOAD(ra, st);
        for (; st < NSTEP; st += 7) {
            const bool more = st + 7 < NSTEP;
            if (more) SC_LOAD(rb, st + 7);
            if (st >= SC_NS) { while ((int)flg[SC_NS] < st - SC_NS + 1) __builtin_amdgcn_s_sleep(1); }
            asm volatile("" ::: "memory");
            unsigned char* sl = lds + (st % SC_NS) * SC_SLOT;
#pragma unroll
            for (int x = 0; x < 8; ++x) *(u32x4*)(sl + x * 1024 + lane * 16) = ra[x];
            *(u32x4*)(sl + 8192 + lane * 32) = ra[8]; *(u32x4*)(sl + 8192 + lane * 32 + 16) = ra[9];
            asm volatile("s_waitcnt lgkmcnt(0)" ::: "memory");
            if (lane == 0) flg[st % SC_NS] = (unsigned)(st + 1);
            if (more) {
#pragma unroll
                for (int x = 0; x < 10; ++x) ra[x] = rb[x];
            }
        }
#undef SC_LOAD
    } else {
        const int q = lane >> 4, il = lane & 15;
        f32x4 S[4];
#pragma unroll
        for (int m = 0; m < 4; ++m) S[m] = (f32x4){0.f, 0.f, 0.f, 0.f};
        u32x4 cur[10], nxt[10];
#define SC_READ(dst, st) do { while (flg[(st) % SC_NS] != (unsigned)((st) + 1)) __builtin_amdgcn_s_sleep(1); asm volatile("" ::: "memory"); \
        const unsigned char* sl_ = lds + ((st) % SC_NS) * SC_SLOT; \
        _Pragma("unroll") for (int x = 0; x < 8; ++x) dst[x] = *(const u32x4*)(sl_ + x * 1024 + lane * 16); \
        dst[8] = *(const u32x4*)(sl_ + 8192 + lane * 32); dst[9] = *(const u32x4*)(sl_ + 8192 + lane * 32 + 16); } while (0)
        SC_READ(cur, 0);
        for (int cc = 0; cc < NSTEP; ++cc) {
            if (cc + 1 < NSTEP) SC_READ(nxt, cc + 1);
            u32x4 sb0, sb1;
            sb0.x = pk2(S[0][0], S[0][1]); sb0.y = pk2(S[0][2], S[0][3]); sb0.z = pk2(S[1][0], S[1][1]); sb0.w = pk2(S[1][2], S[1][3]);
            sb1.x = pk2(S[2][0], S[2][1]); sb1.y = pk2(S[2][2], S[2][3]); sb1.z = pk2(S[3][0], S[3][1]); sb1.w = pk2(S[3][2], S[3][3]);
            bf16* so = S0 + (item0 + (size_t)cc * NH) * 4096 + (iq * 16 + il) * 64 + 4 * q;
            *(u32x2*)(so) = (u32x2){sb0.x, sb0.y}; *(u32x2*)(so + 16) = (u32x2){sb0.z, sb0.w};
            *(u32x2*)(so + 32) = (u32x2){sb1.x, sb1.y}; *(u32x2*)(so + 48) = (u32x2){sb1.z, sb1.w};
            f32x4 gi[4];
            gi[0] = (f32x4){bflo(cur[8].x), bfhi(cur[8].x), bflo(cur[8].y), bfhi(cur[8].y)};
            gi[1] = (f32x4){bflo(cur[8].z), bfhi(cur[8].z), bflo(cur[8].w), bfhi(cur[8].w)};
            gi[2] = (f32x4){bflo(cur[9].x), bfhi(cur[9].x), bflo(cur[9].y), bfhi(cur[9].y)};
            gi[3] = (f32x4){bflo(cur[9].z), bfhi(cur[9].z), bflo(cur[9].w), bfhi(cur[9].w)};
            const bf16x8 b0 = __builtin_bit_cast(bf16x8, sb0), b1 = __builtin_bit_cast(bf16x8, sb1);
#pragma unroll
            for (int m = 0; m < 4; ++m) {
                S[m] = MFMA16(__builtin_bit_cast(bf16x8, cur[2 * m]), b0, gi[m]);
                S[m] = MFMA16(__builtin_bit_cast(bf16x8, cur[2 * m + 1]), b1, S[m]);
            }
            asm volatile("s_waitcnt lgkmcnt(0)" ::: "memory");
            if (lane == 0) flg[SC_NS] = (unsigned)min(cc + 2, NSTEP);
#pragma unroll
            for (int x = 0; x < 10; ++x) cur[x] = nxt[x];
        }
#undef SC_READ
    }
}

__device__ __forceinline__ void phase_rwkv_out(const Params& p, int bid, int nb) {
    const int tid = opaque_tid(), lane = tid & 63, w = tid >> 6, ln = lane & 31, hh = lane >> 5;
    const bf16* S0 = (const bf16*)(p.ws + WS_S0); const bf16* QC = (const bf16*)(p.ws + WS_QC); const bf16* OL = (const bf16*)(p.ws + WS_OL);
    const bf16* G1 = (const bf16*)((const unsigned char*)p.out + OUT_G1); const bf16* G2 = (const bf16*)((const unsigned char*)p.out + OUT_G2);
    bf16* mix = (bf16*)(p.ws + WS_MIXIN);
    const int ntask = BATCH * (SEQ / 64) * NH * 2;
    for (int task = bid * 8 + w; task < ntask; task += nb * 8) {
        const int item = task >> 1, nt = task & 1;
        const int h = item % NH, bc = item / NH;
        const int tok0 = bc * 64;
        f32x16 acc[2];
#pragma unroll
        for (int mt = 0; mt < 2; ++mt)
#pragma unroll
            for (int g = 0; g < 4; ++g) {
                const u32x2 v = *(const u32x2*)(OL + (size_t)item * 4096 + (((nt * 2 + mt) * 4 + g) * 64 + lane) * 4);
                acc[mt][4 * g] = bflo(v.x); acc[mt][4 * g + 1] = bfhi(v.x); acc[mt][4 * g + 2] = bflo(v.y); acc[mt][4 * g + 3] = bfhi(v.y);
            }
        const int t = nt * 32 + ln;
#pragma unroll
        for (int s = 0; s < 4; ++s) {
            const bf16x8 bq = *(const bf16x8*)(QC + (size_t)item * 4096 + t * 64 + 16 * s + 8 * hh);
#pragma unroll
            for (int mt = 0; mt < 2; ++mt) {
                const bf16x8 a = *(const bf16x8*)(S0 + (size_t)item * 4096 + (mt * 32 + ln) * 64 + 16 * s + 8 * hh);
                acc[mt] = MFMA32(a, bq, acc[mt]);
            }
        }
        float s1 = 0.f;
#pragma unroll
        for (int mt = 0; mt < 2; ++mt)
#pragma unroll
            for (int r = 0; r < 16; ++r) s1 += acc[mt][r];
        s1 += __shfl_xor(s1, 32);
        const float mean = s1 * (1.f / 64.f);
        float s2 = 0.f;
#pragma unroll
        for (int mt = 0; mt < 2; ++mt)
#pragma unroll
            for (int r = 0; r < 16; ++r) { acc[mt][r] -= mean; s2 += acc[mt][r] * acc[mt][r]; }
        s2 += __shfl_xor(s2, 32);
        const float rstd = rsqrtf(s2 * (1.f / 64.f) + LNX_EPS);
#pragma unroll
        for (int mt = 0; mt < 2; ++mt)
#pragma unroll
            for (int g = 0; g < 4; ++g) {
                const int i0 = mt * 32 + 8 * g + 4 * hh;
                const u32x2 a1 = *(const u32x2*)(G1 + (size_t)item * 4096 + t * 64 + i0), a2 = *(const u32x2*)(G2 + (size_t)item * 4096 + t * 64 + i0);
                u32x2 o;
                o.x = pk2(acc[mt][4 * g] * rstd * bflo(a1.x) + bflo(a2.x), acc[mt][4 * g + 1] * rstd * bfhi(a1.x) + bfhi(a2.x));
                o.y = pk2(acc[mt][4 * g + 2] * rstd * bflo(a1.y) + bflo(a2.y), acc[mt][4 * g + 3] * rstd * bfhi(a1.y) + bfhi(a2.y));
                *(u32x2*)(mix + (size_t)(tok0 + t) * DM + D_POOL + h * 64 + i0) = o;
            }
    }
}

struct EpiOut {
    const float* X; float* O; int row0, col0;
    __device__ __forceinline__ void operator()(const f32x4 (&acc)[8][4], int wr, int wc, int fr, int fq) const {
#pragma unroll
        for (int m = 0; m < 8; ++m) {
            const size_t off = (size_t)(row0 + wr * 128 + m * 16 + fr) * DM + col0 + wc * 64 + fq * 4;
#pragma unroll
            for (int n = 0; n < 4; ++n) { const f32x4 xv = *(const f32x4*)(X + off + n * 16); *(f32x4*)(O + off + n * 16) = xv * ALPHA + acc[m][n]; }
        }
    }
};
__device__ __forceinline__ void phase_outproj(const Params& p, unsigned char* lds, int bid, int nb) {
    pg8::Gemm g{(const pg8::bf16_t*)(p.ws + WS_MIXIN), (const pg8::bf16_t*)(p.ws + WS_WOUT_T), NTOK, DM, DM};
    pg8::StaticOrder S; S.init(NTOK, DM, nb, bid);
    pg8::EpiResF32 E{p.in[0], p.out, DM, ALPHA};
    pg8::gemm_phase<pg8::EpiResF32, pg8::StaticOrder>((PG8_LAS unsigned char*)lds, g, S, E);
}

__device__ __forceinline__ void phase_ln_router(const Params& p, unsigned char* lds, int bid, int nb) {
    const int tid = opaque_tid(), lane = tid & 63, w = __builtin_amdgcn_readfirstlane(tid >> 6);
    float* RT = (float*)lds;
    unsigned* LCNT = (unsigned*)(lds + 147456);
    int* LENT = (int*)(lds + 147456 + 128);
    (void)LENT;
    __syncthreads();
    {
        const f32x4* src = (const f32x4*)(p.ws + WS_RTT);
        f32x4 tmp[18];
#pragma unroll
        for (int i = 0; i < 18; ++i) tmp[i] = src[tid + i * NT];
#pragma unroll
        for (int i = 0; i < 18; ++i) ((f32x4*)RT)[tid + i * NT] = tmp[i];
    }
    const float* g1 = p.in[16]; const float* b1 = p.in[17]; const float* rgb = p.in[19]; const float* reb = p.in[21];
    float* H = p.out; bf16* hb = (bf16*)(p.ws + WS_HB);
    unsigned* cnt = (unsigned*)(p.ws + WS_CTL);
    int* list = (int*)(p.ws + WS_LIST); float* lwt = (float*)(p.ws + WS_LWT);
    const int rows_per_wg = NTOK / nb;
    const int rpw = rows_per_wg / 8;
    const int row0 = bid * rows_per_wg + w * rpw;
    if (tid < 32) LCNT[tid] = 0u;
    __syncthreads();
    int my_e0 = 0, my_e1 = 0, my_r0 = 0, my_r1 = 0; float my_w0 = 0.f, my_w1 = 0.f;
    f32x4 nx[4];
#pragma unroll
    for (int j = 0; j < 4; ++j) nx[j] = *(const f32x4*)(H + (size_t)row0 * DM + j * 256 + lane * 4);
    for (int ri = 0; ri < rpw; ++ri) {
        const int row = row0 + ri;
        float* hr = H + (size_t)row * DM;
        f32x4 v[4]; float s = 0.f;
#pragma unroll
        for (int j = 0; j < 4; ++j) { v[j] = nx[j]; s += (v[j].x + v[j].y) + (v[j].z + v[j].w); }
        if (ri + 1 < rpw) {
#pragma unroll
            for (int j = 0; j < 4; ++j) nx[j] = *(const f32x4*)(hr + DM + j * 256 + lane * 4);
        }
        const float mean = wave_sum(s) * (1.f / DM);
        float s2 = 0.f;
#pragma unroll
        for (int j = 0; j < 4; ++j) { v[j] = v[j] - mean; s2 += (v[j].x * v[j].x + v[j].y * v[j].y) + (v[j].z * v[j].z + v[j].w * v[j].w); }
        const float rstd = rsqrtf(wave_sum(s2) * (1.f / DM) + LN_EPS);
#pragma unroll
        for (int j = 0; j < 4; ++j) {
            const f32x4 g = *(const f32x4*)(g1 + j * 256 + lane * 4), bb = *(const f32x4*)(b1 + j * 256 + lane * 4);
            v[j] = v[j] * rstd * g + bb;
            u32x2 o; o.x = pk2(v[j].x, v[j].y); o.y = pk2(v[j].z, v[j].w);
            *(u32x2*)(hb + (size_t)row * DM + j * 256 + lane * 4) = o;
        }
        float gl[4];
#pragma unroll
        for (int q = 0; q < 4; ++q) {
            float a = 0.f;
#pragma unroll
            for (int j = 0; j < 4; ++j) { const f32x4 r = *(const f32x4*)(RT + q * 1024 + j * 256 + lane * 4); a += v[j].x * r.x + v[j].y * r.y + v[j].z * r.z + v[j].w * r.w; }
            gl[q] = a;
        }
#pragma unroll
        for (int q = 0; q < 4; ++q) gl[q] = wave_sum(gl[q]) + rgb[q];
        int gi = 0; float gm = gl[0];
#pragma unroll
        for (int q = 1; q < 4; ++q) if (gl[q] > gm) { gm = gl[q]; gi = q; }
        float den = 0.f;
#pragma unroll
        for (int q = 0; q < 4; ++q) den += __expf(gl[q] - gm);
        const float gp = 1.f / den;
        gi = __builtin_amdgcn_readfirstlane(gi);
        float el[8];
        const float* rtg = RT + (4 + gi * 8) * 1024 + lane * 4;
#pragma unroll
        for (int hq = 0; hq < 2; ++hq) {
            float part[4];
#pragma unroll
            for (int q = 0; q < 4; ++q) {
                float a = 0.f;
#pragma unroll
                for (int j = 0; j < 4; ++j) { const f32x4 r = *(const f32x4*)(rtg + (hq * 4 + q) * 1024 + j * 256); a += v[j].x * r.x + v[j].y * r.y + v[j].z * r.z + v[j].w * r.w; }
                part[q] = a;
            }
#pragma unroll
            for (int q = 0; q < 4; ++q) el[hq * 4 + q] = wave_sum(part[q]) + reb[gi * 8 + hq * 4 + q];
        }
        int i0 = 0; float m0 = el[0];
#pragma unroll
        for (int q = 1; q < 8; ++q) if (el[q] > m0) { m0 = el[q]; i0 = q; }
        int i1 = -1; float m1 = -3.0e38f;
#pragma unroll
        for (int q = 0; q < 8; ++q) if (q != i0 && el[q] > m1) { m1 = el[q]; i1 = q; }
        const float e1 = __expf(m1 - m0);
        const float w0 = gp / (1.f + e1), w1 = gp * e1 / (1.f + e1);
        if (lane == ri) {
            my_e0 = gi * 8 + i0; my_e1 = gi * 8 + i1; my_w0 = w0; my_w1 = w1;
            my_r0 = (int)atomicAdd(&LCNT[my_e0], 1u); my_r1 = (int)atomicAdd(&LCNT[my_e1], 1u);
        }
    }
    __syncthreads();
    if (tid < 32) { const unsigned c = LCNT[tid]; LCNT[tid] = c ? atomicAdd(&cnt[tid], c) : 0u; }
    __syncthreads();
    if (lane < rpw) {
        const int row = row0 + lane;
        const int p0 = (int)LCNT[my_e0] + my_r0, p1 = (int)LCNT[my_e1] + my_r1;
        list[my_e0 * NTOK + p0] = row * 2; lwt[my_e0 * NTOK + p0] = my_w0;
        list[my_e1 * NTOK + p1] = row * 2 + 1; lwt[my_e1 * NTOK + p1] = my_w1;
    }
}

__device__ __forceinline__ float siluf_(float x) { return x / (1.f + __expf(-x)); }
constexpr int MOE_MR = 144, MOE_MT = 9;
constexpr int MOE_BUFB = 41984, MOE_BOFF = 9216, MOE_HID = 83968, MOE_ROW = 157696;
__device__ __forceinline__ int key64(int row) { return (0x78 >> (2 * ((row >> 2) & 3))) & 3; }
#define GLDS16(gptr, ldsptr) __builtin_amdgcn_global_load_lds((const __attribute__((address_space(1))) unsigned*)(gptr), (__attribute__((address_space(3))) unsigned*)(ldsptr), 16, 0, 0)
__device__ __forceinline__ void phase_moe(const Params& p, unsigned char* lds, int bid, int nb) {
    const int tid0 = opaque_tid();
    const unsigned* cnt = (const unsigned*)(p.ws + WS_CTL);
    const bf16* hb = (const bf16*)(p.ws + WS_HB);
    bf16* YS = (bf16*)(p.ws + WS_YS);
    int* ROWTS = (int*)(lds + MOE_ROW); float* ROWWT = (float*)(lds + MOE_ROW + 576);
    for (int u0 = bid; u0 < NEXP * 8; u0 += nb) {
        const int u = (nb == 256) ? ((u0 & 7) * 32 + (u0 >> 3)) : u0;
        int tid = tid0; asm volatile("" : "+v"(tid));
        const int lane = tid & 63, wv = __builtin_amdgcn_readfirstlane(tid >> 6);
        const int fr = lane & 15, fq = lane >> 4;
        const int srow = tid >> 2, schunk = (tid & 3) ^ key64(srow);
        const int offA = fr * 64 + ((fq ^ key64(fr)) << 4);
        const int offB = MOE_BOFF + (wv * 64 + fr) * 64 + ((fq ^ key64(fr)) << 4);
        const int e = u >> 3, part = u & 7;
        const int ce = (int)cnt[e], hrows = (ce + 7) >> 3;
        const int rbeg = part * hrows, rend = min(ce, rbeg + hrows);
        const int* lst = (const int*)(p.ws + WS_LIST) + e * NTOK; const float* lw_ = (const float*)(p.ws + WS_LWT) + e * NTOK;
        const bf16* wgu = (const bf16*)(p.ws + WS_EGU) + (size_t)e * 512 * DM;
        const bf16* wdn = (const bf16*)(p.ws + WS_EDN) + (size_t)e * DM * DE;
        for (int r0 = rbeg; r0 < rend; r0 += MOE_MR) {
            const int nrows = min(MOE_MR, rend - r0), mt = (nrows + 15) >> 4;
            __syncthreads();
            if (tid < MOE_MR) { const bool ok = tid < nrows; ROWTS[tid] = ok ? lst[r0 + tid] : lst[r0]; ROWWT[tid] = ok ? lw_[r0 + tid] : 0.f; }
            __syncthreads();
            const bool a2 = wv == 0;
            const unsigned aoff0 = (unsigned)((ROWTS[srow] >> 1) * DM + schunk * 8);
            const unsigned aoff1 = (unsigned)((ROWTS[a2 ? 128 + srow : 0] >> 1) * DM + schunk * 8);
            f32x4 acc[MOE_MT][4];
#pragma unroll
            for (int m = 0; m < MOE_MT; ++m)
#pragma unroll
                for (int n = 0; n < 4; ++n) acc[m][n] = (f32x4){0.f, 0.f, 0.f, 0.f};
            {
                const unsigned boff = (unsigned)(srow * DM + schunk * 8);
#define MOE_STAGE1(buf_, k_) do { unsigned char* sb_ = lds + (buf_) * MOE_BUFB + wv * 1024; \
                    GLDS16(hb + aoff0 + (k_), sb_); if (a2) GLDS16(hb + aoff1 + (k_), sb_ + 8192); \
                    _Pragma("unroll") for (int i = 0; i < 4; ++i) GLDS16(wgu + boff + i * 128 * DM + (k_), sb_ + MOE_BOFF + i * 8192); } while (0)
                MOE_STAGE1(0, 0);
                MOE_STAGE1(1, 32);
#pragma unroll 1
                for (int kt = 0; kt < DM / 32; ++kt) {
                    if (kt + 1 < DM / 32) { if (a2) asm volatile("s_waitcnt vmcnt(6)" ::: "memory"); else asm volatile("s_waitcnt vmcnt(5)" ::: "memory"); }
                    else asm volatile("s_waitcnt vmcnt(0)" ::: "memory");
                    __builtin_amdgcn_s_barrier();
                    asm volatile("" ::: "memory");
                    const int b0 = kt % 3;
                    if (kt + 2 < DM / 32) MOE_STAGE1((kt + 2) % 3, (kt + 2) * 32);
                    const unsigned char* cur = lds + b0 * MOE_BUFB;
                    bf16x8 bfr[4], afr[MOE_MT];
#pragma unroll
                    for (int n = 0; n < 4; ++n) bfr[n] = *(const bf16x8*)(cur + offB + n * 1024);
#pragma unroll
                    for (int m = 0; m < MOE_MT; ++m) afr[m] = *(const bf16x8*)(cur + offA + m * 1024);
#pragma unroll
                    for (int m = 0; m < MOE_MT - 1; ++m)
#pragma unroll
                        for (int n = 0; n < 4; ++n) acc[m][n] = MFMA16(bfr[n], afr[m], acc[m][n]);
                    if (mt > MOE_MT - 1) {
#pragma unroll
                        for (int n = 0; n < 4; ++n) acc[MOE_MT - 1][n] = MFMA16(bfr[n], afr[MOE_MT - 1], acc[MOE_MT - 1][n]);
                    }
                }
                __syncthreads();
#undef MOE_STAGE1
            }
            const unsigned doff = (unsigned)(srow * DE + schunk * 8);
#define MOE_STAGE2(buf_, it_) do { unsigned char* sb_ = lds + (buf_) * MOE_BUFB + wv * 1024 + MOE_BOFF; const bf16* g_ = wdn + doff + (size_t)(((it_) >> 3) * 512) * DE + ((it_) & 7) * 32; \
                    _Pragma("unroll") for (int i = 0; i < 4; ++i) GLDS16(g_ + i * 128 * DE, sb_ + i * 8192); } while (0)
            MOE_STAGE2(0, 0);
#pragma unroll
            for (int m = 0; m < MOE_MT; ++m) {
                const int row = m * 16 + fr;
#pragma unroll
                for (int n = 0; n < 2; ++n) {
                    const f32x4 g = acc[m][n], uu = acc[m][n + 2];
                    const int hcol = wv * 32 + n * 16 + fq * 4;
                    u32x2 v; v.x = pk2(siluf_(g[0]) * uu[0], siluf_(g[1]) * uu[1]); v.y = pk2(siluf_(g[2]) * uu[2], siluf_(g[3]) * uu[3]);
                    *(u32x2*)(lds + MOE_HID + row * 512 + (((hcol >> 3) ^ (row & 15)) << 4) + (hcol & 7) * 2) = v;
                }
            }
            int hoff4[4];
#pragma unroll
            for (int sp = 0; sp < 4; ++sp) hoff4[sp] = MOE_HID + fr * 512 + (((sp * 4 + fq) ^ fr) << 4);
            __syncthreads();
#pragma unroll 1
            for (int np = 0; np < 2; ++np) {
#pragma unroll
                for (int m = 0; m < MOE_MT; ++m)
#pragma unroll
                    for (int n = 0; n < 4; ++n) acc[m][n] = (f32x4){0.f, 0.f, 0.f, 0.f};
#pragma unroll 1
                for (int kt = 0; kt < DE / 32; ++kt) {
                    const int it_ = np * 8 + kt;
                    const unsigned char* cur = lds + (it_ & 1) * MOE_BUFB;
                    if (it_ + 1 < 16) MOE_STAGE2((it_ + 1) & 1, it_ + 1);
                    bf16x8 bfr[4], afr[MOE_MT];
#pragma unroll
                    for (int n = 0; n < 4; ++n) bfr[n] = *(const bf16x8*)(cur + offB + n * 1024);
                    const int ho = hoff4[kt & 3] + (kt >> 2) * 256;
#pragma unroll
                    for (int m = 0; m < MOE_MT; ++m) afr[m] = *(const bf16x8*)(lds + ho + m * 8192);
#pragma unroll
                    for (int m = 0; m < MOE_MT - 1; ++m)
#pragma unroll
                        for (int n = 0; n < 4; ++n) acc[m][n] = MFMA16(bfr[n], afr[m], acc[m][n]);
                    if (mt > MOE_MT - 1) {
#pragma unroll
                        for (int n = 0; n < 4; ++n) acc[MOE_MT - 1][n] = MFMA16(bfr[n], afr[MOE_MT - 1], acc[MOE_MT - 1][n]);
                    }
                    __syncthreads();
                }
#pragma unroll
                for (int m = 0; m < MOE_MT; ++m) {
                    const int r = m * 16 + fr;
                    if (r < nrows) {
                        const int ts = ROWTS[r]; const float wt = ROWWT[r];
                        bf16* rp = YS + (size_t)ts * DM + np * 512 + wv * 64 + fq * 4;
#pragma unroll
                        for (int n = 0; n < 4; ++n) { u32x2 v; v.x = pk2(acc[m][n][0] * wt, acc[m][n][1] * wt); v.y = pk2(acc[m][n][2] * wt, acc[m][n][3] * wt); *(u32x2*)(rp + n * 16) = v; }
                    }
                }
            }
#undef MOE_STAGE2
        }
    }
}

__device__ __forceinline__ void phase_final(const Params& p, int bid, int nb) {
    const int tid = opaque_tid(), lane = tid & 63, w = tid >> 6;
    const float* g2 = p.in[25]; const float* b2 = p.in[26];
    const bf16* ys = (const bf16*)(p.ws + WS_YS); const bf16* hb = (const bf16*)(p.ws + WS_HB);
    for (int row = bid * 8 + w; row < NTOK; row += nb * 8) {
        float* hr = p.out + (size_t)row * DM;
        f32x4 v[4]; float s = 0.f;
#pragma unroll
        for (int j = 0; j < 4; ++j) {
            const u32x2 hq = *(const u32x2*)(hb + (size_t)row * DM + j * 256 + lane * 4);
            const f32x4 hv = {bflo(hq.x), bfhi(hq.x), bflo(hq.y), bfhi(hq.y)};
            const u32x2 y0 = *(const u32x2*)(ys + (size_t)row * 2 * DM + j * 256 + lane * 4), y1 = *(const u32x2*)(ys + (size_t)row * 2 * DM + DM + j * 256 + lane * 4);
            v[j].x = hv.x * ALPHA + (bflo(y0.x) + bflo(y1.x)); v[j].y = hv.y * ALPHA + (bfhi(y0.x) + bfhi(y1.x));
            v[j].z = hv.z * ALPHA + (bflo(y0.y) + bflo(y1.y)); v[j].w = hv.w * ALPHA + (bfhi(y0.y) + bfhi(y1.y));
            s += (v[j].x + v[j].y) + (v[j].z + v[j].w);
        }
        const float mean = wave_sum(s) * (1.f / DM);
        float s2 = 0.f;
#pragma unroll
        for (int j = 0; j < 4; ++j) { v[j] = v[j] - mean; s2 += (v[j].x * v[j].x + v[j].y * v[j].y) + (v[j].z * v[j].z + v[j].w * v[j].w); }
        const float rstd = rsqrtf(wave_sum(s2) * (1.f / DM) + LN_EPS);
#pragma unroll
        for (int j = 0; j < 4; ++j) {
            const f32x4 g = *(const f32x4*)(g2 + j * 256 + lane * 4), bb = *(const f32x4*)(b2 + j * 256 + lane * 4);
            *(f32x4*)(hr + j * 256 + lane * 4) = v[j] * rstd * g + bb;
        }
    }
}

#define XB_TMO      128
#define XB_XCNT(j)  (256  + 64 * (j))
#define XB_XSUB(j)  (1280 + 64 * (j))
#define XB_XGEN(j)  (2304 + 64 * (j))
#define XB_TOP      3328
#define XB_TOPGEN   3392
#define XCD_BAR_WORDS 3456
#define XB_SPIN_CAP (1u << 18)
__device__ __forceinline__ unsigned xb_ld(unsigned* p)              { return __hip_atomic_load(p, __ATOMIC_RELAXED, __HIP_MEMORY_SCOPE_AGENT); }
__device__ __forceinline__ unsigned xb_add(unsigned* p, unsigned v) { return __hip_atomic_fetch_add(p, v, __ATOMIC_RELAXED, __HIP_MEMORY_SCOPE_AGENT); }
__device__ __forceinline__ unsigned xb_xcc_id() { return (unsigned)__builtin_amdgcn_s_getreg((3 << 11) | 20) & 0xFu; }
#define XB_SPIN(cond, bar) do { unsigned _sp = 0; while (cond) { __builtin_amdgcn_s_sleep(1); \
    if ((++_sp & 255u) == 0u) { if (xb_ld(&(bar)[XB_TMO])) break; if (_sp > XB_SPIN_CAP) { atomicAdd(&(bar)[XB_TMO], 1u); break; } } } } while (0)
struct XcdBarrier { unsigned* bar; unsigned x; volatile LAS unsigned* st; };
__device__ __forceinline__ XcdBarrier xcd_barrier_post(unsigned* bar, volatile LAS unsigned* st) {
    XcdBarrier b; b.bar = bar; b.x = xb_xcc_id(); b.st = st;
    if (threadIdx.x == 0) (void)xb_add(&bar[XB_XCNT(b.x)], 1u);
    return b;
}
__device__ __forceinline__ void xcd_barrier_complete(unsigned* bar, unsigned x, unsigned& nloc, unsigned& nx) {
    const unsigned G = gridDim.x * gridDim.y * gridDim.z;
    unsigned sum, cnt, mine, sp = 0u;
    for (;;) {
        sum = 0u; cnt = 0u; mine = 0u;
#pragma unroll
        for (unsigned j = 0; j < 16; ++j) { const unsigned c = xb_ld(&bar[XB_XCNT(j)]); sum += c; cnt += (c > 0u) ? 1u : 0u; mine = (j == x) ? c : mine; }
        if (sum == G) break;
        __builtin_amdgcn_s_sleep(1);
        if ((++sp & 255u) == 0u) { if (xb_ld(&bar[XB_TMO])) break; if (sp > XB_SPIN_CAP) { atomicAdd(&bar[XB_TMO], 1u); break; } }
    }
    nloc = mine > 0u ? mine : 1u; nx = cnt > 0u ? cnt : 1u;
}
__device__ __forceinline__ void xcd_barrier(const XcdBarrier& b) {
    asm volatile("s_waitcnt vmcnt(0)" ::: "memory");
    __syncthreads();
    if (threadIdx.x == 0) {
        unsigned* bar = b.bar;
        __builtin_amdgcn_s_waitcnt(0);
        unsigned nloc = b.st[0], nx = b.st[1];
        if (nloc == 0u) { xcd_barrier_complete(bar, b.x, nloc, nx); b.st[0] = nloc; b.st[1] = nx; }
        const unsigned old = xb_add(&bar[XB_XSUB(b.x)], 1u);
        const unsigned gen = old / nloc;
        if (old + 1u == (gen + 1u) * nloc) {
            __builtin_amdgcn_fence(__ATOMIC_RELEASE, "agent");
            asm volatile("s_waitcnt vmcnt(0)" ::: "memory");
            const unsigned og = xb_add(&bar[XB_TOP], 1u);
            const unsigned tg = og / nx;
            if (og + 1u == (tg + 1u) * nx) xb_add(&bar[XB_TOPGEN], 1u);
            else XB_SPIN(xb_ld(&bar[XB_TOPGEN]) == tg, bar);
            __builtin_amdgcn_fence(__ATOMIC_ACQUIRE, "agent");
            xb_add(&bar[XB_XGEN(b.x)], 1u);
            asm volatile("s_waitcnt vmcnt(0)" ::: "memory");
        } else {
            XB_SPIN(xb_ld(&bar[XB_XGEN(b.x)]) == gen, bar);
            __builtin_amdgcn_fence(__ATOMIC_ACQUIRE, "agent");
            asm volatile("s_waitcnt vmcnt(0)" ::: "memory");
        }
    }
    __syncthreads();
}

__global__ void __launch_bounds__(NT) fwd_kernel(Params p) {
    extern __shared__ __attribute__((aligned(16))) unsigned char lds[];
    cg::grid_group grid = cg::this_grid();
    const int bid = blockIdx.x, nb = gridDim.x;
    volatile LAS unsigned* bst = (volatile LAS unsigned*)(LAS unsigned char*)(lds + BAR_LDS_OFF);
    if (threadIdx.x < 2) bst[threadIdx.x] = 0u;
    __syncthreads();
    XcdBarrier xb = xcd_barrier_post((unsigned*)(p.ws + WS_CTL) + CW_BAR, bst);
#define GRID_BAR() xcd_barrier(xb)
    if (p.pad != 0) grid.sync();
    phase_convert(p, lds, bid, nb);
    GRID_BAR();
    phase_proj(p, lds, bid, nb);
    GRID_BAR();
    phase_prep(p, lds, bid, nb);
    phase_pool(p, lds, bid, nb);
    GRID_BAR();
    if (bid < 96) phase_scan(p, lds, (bid & 7) * 12 + (bid >> 3));
    else phase_convert_experts(p, lds, bid - 96, nb - 96);
    GRID_BAR();
    phase_rwkv_out(p, bid, nb);
    GRID_BAR();
    phase_outproj(p, lds, bid, nb);
    GRID_BAR();
    phase_ln_router(p, lds, bid, nb);
    GRID_BAR();
    phase_moe(p, lds, bid, nb);
    GRID_BAR();
    phase_final(p, bid, nb);
}

extern "C" void kernel_launch(void* const* d_in, const int* in_sizes, int n_in, void* d_out, int out_size, void* d_ws, size_t ws_size, hipStream_t stream) {
    static int grid_blocks = 0;
    if (!grid_blocks) {
        if (hipFuncSetAttribute((const void*)fwd_kernel, hipFuncAttributeMaxDynamicSharedMemorySize, LDS_BYTES) != hipSuccess) fprintf(stderr, "hipFuncSetAttribute failed\n");
        int dev = 0, cus = 0, per_cu = 0;
        (void)hipGetDevice(&dev);
        (void)hipDeviceGetAttribute(&cus, hipDeviceAttributeMultiprocessorCount, dev);
        (void)hipOccupancyMaxActiveBlocksPerMultiprocessor(&per_cu, (const void*)fwd_kernel, NT, LDS_BYTES);
        if (per_cu < 1) { fprintf(stderr, "occupancy query says %d blocks/CU\n", per_cu); per_cu = 1; }
        grid_blocks = cus >= 256 ? 256 : cus;
        fprintf(stderr, "grid %d (cus %d, per_cu %d)\n", grid_blocks, cus, per_cu);
    }
    Params p{};
    for (int i = 0; i < 27; ++i) p.in[i] = (const float*)d_in[i];
    p.out = (float*)d_out; p.ws = (unsigned char*)d_ws;
    (void)hipMemsetAsync((char*)d_ws + WS_CTL, 0, 65536, stream);
    void* args[] = {&p};
    hipError_t e = hipLaunchCooperativeKernel((const void*)fwd_kernel, dim3(grid_blocks), dim3(NT), args, LDS_BYTES, stream);
    if (e != hipSuccess) fprintf(stderr, "cooperative launch failed: %s (grid %d)\n", hipGetErrorString(e), grid_blocks);
}
```

```cpp
#include <hip/hip_runtime.h>
#include <hip/hip_cooperative_groups.h>
#include <cstdio>
#include <cstdint>
namespace cg = cooperative_groups;

typedef unsigned short bf16;
typedef short bf16x8 __attribute__((ext_vector_type(8)));
typedef float f32x4 __attribute__((ext_vector_type(4)));
typedef unsigned u32x4 __attribute__((ext_vector_type(4)));
typedef unsigned u32x2 __attribute__((ext_vector_type(2)));
typedef float f32x16 __attribute__((ext_vector_type(16)));
typedef float f32x2 __attribute__((ext_vector_type(2)));
typedef __bf16 bf16x2_t __attribute__((ext_vector_type(2)));

constexpr int DM = 1024, BATCH = 2, SEQ = 8192, NTOK = BATCH * SEQ;
constexpr int D_POOL = 256, D_RWKV = 768, NH = 12, HS = 64;
constexpr int D_IN = 2816;
constexpr int C_R = 256, C_K = 1024, C_V = 1792, C_WD = 2560, C_AD = 2624, C_GD = 2688;
constexpr int NEXP = 32, DE = 256;
constexpr float LN_EPS = 1e-5f, LNX_EPS = 64e-5f;
constexpr float ALPHA = 1.189207115002721f;
constexpr int NT = 512;
constexpr int BAR_LDS_OFF = 163776;
constexpr int CW_BAR = 4096;
constexpr int CST_LDS_OFF = 148480;
constexpr int PREV_LDS_OFF = 151040;
constexpr int LDS_BYTES = 163840;

constexpr size_t MiB = 1u << 20;
constexpr size_t WS_CTL = 0;
constexpr size_t WS_WIN_T = 1 * MiB;
constexpr size_t WS_WOUT_T = 7 * MiB;
constexpr size_t WS_WUPT = 9 * MiB;
constexpr size_t WS_AUPT = 9 * MiB + 128 * 1024;
constexpr size_t WS_GUPT = 9 * MiB + 256 * 1024;
constexpr size_t WS_RTT = 9 * MiB + 512 * 1024;
constexpr size_t WS_PWT = 9 * MiB + 768 * 1024;
constexpr size_t WS_XB = 10 * MiB;
constexpr size_t WS_TC = 10 * MiB;
constexpr size_t WS_MIXIN = 42 * MiB;
constexpr size_t WS_PROJ = 74 * MiB;
constexpr size_t WS_EGU = 74 * MiB;
constexpr size_t WS_EDN = 106 * MiB;
constexpr size_t WS_S0 = 122 * MiB;
constexpr size_t WS_GC = 162 * MiB;
constexpr size_t WS_QC = 186 * MiB;
constexpr size_t WS_OL = 210 * MiB;
constexpr size_t OUT_G1 = 0;
constexpr size_t OUT_G2 = 24 * MiB;
constexpr size_t WS_YS = 122 * MiB;
constexpr size_t WS_HB = 186 * MiB;
constexpr size_t WS_LIST = 218 * MiB;
constexpr size_t WS_LWT = 220 * MiB;
constexpr size_t WS_HID = 222 * MiB;

struct Params {
    const float* in[27];
    float* out;
    unsigned char* ws;
    int phase;
    int pad;
};

#define LAS __attribute__((address_space(3)))
__device__ __forceinline__ unsigned f2bf(float f) { unsigned u = __builtin_bit_cast(unsigned, f); return (u + 0x7fffu + ((u >> 16) & 1u)) >> 16; }
__device__ __forceinline__ unsigned pk2(float lo, float hi) { f32x2 v = {lo, hi}; bf16x2_t b = __builtin_convertvector(v, bf16x2_t); return __builtin_bit_cast(unsigned, b); }
__device__ __forceinline__ float bf2f(unsigned short b) { return __builtin_bit_cast(float, (unsigned)b << 16); }
__device__ __forceinline__ float bflo(unsigned u) { return __builtin_bit_cast(float, u << 16); }
__device__ __forceinline__ float bfhi(unsigned u) { return __builtin_bit_cast(float, u & 0xffff0000u); }
template <int CTRL> __device__ __forceinline__ float dppmov(float v) { return __builtin_bit_cast(float, __builtin_amdgcn_update_dpp(0, __builtin_bit_cast(int, v), CTRL, 0xf, 0xf, true)); }
__device__ __forceinline__ float wave_sum(float v) {
    v += dppmov<0xB1>(v);
    v += dppmov<0x4E>(v);
    v += dppmov<0x141>(v);
    v += dppmov<0x140>(v);
    const float s0 = __builtin_bit_cast(float, __builtin_amdgcn_readlane(__builtin_bit_cast(int, v), 0));
    const float s1 = __builtin_bit_cast(float, __builtin_amdgcn_readlane(__builtin_bit_cast(int, v), 16));
    const float s2 = __builtin_bit_cast(float, __builtin_amdgcn_readlane(__builtin_bit_cast(int, v), 32));
    const float s3 = __builtin_bit_cast(float, __builtin_amdgcn_readlane(__builtin_bit_cast(int, v), 48));
    return (s0 + s1) + (s2 + s3);
}
__device__ __forceinline__ int opaque_tid() { int t = threadIdx.x; asm volatile("" : "+v"(t)); return t; }
__device__ __forceinline__ float sigmoidf_(float x) { return 1.f / (1.f + __expf(-x)); }

template <class Epi>
__device__ __forceinline__ void gemm_unit(unsigned char* lds, const bf16* __restrict__ abase, const unsigned (&arow)[4], const bf16* __restrict__ bbase, const unsigned (&brow)[4], int K, Epi& epi) {
    const int tid = opaque_tid(), lane = tid & 63, w = tid >> 6, wr = w >> 2, wc = w & 3;
    const int srow = tid >> 3, sslot = tid & 7;
    const int st_off = srow * 128 + ((sslot ^ ((srow >> 1) & 7)) << 4);
    const int fr = lane & 15, fq = lane >> 4, x = fr >> 1;
    int offA[2], offB[2];
#pragma unroll
    for (int s = 0; s < 2; ++s) {
        const int slot = (s * 4 + fq) ^ x;
        offA[s] = (wr * 128 + fr) * 128 + (slot << 4);
        offB[s] = 32768 + (wc * 64 + fr) * 128 + (slot << 4);
    }
    f32x4 acc[8][4];
#pragma unroll
    for (int m = 0; m < 8; ++m)
#pragma unroll
        for (int n = 0; n < 4; ++n) acc[m][n] = (f32x4){0.f, 0.f, 0.f, 0.f};
    u32x4 ra[4], rb[4];
#pragma unroll
    for (int i = 0; i < 4; ++i) { ra[i] = *(const u32x4*)(abase + arow[i]); rb[i] = *(const u32x4*)(bbase + brow[i]); }
    __syncthreads();
#pragma unroll
    for (int i = 0; i < 4; ++i) { *(u32x4*)(lds + st_off + i * 8192) = ra[i]; *(u32x4*)(lds + 32768 + st_off + i * 8192) = rb[i]; }
    __syncthreads();
    const int KT = K >> 6;
    for (int kt = 0; kt < KT; ++kt) {
        unsigned char* cur = lds + (kt & 1) * 65536;
        unsigned char* nxt = lds + ((kt + 1) & 1) * 65536;
        if (kt + 1 < KT) {
#pragma unroll
            for (int i = 0; i < 4; ++i) { ra[i] = *(const u32x4*)(abase + arow[i] + (kt + 1) * 64); rb[i] = *(const u32x4*)(bbase + brow[i] + (kt + 1) * 64); }
        }
#pragma unroll
        for (int s = 0; s < 2; ++s) {
            bf16x8 bfr[4];
#pragma unroll
            for (int n = 0; n < 4; ++n) bfr[n] = *(const bf16x8*)(cur + offB[s] + n * 2048);
#pragma unroll
            for (int m = 0; m < 8; ++m) {
                const bf16x8 afr = *(const bf16x8*)(cur + offA[s] + m * 2048);
#pragma unroll
                for (int n = 0; n < 4; ++n) acc[m][n] = __builtin_amdgcn_mfma_f32_16x16x32_bf16(bfr[n], afr, acc[m][n], 0, 0, 0);
            }
        }
        if (kt + 1 < KT) {
#pragma unroll
            for (int i = 0; i < 4; ++i) { *(u32x4*)(nxt + st_off + i * 8192) = ra[i]; *(u32x4*)(nxt + 32768 + st_off + i * 8192) = rb[i]; }
        }
        __syncthreads();
    }
    epi(acc, wr, wc, fr, fq);
}

namespace pg8 {
#define PG8_LAS __attribute__((address_space(3)))
typedef unsigned short bf16_t;
typedef short bf16x8 __attribute__((ext_vector_type(8)));
typedef float f32x4 __attribute__((ext_vector_type(4)));
typedef unsigned u32x4 __attribute__((ext_vector_type(4)));
constexpr int BM = 256, BK = 64, HALF = 128, HTB = HALF * BK * 2  , STAGE_BYTES = 8 * HTB, NXCD = 8, WGM = 8;

__host__ __device__ __forceinline__ int lds_byte(int r, int c) { const int st = (r >> 4) * 2 + (c >> 5), rr = r & 15, cc = c & 31, ob = rr * 64 + cc * 2; return st * 1024 + (ob ^ (((ob >> 9) & 1) << 5)); }
__host__ __device__ __forceinline__ void stage_rc(int b, int& R, int& C) { const int st = b / 1024, sb = b % 1024, swz = sb ^ (((sb >> 9) & 1) << 5); R = (st >> 1) * 16 + swz / 64; C = (st & 1) * 32 + (swz % 64) / 2; }
__host__ __device__ __forceinline__ int perm32(int rho) { const int n = rho >> 4, i = rho & 15; return 8 * (i >> 2) + 4 * n + (i & 3); }

struct Unit { int pm, pn; };
struct Gemm { const bf16_t* A; const bf16_t* Bt; int M, N, K; };

struct StaticOrder {
    int nM, nN, nwg, G, c;
    __host__ __device__ void init(int M, int N, int G_, int c_) { nM = M / BM; nN = N / BM; nwg = nM * nN; G = G_; c = c_; }
    __host__ __device__ bool next(int i, Unit& u) const {
        const long L = (long)i * G + c; if (L >= nwg) return false;
        int wgid = (int)L; { const int q = nwg / NXCD, r = nwg % NXCD, xcd = wgid % NXCD, off = wgid / NXCD; wgid = (xcd < r ? xcd * (q + 1) : r * (q + 1) + (xcd - r) * q) + off; }
        const int nig = WGM * nN, gid = wgid / nig, fm = gid * WGM, gsz = (nM - fm) < WGM ? (nM - fm) : WGM;
        u.pm = fm + ((wgid % nig) % gsz); u.pn = (wgid % nig) / gsz; return true;
    }
    __device__ __forceinline__ void a_ready(const Unit&) const {}
    __device__ __forceinline__ void done(const Unit&) const {}
};

__device__ __forceinline__ unsigned cvt_pk_bf16(float lo, float hi) { unsigned r; asm volatile("v_cvt_pk_bf16_f32 %0, %1, %2" : "=v"(r) : "v"(lo), "v"(hi)); return r; }
struct EpiProjBf16 {
    static constexpr bool PERM = true, AFTER_DRAIN = false;
    bf16_t* O; int ldc;
    __device__ __forceinline__ void operator()(const f32x4 (&acc)[2][2][4][2], const Unit& u, int wr, int wc, int fr, int fq) const {
        const int row0 = u.pm * BM + wr * 64 + fr; const int col0 = u.pn * BM + wc * 32 + 8 * fq;
#pragma unroll
        for (int ai = 0; ai < 2; ++ai)
#pragma unroll
            for (int m = 0; m < 4; ++m) { bf16_t* rowp = O + (size_t)(row0 + ai * HALF + m * 16) * ldc + col0;
#pragma unroll
                for (int bj = 0; bj < 2; ++bj) { const f32x4 v0 = acc[ai][bj][m][0], v1 = acc[ai][bj][m][1];
                    u32x4 w; w.x = cvt_pk_bf16(v0[0], v0[1]); w.y = cvt_pk_bf16(v0[2], v0[3]); w.z = cvt_pk_bf16(v1[0], v1[1]); w.w = cvt_pk_bf16(v1[2], v1[3]);
                    *(u32x4*)(rowp + bj * HALF) = w; } }
    }
};
struct EpiResF32 {
    static constexpr bool PERM = false, AFTER_DRAIN = false;
    const float* X; float* C; int ldc; float alpha;
    __device__ __forceinline__ void operator()(const f32x4 (&acc)[2][2][4][2], const Unit& u, int wr, int wc, int fr, int fq) const {
        const int row0 = u.pm * BM + wr * 64 + fr, col0 = u.pn * BM + wc * 32 + 4 * fq;
#pragma unroll
        for (int ai = 0; ai < 2; ++ai)
#pragma unroll
            for (int m = 0; m < 4; ++m) { const size_t off = (size_t)(row0 + ai * HALF + m * 16) * ldc + col0;
#pragma unroll
                for (int bj = 0; bj < 2; ++bj)
#pragma unroll
                    for (int n = 0; n < 2; ++n) { const f32x4 xv = *(const f32x4*)(X + off + bj * HALF + n * 16); *(f32x4*)(C + off + bj * HALF + n * 16) = xv * alpha + acc[ai][bj][m][n]; } }
    }
};
template <class Epi, class Sched>
__device__ __forceinline__ void gemm_phase(PG8_LAS unsigned char* lds, const Gemm g, const Sched& S, const Epi& E) {
    const int tid = opaque_tid(), wid = __builtin_amdgcn_readfirstlane(tid >> 6), lane = tid & 63, wr = wid >> 2, wc = wid & 3, fr = lane & 15, fq = lane >> 4;
    const int K = g.K, nt = K / BK;
    unsigned voffA[2], voffB[2];
#pragma unroll
    for (int i = 0; i < 2; ++i) { int R, C; stage_rc(tid * 16 + i * 8192, R, C); const int Rb = Epi::PERM ? ((R & ~31) + perm32(R & 31)) : R;
        voffA[i] = (unsigned)(R * K + C) * 2u; voffB[i] = (unsigned)(Rb * K + C) * 2u; }
    const size_t kstep = (size_t)(BK * 2);
    const size_t hstep = (size_t)HALF * K * 2;
    const size_t tstep = 2 * hstep;
    const unsigned ldsw = (unsigned)wid * 1024u;
    const int aoff = lds_byte(wr * 64 + fr, fq * 8), boff = lds_byte(wc * 32 + fr, fq * 8);
#define PG8_SA(b, h) (((b) * 2 + (h)) * HTB)
#define PG8_SB(b, h) ((4 + (b) * 2 + (h)) * HTB)
#define PG8_STAGE(bufoff, gbase, voff) do { _Pragma("unroll") for (int _i = 0; _i < 2; ++_i) \
        __builtin_amdgcn_global_load_lds((const unsigned*)((const char*)(gbase) + (voff)[_i]), (PG8_LAS unsigned*)(lds + (bufoff) + ldsw + _i * 8192), 16, 0, 0); } while (0)
#define PG8_LDA(dst, b, h) do { _Pragma("unroll") for (int m = 0; m < 4; ++m) _Pragma("unroll") for (int k = 0; k < 2; ++k) dst[m][k] = *(const PG8_LAS bf16x8*)(lds + PG8_SA(b, h) + aoff + m * 2048 + k * 1024); } while (0)
#define PG8_LDB(dst, b, h) do { _Pragma("unroll") for (int n = 0; n < 2; ++n) _Pragma("unroll") for (int k = 0; k < 2; ++k) dst[n][k] = *(const PG8_LAS bf16x8*)(lds + PG8_SB(b, h) + boff + n * 2048 + k * 1024); } while (0)
#define PG8_MMA(ai, bj, At, Bt) do { __builtin_amdgcn_s_setprio(1); _Pragma("unroll") for (int m = 0; m < 4; ++m) _Pragma("unroll") for (int n = 0; n < 2; ++n) _Pragma("unroll") for (int k = 0; k < 2; ++k) \
        acc[ai][bj][m][n] = __builtin_amdgcn_mfma_f32_16x16x32_bf16(Bt[n][k], At[m][k], acc[ai][bj][m][n], 0, 0, 0); __builtin_amdgcn_s_setprio(0); } while (0)
#define PG8_WAIT_V(n) asm volatile("s_waitcnt vmcnt(" #n ")" ::: "memory")
#define PG8_WAIT_L(n) asm volatile("s_waitcnt lgkmcnt(" #n ")" ::: "memory")
#define PG8_BAR __builtin_amdgcn_s_barrier()
#define PG8_SCHED __builtin_amdgcn_sched_barrier(0)
    Unit cur, nxt; int ui = 0;
    if (!S.next(0, cur)) return;
    f32x4 acc[2][2][4][2];
#pragma unroll
    for (int a = 0; a < 2; ++a)
#pragma unroll
        for (int b = 0; b < 2; ++b)
#pragma unroll
            for (int m = 0; m < 4; ++m)
#pragma unroll
                for (int n = 0; n < 2; ++n) acc[a][b][m][n] = (f32x4){0.f, 0.f, 0.f, 0.f};
    bf16x8 At[4][2], B0[2][2], B1[2][2];
    const char* cA = (const char*)g.A + (size_t)cur.pm * tstep; const char* cB = (const char*)g.Bt + (size_t)cur.pn * tstep;
    S.a_ready(cur);
    PG8_STAGE(PG8_SB(0, 0), cB, voffB); PG8_STAGE(PG8_SA(0, 0), cA, voffA); PG8_STAGE(PG8_SB(0, 1), cB + hstep, voffB); PG8_STAGE(PG8_SA(0, 1), cA + hstep, voffA);
    if (wr == 1) PG8_BAR;
    PG8_WAIT_V(4); PG8_BAR;
    PG8_STAGE(PG8_SB(1, 0), cB + kstep, voffB); PG8_STAGE(PG8_SA(1, 0), cA + kstep, voffA); PG8_STAGE(PG8_SB(1, 1), cB + hstep + kstep, voffB);
    PG8_WAIT_V(6); PG8_BAR;
    for (;;) {
        const bool has_next = S.next(ui + 1, nxt);
        const char* nA = has_next ? (const char*)g.A + (size_t)nxt.pm * tstep : cA; const char* nB = has_next ? (const char*)g.Bt + (size_t)nxt.pn * tstep : cB;
        for (int t = 0; t < nt; t += 2) {
            const bool last = (t == nt - 2);
            const char* a1 = cA + (size_t)(t + 1) * kstep;
            const char* a2 = last ? nA : cA + (size_t)(t + 2) * kstep; const char* b2 = last ? nB : cB + (size_t)(t + 2) * kstep;
            const char* a3 = a2 + kstep; const char* b3 = b2 + kstep;
            if (last && has_next) S.a_ready(nxt);
            PG8_LDB(B0, 0, 0); PG8_SCHED; PG8_LDA(At, 0, 0); PG8_STAGE(PG8_SA(1, 1), a1 + hstep, voffA);
            PG8_WAIT_L(8); PG8_BAR; PG8_WAIT_L(0); PG8_MMA(0, 0, At, B0); PG8_BAR; PG8_SCHED;
            PG8_LDB(B1, 0, 1); PG8_STAGE(PG8_SB(0, 0), b2, voffB);
            PG8_BAR; PG8_WAIT_L(0); PG8_MMA(0, 1, At, B1); PG8_BAR;
            PG8_LDA(At, 0, 1); PG8_STAGE(PG8_SA(0, 0), a2, voffA);
            PG8_BAR; PG8_WAIT_L(0); PG8_MMA(1, 0, At, B0); PG8_BAR; PG8_SCHED;
            PG8_STAGE(PG8_SB(0, 1), b2 + hstep, voffB);
            PG8_WAIT_V(6); PG8_BAR; PG8_MMA(1, 1, At, B1); PG8_BAR;
            PG8_LDB(B0, 1, 0); PG8_SCHED; PG8_LDA(At, 1, 0); PG8_STAGE(PG8_SA(0, 1), a2 + hstep, voffA);
            PG8_WAIT_L(8); PG8_BAR; PG8_WAIT_L(0); PG8_MMA(0, 0, At, B0); PG8_BAR; PG8_SCHED;
            PG8_LDB(B1, 1, 1); PG8_STAGE(PG8_SB(1, 0), b3, voffB);
            PG8_BAR; PG8_WAIT_L(0); PG8_MMA(0, 1, At, B1); PG8_BAR;
            PG8_LDA(At, 1, 1); PG8_STAGE(PG8_SA(1, 0), a3, voffA);
            PG8_BAR; PG8_WAIT_L(0); PG8_MMA(1, 0, At, B0); PG8_BAR; PG8_SCHED;
            PG8_STAGE(PG8_SB(1, 1), b3 + hstep, voffB);
            PG8_WAIT_V(6); PG8_BAR; PG8_MMA(1, 1, At, B1); PG8_BAR;
        }
            if constexpr (!Epi::AFTER_DRAIN) { E(acc, cur, wr, wc, fr, fq); S.done(cur); }
            if (!has_next) break;
#pragma unroll
        for (int a = 0; a < 2; ++a)
#pragma unroll
            for (int b = 0; b < 2; ++b)
#pragma unroll
                for (int m = 0; m < 4; ++m)
#pragma unroll
                    for (int n = 0; n < 2; ++n) acc[a][b][m][n] = (f32x4){0.f, 0.f, 0.f, 0.f};
        cur = nxt; cA = nA; cB = nB; ++ui;
    }
    PG8_WAIT_V(0);
    if (wr == 0) PG8_BAR;
    PG8_BAR;
    if constexpr (Epi::AFTER_DRAIN) { E.fused(acc, cur, wr, wc, fr, fq, lds, wid, lane); S.done(cur); }
#undef PG8_SA
#undef PG8_SB
#undef PG8_STAGE
#undef PG8_LDA
#undef PG8_LDB
#undef PG8_MMA
#undef PG8_WAIT_V
#undef PG8_WAIT_L
#undef PG8_BAR
#undef PG8_SCHED
}
}

__device__ __forceinline__ int gu_row(int c, int half) { return ((c >> 7) << 8) + (((c >> 5) & 3) << 6) + (half << 5) + (c & 31); }
__device__ __forceinline__ void tr_tile(unsigned char* lds, const float* __restrict__ src, int ldsrc, int k0, int n0, bf16* __restrict__ dst, int ldd, int mode) {
    float* t = (float*)lds;
    const int tid = opaque_tid();
    __syncthreads();
#pragma unroll
    for (int i = 0; i < 8; ++i) { const int e = tid + i * NT, k = e >> 6, n = e & 63; t[k * 65 + n] = src[(size_t)(k0 + k) * ldsrc + n0 + n]; }
    __syncthreads();
    const int n = tid >> 3, kc = tid & 7;
    const float* s = t + (kc * 8) * 65 + n;
    u32x4 o; o.x = pk2(s[0], s[65]); o.y = pk2(s[2 * 65], s[3 * 65]); o.z = pk2(s[4 * 65], s[5 * 65]); o.w = pk2(s[6 * 65], s[7 * 65]);
    const int nn = n0 + n;
    const int drow = mode == 0 ? nn : gu_row(nn, mode - 1);
    *(u32x4*)(dst + (size_t)drow * ldd + k0 + kc * 8) = o;
}

__device__ __forceinline__ void phase_convert(const Params& p, unsigned char* lds, int bid, int nb) {
    const int tid = opaque_tid();
    {
        const float* x = p.in[0]; bf16* xb = (bf16*)(p.ws + WS_XB);
        const size_t n8 = (size_t)NTOK * DM / 8;
        for (size_t i = (size_t)bid * NT + tid; i < n8; i += (size_t)nb * NT) {
            const f32x4 a = *(const f32x4*)(x + i * 8), b = *(const f32x4*)(x + i * 8 + 4);
            u32x4 o; o.x = pk2(a.x, a.y); o.y = pk2(a.z, a.w); o.z = pk2(b.x, b.y); o.w = pk2(b.z, b.w);
            *(u32x4*)(xb + i * 8) = o;
        }
    }
    constexpr int T_WIN = (DM / 64) * (D_IN / 64);
    constexpr int T_WOUT = (DM / 64) * (DM / 64);
    constexpr int T_ALL = T_WIN + T_WOUT + 12 + 12 + 24 + 4;
    for (int it = bid; it < T_ALL; it += nb) {
        int r = it;
        if (r < T_WIN) { const int kb = r / (D_IN / 64), nbk = r % (D_IN / 64); tr_tile(lds, p.in[1], D_IN, kb * 64, nbk * 64, (bf16*)(p.ws + WS_WIN_T), DM, 0); continue; }
        r -= T_WIN;
        if (r < T_WOUT) { const int kb = r / (DM / 64), nbk = r % (DM / 64); tr_tile(lds, p.in[15], DM, kb * 64, nbk * 64, (bf16*)(p.ws + WS_WOUT_T), DM, 0); continue; }
        r -= T_WOUT;
        if (r < 12) { tr_tile(lds, p.in[6], D_RWKV, 0, r * 64, (bf16*)(p.ws + WS_WUPT), 64, 0); continue; }
        r -= 12;
        if (r < 12) { tr_tile(lds, p.in[8], D_RWKV, 0, r * 64, (bf16*)(p.ws + WS_AUPT), 64, 0); continue; }
        r -= 12;
        if (r < 24) { tr_tile(lds, p.in[9], D_RWKV, (r / 12) * 64, (r % 12) * 64, (bf16*)(p.ws + WS_GUPT), 128, 0); continue; }
        r -= 24;
        { tr_tile(lds, p.in[2] + r * 4096, 64, 0, 0, (bf16*)(p.ws + WS_PWT) + r * 4096, 64, 0); }
    }
    {
        float* rtt = (float*)(p.ws + WS_RTT); const float* rg = p.in[18]; const float* re = p.in[20];
        for (int e = bid * NT + tid; e < 36 * 1024; e += nb * NT) { const int j = e >> 10, k = e & 1023; rtt[e] = j < 4 ? rg[k * 4 + j] : re[k * 32 + (j - 4)]; }
    }
}
__device__ __forceinline__ void phase_convert_experts(const Params& p, unsigned char* lds, int bid, int nb) {
    constexpr int T_EG = NEXP * (DM / 64) * (DE / 64);
    constexpr int T_ED = NEXP * (DE / 64) * (DM / 64);
    constexpr int T_ALL = 2 * T_EG + T_ED;
    for (int it = bid; it < T_ALL; it += nb) {
        int r = it;
        if (r < 2 * T_EG) {
            const int half = r / T_EG; r -= half * T_EG;
            const int e = r / 64, q = r % 64, kb = q / 4, nbk = q % 4;
            tr_tile(lds, p.in[22 + half] + (size_t)e * DM * DE, DE, kb * 64, nbk * 64, (bf16*)(p.ws + WS_EGU) + (size_t)e * 512 * DM, DM, 1 + half); continue;
        }
        r -= 2 * T_EG;
        { const int e = r / 64, q = r % 64, kb = q / 16, nbk = q % 16;
          tr_tile(lds, p.in[24] + (size_t)e * DE * DM, DM, kb * 64, nbk * 64, (bf16*)(p.ws + WS_EDN) + (size_t)e * DM * DE, DE, 0); }
    }
}

struct EpiProj {
    bf16* O; int row0, col0;
    __device__ __forceinline__ void operator()(const f32x4 (&acc)[8][4], int wr, int wc, int fr, int fq) const {
#pragma unroll
        for (int m = 0; m < 8; ++m) {
            bf16* rp = O + (size_t)(row0 + wr * 128 + m * 16 + fr) * D_IN + col0 + wc * 64 + fq * 4;
#pragma unroll
            for (int n = 0; n < 4; ++n) { u32x2 v; v.x = pk2(acc[m][n][0], acc[m][n][1]); v.y = pk2(acc[m][n][2], acc[m][n][3]); *(u32x2*)(rp + n * 16) = v; }
        }
    }
};
__device__ __forceinline__ void phase_proj(const Params& p, unsigned char* lds, int bid, int nb) {
    pg8::Gemm g{(const pg8::bf16_t*)(p.ws + WS_XB), (const pg8::bf16_t*)(p.ws + WS_WIN_T), NTOK, D_IN, DM};
    pg8::StaticOrder S; S.init(NTOK, D_IN, nb, bid);
    pg8::EpiProjBf16 E{(pg8::bf16_t*)(p.ws + WS_PROJ), D_IN};
    pg8::gemm_phase<pg8::EpiProjBf16, pg8::StaticOrder>((PG8_LAS unsigned char*)lds, g, S, E);
}

__device__ __forceinline__ int sw_off(int row, int col) { return row * 128 + ((((col >> 3) ^ ((row >> 1) & 7)) << 4) | ((col & 7) << 1)); }
__device__ __forceinline__ void phase_pool(const Params& p, unsigned char* lds, int bid, int nb) {
    const int tid = opaque_tid(), lane = tid & 63, w = __builtin_amdgcn_readfirstlane(tid >> 6);
    const bf16* proj = (const bf16*)(p.ws + WS_PROJ);
    bf16* mix = (bf16*)(p.ws + WS_MIXIN);
    const bf16* pwT = (const bf16*)(p.ws + WS_PWT); const float* ps = p.in[3];
    float* pbuf = (float*)lds;
    unsigned char* dslot = lds + 81920;
    for (int it = bid; it < NTOK / 64; it += nb) {
        const int tok0 = it * 64, t0 = tok0 % SEQ;
        __syncthreads();
#pragma unroll 2
        for (int e = tid; e < 79 * 64; e += NT) {
            const int r = e >> 6, c4 = e & 63; const int tt = t0 - 15 + r;
            float4 v = {0.f, 0.f, 0.f, 0.f};
            if (tt >= 0) { const u32x2 q = *(const u32x2*)(proj + (size_t)(tok0 - 15 + r) * D_IN + c4 * 4); v.x = bflo(q.x); v.y = bfhi(q.x); v.z = bflo(q.y); v.w = bfhi(q.y); }
            *(float4*)(pbuf + r * 256 + c4 * 4) = v;
        }
        __syncthreads();
#pragma unroll 2
        for (int e = tid; e < 64 * 64; e += NT) {
            const int t = e >> 6, c = (e & 63) * 4, g = c >> 6, win = 2 << g;
            const int cnt = min(t0 + t + 1, win);
            f32x4 sm = {0.f, 0.f, 0.f, 0.f};
            for (int j = 0; j < cnt; ++j) sm += *(const f32x4*)(pbuf + (t + 15 - j) * 256 + c);
            const f32x4 d = sm * (1.f / (float)cnt) - *(const f32x4*)(pbuf + (t + 15) * 256 + c);
            u32x2 o; o.x = pk2(d.x, d.y); o.y = pk2(d.z, d.w);
            *(u32x2*)(dslot + g * 8192 + sw_off(t, c & 63)) = o;
        }
        __syncthreads();
        {
            const int g = w >> 1, nt = w & 1, ln = lane & 31, hh = lane >> 5, t = nt * 32 + ln;
            f32x16 acc[2];
#pragma unroll
            for (int mt = 0; mt < 2; ++mt) for (int r = 0; r < 16; ++r) acc[mt][r] = 0.f;
#pragma unroll
            for (int s_ = 0; s_ < 4; ++s_) {
                const bf16x8 bd = *(const bf16x8*)(dslot + g * 8192 + sw_off(t, 16 * s_ + 8 * hh));
#pragma unroll
                for (int mt = 0; mt < 2; ++mt) {
                    const bf16x8 aw = *(const bf16x8*)(pwT + g * 4096 + (mt * 32 + ln) * 64 + 16 * s_ + 8 * hh);
                    acc[mt] = __builtin_amdgcn_mfma_f32_32x32x16_bf16(aw, bd, acc[mt], 0, 0, 0);
                }
            }
#pragma unroll
            for (int mt = 0; mt < 2; ++mt)
#pragma unroll
                for (int gg = 0; gg < 4; ++gg) {
                    const int d0 = mt * 32 + 8 * gg + 4 * hh;
                    const f32x4 sc = *(const f32x4*)(ps + g * 64 + d0);
                    u32x2 o; o.x = pk2(acc[mt][4 * gg] * sc.x, acc[mt][4 * gg + 1] * sc.y); o.y = pk2(acc[mt][4 * gg + 2] * sc.z, acc[mt][4 * gg + 3] * sc.w);
                    *(u32x2*)(mix + (size_t)(tok0 + t) * DM + g * 64 + d0) = o;
                }
        }
    }
}

constexpr int SLOTB = 8192;
#define MFMA32(a, b, c) __builtin_amdgcn_mfma_f32_32x32x16_bf16((a), (b), (c), 0, 0, 0)
#define MFMA16(a, b, c) __builtin_amdgcn_mfma_f32_16x16x32_bf16((a), (b), (c), 0, 0, 0)
__device__ __forceinline__ f32x16 mm32(const unsigned char* X, const int (&ox)[4], const unsigned char* Y, const int (&oy)[4], f32x16 acc) {
#pragma unroll
    for (int s = 0; s < 4; ++s) {
        const bf16x8 a = *(const bf16x8*)(X + ox[s]);
        const bf16x8 b = *(const bf16x8*)(Y + oy[s]);
        acc = MFMA32(a, b, acc);
    }
    return acc;
}
template <class F>
__device__ __forceinline__ void store_T(unsigned char* Z, const f32x16& d, int mt, int nt, int lane, const int (&ost)[4], F f) {
    const int n = nt * 32 + (lane & 31), h = lane >> 5;
#pragma unroll
    for (int g = 0; g < 4; ++g) {
        const int m0 = mt * 32 + 8 * g + 4 * h;
        u32x2 v; v.x = pk2(f(d[4 * g], m0, n), f(d[4 * g + 1], m0 + 1, n)); v.y = pk2(f(d[4 * g + 2], m0 + 2, n), f(d[4 * g + 3], m0 + 3, n));
        *(u32x2*)(Z + ost[g]) = v;
    }
}
__device__ __forceinline__ f32x16 zero16() { f32x16 z; for (int i = 0; i < 16; ++i) z[i] = 0.f; return z; }
__device__ __forceinline__ void st_b16(unsigned char* Z, int row, int col, float v) { *(unsigned short*)(Z + sw_off(row, col)) = (unsigned short)pk2(v, 0.f); }

__device__ __forceinline__ void phase_prep(const Params& p, unsigned char* lds, int bid, int nb) {
    const int tid = opaque_tid();
    const bf16* proj = (const bf16*)(p.ws + WS_PROJ);
    const float* mu = p.in[4]; const float* w0 = p.in[5]; const float* a0 = p.in[7];
    const float* k_k = p.in[10]; const float* k_a = p.in[11]; const float* r_k = p.in[12];
    const float* lnx_g = p.in[13]; const float* lnx_b = p.in[14];
    const bf16* wupT = (const bf16*)(p.ws + WS_WUPT); const bf16* aupT = (const bf16*)(p.ws + WS_AUPT); const bf16* gupT = (const bf16*)(p.ws + WS_GUPT);
    bf16* TC = (bf16*)(p.ws + WS_TC); bf16* GC = (bf16*)(p.ws + WS_GC); bf16* QC = (bf16*)(p.ws + WS_QC); bf16* OL = (bf16*)(p.ws + WS_OL);
    bf16* G1 = (bf16*)((unsigned char*)p.out + OUT_G1); bf16* G2 = (bf16*)((unsigned char*)p.out + OUT_G2);
#define SL(i) (lds + (i) * SLOTB)
    float* PC = (float*)(lds + 18 * SLOTB);
    float* CST = (float*)(lds + CST_LDS_OFF);
    unsigned char* PREV = lds + PREV_LDS_OFF;
    float* NSB = (float*)(lds + PREV_LDS_OFF + 384);
    u32x4 pf[8];
    const int prow = tid >> 3, pchunk = tid & 7;
    const int pst = prow * 128 + ((pchunk ^ ((prow >> 1) & 7)) << 4);
    const unsigned pgo = (unsigned)(prow * (D_IN * 2) + pchunk * 16), pgg = (unsigned)(prow * 256 + pchunk * 16);
#define PREP_PREFETCH(hn, tok0_, has_prev) do { \
        const unsigned char* pb_ = (const unsigned char*)(proj + (size_t)(tok0_) * D_IN + C_R + (hn) * 64); \
        pf[0] = *(const u32x4*)(pb_ + pgo); pf[1] = *(const u32x4*)(pb_ + 2 * D_RWKV + pgo); pf[2] = *(const u32x4*)(pb_ + 4 * D_RWKV + pgo); \
        int tl_ = tid; asm volatile("" : "+v"(tl_)); \
        pf[3] = ((const u32x4*)(wupT + (hn) * 4096))[tl_]; \
        pf[4] = ((const u32x4*)(aupT + (hn) * 4096))[tl_]; \
        const unsigned char* gb_ = (const unsigned char*)(gupT + (hn) * 8192); \
        pf[5] = *(const u32x4*)(gb_ + pgg); pf[6] = *(const u32x4*)(gb_ + 128 + pgg); \
        pf[7] = (u32x4){0u, 0u, 0u, 0u}; \
        if (tid < 160) { const int arr_ = tl_ >> 4, c4_ = (tl_ & 15) * 4; \
            const float* src_ = arr_ < 3 ? mu + arr_ * D_RWKV : (arr_ == 3 ? w0 : (arr_ == 4 ? a0 : (arr_ == 5 ? k_k : (arr_ == 6 ? k_a : (arr_ == 7 ? r_k : (arr_ == 8 ? lnx_g : lnx_b)))))); \
            pf[7] = *(const u32x4*)(src_ + (hn) * 64 + c4_); } \
        else if (tid < 184 && (has_prev)) { const int x_ = (tl_ - 160) >> 3, ch_ = (tl_ - 160) & 7; \
            pf[7] = *(const u32x4*)(pb_ - 2 * D_IN + x_ * 2 * D_RWKV + ch_ * 16); } \
    } while (0)
#define PREP_STAGE() do { \
        *(u32x4*)(SL(6) + pst) = pf[0]; *(u32x4*)(SL(7) + pst) = pf[1]; *(u32x4*)(SL(8) + pst) = pf[2]; \
        *(u32x4*)(SL(9) + pst) = pf[3]; *(u32x4*)(SL(10) + pst) = pf[4]; *(u32x4*)(SL(11) + pst) = pf[5]; *(u32x4*)(SL(12) + pst) = pf[6]; \
        if (tid < 160) *(u32x4*)((unsigned char*)CST + tid * 16) = pf[7]; \
        else if (tid < 184) *(u32x4*)(PREV + (tid - 160) * 16) = pf[7]; \
    } while (0)
    for (int it = bid; it < BATCH * (SEQ / 64); it += nb) {
        const int b = it / (SEQ / 64), c = it % (SEQ / 64), tok0 = b * SEQ + c * 64;
        PREP_PREFETCH(0, tok0, c > 0);
        __syncthreads();
#pragma unroll
        for (int e = tid; e < 64 * 32; e += NT) {
            const int tt = e >> 5, k8 = (e & 31) * 8;
            const bf16* cur = proj + (size_t)(tok0 + tt) * D_IN + C_WD + k8;
            const u32x4 cv = *(const u32x4*)cur;
            u32x4 pv = {0u, 0u, 0u, 0u};
            if (c * 64 + tt > 0) pv = *(const u32x4*)(cur - D_IN);
            const f32x4 m0 = *(const f32x4*)(mu + C_WD - D_POOL + k8), m1 = *(const f32x4*)(mu + C_WD - D_POOL + k8 + 4);
            float z[8];
            z[0] = bflo(cv.x) + (bflo(pv.x) - bflo(cv.x)) * m0.x; z[1] = bfhi(cv.x) + (bfhi(pv.x) - bfhi(cv.x)) * m0.y;
            z[2] = bflo(cv.y) + (bflo(pv.y) - bflo(cv.y)) * m0.z; z[3] = bfhi(cv.y) + (bfhi(pv.y) - bfhi(cv.y)) * m0.w;
            z[4] = bflo(cv.z) + (bflo(pv.z) - bflo(cv.z)) * m1.x; z[5] = bfhi(cv.z) + (bfhi(pv.z) - bfhi(cv.z)) * m1.y;
            z[6] = bflo(cv.w) + (bflo(pv.w) - bflo(cv.w)) * m1.z; z[7] = bfhi(cv.w) + (bfhi(pv.w) - bfhi(cv.w)) * m1.w;
            if (k8 < 64) { for (int j = 0; j < 8; ++j) z[j] = 1.f - 2.f / (1.f + __expf(2.f * z[j])); }
            else if (k8 >= 128) { for (int j = 0; j < 8; ++j) z[j] = sigmoidf_(z[j]); }
            u32x4 o; o.x = pk2(z[0], z[1]); o.y = pk2(z[2], z[3]); o.z = pk2(z[4], z[5]); o.w = pk2(z[6], z[7]);
            *(u32x4*)(SL(k8 >> 6) + sw_off(tt, k8 & 63)) = o;
        }
#pragma unroll 1
        for (int h = 0; h < NH; ++h) {
            const size_t item = ((size_t)(b * (SEQ / 64) + c)) * NH + h;
            int tid_ = tid; asm volatile("" : "+v"(tid_));
            const int lane = tid_ & 63, w = __builtin_amdgcn_readfirstlane(tid_ >> 6);
            const int ts = w & 3, tl = lane & 15, q = lane >> 4, t = ts * 16 + tl;
            const int tmt = (w >> 1) & 1, tnt = w & 1, hh = lane >> 5;
            int offT[4], offL[2], offM[2];
        #pragma unroll
            for (int r = 0; r < 4; ++r) { offT[r] = sw_off(4 * q + r, t); }
        #pragma unroll
            for (int ks = 0; ks < 2; ++ks) { offL[ks] = sw_off(t, 32 * ks + 8 * q); offM[ks] = sw_off(tl, 32 * ks + 8 * q); }
            int oxm[4], oyn[4], ost[4];
        #pragma unroll
            for (int s_ = 0; s_ < 4; ++s_) { oxm[s_] = sw_off(tmt * 32 + (lane & 31), 16 * s_ + 8 * hh); oyn[s_] = sw_off(tnt * 32 + (lane & 31), 16 * s_ + 8 * hh); ost[s_] = sw_off(tnt * 32 + (lane & 31), tmt * 32 + 8 * s_ + 4 * hh); }
            __syncthreads();
            PREP_STAGE();
            if (h + 1 < NH) PREP_PREFETCH(h + 1, tok0, c > 0);
            __syncthreads();
            {
                const int cg = w >> 2;
                float lw[8], kap[8], bv[8], kn[8], rm[8], vm[8];
                float nsq = 0.f, bon = 0.f;
                {
                    f32x4 accw[2], acca[2];
#pragma unroll
                    for (int mi = 0; mi < 2; ++mi) { accw[mi] = (f32x4){0.f, 0.f, 0.f, 0.f}; acca[mi] = accw[mi]; }
#pragma unroll
                    for (int ks = 0; ks < 2; ++ks) {
                        const bf16x8 bw = *(const bf16x8*)(SL(0) + offL[ks]);
                        const bf16x8 ba = *(const bf16x8*)(SL(1) + offL[ks]);
#pragma unroll
                        for (int mi = 0; mi < 2; ++mi) {
                            const int m = 2 * cg + mi;
                            const bf16x8 aw = *(const bf16x8*)(SL(9) + offM[ks] + m * 2048);
                            const bf16x8 aa = *(const bf16x8*)(SL(10) + offM[ks] + m * 2048);
                            accw[mi] = MFMA16(aw, bw, accw[mi]); acca[mi] = MFMA16(aa, ba, acca[mi]);
                        }
                    }
                    const bool hp = (c * 64 + t) > 0;
#pragma unroll
                    for (int mi = 0; mi < 2; ++mi) {
                        const int m = 2 * cg + mi;
                        const int ch0 = m * 16 + 4 * q;
                        const int oR = sw_off(t, ch0), oRp = sw_off((t + 63) & 63, ch0);
                        float zz[3][4];
#pragma unroll
                        for (int x = 0; x < 3; ++x) {
                            const u32x2 cv = *(const u32x2*)(SL(6 + x) + oR);
                            u32x2 pv = *(const u32x2*)(t > 0 ? SL(6 + x) + oRp : PREV + x * 128 + ch0 * 2);
                            if (!hp) pv = (u32x2){0u, 0u};
                            const f32x4 mm = *(const f32x4*)(CST + x * 64 + ch0);
                            zz[x][0] = bflo(cv.x) + (bflo(pv.x) - bflo(cv.x)) * mm.x; zz[x][1] = bfhi(cv.x) + (bfhi(pv.x) - bfhi(cv.x)) * mm.y;
                            zz[x][2] = bflo(cv.y) + (bflo(pv.y) - bflo(cv.y)) * mm.z; zz[x][3] = bfhi(cv.y) + (bfhi(pv.y) - bfhi(cv.y)) * mm.w;
                        }
                        const f32x4 w0v = *(const f32x4*)(CST + 3 * 64 + ch0), a0v = *(const f32x4*)(CST + 4 * 64 + ch0), kkv = *(const f32x4*)(CST + 5 * 64 + ch0), kav = *(const f32x4*)(CST + 6 * 64 + ch0), rkv = *(const f32x4*)(CST + 7 * 64 + ch0);
#pragma unroll
                        for (int r = 0; r < 4; ++r) {
                            const int e = mi * 4 + r;
                            const float xx = w0v[r] + accw[mi][r];
                            const float sp = (-xx > 20.f) ? -xx : __logf(1.f + __expf(-xx));
                            lw[e] = -__expf(-sp - 0.5f);
                            const float av = sigmoidf_(a0v[r] + acca[mi][r]);
                            rm[e] = zz[0][r]; vm[e] = zz[2][r];
                            kap[e] = zz[1][r] * kkv[r]; nsq += kap[e] * kap[e];
                            kn[e] = zz[1][r] * (1.f + (av - 1.f) * kav[r]);
                            bon += rm[e] * kn[e] * rkv[r];
                            bv[e] = av;
                        }
                    }
                }
                nsq += __shfl_xor(nsq, 16); nsq += __shfl_xor(nsq, 32);
                bon += __shfl_xor(bon, 16); bon += __shfl_xor(bon, 32);
                if (q == 0) { NSB[cg * 64 + t] = nsq; NSB[128 + cg * 64 + t] = bon; }
                __syncthreads();
                nsq = NSB[t] + NSB[64 + t]; bon = NSB[128 + t] + NSB[192 + t];
                const float inv = 1.f / fmaxf(sqrtf(nsq), 1e-12f);
#pragma unroll
                for (int mi = 0; mi < 2; ++mi) {
                    const int m = 2 * cg + mi;
#pragma unroll
                    for (int r = 0; r < 4; ++r) {
                        const int e = mi * 4 + r;
                        kap[e] *= inv; bv[e] *= kap[e];
                        const unsigned hi = pk2(lw[e], 0.f) & 0xffffu; const float hif = __builtin_bit_cast(float, hi << 16);
                        *(unsigned short*)(SL(4) + offT[r] + m * 2048) = (unsigned short)hi;
                        *(unsigned short*)(SL(5) + offT[r] + m * 2048) = (unsigned short)pk2(lw[e] - hif, 0.f);
                        *(unsigned short*)(SL(13) + offT[r] + m * 2048) = (unsigned short)pk2(vm[e], 0.f);
                    }
                }
                {
                    f32x4 accg[2];
#pragma unroll
                    for (int mi = 0; mi < 2; ++mi) accg[mi] = (f32x4){0.f, 0.f, 0.f, 0.f};
#pragma unroll
                    for (int ks = 0; ks < 4; ++ks) {
                        const bf16x8 bg = *(const bf16x8*)(SL(2 + (ks >> 1)) + offL[ks & 1]);
#pragma unroll
                        for (int mi = 0; mi < 2; ++mi) {
                            const bf16x8 ag = *(const bf16x8*)(SL(11 + (ks >> 1)) + offM[ks & 1] + (2 * cg + mi) * 2048);
                            accg[mi] = MFMA16(ag, bg, accg[mi]);
                        }
                    }
#pragma unroll
                    for (int mi = 0; mi < 2; ++mi) {
                        const int ch0 = (2 * cg + mi) * 16 + 4 * q;
                        const f32x4 lg = *(const f32x4*)(CST + 8 * 64 + ch0), lb = *(const f32x4*)(CST + 9 * 64 + ch0);
                        u32x2 v1, v2;
                        v1.x = pk2(lg[0] * accg[mi][0], lg[1] * accg[mi][1]); v1.y = pk2(lg[2] * accg[mi][2], lg[3] * accg[mi][3]);
                        v2.x = pk2((lb[0] + bon * vm[mi * 4]) * accg[mi][0], (lb[1] + bon * vm[mi * 4 + 1]) * accg[mi][1]);
                        v2.y = pk2((lb[2] + bon * vm[mi * 4 + 2]) * accg[mi][2], (lb[3] + bon * vm[mi * 4 + 3]) * accg[mi][3]);
                        const int gidx = ((((t >> 5) * 2 + (ch0 >> 5)) * 4 + ((ch0 & 31) >> 3)) * 64 + (t & 31) + 32 * ((ch0 >> 2) & 1)) * 4;
                        *(u32x2*)(G1 + item * 4096 + gidx) = v1;
                        *(u32x2*)(G2 + item * 4096 + gidx) = v2;
                    }
                }
                __syncthreads();
                f32x4 La[2], Ta[2];
#pragma unroll
                for (int mi = 0; mi < 2; ++mi) { La[mi] = (f32x4){0.f, 0.f, 0.f, 0.f}; Ta[mi] = La[mi]; }
#pragma unroll
                for (int ks = 0; ks < 2; ++ks) {
                    bf16x8 btri, bone;
#pragma unroll
                    for (int e = 0; e < 8; ++e) { const int s_ = 32 * ks + 8 * q + e; btri[e] = (short)((s_ <= t) ? 0x3F80 : 0); bone[e] = (short)0x3F80; }
#pragma unroll
                    for (int mi = 0; mi < 2; ++mi) {
                        const int m = 2 * cg + mi;
                        const bf16x8 ah = *(const bf16x8*)(SL(4) + offM[ks] + m * 2048);
                        const bf16x8 al = *(const bf16x8*)(SL(5) + offM[ks] + m * 2048);
                        La[mi] = MFMA16(ah, btri, La[mi]); La[mi] = MFMA16(al, btri, La[mi]);
                        Ta[mi] = MFMA16(ah, bone, Ta[mi]); Ta[mi] = MFMA16(al, bone, Ta[mi]);
                    }
                }
                __syncthreads();
#pragma unroll
                for (int mi = 0; mi < 2; ++mi) {
                    const int m = 2 * cg + mi;
                    const int ch0 = m * 16 + 4 * q;
                    float kt[4], rt[4], bt[4], kkt[4];
#pragma unroll
                    for (int r = 0; r < 4; ++r) {
                        const int e = mi * 4 + r;
                        const float L = La[mi][r], Lt = Ta[mi][r];
                        const float eL = __expf(L), em = __expf(-L), eh = __expf(Lt - L), ex = __expf(L - lw[e]);
                        kt[r] = kap[e] * ex; rt[r] = rm[e] * eL; bt[r] = bv[e] * em; kkt[r] = kn[e] * em;
                        *(unsigned short*)(SL(9) + offT[r] + m * 2048) = (unsigned short)pk2(kt[r], 0.f);
                        *(unsigned short*)(SL(11) + offT[r] + m * 2048) = (unsigned short)pk2(bv[e] * eh, 0.f);
                        *(unsigned short*)(SL(12) + offT[r] + m * 2048) = (unsigned short)pk2(kn[e] * eh, 0.f);
                        if (t == 0) PC[ch0 + r] = __expf(Lt);
                    }
                    const int oR = sw_off(t, ch0);
                    u32x2 v;
                    v.x = pk2(kt[0], kt[1]); v.y = pk2(kt[2], kt[3]); *(u32x2*)(SL(6) + oR) = v;
                    v.x = pk2(bt[0], bt[1]); v.y = pk2(bt[2], bt[3]); *(u32x2*)(SL(7) + oR) = v;
                    v.x = pk2(kkt[0], kkt[1]); v.y = pk2(kkt[2], kkt[3]); *(u32x2*)(SL(8) + oR) = v;
                    v.x = pk2(rt[0], rt[1]); v.y = pk2(rt[2], rt[3]); *(u32x2*)(SL(10) + oR) = v;
                }
            }
            __syncthreads();
            f32x16 racc = zero16();
            {
                if (w < 4) {
                    f32x16 d = mm32(SL(7), oxm, SL(6), oyn, zero16());
                    const int tq_ = tnt * 32 + (lane & 31);
#pragma unroll
                    for (int r = 0; r < 16; ++r) { const int s_ = tmt * 32 + (r & 3) + 8 * (r >> 2) + 4 * hh; const float v = (s_ < tq_) ? d[r] : 0.f; d[r] = v; racc[r] = ((s_ == tq_) ? 1.f : 0.f) - v; }
                    store_T(SL(4), d, tmt, tnt, lane, ost, [](float v, int, int) { return v; });
                    store_T(SL(17), racc, tmt, tnt, lane, ost, [](float v, int, int) { return v; });
                } else {
                    f32x16 d = mm32(SL(6), oxm, SL(7), oyn, zero16());
                    store_T(SL(5), d, tmt, tnt, lane, ost, [](float v, int m, int n) { return (n < m) ? v : 0.f; });
                }
                if (w < 4) {
                    f32x16 d = mm32(SL(8), oxm, SL(6), oyn, zero16());
                    store_T(SL(14), d, tmt, tnt, lane, ost, [](float v, int m, int n) { return (m < n) ? v : 0.f; });
                } else {
                    f32x16 d = mm32(SL(7), oxm, SL(10), oyn, zero16());
                    store_T(SL(15), d, tmt, tnt, lane, ost, [](float v, int m, int n) { return (m <= n) ? v : 0.f; });
                }
                if (w < 4) {
                    f32x16 d = mm32(SL(8), oxm, SL(10), oyn, zero16());
                    store_T(SL(16), d, tmt, tnt, lane, ost, [](float v, int m, int n) { return (m <= n) ? v : 0.f; });
                }
            }
            __syncthreads();
            auto ident = [](float v, int, int) { return v; };
            if (w < 4) { f32x16 d = mm32(SL(5), oxm, SL(4), oyn, zero16()); store_T(SL(6), d, tmt, tnt, lane, ost, ident); }
            else       { f32x16 d = mm32(SL(4), oxm, SL(5), oyn, zero16()); store_T(SL(7), d, tmt, tnt, lane, ost, ident); }
            __syncthreads();
            if (w < 4) { f32x16 d = mm32(SL(7), oxm, SL(6), oyn, zero16()); store_T(SL(4), d, tmt, tnt, lane, ost, ident);
                         racc = mm32(SL(7), oxm, SL(17), oyn, racc); store_T(SL(8), racc, tmt, tnt, lane, ost, ident); }
            else       { f32x16 d = mm32(SL(6), oxm, SL(7), oyn, zero16()); store_T(SL(5), d, tmt, tnt, lane, ost, ident); }
            __syncthreads();
            if (w < 4) { f32x16 d = mm32(SL(5), oxm, SL(4), oyn, zero16()); store_T(SL(6), d, tmt, tnt, lane, ost, ident);
                         racc = mm32(SL(5), oxm, SL(8), oyn, racc); store_T(SL(17), racc, tmt, tnt, lane, ost, ident); }
            else       { f32x16 d = mm32(SL(4), oxm, SL(5), oyn, zero16()); store_T(SL(7), d, tmt, tnt, lane, ost, ident); }
            __syncthreads();
            if (w < 4) { f32x16 d = mm32(SL(7), oxm, SL(6), oyn, zero16()); store_T(SL(4), d, tmt, tnt, lane, ost, ident);
                         racc = mm32(SL(7), oxm, SL(17), oyn, racc); store_T(SL(8), racc, tmt, tnt, lane, ost, ident); }
            else       { f32x16 d = mm32(SL(6), oxm, SL(7), oyn, zero16()); store_T(SL(5), d, tmt, tnt, lane, ost, ident); }
            __syncthreads();
            if (w < 4) { racc = mm32(SL(5), oxm, SL(8), oyn, racc); store_T(SL(17), racc, tmt, tnt, lane, ost, ident); }
            else       { f32x16 d = mm32(SL(4), oxm, SL(5), oyn, zero16()); store_T(SL(7), d, tmt, tnt, lane, ost, ident); }
            __syncthreads();
            if (w < 4) { racc = mm32(SL(7), oxm, SL(17), oyn, racc); store_T(SL(8), racc, tmt, tnt, lane, ost, ident); }
            else       { f32x16 d = mm32(SL(14), oxm, SL(13), oyn, zero16()); store_T(SL(6), d, tmt, tnt, lane, ost, ident); }
            __syncthreads();
            if (w < 4) { f32x16 d = mm32(SL(8), oxm, SL(9), oyn, zero16()); store_T(SL(4), d, tmt, tnt, lane, ost, ident); }
            else       { f32x16 d = mm32(SL(8), oxm, SL(6), oyn, zero16()); store_T(SL(5), d, tmt, tnt, lane, ost, [](float v, int, int) { return -v; }); }
            __syncthreads();
            {
                const int ln = lane & 31;
                if (w < 4) {
                    const f32x16 d = mm32(SL(4), oxm, SL(11), oyn, zero16());
                    const int j = tnt * 32 + ln; const float pc = PC[j];
                    bf16* dst = TC + item * 4096;
#pragma unroll
                    for (int g = 0; g < 4; ++g) {
                        const int jp0 = tmt * 32 + 8 * g + 4 * hh;
                        float v[4];
#pragma unroll
                        for (int r = 0; r < 4; ++r) v[r] = ((jp0 + r == j) ? pc : 0.f) - d[4 * g + r];
                        const int a = jp0 >> 4, qp = (jp0 & 15) >> 2, s_ = a >> 1, m16 = j >> 4, L = (qp << 4) | (j & 15);
                        u32x2 o; o.x = pk2(v[0], v[1]); o.y = pk2(v[2], v[3]);
                        *(u32x2*)(dst + ((m16 * 2 + s_) * 64 + L) * 8 + (a & 1) * 4) = o;
                    }
                    const f32x16 d2 = mm32(SL(4), oxm, SL(15), oyn, zero16());
                    const int tq_ = tnt * 32 + ln;
                    bf16* dq = QC + item * 4096;
#pragma unroll
                    for (int g = 0; g < 4; ++g) {
                        const int j0 = tmt * 32 + 8 * g + 4 * hh;
                        const u32x2 rv = *(const u32x2*)(SL(10) + ost[g]);
                        u32x2 o; o.x = pk2(bflo(rv.x) - d2[4 * g], bfhi(rv.x) - d2[4 * g + 1]); o.y = pk2(bflo(rv.y) - d2[4 * g + 2], bfhi(rv.y) - d2[4 * g + 3]);
                        *(u32x2*)(dq + tq_ * 64 + j0) = o;
                    }
                } else {
                    f32x16 d = mm32(SL(11), oxm, SL(5), oyn, zero16());
                    d = mm32(SL(12), oxm, SL(13), oyn, d);
                    const int i = tnt * 32 + ln;
                    bf16* dg = GC + item * 4096;
#pragma unroll
                    for (int g = 0; g < 4; ++g) {
                        const int j0 = tmt * 32 + 8 * g + 4 * hh;
                        const int m16 = j0 >> 4, qq = (j0 & 15) >> 2, L = (qq << 4) | (i & 15), iq = i >> 4;
                        u32x2 o; o.x = pk2(d[4 * g], d[4 * g + 1]); o.y = pk2(d[4 * g + 2], d[4 * g + 3]);
                        *(u32x2*)(dg + (iq * 64 + L) * 16 + m16 * 4) = o;
                    }
                    f32x16 d2 = mm32(SL(5), oxm, SL(15), oyn, zero16());
                    d2 = mm32(SL(13), oxm, SL(16), oyn, d2);
                    bf16* dol = OL + item * 4096;
#pragma unroll
                    for (int g = 0; g < 4; ++g) {
                        u32x2 o; o.x = pk2(d2[4 * g], d2[4 * g + 1]); o.y = pk2(d2[4 * g + 2], d2[4 * g + 3]);
                        *(u32x2*)(dol + (((tnt * 2 + tmt) * 4 + g) * 64 + lane) * 4) = o;
                    }
                }
            }
        }
    }
#undef SL
}

constexpr int SC_NS = 14, SC_SLOT = 10240, SC_FLAGS = SC_NS * SC_SLOT;
__device__ __forceinline__ void phase_scan(const Params& p, unsigned char* lds, int chain) {
    const int tid = opaque_tid(), lane = tid & 63, wv = __builtin_amdgcn_readfirstlane(tid >> 6);
    const int b = chain / 48, h = (chain >> 2) % NH, iq = chain & 3;
    const unsigned char* TCb = p.ws + WS_TC; const unsigned char* GCb = p.ws + WS_GC + iq * 2048; bf16* S0 = (bf16*)(p.ws + WS_S0);
    const size_t item0 = (size_t)(b * (SEQ / 64)) * NH + h;
    volatile LAS unsigned* flg = (volatile LAS unsigned*)(LAS unsigned char*)(lds + SC_FLAGS);
    constexpr int NSTEP = SEQ / 64;
    if (tid < 16) flg[tid] = 0u;
    __syncthreads();
    if (wv > 0) {
        u32x4 ra[10], rb[10];
#define SC_LOAD(dst, st) do { const unsigned char* tb_ = TCb + (item0 + (size_t)(st) * NH) * 8192; const unsigned char* gb_ = GCb + (item0 + (size_t)(st) * NH) * 8192; \
        _Pragma("unroll") for (int x = 0; x < 8; ++x) dst[x] = *(const u32x4*)(tb_ + x * 1024 + lane * 16); \
        dst[8] = *(const u32x4*)(gb_ + lane * 32); dst[9] = *(const u32x4*)(gb_ + lane * 32 + 16); } while (0)
        int st = wv - 1;
        SC_LOAD(ra, st);
        for (; st < NSTEP; st += 7) {
            const bool more = st + 7 < NSTEP;
            if (more) SC_LOAD(rb, st + 7);
            if (st >= SC_NS) { while ((int)flg[SC_NS] < st - SC_NS + 1) __builtin_amdgcn_s_sleep(1); }
            asm volatile("" ::: "memory");
            unsigned char* sl = lds + (st % SC_NS) * SC_SLOT;
#pragma unroll
            for (int x = 0; x < 8; ++x) *(u32x4*)(sl + x * 1024 + lane * 16) = ra[x];
            *(u32x4*)(sl + 8192 + lane * 32) = ra[8]; *(u32x4*)(sl + 8192 + lane * 32 + 16) = ra[9];
            asm volatile("s_waitcnt lgkmcnt(0)" ::: "memory");
            if (lane == 0) flg[st % SC_NS] = (unsigned)(st + 1);
            if (more) {
#pragma unroll
                for (int x = 0; x < 10; ++x) ra[x] = rb[x];
            }
        }
#undef SC_LOAD
    } else {
        const int q = lane >> 4, il = lane & 15;
        f32x4 S[4];
#pragma unroll
        for (int m = 0; m < 4; ++m) S[m] = (f32x4){0.f, 0.f, 0.f, 0.f};
        u32x4 cur[10], nxt[10];
#define SC_READ(dst, st) do { while (flg[(st) % SC_NS] != (unsigned)((st) + 1)) __builtin_amdgcn_s_sleep(1); asm volatile("" ::: "memory"); \
        const unsigned char* sl_ = lds + ((st) % SC_NS) * SC_SLOT; \
        _Pragma("unroll") for (int x = 0; x < 8; ++x) dst[x] = *(const u32x4*)(sl_ + x * 1024 + lane * 16); \
        dst[8] = *(const u32x4*)(sl_ + 8192 + lane * 32); dst[9] = *(const u32x4*)(sl_ + 8192 + lane * 32 + 16); } while (0)
        SC_READ(cur, 0);
        for (int cc = 0; cc < NSTEP; ++cc) {
            if (cc + 1 < NSTEP) SC_READ(nxt, cc + 1);
            u32x4 sb0, sb1;
            sb0.x = pk2(S[0][0], S[0][1]); sb0.y = pk2(S[0][2], S[0][3]); sb0.z = pk2(S[1][0], S[1][1]); sb0.w = pk2(S[1][2], S[1][3]);
            sb1.x = pk2(S[2][0], S[2][1]); sb1.y = pk2(S[2][2], S[2][3]); sb1.z = pk2(S[3][0], S[3][1]); sb1.w = pk2(S[3][2], S[3][3]);
            bf16* so = S0 + (item0 + (size_t)cc * NH) * 4096 + (iq * 16 + il) * 64 + 4 * q;
            *(u32x2*)(so) = (u32x2){sb0.x, sb0.y}; *(u32x2*)(so + 16) = (u32x2){sb0.z, sb0.w};
            *(u32x2*)(so + 32) = (u32x2){sb1.x, sb1.y}; *(u32x2*)(so + 48) = (u32x2){sb1.z, sb1.w};
            f32x4 gi[4];
            gi[0] = (f32x4){bflo(cur[8].x), bfhi(cur[8].x), bflo(cur[8].y), bfhi(cur[8].y)};
            gi[1] = (f32x4){bflo(cur[8].z), bfhi(cur[8].z), bflo(cur[8].w), bfhi(cur[8].w)};
            gi[2] = (f32x4){bflo(cur[9].x), bfhi(cur[9].x), bflo(cur[9].y), bfhi(cur[9].y)};
            gi[3] = (f32x4){bflo(cur[9].z), bfhi(cur[9].z), bflo(cur[9].w), bfhi(cur[9].w)};
            const bf16x8 b0 = __builtin_bit_cast(bf16x8, sb0), b1 = __builtin_bit_cast(bf16x8, sb1);
#pragma unroll
            for (int m = 0; m < 4; ++m) {
                S[m] = MFMA16(__builtin_bit_cast(bf16x8, cur[2 * m]), b0, gi[m]);
                S[m] = MFMA16(__builtin_bit_cast(bf16x8, cur[2 * m + 1]), b1, S[m]);
            }
            asm volatile("s_waitcnt lgkmcnt(0)" ::: "memory");
            if (lane == 0) flg[SC_NS] = (unsigned)min(cc + 2, NSTEP);
#pragma unroll
            for (int x = 0; x < 10; ++x) cur[x] = nxt[x];
        }
#undef SC_READ
    }
}

__device__ __forceinline__ void phase_rwkv_out(const Params& p, unsigned char* lds, int bid, int nb) {
    const int tid = opaque_tid(), lane = tid & 63, w = tid >> 6, ln = lane & 31, hh = lane >> 5;
    const bf16* S0 = (const bf16*)(p.ws + WS_S0); const bf16* QC = (const bf16*)(p.ws + WS_QC); const bf16* OL = (const bf16*)(p.ws + WS_OL);
    const bf16* G1 = (const bf16*)((const unsigned char*)p.out + OUT_G1); const bf16* G2 = (const bf16*)((const unsigned char*)p.out + OUT_G2);
    bf16* mix = (bf16*)(p.ws + WS_MIXIN);
    const int ntask = BATCH * (SEQ / 64) * NH * 2;
    for (int task = bid * 8 + w; task < ntask; task += nb * 8) {
        const int item = task >> 1, nt = task & 1;
        const int h = item % NH, bc = item / NH;
        const int tok0 = bc * 64;
        f32x16 acc[2];
#pragma unroll
        for (int mt = 0; mt < 2; ++mt)
#pragma unroll
            for (int g = 0; g < 4; ++g) {
                const u32x2 v = *(const u32x2*)(OL + (size_t)item * 4096 + (((nt * 2 + mt) * 4 + g) * 64 + lane) * 4);
                acc[mt][4 * g] = bflo(v.x); acc[mt][4 * g + 1] = bfhi(v.x); acc[mt][4 * g + 2] = bflo(v.y); acc[mt][4 * g + 3] = bfhi(v.y);
            }
        const int t = nt * 32 + ln;
#pragma unroll
        for (int s = 0; s < 4; ++s) {
            const bf16x8 bq = *(const bf16x8*)(QC + (size_t)item * 4096 + t * 64 + 16 * s + 8 * hh);
#pragma unroll
            for (int mt = 0; mt < 2; ++mt) {
                const bf16x8 a = *(const bf16x8*)(S0 + (size_t)item * 4096 + (mt * 32 + ln) * 64 + 16 * s + 8 * hh);
                acc[mt] = MFMA32(a, bq, acc[mt]);
            }
        }
        float s1 = 0.f;
#pragma unroll
        for (int mt = 0; mt < 2; ++mt)
#pragma unroll
            for (int r = 0; r < 16; ++r) s1 += acc[mt][r];
        s1 += __shfl_xor(s1, 32);
        const float mean = s1 * (1.f / 64.f);
        float s2 = 0.f;
#pragma unroll
        for (int mt = 0; mt < 2; ++mt)
#pragma unroll
            for (int r = 0; r < 16; ++r) { acc[mt][r] -= mean; s2 += acc[mt][r] * acc[mt][r]; }
        s2 += __shfl_xor(s2, 32);
        const float rstd = rsqrtf(s2 * (1.f / 64.f) + LNX_EPS);
        unsigned char* ost = lds + w * 4096;
#pragma unroll
        for (int mt = 0; mt < 2; ++mt)
#pragma unroll
            for (int g = 0; g < 4; ++g) {
                const int i0 = mt * 32 + 8 * g + 4 * hh;
                const size_t gi = (size_t)item * 4096 + (((nt * 2 + mt) * 4 + g) * 64 + lane) * 4;
                const u32x2 a1 = *(const u32x2*)(G1 + gi), a2 = *(const u32x2*)(G2 + gi);
                u32x2 o;
                o.x = pk2(acc[mt][4 * g] * rstd * bflo(a1.x) + bflo(a2.x), acc[mt][4 * g + 1] * rstd * bfhi(a1.x) + bfhi(a2.x));
                o.y = pk2(acc[mt][4 * g + 2] * rstd * bflo(a1.y) + bflo(a2.y), acc[mt][4 * g + 3] * rstd * bfhi(a1.y) + bfhi(a2.y));
                *(u32x2*)(ost + ln * 128 + (((i0 >> 3) ^ (ln & 7)) << 4) + (i0 & 4) * 2) = o;
            }
        asm volatile("s_waitcnt lgkmcnt(0)" ::: "memory");
#pragma unroll
        for (int j = 0; j < 4; ++j) {
            const int r = (lane >> 3) + 8 * j, cch = lane & 7;
            const u32x4 v = *(const u32x4*)(ost + r * 128 + ((cch ^ (r & 7)) << 4));
            *(u32x4*)(mix + (size_t)(tok0 + nt * 32 + r) * DM + D_POOL + h * 64 + cch * 8) = v;
        }
        asm volatile("s_waitcnt lgkmcnt(0)" ::: "memory");
    }
}

struct EpiOut {
    const float* X; float* O; int row0, col0;
    __device__ __forceinline__ void operator()(const f32x4 (&acc)[8][4], int wr, int wc, int fr, int fq) const {
#pragma unroll
        for (int m = 0; m < 8; ++m) {
            const size_t off = (size_t)(row0 + wr * 128 + m * 16 + fr) * DM + col0 + wc * 64 + fq * 4;
#pragma unroll
            for (int n = 0; n < 4; ++n) { const f32x4 xv = *(const f32x4*)(X + off + n * 16); *(f32x4*)(O + off + n * 16) = xv * ALPHA + acc[m][n]; }
        }
    }
};
__device__ __forceinline__ void phase_outproj(const Params& p, unsigned char* lds, int bid, int nb) {
    pg8::Gemm g{(const pg8::bf16_t*)(p.ws + WS_MIXIN), (const pg8::bf16_t*)(p.ws + WS_WOUT_T), NTOK, DM, DM};
    pg8::StaticOrder S; S.init(NTOK, DM, nb, bid);
    pg8::EpiResF32 E{p.in[0], p.out, DM, ALPHA};
    pg8::gemm_phase<pg8::EpiResF32, pg8::StaticOrder>((PG8_LAS unsigned char*)lds, g, S, E);
}

__device__ __forceinline__ void phase_ln_router(const Params& p, unsigned char* lds, int bid, int nb) {
    const int tid = opaque_tid(), lane = tid & 63, w = __builtin_amdgcn_readfirstlane(tid >> 6);
    float* RT = (float*)lds;
    unsigned* LCNT = (unsigned*)(lds + 147456);
    int* LENT = (int*)(lds + 147456 + 128);
    (void)LENT;
    __syncthreads();
    {
        const f32x4* src = (const f32x4*)(p.ws + WS_RTT);
        f32x4 tmp[18];
#pragma unroll
        for (int i = 0; i < 18; ++i) tmp[i] = src[tid + i * NT];
#pragma unroll
        for (int i = 0; i < 18; ++i) ((f32x4*)RT)[tid + i * NT] = tmp[i];
    }
    const float* g1 = p.in[16]; const float* b1 = p.in[17]; const float* rgb = p.in[19]; const float* reb = p.in[21];
    float* H = p.out; bf16* hb = (bf16*)(p.ws + WS_HB);
    unsigned* cnt = (unsigned*)(p.ws + WS_CTL);
    int* list = (int*)(p.ws + WS_LIST); float* lwt = (float*)(p.ws + WS_LWT);
    const int rows_per_wg = NTOK / nb;
    const int rpw = rows_per_wg / 8;
    const int row0 = bid * rows_per_wg + w * rpw;
    if (tid < 32) LCNT[tid] = 0u;
    __syncthreads();
    int my_e0 = 0, my_e1 = 0, my_r0 = 0, my_r1 = 0; float my_w0 = 0.f, my_w1 = 0.f;
    f32x4 nx[4];
#pragma unroll
    for (int j = 0; j < 4; ++j) nx[j] = *(const f32x4*)(H + (size_t)row0 * DM + j * 256 + lane * 4);
    for (int ri = 0; ri < rpw; ++ri) {
        const int row = row0 + ri;
        float* hr = H + (size_t)row * DM;
        f32x4 v[4]; float s = 0.f;
#pragma unroll
        for (int j = 0; j < 4; ++j) { v[j] = nx[j]; s += (v[j].x + v[j].y) + (v[j].z + v[j].w); }
        if (ri + 1 < rpw) {
#pragma unroll
            for (int j = 0; j < 4; ++j) nx[j] = *(const f32x4*)(hr + DM + j * 256 + lane * 4);
        }
        const float mean = wave_sum(s) * (1.f / DM);
        float s2 = 0.f;
#pragma unroll
        for (int j = 0; j < 4; ++j) { v[j] = v[j] - mean; s2 += (v[j].x * v[j].x + v[j].y * v[j].y) + (v[j].z * v[j].z + v[j].w * v[j].w); }
        const float rstd = rsqrtf(wave_sum(s2) * (1.f / DM) + LN_EPS);
#pragma unroll
        for (int j = 0; j < 4; ++j) {
            const f32x4 g = *(const f32x4*)(g1 + j * 256 + lane * 4), bb = *(const f32x4*)(b1 + j * 256 + lane * 4);
            v[j] = v[j] * rstd * g + bb;
            u32x2 o; o.x = pk2(v[j].x, v[j].y); o.y = pk2(v[j].z, v[j].w);
            *(u32x2*)(hb + (size_t)row * DM + j * 256 + lane * 4) = o;
        }
        float gl[4];
#pragma unroll
        for (int q = 0; q < 4; ++q) {
            float a = 0.f;
#pragma unroll
            for (int j = 0; j < 4; ++j) { const f32x4 r = *(const f32x4*)(RT + q * 1024 + j * 256 + lane * 4); a += v[j].x * r.x + v[j].y * r.y + v[j].z * r.z + v[j].w * r.w; }
            gl[q] = a;
        }
#pragma unroll
        for (int q = 0; q < 4; ++q) gl[q] = wave_sum(gl[q]) + rgb[q];
        int gi = 0; float gm = gl[0];
#pragma unroll
        for (int q = 1; q < 4; ++q) if (gl[q] > gm) { gm = gl[q]; gi = q; }
        float den = 0.f;
#pragma unroll
        for (int q = 0; q < 4; ++q) den += __expf(gl[q] - gm);
        const float gp = 1.f / den;
        gi = __builtin_amdgcn_readfirstlane(gi);
        float el[8];
        const float* rtg = RT + (4 + gi * 8) * 1024 + lane * 4;
#pragma unroll
        for (int hq = 0; hq < 2; ++hq) {
            float part[4];
#pragma unroll
            for (int q = 0; q < 4; ++q) {
                float a = 0.f;
#pragma unroll
                for (int j = 0; j < 4; ++j) { const f32x4 r = *(const f32x4*)(rtg + (hq * 4 + q) * 1024 + j * 256); a += v[j].x * r.x + v[j].y * r.y + v[j].z * r.z + v[j].w * r.w; }
                part[q] = a;
            }
#pragma unroll
            for (int q = 0; q < 4; ++q) el[hq * 4 + q] = wave_sum(part[q]) + reb[gi * 8 + hq * 4 + q];
        }
        int i0 = 0; float m0 = el[0];
#pragma unroll
        for (int q = 1; q < 8; ++q) if (el[q] > m0) { m0 = el[q]; i0 = q; }
        int i1 = -1; float m1 = -3.0e38f;
#pragma unroll
        for (int q = 0; q < 8; ++q) if (q != i0 && el[q] > m1) { m1 = el[q]; i1 = q; }
        const float e1 = __expf(m1 - m0);
        const float w0 = gp / (1.f + e1), w1 = gp * e1 / (1.f + e1);
        if (lane == ri) {
            my_e0 = gi * 8 + i0; my_e1 = gi * 8 + i1; my_w0 = w0; my_w1 = w1;
            my_r0 = (int)atomicAdd(&LCNT[my_e0], 1u); my_r1 = (int)atomicAdd(&LCNT[my_e1], 1u);
        }
    }
    __syncthreads();
    if (tid < 32) { const unsigned c = LCNT[tid]; LCNT[tid] = c ? atomicAdd(&cnt[tid], c) : 0u; }
    __syncthreads();
    if (lane < rpw) {
        const int row = row0 + lane;
        const int p0 = (int)LCNT[my_e0] + my_r0, p1 = (int)LCNT[my_e1] + my_r1;
        list[my_e0 * NTOK + p0] = row * 2; lwt[my_e0 * NTOK + p0] = my_w0;
        list[my_e1 * NTOK + p1] = row * 2 + 1; lwt[my_e1 * NTOK + p1] = my_w1;
    }
}

__device__ __forceinline__ float siluf_(float x) { return x / (1.f + __expf(-x)); }
constexpr int MOE_MR = 144, MOE_MT = 9;
constexpr int MOE_BUFB = 41984, MOE_BOFF = 9216, MOE_HID = 83968, MOE_ROW = 157696;
__device__ __forceinline__ int key64(int row) { return (0x78 >> (2 * ((row >> 2) & 3))) & 3; }
#define GLDS16(gptr, ldsptr) __builtin_amdgcn_global_load_lds((const __attribute__((address_space(1))) unsigned*)(gptr), (__attribute__((address_space(3))) unsigned*)(ldsptr), 16, 0, 0)
__device__ __forceinline__ void phase_moe(const Params& p, unsigned char* lds, int bid, int nb) {
    const int tid0 = opaque_tid();
    const unsigned* cnt = (const unsigned*)(p.ws + WS_CTL);
    const bf16* hb = (const bf16*)(p.ws + WS_HB);
    bf16* YS = (bf16*)(p.ws + WS_YS);
    int* ROWTS = (int*)(lds + MOE_ROW); float* ROWWT = (float*)(lds + MOE_ROW + 576);
    for (int u0 = bid; u0 < NEXP * 8; u0 += nb) {
        const int u = (nb == 256) ? ((u0 & 7) * 32 + (u0 >> 3)) : u0;
        int tid = tid0; asm volatile("" : "+v"(tid));
        const int lane = tid & 63, wv = __builtin_amdgcn_readfirstlane(tid >> 6);
        const int fr = lane & 15, fq = lane >> 4;
        const int srow = tid >> 2, schunk = (tid & 3) ^ key64(srow);
        const int offA = fr * 64 + ((fq ^ key64(fr)) << 4);
        const int offB = MOE_BOFF + (wv * 64 + fr) * 64 + ((fq ^ key64(fr)) << 4);
        const int e = u >> 3, part = u & 7;
        const int ce = (int)cnt[e], hrows = (ce + 7) >> 3;
        const int rbeg = part * hrows, rend = min(ce, rbeg + hrows);
        const int* lst = (const int*)(p.ws + WS_LIST) + e * NTOK; const float* lw_ = (const float*)(p.ws + WS_LWT) + e * NTOK;
        const bf16* wgu = (const bf16*)(p.ws + WS_EGU) + (size_t)e * 512 * DM;
        const bf16* wdn = (const bf16*)(p.ws + WS_EDN) + (size_t)e * DM * DE;
        for (int r0 = rbeg; r0 < rend; r0 += MOE_MR) {
            const int nrows = min(MOE_MR, rend - r0), mt = (nrows + 15) >> 4;
            __syncthreads();
            if (tid < MOE_MR) { const bool ok = tid < nrows; ROWTS[tid] = ok ? lst[r0 + tid] : lst[r0]; ROWWT[tid] = ok ? lw_[r0 + tid] : 0.f; }
            __syncthreads();
            const bool a2 = wv == 0;
            const unsigned aoff0 = (unsigned)((ROWTS[srow] >> 1) * DM + schunk * 8);
            const unsigned aoff1 = (unsigned)((ROWTS[a2 ? 128 + srow : 0] >> 1) * DM + schunk * 8);
            f32x4 acc[MOE_MT][4];
#pragma unroll
            for (int m = 0; m < MOE_MT; ++m)
#pragma unroll
                for (int n = 0; n < 4; ++n) acc[m][n] = (f32x4){0.f, 0.f, 0.f, 0.f};
            {
                const unsigned boff = (unsigned)(srow * DM + schunk * 8);
#define MOE_STAGE1(buf_, k_) do { unsigned char* sb_ = lds + (buf_) * MOE_BUFB + wv * 1024; \
                    GLDS16(hb + aoff0 + (k_), sb_); if (a2) GLDS16(hb + aoff1 + (k_), sb_ + 8192); \
                    _Pragma("unroll") for (int i = 0; i < 4; ++i) GLDS16(wgu + boff + i * 128 * DM + (k_), sb_ + MOE_BOFF + i * 8192); } while (0)
                MOE_STAGE1(0, 0);
                MOE_STAGE1(1, 32);
#pragma unroll 1
                for (int kt = 0; kt < DM / 32; ++kt) {
                    if (kt + 1 < DM / 32) { if (a2) asm volatile("s_waitcnt vmcnt(6)" ::: "memory"); else asm volatile("s_waitcnt vmcnt(5)" ::: "memory"); }
                    else asm volatile("s_waitcnt vmcnt(0)" ::: "memory");
                    __builtin_amdgcn_s_barrier();
                    asm volatile("" ::: "memory");
                    const int b0 = kt % 3;
                    if (kt + 2 < DM / 32) MOE_STAGE1((kt + 2) % 3, (kt + 2) * 32);
                    const unsigned char* cur = lds + b0 * MOE_BUFB;
                    bf16x8 bfr[4], afr[MOE_MT];
#pragma unroll
                    for (int n = 0; n < 4; ++n) bfr[n] = *(const bf16x8*)(cur + offB + n * 1024);
#pragma unroll
                    for (int m = 0; m < MOE_MT; ++m) afr[m] = *(const bf16x8*)(cur + offA + m * 1024);
#pragma unroll
                    for (int m = 0; m < MOE_MT - 1; ++m)
#pragma unroll
                        for (int n = 0; n < 4; ++n) acc[m][n] = MFMA16(bfr[n], afr[m], acc[m][n]);
                    if (mt > MOE_MT - 1) {
#pragma unroll
                        for (int n = 0; n < 4; ++n) acc[MOE_MT - 1][n] = MFMA16(bfr[n], afr[MOE_MT - 1], acc[MOE_MT - 1][n]);
                    }
                }
                __syncthreads();
#undef MOE_STAGE1
            }
            const unsigned doff = (unsigned)(srow * DE + schunk * 8);
#define MOE_STAGE2(buf_, it_) do { unsigned char* sb_ = lds + (buf_) * MOE_BUFB + wv * 1024 + MOE_BOFF; const bf16* g_ = wdn + doff + (size_t)(((it_) >> 3) * 512) * DE + ((it_) & 7) * 32; \
                    _Pragma("unroll") for (int i = 0; i < 4; ++i) GLDS16(g_ + i * 128 * DE, sb_ + i * 8192); } while (0)
            MOE_STAGE2(0, 0);
#pragma unroll
            for (int m = 0; m < MOE_MT; ++m) {
                const int row = m * 16 + fr;
#pragma unroll
                for (int n = 0; n < 2; ++n) {
                    const f32x4 g = acc[m][n], uu = acc[m][n + 2];
                    const int hcol = wv * 32 + n * 16 + fq * 4;
                    u32x2 v; v.x = pk2(siluf_(g[0]) * uu[0], siluf_(g[1]) * uu[1]); v.y = pk2(siluf_(g[2]) * uu[2], siluf_(g[3]) * uu[3]);
                    *(u32x2*)(lds + MOE_HID + row * 512 + (((hcol >> 3) ^ (row & 15)) << 4) + (hcol & 7) * 2) = v;
                }
            }
            int hoff4[4];
#pragma unroll
            for (int sp = 0; sp < 4; ++sp) hoff4[sp] = MOE_HID + fr * 512 + (((sp * 4 + fq) ^ fr) << 4);
            __syncthreads();
#pragma unroll 1
            for (int np = 0; np < 2; ++np) {
#pragma unroll
                for (int m = 0; m < MOE_MT; ++m)
#pragma unroll
                    for (int n = 0; n < 4; ++n) acc[m][n] = (f32x4){0.f, 0.f, 0.f, 0.f};
#pragma unroll 1
                for (int kt = 0; kt < DE / 32; ++kt) {
                    const int it_ = np * 8 + kt;
                    const unsigned char* cur = lds + (it_ & 1) * MOE_BUFB;
                    if (it_ + 1 < 16) MOE_STAGE2((it_ + 1) & 1, it_ + 1);
                    bf16x8 bfr[4], afr[MOE_MT];
#pragma unroll
                    for (int n = 0; n < 4; ++n) bfr[n] = *(const bf16x8*)(cur + offB + n * 1024);
                    const int ho = hoff4[kt & 3] + (kt >> 2) * 256;
#pragma unroll
                    for (int m = 0; m < MOE_MT; ++m) afr[m] = *(const bf16x8*)(lds + ho + m * 8192);
#pragma unroll
                    for (int m = 0; m < MOE_MT - 1; ++m)
#pragma unroll
                        for (int n = 0; n < 4; ++n) acc[m][n] = MFMA16(bfr[n], afr[m], acc[m][n]);
                    if (mt > MOE_MT - 1) {
#pragma unroll
                        for (int n = 0; n < 4; ++n) acc[MOE_MT - 1][n] = MFMA16(bfr[n], afr[MOE_MT - 1], acc[MOE_MT - 1][n]);
                    }
                    __syncthreads();
                }
#pragma unroll
                for (int m = 0; m < MOE_MT; ++m) {
                    const int r = m * 16 + fr;
                    if (r < nrows) {
                        const int ts = ROWTS[r]; const float wt = ROWWT[r];
                        bf16* rp = YS + (size_t)ts * DM + np * 512 + wv * 64 + fq * 4;
#pragma unroll
                        for (int n = 0; n < 4; ++n) { u32x2 v; v.x = pk2(acc[m][n][0] * wt, acc[m][n][1] * wt); v.y = pk2(acc[m][n][2] * wt, acc[m][n][3] * wt); *(u32x2*)(rp + n * 16) = v; }
                    }
                }
            }
#undef MOE_STAGE2
        }
    }
}

__device__ __forceinline__ void phase_final(const Params& p, int bid, int nb) {
    const int tid = opaque_tid(), lane = tid & 63, w = tid >> 6;
    const float* g2 = p.in[25]; const float* b2 = p.in[26];
    const bf16* ys = (const bf16*)(p.ws + WS_YS); const bf16* hb = (const bf16*)(p.ws + WS_HB);
    for (int row = bid * 8 + w; row < NTOK; row += nb * 8) {
        float* hr = p.out + (size_t)row * DM;
        f32x4 v[4]; float s = 0.f;
#pragma unroll
        for (int j = 0; j < 4; ++j) {
            const u32x2 hq = *(const u32x2*)(hb + (size_t)row * DM + j * 256 + lane * 4);
            const f32x4 hv = {bflo(hq.x), bfhi(hq.x), bflo(hq.y), bfhi(hq.y)};
            const u32x2 y0 = *(const u32x2*)(ys + (size_t)row * 2 * DM + j * 256 + lane * 4), y1 = *(const u32x2*)(ys + (size_t)row * 2 * DM + DM + j * 256 + lane * 4);
            v[j].x = hv.x * ALPHA + (bflo(y0.x) + bflo(y1.x)); v[j].y = hv.y * ALPHA + (bfhi(y0.x) + bfhi(y1.x));
            v[j].z = hv.z * ALPHA + (bflo(y0.y) + bflo(y1.y)); v[j].w = hv.w * ALPHA + (bfhi(y0.y) + bfhi(y1.y));
            s += (v[j].x + v[j].y) + (v[j].z + v[j].w);
        }
        const float mean = wave_sum(s) * (1.f / DM);
        float s2 = 0.f;
#pragma unroll
        for (int j = 0; j < 4; ++j) { v[j] = v[j] - mean; s2 += (v[j].x * v[j].x + v[j].y * v[j].y) + (v[j].z * v[j].z + v[j].w * v[j].w); }
        const float rstd = rsqrtf(wave_sum(s2) * (1.f / DM) + LN_EPS);
#pragma unroll
        for (int j = 0; j < 4; ++j) {
            const f32x4 g = *(const f32x4*)(g2 + j * 256 + lane * 4), bb = *(const f32x4*)(b2 + j * 256 + lane * 4);
            *(f32x4*)(hr + j * 256 + lane * 4) = v[j] * rstd * g + bb;
        }
    }
}

#define XB_TMO      128
#define XB_XCNT(j)  (256  + 64 * (j))
#define XB_XSUB(j)  (1280 + 64 * (j))
#define XB_XGEN(j)  (2304 + 64 * (j))
#define XB_TOP      3328
#define XB_TOPGEN   3392
#define XCD_BAR_WORDS 3456
#define XB_SPIN_CAP (1u << 18)
__device__ __forceinline__ unsigned xb_ld(unsigned* p)              { return __hip_atomic_load(p, __ATOMIC_RELAXED, __HIP_MEMORY_SCOPE_AGENT); }
__device__ __forceinline__ unsigned xb_add(unsigned* p, unsigned v) { return __hip_atomic_fetch_add(p, v, __ATOMIC_RELAXED, __HIP_MEMORY_SCOPE_AGENT); }
__device__ __forceinline__ unsigned xb_xcc_id() { return (unsigned)__builtin_amdgcn_s_getreg((3 << 11) | 20) & 0xFu; }
#define XB_SPIN(cond, bar) do { unsigned _sp = 0; while (cond) { __builtin_amdgcn_s_sleep(1); \
    if ((++_sp & 255u) == 0u) { if (xb_ld(&(bar)[XB_TMO])) break; if (_sp > XB_SPIN_CAP) { atomicAdd(&(bar)[XB_TMO], 1u); break; } } } } while (0)
struct XcdBarrier { unsigned* bar; unsigned x; volatile LAS unsigned* st; };
__device__ __forceinline__ XcdBarrier xcd_barrier_post(unsigned* bar, volatile LAS unsigned* st) {
    XcdBarrier b; b.bar = bar; b.x = xb_xcc_id(); b.st = st;
    if (threadIdx.x == 0) (void)xb_add(&bar[XB_XCNT(b.x)], 1u);
    return b;
}
__device__ __forceinline__ void xcd_barrier_complete(unsigned* bar, unsigned x, unsigned& nloc, unsigned& nx) {
    const unsigned G = gridDim.x * gridDim.y * gridDim.z;
    unsigned sum, cnt, mine, sp = 0u;
    for (;;) {
        sum = 0u; cnt = 0u; mine = 0u;
#pragma unroll
        for (unsigned j = 0; j < 16; ++j) { const unsigned c = xb_ld(&bar[XB_XCNT(j)]); sum += c; cnt += (c > 0u) ? 1u : 0u; mine = (j == x) ? c : mine; }
        if (sum == G) break;
        __builtin_amdgcn_s_sleep(1);
        if ((++sp & 255u) == 0u) { if (xb_ld(&bar[XB_TMO])) break; if (sp > XB_SPIN_CAP) { atomicAdd(&bar[XB_TMO], 1u); break; } }
    }
    nloc = mine > 0u ? mine : 1u; nx = cnt > 0u ? cnt : 1u;
}
__device__ __forceinline__ void xcd_barrier(const XcdBarrier& b) {
    asm volatile("s_waitcnt vmcnt(0)" ::: "memory");
    __syncthreads();
    if (threadIdx.x == 0) {
        unsigned* bar = b.bar;
        __builtin_amdgcn_s_waitcnt(0);
        unsigned nloc = b.st[0], nx = b.st[1];
        if (nloc == 0u) { xcd_barrier_complete(bar, b.x, nloc, nx); b.st[0] = nloc; b.st[1] = nx; }
        const unsigned old = xb_add(&bar[XB_XSUB(b.x)], 1u);
        const unsigned gen = old / nloc;
        if (old + 1u == (gen + 1u) * nloc) {
            __builtin_amdgcn_fence(__ATOMIC_RELEASE, "agent");
            asm volatile("s_waitcnt vmcnt(0)" ::: "memory");
            const unsigned og = xb_add(&bar[XB_TOP], 1u);
            const unsigned tg = og / nx;
            if (og + 1u == (tg + 1u) * nx) xb_add(&bar[XB_TOPGEN], 1u);
            else XB_SPIN(xb_ld(&bar[XB_TOPGEN]) == tg, bar);
            __builtin_amdgcn_fence(__ATOMIC_ACQUIRE, "agent");
            xb_add(&bar[XB_XGEN(b.x)], 1u);
            asm volatile("s_waitcnt vmcnt(0)" ::: "memory");
        } else {
            XB_SPIN(xb_ld(&bar[XB_XGEN(b.x)]) == gen, bar);
            __builtin_amdgcn_fence(__ATOMIC_ACQUIRE, "agent");
            asm volatile("s_waitcnt vmcnt(0)" ::: "memory");
        }
    }
    __syncthreads();
}

__global__ void __launch_bounds__(NT) fwd_kernel(Params p) {
    extern __shared__ __attribute__((aligned(16))) unsigned char lds[];
    cg::grid_group grid = cg::this_grid();
    const int bid = blockIdx.x, nb = gridDim.x;
    volatile LAS unsigned* bst = (volatile LAS unsigned*)(LAS unsigned char*)(lds + BAR_LDS_OFF);
    if (threadIdx.x < 2) bst[threadIdx.x] = 0u;
    __syncthreads();
    XcdBarrier xb = xcd_barrier_post((unsigned*)(p.ws + WS_CTL) + CW_BAR, bst);
#define GRID_BAR() xcd_barrier(xb)
    if (p.pad != 0) grid.sync();
    phase_convert(p, lds, bid, nb);
    GRID_BAR();
    phase_proj(p, lds, bid, nb);
    GRID_BAR();
    phase_prep(p, lds, bid, nb);
    phase_pool(p, lds, bid, nb);
    GRID_BAR();
    if (bid < 96) phase_scan(p, lds, (bid & 7) * 12 + (bid >> 3));
    else phase_convert_experts(p, lds, bid - 96, nb - 96);
    GRID_BAR();
    phase_rwkv_out(p, lds, bid, nb);
    GRID_BAR();
    phase_outproj(p, lds, bid, nb);
    GRID_BAR();
    phase_ln_router(p, lds, bid, nb);
    GRID_BAR();
    phase_moe(p, lds, bid, nb);
    GRID_BAR();
    phase_final(p, bid, nb);
}

extern "C" void kernel_launch(void* const* d_in, const int* in_sizes, int n_in, void* d_out, int out_size, void* d_ws, size_t ws_size, hipStream_t stream) {
    static int grid_blocks = 0;
    if (!grid_blocks) {
        if (hipFuncSetAttribute((const void*)fwd_kernel, hipFuncAttributeMaxDynamicSharedMemorySize, LDS_BYTES) != hipSuccess) fprintf(stderr, "hipFuncSetAttribute failed\n");
        int dev = 0, cus = 0, per_cu = 0;
        (void)hipGetDevice(&dev);
        (void)hipDeviceGetAttribute(&cus, hipDeviceAttributeMultiprocessorCount, dev);
        (void)hipOccupancyMaxActiveBlocksPerMultiprocessor(&per_cu, (const void*)fwd_kernel, NT, LDS_BYTES);
        if (per_cu < 1) { fprintf(stderr, "occupancy query says %d blocks/CU\n", per_cu); per_cu = 1; }
        grid_blocks = cus >= 256 ? 256 : cus;
        fprintf(stderr, "grid %d (cus %d, per_cu %d)\n", grid_blocks, cus, per_cu);
    }
    Params p{};
    for (int i = 0; i < 27; ++i) p.in[i] = (const float*)d_in[i];
    p.out = (float*)d_out; p.ws = (unsigned char*)d_ws;
    (void)hipMemsetAsync((char*)d_ws + WS_CTL, 0, 65536, stream);
    void* args[] = {&p};
    hipError_t e = hipLaunchCooperativeKernel((const void*)fwd_kernel, dim3(grid_blocks), dim3(NT), args, LDS_BYTES, stream);
    if (e != hipSuccess) fprintf(stderr, "cooperative launch failed: %s (grid %d)\n", hipGetErrorString(e), grid_blocks);
}
```
